# Optimizing an MI355X kernel written in HIP

```python
import math
import jax
import jax.numpy as jnp
from jax import lax
import numpy as np

D_MODEL = 1024
BATCH = 8
SEQ = 2048
DEPTH = 1
DEC_BATCH = 128
DEC_SEQ = 4
PAST_LEN = 16384
PAGE_SIZE = 128

POOL_WINDOWS = (2, 4, 8, 16)
POOL_GROUPS = 4
POOL_WIDTH = D_MODEL // 2
POOL_GROUP_DIM = POOL_WIDTH // POOL_GROUPS
POOL_BUF = max(POOL_WINDOWS) - 1
M_HEADS = 4
M_WIDTH = D_MODEL
M_HEAD_DIM = M_WIDTH // M_HEADS
M_CHUNK = 64
D_FF = 4 * D_MODEL
N_ADA = 6
EPS = 1e-6
IN_SIZES = (POOL_WIDTH, M_WIDTH, M_WIDTH, M_WIDTH, M_WIDTH, M_HEADS, M_HEADS, D_MODEL, D_MODEL)
IN_WIDTH = POOL_WIDTH + 4 * M_WIDTH + 2 * M_HEADS + 2 * D_MODEL

kernel_name = "hybrid_pool_mlstm_decoder_step"


def rmsnorm(x, g):
    xf = x.astype(jnp.float32)
    y = xf * lax.rsqrt(jnp.mean(xf * xf, axis=-1, keepdims=True) + EPS)
    return (y * g.astype(jnp.float32)).astype(x.dtype)


def split_cols(z):
    outs, start = [], 0
    for s in IN_SIZES:
        outs.append(z[..., start:start + s])
        start += s
    return outs


def pool_mixer(u, buf, offset, w_group, scale):
    B, S, _ = u.shape
    full = jnp.concatenate([buf.astype(jnp.float32), u.astype(jnp.float32)], axis=1)
    cs = jnp.concatenate([jnp.zeros((B, 1, POOL_WIDTH), jnp.float32), jnp.cumsum(full, axis=1)], axis=1)
    end = cs[:, POOL_BUF + 1:]
    pos = offset + jnp.arange(S)
    outs = []
    for gi, w in enumerate(POOL_WINDOWS):
        lo, hi = gi * POOL_GROUP_DIM, (gi + 1) * POOL_GROUP_DIM
        start = POOL_BUF + 1 - w
        win = end[:, :, lo:hi] - cs[:, start:start + S, lo:hi]
        cnt = jnp.minimum(pos + 1, w).astype(jnp.float32)
        outs.append(win / cnt[None, :, None])
    pooled = jnp.concatenate(outs, axis=-1) - full[:, POOL_BUF:]
    r = pooled.reshape(B, S, POOL_GROUPS, POOL_GROUP_DIM)
    y = jnp.einsum('bsgc,gcd->bsgd', r, w_group.astype(jnp.float32)).reshape(B, S, POOL_WIDTH)
    y = y * scale.astype(jnp.float32)
    return y, full[:, -POOL_BUF:]


def mlstm(q, k, v, i_log, logf, C0, n0, m0):
    B, S, H, Dh = q.shape
    L = math.gcd(S, M_CHUNK)
    NC = S // L

    def to_chunks(a):
        return a.reshape((B, NC, L, H) + a.shape[3:]).swapaxes(2, 3).swapaxes(0, 1)

    xs = (to_chunks(q), to_chunks(k), to_chunks(v), to_chunks(i_log), to_chunks(logf))
    mask = jnp.tril(jnp.ones((L, L), dtype=bool))

    def step(carry, inp):
        C, n, m = carry
        qc, kc, vc, ic, fc = inp
        b = jnp.cumsum(fc, axis=-1)
        g = b + m[..., None]
        dmat = jnp.where(mask, b[..., :, None] - b[..., None, :] + ic[..., None, :], -jnp.inf)
        mt = jnp.maximum(g, jnp.max(dmat, axis=-1))
        w_inter = jnp.exp(g - mt)
        s = jnp.einsum('bhtd,bhsd->bhts', qc, kc) * jnp.exp(dmat - mt[..., None])
        num = w_inter[..., None] * jnp.einsum('bhtd,bhde->bhte', qc, C) + jnp.einsum('bhts,bhse->bhte', s, vc)
        den = w_inter * jnp.einsum('bhtd,bhd->bht', qc, n) + jnp.sum(s, axis=-1)
        h = num / jnp.maximum(jnp.abs(den), jnp.exp(-mt))[..., None]
        bL = b[..., -1]
        a = bL[..., None] - b + ic
        m_new = jnp.maximum(bL + m, jnp.max(a, axis=-1))
        decay = jnp.exp(bL + m - m_new)
        ws = jnp.exp(a - m_new[..., None])
        C_new = decay[..., None, None] * C + jnp.einsum('bhs,bhsd,bhse->bhde', ws, kc, vc)
        n_new = decay[..., None] * n + jnp.einsum('bhs,bhsd->bhd', ws, kc)
        return (C_new, n_new, m_new), h

    carry0 = (C0.astype(jnp.float32), n0.astype(jnp.float32), m0.astype(jnp.float32))
    (Cn, nn_, mn), hs = lax.scan(step, carry0, xs)
    h = hs.swapaxes(0, 1).swapaxes(2, 3).reshape(B, S, H, Dh)
    return h, Cn, nn_, mn


def hybrid_layer(x, c, pool_buf, C0, n0, m0, offset, g_mix, g_ffn, w_ada, b_ada, w_in, b_i, b_f,
                 w_pool_group, pool_scale, w_pool_out, m_norm, w_m_out, w_out, w1, w2):
    B, S, _ = x.shape
    ada = jax.nn.silu(c) @ w_ada + b_ada
    sh1, sc1, gt1, sh2, sc2, gt2 = jnp.split(ada, N_ADA, axis=-1)
    h = rmsnorm(x, g_mix) * (1 + sc1[:, None]) + sh1[:, None]
    z = h @ w_in
    u, q, k, v, o, i_pre, f_pre, g_a, g_b = split_cols(z)
    y_pool, pool_new = pool_mixer(u, pool_buf, offset, w_pool_group, pool_scale)
    q = q.reshape(B, S, M_HEADS, M_HEAD_DIM).astype(jnp.float32)
    k = k.reshape(B, S, M_HEADS, M_HEAD_DIM).astype(jnp.float32) * (M_HEAD_DIM ** -0.5)
    v = v.reshape(B, S, M_HEADS, M_HEAD_DIM).astype(jnp.float32)
    i_log = (i_pre + b_i).astype(jnp.float32)
    logf = jax.nn.log_sigmoid((f_pre + b_f).astype(jnp.float32))
    hm, Cn, nn_, mn = mlstm(q, k, v, i_log, logf, C0, n0, m0)
    hm = rmsnorm(hm, m_norm).reshape(B, S, M_WIDTH) * jax.nn.sigmoid(o.astype(jnp.float32))
    merged = jax.nn.sigmoid(g_a) * (y_pool @ w_pool_out) + jax.nn.sigmoid(g_b) * (hm @ w_m_out)
    x = x + gt1[:, None] * (merged @ w_out)
    h2 = rmsnorm(x, g_ffn) * (1 + sc2[:, None]) + sh2[:, None]
    x = x + gt2[:, None] * (jnp.square(jax.nn.relu(h2 @ w1)) @ w2)
    return x, pool_new, Cn, nn_, mn


def setup_inputs(seed: int = 0) -> dict:
    key = jax.random.key(seed)
    ks = jax.random.split(key, 32)
    f32 = jnp.float32
    nrm = lambda k_, shape, s: jax.random.normal(k_, shape, f32) * s
    d = {}
    d['x_prompt'] = nrm(ks[0], (BATCH, SEQ, D_MODEL), 1.0)
    d['x_sample'] = nrm(ks[1], (DEC_BATCH, DEC_SEQ, D_MODEL), 1.0)
    d['state_pool'] = nrm(ks[2], (DEPTH, DEC_BATCH, POOL_BUF, POOL_WIDTH), 1.0)
    d['state_C'] = nrm(ks[3], (DEPTH, DEC_BATCH, M_HEADS, M_HEAD_DIM, M_HEAD_DIM), 0.3)
    d['state_n'] = nrm(ks[4], (DEPTH, DEC_BATCH, M_HEADS, M_HEAD_DIM), 0.3)
    d['state_m'] = nrm(ks[5], (DEPTH, DEC_BATCH, M_HEADS), 1.0)
    d['c_prompt'] = nrm(ks[6], (BATCH, D_MODEL), 1.0)
    d['c_sample'] = nrm(ks[7], (DEC_BATCH, D_MODEL), 1.0)
    d['g_mix'] = 1.0 + nrm(ks[8], (DEPTH, D_MODEL), 0.05)
    d['g_ffn'] = 1.0 + nrm(ks[9], (DEPTH, D_MODEL), 0.05)
    d['w_ada'] = nrm(ks[10], (DEPTH, D_MODEL, N_ADA * D_MODEL), D_MODEL ** -0.5)
    d['b_ada'] = nrm(ks[11], (DEPTH, N_ADA * D_MODEL), 0.02)
    d['w_in'] = nrm(ks[12], (DEPTH, D_MODEL, IN_WIDTH), D_MODEL ** -0.5)
    d['b_i'] = nrm(ks[13], (DEPTH, M_HEADS), 0.1)
    d['b_f'] = 3.0 + nrm(ks[14], (DEPTH, M_HEADS), 0.5)
    d['w_pool_group'] = nrm(ks[15], (DEPTH, POOL_GROUPS, POOL_GROUP_DIM, POOL_GROUP_DIM), POOL_GROUP_DIM ** -0.5)
    d['pool_scale'] = 1.0 + nrm(ks[16], (DEPTH, POOL_WIDTH), 0.1)
    d['w_pool_out'] = nrm(ks[17], (DEPTH, POOL_WIDTH, D_MODEL), POOL_WIDTH ** -0.5)
    d['m_norm'] = 1.0 + nrm(ks[18], (DEPTH, M_HEADS, M_HEAD_DIM), 0.05)
    d['w_m_out'] = nrm(ks[19], (DEPTH, M_WIDTH, D_MODEL), M_WIDTH ** -0.5)
    d['w_out'] = nrm(ks[20], (DEPTH, D_MODEL, D_MODEL), D_MODEL ** -0.5)
    d['w1'] = nrm(ks[21], (DEPTH, D_MODEL, D_FF), D_MODEL ** -0.5)
    d['w2'] = nrm(ks[22], (DEPTH, D_FF, D_MODEL), D_FF ** -0.5)
    d['g_final'] = 1.0 + nrm(ks[23], (D_MODEL,), 0.05)
    return d


def reference(x_prompt, x_sample, state_pool, state_C, state_n, state_m, c_prompt, c_sample,
              g_mix, g_ffn, w_ada, b_ada, w_in, b_i, b_f, w_pool_group, pool_scale, w_pool_out,
              m_norm, w_m_out, w_out, w1, w2, g_final):
    xp, xs = x_prompt, x_sample
    pp_l, cp_l, np_l, mp_l = [], [], [], []
    ps_l, cs_l, ns_l, ms_l = [], [], [], []
    for l in range(DEPTH):
        wl = (g_mix[l], g_ffn[l], w_ada[l], b_ada[l], w_in[l], b_i[l], b_f[l], w_pool_group[l],
              pool_scale[l], w_pool_out[l], m_norm[l], w_m_out[l], w_out[l], w1[l], w2[l])
        Bp = xp.shape[0]
        buf0 = jnp.zeros((Bp, POOL_BUF, POOL_WIDTH), jnp.float32)
        C0 = jnp.zeros((Bp, M_HEADS, M_HEAD_DIM, M_HEAD_DIM), jnp.float32)
        n0 = jnp.zeros((Bp, M_HEADS, M_HEAD_DIM), jnp.float32)
        m0 = jnp.zeros((Bp, M_HEADS), jnp.float32)
        xp, pp, cp, npr, mp = hybrid_layer(xp, c_prompt, buf0, C0, n0, m0, 0, *wl)
        xs, ps, csm, ns, ms = hybrid_layer(xs, c_sample, state_pool[l], state_C[l], state_n[l], state_m[l], PAST_LEN, *wl)
        pp_l.append(pp); cp_l.append(cp); np_l.append(npr); mp_l.append(mp)
        ps_l.append(ps); cs_l.append(csm); ns_l.append(ns); ms_l.append(ms)
    y_prompt = rmsnorm(xp, g_final)
    y_sample = rmsnorm(xs, g_final)
    return (y_prompt, y_sample, jnp.stack(pp_l), jnp.stack(cp_l), jnp.stack(np_l), jnp.stack(mp_l),
            jnp.stack(ps_l), jnp.stack(cs_l), jnp.stack(ns_l), jnp.stack(ms_l))
```

```cpp
#include <hip/hip_runtime.h>
#include <hip/hip_cooperative_groups.h>
#include <cstdio>
#include <cstdint>
namespace cg = cooperative_groups;

typedef unsigned short bf16_t;
typedef short bf16x8 __attribute__((ext_vector_type(8)));
typedef float f32x4 __attribute__((ext_vector_type(4)));
typedef unsigned u32x4 __attribute__((ext_vector_type(4)));
typedef unsigned u32x2 __attribute__((ext_vector_type(2)));

constexpr int NTH = 512;
constexpr int DM = 1024, NPR = 16384, NSA = 512, MROWS = 16896, NBATCH = 136, SEQ = 2048;
constexpr int NIN = 6656, DFF = 4096, ADAW = 6144, INW = 6664;
constexpr int LDS_BYTES = 131072;
constexpr float EPS = 1e-6f;

constexpr size_t O_Y = 0;
constexpr size_t O_POOLP = 17301504;
constexpr size_t O_CP = 17362944;
constexpr size_t O_NP = 19460096;
constexpr size_t O_MP = 19468288;
constexpr size_t O_POOLS = 19468320;
constexpr size_t O_CS = 20451360;
constexpr size_t O_NS = 54005792;
constexpr size_t O_MS = 54136864;

constexpr size_t AL(size_t x) { return (x + 255) & ~(size_t)255; }
constexpr size_t WS_WIN = 0;
constexpr size_t WS_WPG = WS_WIN + AL((size_t)NIN * DM * 2);
constexpr size_t WS_WPO = WS_WPG + AL((size_t)4 * 128 * 128 * 2);
constexpr size_t WS_WMO = WS_WPO + AL((size_t)1024 * 512 * 2);
constexpr size_t WS_WOUT = WS_WMO + AL((size_t)1024 * 1024 * 2);
constexpr size_t WS_W1 = WS_WOUT + AL((size_t)1024 * 1024 * 2);
constexpr size_t WS_W2 = WS_W1 + AL((size_t)4096 * 1024 * 2);
constexpr size_t WS_ADAP = WS_W2 + AL((size_t)4096 * 1024 * 2);
constexpr size_t WS_ADA = WS_ADAP + AL((size_t)8 * NBATCH * ADAW * 4);
constexpr size_t WS_H = WS_ADA + AL((size_t)NBATCH * ADAW * 4);
constexpr size_t WS_GI = WS_H + AL((size_t)MROWS * DM * 2);
constexpr size_t WS_GF = WS_GI + AL((size_t)MROWS * 4 * 4);
constexpr size_t WS_U = WS_GF + AL((size_t)MROWS * 4 * 4);
constexpr size_t WS_QKV = WS_U + AL((size_t)MROWS * 512 * 4);
constexpr size_t WS_CST = WS_QKV + AL((size_t)6 * MROWS * DM * 2);
constexpr size_t WS_NST = WS_CST + AL((size_t)MROWS * DFF * 2);
constexpr size_t WS_MST = WS_NST + AL((size_t)32 * 32 * 256 * 4);
constexpr size_t WS_YP = WS_MST + AL((size_t)32 * 64 * 4);
constexpr size_t WS_HM = WS_YP + AL((size_t)MROWS * 512 * 2);
constexpr size_t WS_GW = WS_HM + AL((size_t)MROWS * DM * 2);
constexpr size_t WS_CTR = WS_GW + AL((size_t)1024 * 8 * 4);
constexpr size_t WS_XCNT = WS_CTR + 4096;
constexpr size_t WS_RSB = WS_XCNT + 80 * 256;
constexpr size_t WS_RSS = WS_RSB + AL((size_t)NPR * 4 * 4);
constexpr size_t WS_END = WS_RSS + AL((size_t)NSA * 16 * 4);
static_assert((size_t)32 * 31 * 65536 * 2 <= (size_t)MROWS * DFF * 2, "Cst fits in act region");
static_assert(WS_END <= (size_t)536870912, "workspace map exceeds 512 MiB");

struct Params {
    const float *x_p, *x_s, *st_pool, *st_C, *st_n, *st_m, *c_p, *c_s, *g_mix, *g_ffn, *w_ada, *b_ada, *w_in, *b_i, *b_f, *w_pg, *pool_scale, *w_po, *m_norm, *w_mo, *w_out, *w1, *w2, *g_final;
    float* out; unsigned char* ws; int ph_lo, ph_hi;
};

typedef float f32x2 __attribute__((ext_vector_type(2)));
typedef __bf16 bf16x2_t __attribute__((ext_vector_type(2)));
__device__ __forceinline__ unsigned pk_bf16(float lo, float hi) { f32x2 v = {lo, hi}; bf16x2_t b = __builtin_convertvector(v, bf16x2_t); return __builtin_bit_cast(unsigned, b); }
__device__ __forceinline__ float bf2f(unsigned v) { return __uint_as_float(v << 16); }
__device__ __forceinline__ float bflo(unsigned v) { return __uint_as_float(v << 16); }
__device__ __forceinline__ float bfhi(unsigned v) { return __uint_as_float(v & 0xffff0000u); }
__device__ __forceinline__ bf16_t f2bf(float f) { return (bf16_t)(pk_bf16(f, 0.f) & 0xffffu); }
__device__ __forceinline__ float sigmoidf_(float x) { return __builtin_amdgcn_rcpf(1.f + __expf(-x)); }
__device__ __forceinline__ int row_batch(int row) { return row < NPR ? (row >> 11) : 8 + ((row - NPR) >> 2); }
__device__ __forceinline__ float wave_sum(float v) {
#pragma unroll
    for (int d = 32; d >= 1; d >>= 1) v += __shfl_xor(v, d);
    return v;
}
__device__ __forceinline__ float wave_max(float v) {
#pragma unroll
    for (int d = 32; d >= 1; d >>= 1) v = fmaxf(v, __shfl_xor(v, d));
    return v;
}
__device__ __forceinline__ float wave_scan_add(float v, int lane) {
#pragma unroll
    for (int d = 1; d < 64; d <<= 1) { float t = __shfl_up(v, d); if (lane >= d) v += t; }
    return v;
}
__device__ __forceinline__ float wave_scan_max(float v, int lane) {
#pragma unroll
    for (int d = 1; d < 64; d <<= 1) { float t = __shfl_up(v, d); if (lane >= d) v = fmaxf(v, t); }
    return v;
}
__device__ __forceinline__ int otid() { int t = threadIdx.x; asm volatile("" : "+v"(t)); return t; }
#define MFMA16(a, b, c) __builtin_amdgcn_mfma_f32_16x16x32_bf16((a), (b), (c), 0, 0, 0)

#define LAS __attribute__((address_space(3)))
constexpr int BM = 256, BK = 64, HALF = 128, HTB = HALF * BK * 2, NXCD = 8, WGM = 8;
__device__ __forceinline__ int lds_byte(int r, int c) {
    const int st = (r >> 4) * 2 + (c >> 5), rr = r & 15, cc = c & 31, ob = rr * 64 + cc * 2;
    return st * 1024 + (ob ^ (((ob >> 9) & 1) << 5));
}
__device__ __forceinline__ void stage_rc(int b, int& R, int& C) {
    const int st = b / 1024, sb = b % 1024, swz = sb ^ (((sb >> 9) & 1) << 5);
    R = (st >> 1) * 16 + swz / 64; C = (st & 1) * 32 + (swz % 64) / 2;
}
__device__ __forceinline__ int perm32(int rho) { const int n = rho >> 4, i = rho & 15; return 8 * (i >> 2) + 4 * n + (i & 3); }
struct Unit { int pm, pn; };
struct StaticOrder {
    int nM, nN, nwg, G, c;
    __device__ void init(int M, int N, int G_, int c_) { nM = M / BM; nN = N / BM; nwg = nM * nN; G = G_; c = c_; }
    __device__ bool next(int i, Unit& u) const {
        const long L = (long)i * G + c; if (L >= nwg) return false;
        int wgid = (int)L; { const int q = nwg / NXCD, r = nwg % NXCD, xcd = wgid % NXCD, off = wgid / NXCD; wgid = (xcd < r ? xcd * (q + 1) : r * (q + 1) + (xcd - r) * q) + off; }
        const int nig = WGM * nN, gid = wgid / nig, fm = gid * WGM, gsz = (nM - fm) < WGM ? (nM - fm) : WGM;
        u.pm = fm + ((wgid % nig) % gsz); u.pn = (wgid % nig) / gsz; return true;
    }
};

template <class Epi, bool FUSED = false>
__device__ __forceinline__ void gemm_phase(LAS unsigned char* lds, const bf16_t* gA, const bf16_t* gBt, const int N, const int K, const Epi& E, unsigned char* lds_gen = nullptr) {
    const int tid = otid(), wid = __builtin_amdgcn_readfirstlane(tid >> 6), lane = tid & 63, wr = wid >> 2, wc = wid & 3, fr = lane & 15, fq = lane >> 4;
    const int nt = K / BK;
    StaticOrder S; S.init(NPR, N, gridDim.x, blockIdx.x);
    unsigned voffA[2], voffB[2];
#pragma unroll
    for (int i = 0; i < 2; ++i) { int R, C; stage_rc(tid * 16 + i * 8192, R, C); const int Rb = (R & ~31) + perm32(R & 31); voffA[i] = (unsigned)(R * K + C) * 2u; voffB[i] = (unsigned)(Rb * K + C) * 2u; }
    const size_t kstep = (size_t)(BK * 2);
    const size_t hstep = (size_t)HALF * K * 2;
    const size_t tstep = 2 * hstep;
    const unsigned ldsw = (unsigned)wid * 1024u;
    const int aoff = lds_byte(wr * 64 + fr, fq * 8), boff = lds_byte(wc * 32 + fr, fq * 8);
#define PG8_SA(b, h) (((b) * 2 + (h)) * HTB)
#define PG8_SB(b, h) ((4 + (b) * 2 + (h)) * HTB)
#define PG8_STAGE(bufoff, gbase) PG8_STAGEV(bufoff, gbase, voffA)
#define PG8_STAGEB(bufoff, gbase) PG8_STAGEV(bufoff, gbase, voffB)
#define PG8_STAGEV(bufoff, gbase, voff) do { _Pragma("unroll") for (int _i = 0; _i < 2; ++_i) \
        __builtin_amdgcn_global_load_lds((const unsigned*)((const char*)(gbase) + (voff)[_i]), (LAS unsigned*)(lds + (bufoff) + ldsw + _i * 8192), 16, 0, 0); } while (0)
#define PG8_LDA(dst, b, h) do { _Pragma("unroll") for (int m = 0; m < 4; ++m) _Pragma("unroll") for (int k = 0; k < 2; ++k) dst[m][k] = *(const LAS bf16x8*)(lds + PG8_SA(b, h) + aoff + m * 2048 + k * 1024); } while (0)
#define PG8_LDB(dst, b, h) do { _Pragma("unroll") for (int n = 0; n < 2; ++n) _Pragma("unroll") for (int k = 0; k < 2; ++k) dst[n][k] = *(const LAS bf16x8*)(lds + PG8_SB(b, h) + boff + n * 2048 + k * 1024); } while (0)
#define PG8_MMA(ai, bj, At, Bt) do { __builtin_amdgcn_s_setprio(1); _Pragma("unroll") for (int m = 0; m < 4; ++m) _Pragma("unroll") for (int n = 0; n < 2; ++n) _Pragma("unroll") for (int k = 0; k < 2; ++k) \
        acc[ai][bj][m][n] = __builtin_amdgcn_mfma_f32_16x16x32_bf16(Bt[n][k], At[m][k], acc[ai][bj][m][n], 0, 0, 0); __builtin_amdgcn_s_setprio(0); } while (0)
#define PG8_WAIT_V(n) asm volatile("s_waitcnt vmcnt(" #n ")" ::: "memory")
#define PG8_WAIT_L(n) asm volatile("s_waitcnt lgkmcnt(" #n ")" ::: "memory")
#define PG8_BAR __builtin_amdgcn_s_barrier()
#define PG8_SCHED __builtin_amdgcn_sched_barrier(0)
    Unit cur, nxt; int ui = 0;
    if (!S.next(0, cur)) return;
    f32x4 acc[2][2][4][2];
#pragma unroll
    for (int a = 0; a < 2; ++a)
#pragma unroll
        for (int b = 0; b < 2; ++b)
#pragma unroll
            for (int m = 0; m < 4; ++m)
#pragma unroll
                for (int n = 0; n < 2; ++n) acc[a][b][m][n] = (f32x4){0.f, 0.f, 0.f, 0.f};
    bf16x8 At[4][2], B0[2][2], B1[2][2];
    const char* cA = (const char*)gA + (size_t)cur.pm * tstep; const char* cB = (const char*)gBt + (size_t)cur.pn * tstep;
    PG8_STAGEB(PG8_SB(0, 0), cB); PG8_STAGE(PG8_SA(0, 0), cA); PG8_STAGEB(PG8_SB(0, 1), cB + hstep); PG8_STAGE(PG8_SA(0, 1), cA + hstep);
    if (wr == 1) PG8_BAR;
    PG8_WAIT_V(4); PG8_BAR;
    PG8_STAGEB(PG8_SB(1, 0), cB + kstep); PG8_STAGE(PG8_SA(1, 0), cA + kstep); PG8_STAGEB(PG8_SB(1, 1), cB + hstep + kstep);
    PG8_WAIT_V(6); PG8_BAR;
    for (;;) {
        const bool has_next = S.next(ui + 1, nxt);
        const char* nA = has_next ? (const char*)gA + (size_t)nxt.pm * tstep : cA; const char* nB = has_next ? (const char*)gBt + (size_t)nxt.pn * tstep : cB;
        for (int t = 0; t < nt; t += 2) {
            const bool last = (t == nt - 2);
            const char* a1 = cA + (size_t)(t + 1) * kstep;
            const char* a2 = last ? nA : cA + (size_t)(t + 2) * kstep; const char* b2 = last ? nB : cB + (size_t)(t + 2) * kstep;
            const char* a3 = a2 + kstep; const char* b3 = b2 + kstep;
            PG8_LDB(B0, 0, 0); PG8_SCHED; PG8_LDA(At, 0, 0); PG8_STAGE(PG8_SA(1, 1), a1 + hstep);
            PG8_WAIT_L(8); PG8_BAR; PG8_WAIT_L(0); PG8_MMA(0, 0, At, B0); PG8_BAR; PG8_SCHED;
            PG8_LDB(B1, 0, 1); PG8_STAGEB(PG8_SB(0, 0), b2);
            PG8_BAR; PG8_WAIT_L(0); PG8_MMA(0, 1, At, B1); PG8_BAR;
            PG8_LDA(At, 0, 1); PG8_STAGE(PG8_SA(0, 0), a2);
            PG8_BAR; PG8_WAIT_L(0); PG8_MMA(1, 0, At, B0); PG8_BAR; PG8_SCHED;
            PG8_STAGEB(PG8_SB(0, 1), b2 + hstep);
            PG8_WAIT_V(6); PG8_BAR; PG8_MMA(1, 1, At, B1); PG8_BAR;
            PG8_LDB(B0, 1, 0); PG8_SCHED; PG8_LDA(At, 1, 0); PG8_STAGE(PG8_SA(0, 1), a2 + hstep);
            PG8_WAIT_L(8); PG8_BAR; PG8_WAIT_L(0); PG8_MMA(0, 0, At, B0); PG8_BAR; PG8_SCHED;
            PG8_LDB(B1, 1, 1); PG8_STAGEB(PG8_SB(1, 0), b3);
            PG8_BAR; PG8_WAIT_L(0); PG8_MMA(0, 1, At, B1); PG8_BAR;
            PG8_LDA(At, 1, 1); PG8_STAGE(PG8_SA(1, 0), a3);
            PG8_BAR; PG8_WAIT_L(0); PG8_MMA(1, 0, At, B0); PG8_BAR; PG8_SCHED;
            PG8_STAGEB(PG8_SB(1, 1), b3 + hstep);
            PG8_WAIT_V(6); PG8_BAR; PG8_MMA(1, 1, At, B1); PG8_BAR;
        }
        if constexpr (!FUSED) { const int r0 = cur.pm * BM + wr * 64 + fr, c0 = cur.pn * BM + wc * 32 + fq * 8;
#pragma unroll
          for (int ai = 0; ai < 2; ++ai)
#pragma unroll
            for (int m = 0; m < 4; ++m)
#pragma unroll
              for (int bj = 0; bj < 2; ++bj) E.apply8(r0 + ai * 128 + m * 16, c0 + bj * 128, acc[ai][bj][m][0], acc[ai][bj][m][1]); }
        if (!has_next) break;
#pragma unroll
        for (int a = 0; a < 2; ++a)
#pragma unroll
            for (int b = 0; b < 2; ++b)
#pragma unroll
                for (int m = 0; m < 4; ++m)
#pragma unroll
                    for (int n = 0; n < 2; ++n) acc[a][b][m][n] = (f32x4){0.f, 0.f, 0.f, 0.f};
        cur = nxt; cA = nA; cB = nB; ++ui;
    }
    PG8_WAIT_V(0);
    if (wr == 0) PG8_BAR;
    PG8_BAR;
    if constexpr (FUSED) E.fused(acc, cur, wr, wc, fr, fq, lds_gen);
#undef PG8_SA
#undef PG8_SB
#undef PG8_STAGE
#undef PG8_STAGEB
#undef PG8_STAGEV
#undef PG8_LDA
#undef PG8_LDB
#undef PG8_MMA
#undef PG8_WAIT_V
#undef PG8_WAIT_L
#undef PG8_BAR
#undef PG8_SCHED
}

struct EpiG1 {
    float* u; bf16_t* qkv;
    __device__ __forceinline__ void apply(int row, int col, f32x4 v) const {
        const int bcol = col & ~255;
        const int seg = bcol < 512 ? 0 : 1 + ((bcol - 512) >> 10);
        if (seg == 0) { *(f32x4*)(u + (size_t)row * 512 + col) = v; }
        else {
            const int cc = col - 512 - (seg - 1) * 1024;
            if (seg == 2) v *= 0.0625f;
            if (seg >= 4) { v[0] = sigmoidf_(v[0]); v[1] = sigmoidf_(v[1]); v[2] = sigmoidf_(v[2]); v[3] = sigmoidf_(v[3]); }
            u32x2 w; w.x = pk_bf16(v[0], v[1]); w.y = pk_bf16(v[2], v[3]);
            *(u32x2*)(qkv + (size_t)(seg - 1) * MROWS * DM + (size_t)row * DM + cc) = w;
        }
    }
    __device__ __forceinline__ void apply8(int row, int col, f32x4 v0, f32x4 v1) const {
        const int bcol = col & ~255;
        const int seg = bcol < 512 ? 0 : 1 + ((bcol - 512) >> 10);
        if (seg == 0) { *(f32x4*)(u + (size_t)row * 512 + col) = v0; *(f32x4*)(u + (size_t)row * 512 + col + 4) = v1; }
        else {
            const int cc = col - 512 - (seg - 1) * 1024;
            if (seg == 2) { v0 *= 0.0625f; v1 *= 0.0625f; }
            if (seg >= 4) {
#pragma unroll
                for (int j = 0; j < 4; ++j) { v0[j] = sigmoidf_(v0[j]); v1[j] = sigmoidf_(v1[j]); } }
            u32x4 w; w.x = pk_bf16(v0[0], v0[1]); w.y = pk_bf16(v0[2], v0[3]); w.z = pk_bf16(v1[0], v1[1]); w.w = pk_bf16(v1[2], v1[3]);
            *(u32x4*)(qkv + (size_t)(seg - 1) * MROWS * DM + (size_t)row * DM + cc) = w;
        }
    }
};
struct EpiMerge {
    bf16_t* merged; const bf16_t* sg; int mode;
    __device__ __forceinline__ void apply(int row, int col, f32x4 v) const {
        const size_t idx = (size_t)row * DM + col;
        const u32x2 g = *(const u32x2*)(sg + idx);
        v[0] *= bflo(g.x); v[1] *= bfhi(g.x); v[2] *= bflo(g.y); v[3] *= bfhi(g.y);
        if (mode) { const u32x2 o = *(const u32x2*)(merged + idx); v[0] += bflo(o.x); v[1] += bfhi(o.x); v[2] += bflo(o.y); v[3] += bfhi(o.y); }
        u32x2 w; w.x = pk_bf16(v[0], v[1]); w.y = pk_bf16(v[2], v[3]);
        *(u32x2*)(merged + idx) = w;
    }
    __device__ __forceinline__ void apply8(int row, int col, f32x4 v0, f32x4 v1) const {
        const size_t idx = (size_t)row * DM + col;
        const u32x4 g = *(const u32x4*)(sg + idx);
        v0[0] *= bflo(g.x); v0[1] *= bfhi(g.x); v0[2] *= bflo(g.y); v0[3] *= bfhi(g.y); v1[0] *= bflo(g.z); v1[1] *= bfhi(g.z); v1[2] *= bflo(g.w); v1[3] *= bfhi(g.w);
        if (mode) { const u32x4 o = *(const u32x4*)(merged + idx); v0[0] += bflo(o.x); v0[1] += bfhi(o.x); v0[2] += bflo(o.y); v0[3] += bfhi(o.y); v1[0] += bflo(o.z); v1[1] += bfhi(o.z); v1[2] += bflo(o.w); v1[3] += bfhi(o.w); }
        u32x4 w; w.x = pk_bf16(v0[0], v0[1]); w.y = pk_bf16(v0[2], v0[3]); w.z = pk_bf16(v1[0], v1[1]); w.w = pk_bf16(v1[2], v1[3]);
        *(u32x4*)(merged + idx) = w;
    }
};
struct EpiRes {
    float* out; const float* xp; const float* xs; const float* ada; int gate_off; int xin;
    __device__ __forceinline__ void apply(int row, int col, f32x4 v) const {
        const f32x4 g = *(const f32x4*)(ada + (size_t)row_batch(row) * ADAW + gate_off + col);
        const float* bp = xin ? (row < NPR ? xp + (size_t)row * DM : xs + (size_t)(row - NPR) * DM) : out + (size_t)row * DM;
        const f32x4 b = *(const f32x4*)(bp + col);
        *(f32x4*)(out + (size_t)row * DM + col) = b + g * v;
    }
    __device__ __forceinline__ void apply8(int row, int col, f32x4 v0, f32x4 v1) const { apply(row, col, v0); apply(row, col + 4, v1); }
};
struct EpiAct {
    bf16_t* act;
    __device__ __forceinline__ void apply(int row, int col, f32x4 v) const {
#pragma unroll
        for (int j = 0; j < 4; ++j) { float t = fmaxf(v[j], 0.f); v[j] = t * t; }
        u32x2 w; w.x = pk_bf16(v[0], v[1]); w.y = pk_bf16(v[2], v[3]);
        *(u32x2*)(act + (size_t)row * DFF + col) = w;
    }
    __device__ __forceinline__ void apply8(int row, int col, f32x4 v0, f32x4 v1) const {
#pragma unroll
        for (int j = 0; j < 4; ++j) { float t0 = fmaxf(v0[j], 0.f); v0[j] = t0 * t0; float t1 = fmaxf(v1[j], 0.f); v1[j] = t1 * t1; }
        u32x4 w; w.x = pk_bf16(v0[0], v0[1]); w.y = pk_bf16(v0[2], v0[3]); w.z = pk_bf16(v1[0], v1[1]); w.w = pk_bf16(v1[2], v1[3]);
        *(u32x4*)(act + (size_t)row * DFF + col) = w;
    }
};

__device__ __forceinline__ void xchg_publish_wait(unsigned* cnt, unsigned need) {
    asm volatile("s_waitcnt vmcnt(0)" ::: "memory");
    __syncthreads();
    if (threadIdx.x == 0) {
        __builtin_amdgcn_fence(__ATOMIC_RELEASE, "agent");
        asm volatile("s_waitcnt vmcnt(0)" ::: "memory");
        __hip_atomic_fetch_add(cnt, 1u, __ATOMIC_RELAXED, __HIP_MEMORY_SCOPE_AGENT);
        unsigned spins = 0;
        while (__hip_atomic_load(cnt, __ATOMIC_RELAXED, __HIP_MEMORY_SCOPE_AGENT) < need) { __builtin_amdgcn_s_sleep(1); if (++spins > (1u << 24)) break; }
        __builtin_amdgcn_fence(__ATOMIC_ACQUIRE, "agent");
        asm volatile("s_waitcnt vmcnt(0)" ::: "memory");
    }
    __syncthreads();
}
extern __shared__ __attribute__((aligned(16))) unsigned char g_dyn_lds[];
struct EpiFinal {
    float* out; const float* ada; const float* gfin; float* rowpart; unsigned* cnt; float* rowpartS; unsigned* cntS;
    __device__ __forceinline__ void apply(int, int, f32x4) const {}
    __device__ __forceinline__ void apply8(int, int, f32x4, f32x4) const {}
    __device__ __forceinline__ void fused(f32x4 (&acc)[2][2][4][2], const Unit& u, int wr, int wc, int fr, int fq, unsigned char* lds) const {
        const int tid = otid();
        (void)lds;
        float* P = (float*)g_dyn_lds;
        float* S = P + 1024;
        const int r0 = u.pm * BM + wr * 64 + fr, c0 = u.pn * BM + wc * 32 + fq * 8;
#pragma unroll
        for (int ai = 0; ai < 2; ++ai)
#pragma unroll
            for (int m = 0; m < 4; ++m) {
                const int row = r0 + ai * 128 + m * 16;
                const float* ga = ada + (size_t)row_batch(row) * ADAW + 5120;
                float ss = 0.f;
#pragma unroll
                for (int bj = 0; bj < 2; ++bj)
#pragma unroll
                    for (int n = 0; n < 2; ++n) {
                        const int col = c0 + bj * 128 + n * 4;
                        const f32x4 g = *(const f32x4*)(ga + col);
                        const f32x4 b = *(const f32x4*)(out + (size_t)row * DM + col);
                        const f32x4 v = b + g * acc[ai][bj][m][n];
                        acc[ai][bj][m][n] = v;
                        ss += v[0] * v[0] + v[1] * v[1] + v[2] * v[2] + v[3] * v[3];
                    }
                ss += __shfl_xor(ss, 16); ss += __shfl_xor(ss, 32);
                if (fq == 0) P[(ai * 128 + wr * 64 + m * 16 + fr) * 4 + wc] = ss;
                asm volatile("" ::: "memory");
            }
        __syncthreads();
        if (tid < 256) rowpart[((size_t)u.pm * BM + tid) * 4 + u.pn] = (P[tid * 4] + P[tid * 4 + 1]) + (P[tid * 4 + 2] + P[tid * 4 + 3]);
        xchg_publish_wait(cnt + u.pm * 64, 8u);
        if (tid < 256) { const f32x4 rp = *(const f32x4*)(rowpart + ((size_t)u.pm * BM + tid) * 4); S[tid] = rsqrtf(((rp[0] + rp[1]) + (rp[2] + rp[3])) * (1.0f / DM) + EPS); }
        __syncthreads();
#pragma unroll
        for (int ai = 0; ai < 2; ++ai)
#pragma unroll
            for (int m = 0; m < 4; ++m) {
                const int row = r0 + ai * 128 + m * 16;
                const float rs = S[ai * 128 + wr * 64 + m * 16 + fr];
#pragma unroll
                for (int bj = 0; bj < 2; ++bj)
#pragma unroll
                    for (int n = 0; n < 2; ++n) {
                        const int col = c0 + bj * 128 + n * 4;
                        const f32x4 gf = *(const f32x4*)(gfin + col);
                        __builtin_nontemporal_store(acc[ai][bj][m][n] * rs * gf, (f32x4*)(out + (size_t)row * DM + col));
                    }
            }
        __syncthreads();
    }
};

struct EpiMid {
    float* out; const float* xp; const float* xs; const float* ada; const float* gffn; bf16_t* hbuf; float* rowpart; unsigned* cnt; float* rowpartS; unsigned* cntS;
    __device__ __forceinline__ void apply(int, int, f32x4) const {}
    __device__ __forceinline__ void apply8(int, int, f32x4, f32x4) const {}
    __device__ __forceinline__ void fused(f32x4 (&acc)[2][2][4][2], const Unit& u, int wr, int wc, int fr, int fq, unsigned char*) const {
        const int tid = otid();
        float* P = (float*)g_dyn_lds;
        float* S = P + 1024;
        const int r0 = u.pm * BM + wr * 64 + fr, c0 = u.pn * BM + wc * 32 + fq * 8;
#pragma unroll
        for (int ai = 0; ai < 2; ++ai)
#pragma unroll
            for (int m = 0; m < 4; ++m) {
                const int row = r0 + ai * 128 + m * 16;
                const float* ga = ada + (size_t)(row >> 11) * ADAW + 2048;
                float ss = 0.f;
#pragma unroll
                for (int bj = 0; bj < 2; ++bj)
#pragma unroll
                    for (int n = 0; n < 2; ++n) {
                        const int col = c0 + bj * 128 + n * 4;
                        const f32x4 g = *(const f32x4*)(ga + col);
                        const f32x4 b = *(const f32x4*)(xp + (size_t)row * DM + col);
                        const f32x4 v = b + g * acc[ai][bj][m][n];
                        acc[ai][bj][m][n] = v;
                        *(f32x4*)(out + (size_t)row * DM + col) = v;
                        ss += v[0] * v[0] + v[1] * v[1] + v[2] * v[2] + v[3] * v[3];
                    }
                ss += __shfl_xor(ss, 16); ss += __shfl_xor(ss, 32);
                if (fq == 0) P[(ai * 128 + wr * 64 + m * 16 + fr) * 4 + wc] = ss;
                asm volatile("" ::: "memory");
            }
        __syncthreads();
        if (tid < 256) rowpart[((size_t)u.pm * BM + tid) * 4 + u.pn] = (P[tid * 4] + P[tid * 4 + 1]) + (P[tid * 4 + 2] + P[tid * 4 + 3]);
        xchg_publish_wait(cnt + u.pm * 64, 4u);
        if (tid < 256) { const f32x4 rp = *(const f32x4*)(rowpart + ((size_t)u.pm * BM + tid) * 4); S[tid] = rsqrtf(((rp[0] + rp[1]) + (rp[2] + rp[3])) * (1.0f / DM) + EPS); }
        __syncthreads();
        const float* ab = ada + (size_t)(r0 >> 11) * ADAW;
#pragma unroll
        for (int bj = 0; bj < 2; ++bj) {
            const int col = c0 + bj * 128;
            f32x4 G0 = *(const f32x4*)(gffn + col), G1 = *(const f32x4*)(gffn + col + 4);
            G0 *= (*(const f32x4*)(ab + 4096 + col) + 1.0f); G1 *= (*(const f32x4*)(ab + 4096 + col + 4) + 1.0f);
            const f32x4 S0 = *(const f32x4*)(ab + 3072 + col), S1 = *(const f32x4*)(ab + 3072 + col + 4);
#pragma unroll
            for (int ai = 0; ai < 2; ++ai)
#pragma unroll
                for (int m = 0; m < 4; ++m) {
                    const int row = r0 + ai * 128 + m * 16;
                    const float rs = S[ai * 128 + wr * 64 + m * 16 + fr];
                    const f32x4 h0 = acc[ai][bj][m][0] * rs * G0 + S0, h1 = acc[ai][bj][m][1] * rs * G1 + S1;
                    u32x4 w; w.x = pk_bf16(h0[0], h0[1]); w.y = pk_bf16(h0[2], h0[3]); w.z = pk_bf16(h1[0], h1[1]); w.w = pk_bf16(h1[2], h1[3]);
                    *(u32x4*)(hbuf + (size_t)row * DM + col) = w;
                }
        }
        __syncthreads();
    }
};

template <class Epi, int FIN = 0>
__device__ __forceinline__ void small_gemm_phase(unsigned char* lds, const bf16_t* gA, const bf16_t* gBt, const int N, const int K, const Epi& E, const int t_begin, const int t_end) {
    int tid_ = threadIdx.x; asm volatile("" : "+v"(tid_));
    const int tid = tid_, lane = tid & 63, w = tid >> 6, fr = lane & 15, fq = lane >> 4;
    const int kw = K / 8;
    float* red = (float*)lds;
    for (int t = t_begin; t < t_end; ++t) {
        const int rt = t & 15, ct = t >> 4;
        const int row0 = NPR + rt * 32, col0 = ct * 64;
        const bf16_t* ap = gA + (size_t)(row0 + fr) * K + w * kw + fq * 8;
        const bf16_t* bp = gBt + (size_t)(col0 + fr) * K + w * kw + fq * 8;
        f32x4 acc[2][4] = {};
#pragma unroll 2
        for (int k0 = 0; k0 < kw; k0 += 64) {
            bf16x8 af[2][2], bfm[2][4];
#pragma unroll
            for (int s2 = 0; s2 < 2; ++s2) {
#pragma unroll
                for (int m = 0; m < 2; ++m) af[s2][m] = *(const bf16x8*)(ap + (size_t)m * 16 * K + k0 + s2 * 32);
#pragma unroll
                for (int n = 0; n < 4; ++n) bfm[s2][n] = *(const bf16x8*)(bp + (size_t)n * 16 * K + k0 + s2 * 32);
            }
#pragma unroll
            for (int s2 = 0; s2 < 2; ++s2)
#pragma unroll
                for (int m = 0; m < 2; ++m)
#pragma unroll
                    for (int n = 0; n < 4; ++n) acc[m][n] = MFMA16(bfm[s2][n], af[s2][m], acc[m][n]);
        }
#pragma unroll
        for (int m = 0; m < 2; ++m)
#pragma unroll
            for (int n = 0; n < 4; ++n) *(f32x4*)(red + ((w * 32 + m * 16 + fr) * 64 + n * 16 + fq * 4)) = acc[m][n];
        __syncthreads();
        {
            const int r = tid >> 4, c4 = (tid & 15) * 4;
            f32x4 v = *(const f32x4*)(red + (r * 64 + c4));
#pragma unroll
            for (int ww = 1; ww < 8; ++ww) v += *(const f32x4*)(red + ((ww * 32 + r) * 64 + c4));
            if constexpr (FIN == 0) E.apply(row0 + r, col0 + c4, v);
            else if constexpr (FIN == 2) {
                const int row = row0 + r, col = col0 + c4;
                const float* ab = E.ada + (size_t)row_batch(row) * ADAW;
                const f32x4 g = *(const f32x4*)(ab + 2048 + col);
                const f32x4 b = *(const f32x4*)(E.xs + (size_t)(row - NPR) * DM + col);
                const f32x4 x1 = b + g * v;
                *(f32x4*)(E.out + (size_t)row * DM + col) = x1;
                float ss = x1[0] * x1[0] + x1[1] * x1[1] + x1[2] * x1[2] + x1[3] * x1[3];
                ss += __shfl_xor(ss, 1); ss += __shfl_xor(ss, 2); ss += __shfl_xor(ss, 4); ss += __shfl_xor(ss, 8);
                if ((tid & 15) == 0) E.rowpartS[(size_t)(row - NPR) * 16 + ct] = ss;
                xchg_publish_wait(E.cntS + rt * 64, 16u);
                const float* rp = E.rowpartS + (size_t)(row - NPR) * 16;
                float tot = 0.f;
#pragma unroll
                for (int q = 0; q < 16; q += 4) { const f32x4 t4 = *(const f32x4*)(rp + q); tot += (t4[0] + t4[1]) + (t4[2] + t4[3]); }
                const float rs = rsqrtf(tot * (1.0f / DM) + EPS);
                const f32x4 G = *(const f32x4*)(E.gffn + col) * (*(const f32x4*)(ab + 4096 + col) + 1.0f);
                const f32x4 h = x1 * rs * G + *(const f32x4*)(ab + 3072 + col);
                u32x2 wv; wv.x = pk_bf16(h[0], h[1]); wv.y = pk_bf16(h[2], h[3]);
                *(u32x2*)(E.hbuf + (size_t)row * DM + col) = wv;
            }
            else {
                const int row = row0 + r, col = col0 + c4;
                const f32x4 g = *(const f32x4*)(E.ada + (size_t)row_batch(row) * ADAW + 5120 + col);
                const f32x4 b = *(const f32x4*)(E.out + (size_t)row * DM + col);
                const f32x4 x2 = b + g * v;
                float ss = x2[0] * x2[0] + x2[1] * x2[1] + x2[2] * x2[2] + x2[3] * x2[3];
                ss += __shfl_xor(ss, 1); ss += __shfl_xor(ss, 2); ss += __shfl_xor(ss, 4); ss += __shfl_xor(ss, 8);
                if ((tid & 15) == 0) E.rowpartS[(size_t)(row - NPR) * 16 + ct] = ss;
                xchg_publish_wait(E.cntS + rt * 64, 32u);
                const float* rp = E.rowpartS + (size_t)(row - NPR) * 16;
                float tot = 0.f;
#pragma unroll
                for (int q = 0; q < 16; q += 4) { const f32x4 t4 = *(const f32x4*)(rp + q); tot += (t4[0] + t4[1]) + (t4[2] + t4[3]); }
                const float rs = rsqrtf(tot * (1.0f / DM) + EPS);
                const f32x4 gf = *(const f32x4*)(E.gfin + col);
                *(f32x4*)(E.out + (size_t)row * DM + col) = x2 * rs * gf;
            }
        }
        __syncthreads();
    }
}

__device__ __forceinline__ void conv_tile(const float* __restrict__ src, int ld, int K, bf16_t* __restrict__ dst, int kt, int ntile, int src_col0, float* lds) {
    const int tid = otid();
    const int k0 = kt * 64, n0 = ntile * 64;
#pragma unroll
    for (int i = 0; i < 2; ++i) {
        const int r = (tid >> 4) + i * 32, c4 = (tid & 15) * 4;
        const f32x4 v = *(const f32x4*)(src + (size_t)(k0 + r) * ld + src_col0 + c4);
        lds[r * 65 + c4 + 0] = v[0]; lds[r * 65 + c4 + 1] = v[1]; lds[r * 65 + c4 + 2] = v[2]; lds[r * 65 + c4 + 3] = v[3];
    }
    __syncthreads();
    {
        const int n = tid >> 3, k8 = (tid & 7) * 8;
        float v[8];
#pragma unroll
        for (int i = 0; i < 8; ++i) v[i] = lds[(k8 + i) * 65 + n];
        u32x4 w; w.x = pk_bf16(v[0], v[1]); w.y = pk_bf16(v[2], v[3]); w.z = pk_bf16(v[4], v[5]); w.w = pk_bf16(v[6], v[7]);
        *(u32x4*)(dst + (size_t)(n0 + n) * K + k0 + k8) = w;
    }
    __syncthreads();
}

__device__ __forceinline__ void conv_strip(const float* __restrict__ src, int ld, int K, bf16_t* __restrict__ dst, int kt, int nt4, int src_col0, float* lds) {
    const int tid = otid();
    const int k0 = kt * 64, n0 = nt4 * 256;
    f32x4 v[8];
#pragma unroll
    for (int i = 0; i < 8; ++i) { const int r = (tid >> 6) + i * 8, c4 = (tid & 63) * 4; v[i] = __builtin_nontemporal_load((const f32x4*)(src + (size_t)(k0 + r) * ld + src_col0 + c4)); }
#pragma unroll
    for (int i = 0; i < 8; ++i) { const int r = (tid >> 6) + i * 8, c4 = (tid & 63) * 4;
        lds[r * 257 + c4 + 0] = v[i][0]; lds[r * 257 + c4 + 1] = v[i][1]; lds[r * 257 + c4 + 2] = v[i][2]; lds[r * 257 + c4 + 3] = v[i][3]; }
    __syncthreads();
#pragma unroll
    for (int j = 0; j < 4; ++j) {
        const int n = (tid >> 3) + j * 64, k8 = (tid & 7) * 8;
        float x[8];
#pragma unroll
        for (int i = 0; i < 8; ++i) x[i] = lds[(k8 + i) * 257 + n];
        u32x4 w; w.x = pk_bf16(x[0], x[1]); w.y = pk_bf16(x[2], x[3]); w.z = pk_bf16(x[4], x[5]); w.w = pk_bf16(x[6], x[7]);
        *(u32x4*)(dst + (size_t)(n0 + n) * K + k0 + k8) = w;
    }
    __syncthreads();
}

__device__ __forceinline__ void ada_item(const Params& p, int item, float* lds) {
    const int tid = otid(), lane = tid & 63, w = tid >> 6;
    const int cg_ = item >> 3, kq = item & 7;
    const int n0 = cg_ * 128 + lane * 2;
    const int kbase = kq * 128;
    f32x2 acc[17];
#pragma unroll
    for (int r = 0; r < 17; ++r) acc[r] = (f32x2){0.f, 0.f};
    f32x2 wv[16];
#pragma unroll
    for (int j = 0; j < 16; ++j) wv[j] = __builtin_nontemporal_load((const f32x2*)(p.w_ada + (size_t)(kbase + j) * ADAW + n0));
    for (int e = tid; e < NBATCH * 32; e += NTH) {
        const int r = e >> 5, k4 = (e & 31) * 4;
        const float* cp = r < 8 ? p.c_p + (size_t)r * DM : p.c_s + (size_t)(r - 8) * DM;
        f32x4 v = *(const f32x4*)(cp + kbase + k4);
#pragma unroll
        for (int j = 0; j < 4; ++j) v[j] = v[j] * sigmoidf_(v[j]);
        *(f32x4*)(lds + r * 128 + k4) = v;
    }
    __syncthreads();
#pragma unroll 1
    for (int kb = 0; kb < 128; kb += 16) {
        f32x2 wn[16];
        if (kb + 16 < 128) {
#pragma unroll
            for (int j = 0; j < 16; ++j) wn[j] = __builtin_nontemporal_load((const f32x2*)(p.w_ada + (size_t)(kbase + kb + 16 + j) * ADAW + n0));
        }
#pragma unroll
        for (int r = 0; r < 17; ++r) {
#pragma unroll
            for (int k4 = 0; k4 < 16; k4 += 4) {
                const f32x4 sv = *(const f32x4*)(lds + (w * 17 + r) * 128 + kb + k4);
                acc[r] += wv[k4] * sv[0]; acc[r] += wv[k4 + 1] * sv[1]; acc[r] += wv[k4 + 2] * sv[2]; acc[r] += wv[k4 + 3] * sv[3];
            }
        }
        if (kb + 16 < 128) {
#pragma unroll
            for (int j = 0; j < 16; ++j) wv[j] = wn[j];
        }
    }
    __syncthreads();
    float* part = (float*)(p.ws + WS_ADAP) + (size_t)kq * NBATCH * ADAW;
#pragma unroll
    for (int r = 0; r < 17; ++r) *(f32x2*)(part + (size_t)(w * 17 + r) * ADAW + n0) = acc[r];
}

__device__ __forceinline__ void phase0(const Params& p, float* lds) {
    const int NADA = 48 * 8;
    const int T_IN = 16 * 26, T_PG = 16, T_PO = 8 * 4, T_MO = 64, T_OUT = 64, T_W1 = 16 * 16, T_W2 = 64 * 4;
    const int total = NADA + T_IN + T_PG + T_PO + T_MO + T_OUT + T_W1 + T_W2 + 1;
    unsigned* qctr = (unsigned*)(p.ws + WS_CTR) + 16;
    volatile unsigned* slot = (volatile unsigned*)((unsigned char*)lds + LDS_BYTES - 16);
    for (;;) {
        if (threadIdx.x == 0) *slot = atomicAdd(qctr, 1u);
        __syncthreads();
        const int it = (int)*slot;
        __syncthreads();
        if (it >= total) break;
        int t = it;
        if (t < NADA) { ada_item(p, t, lds); continue; }
        t -= NADA;
        if (t < T_IN) { const int kt = t / 26, nt_ = t % 26; const int n0 = nt_ * 256; const int sc = n0 < 4608 ? n0 : n0 + 8;
            conv_strip(p.w_in, INW, DM, (bf16_t*)(p.ws + WS_WIN), kt, nt_, sc, lds); continue; }
        t -= T_IN;
        if (t < T_PG) { const int g = t >> 2, kt = (t >> 1) & 1, nt_ = t & 1;
            conv_tile(p.w_pg + (size_t)g * 128 * 128, 128, 128, (bf16_t*)(p.ws + WS_WPG) + (size_t)g * 128 * 128, kt, nt_, nt_ * 64, lds); continue; }
        t -= T_PG;
        if (t < T_PO) { const int kt = t / 4, nt_ = t % 4; conv_strip(p.w_po, 1024, 512, (bf16_t*)(p.ws + WS_WPO), kt, nt_, nt_ * 256, lds); continue; }
        t -= T_PO;
        if (t < T_MO) { const int kt = t / 4, nt_ = t % 4; conv_strip(p.w_mo, 1024, 1024, (bf16_t*)(p.ws + WS_WMO), kt, nt_, nt_ * 256, lds); continue; }
        t -= T_MO;
        if (t < T_OUT) { const int kt = t / 4, nt_ = t % 4; conv_strip(p.w_out, 1024, 1024, (bf16_t*)(p.ws + WS_WOUT), kt, nt_, nt_ * 256, lds); continue; }
        t -= T_OUT;
        if (t < T_W1) { const int kt = t / 16, nt_ = t % 16; conv_strip(p.w1, 4096, 1024, (bf16_t*)(p.ws + WS_W1), kt, nt_, nt_ * 256, lds); continue; }
        t -= T_W1;
        if (t < T_W2) { const int kt = t / 4, nt_ = t % 4; conv_strip(p.w2, 1024, 4096, (bf16_t*)(p.ws + WS_W2), kt, nt_, nt_ * 256, lds); continue; }
        for (int e = threadIdx.x; e < 1024 * 2; e += NTH) { const int k = e >> 1, hf = e & 1;
            *(f32x4*)((float*)(p.ws + WS_GW) + k * 8 + hf * 4) = *(const f32x4*)(p.w_in + (size_t)k * INW + 4608 + hf * 4); }
    }
}

__device__ __forceinline__ void norm_item(const Params& p, int item, int mode, float* lds) {
    const int tid = otid(), lane = tid & 63, w = tid >> 6;
    const float* adap = (const float*)(p.ws + WS_ADAP);
    const float* adaf = (const float*)(p.ws + WS_ADA);
    bf16_t* hbuf = (bf16_t*)(p.ws + WS_H);
    if (mode == 0) {
        for (int e = tid; e < 1024 * 2; e += NTH) *(f32x4*)(lds + e * 4) = *(const f32x4*)((const float*)(p.ws + WS_GW) + e * 4);
        __syncthreads();
    }
    const int r_begin = item * 64 + w * 8;
    const int r_extra = NPR + item * 2 + w;
    const int nrows = w < 2 ? 9 : 8;
    int cur_b = -1;
    f32x4 G[4], S[4], xn[4];
    { const int row = r_begin; const float* src0 = mode == 0 ? (row < NPR ? p.x_p + (size_t)row * DM : p.x_s + (size_t)(row - NPR) * DM) : p.out + (size_t)row * DM;
#pragma unroll
      for (int i = 0; i < 4; ++i) xn[i] = *(const f32x4*)(src0 + i * 256 + lane * 4); }
    for (int rr = 0; rr < nrows; ++rr) {
        const int row = rr < 8 ? r_begin + rr : r_extra;
        const int b = row_batch(row);
        if (mode != 2 && b != cur_b) {
            cur_b = b;
            const float* gw = mode == 0 ? p.g_mix : p.g_ffn;
            const int sh_off = mode == 0 ? 0 : 3072, sc_off = mode == 0 ? 1024 : 4096;
            f32x4 scv[4], shv[4];
            if (mode == 0) {
#pragma unroll
                for (int i = 0; i < 4; ++i) { const int col = i * 256 + lane * 4; scv[i] = *(const f32x4*)(p.b_ada + sc_off + col); shv[i] = *(const f32x4*)(p.b_ada + sh_off + col); }
#pragma unroll 2
                for (int q = 0; q < 8; ++q) {
                    const float* ap = adap + ((size_t)q * NBATCH + b) * ADAW;
#pragma unroll
                    for (int i = 0; i < 4; ++i) { const int col = i * 256 + lane * 4; scv[i] += *(const f32x4*)(ap + sc_off + col); shv[i] += *(const f32x4*)(ap + sh_off + col); }
                }
            } else {
#pragma unroll
                for (int i = 0; i < 4; ++i) { const int col = i * 256 + lane * 4; scv[i] = *(const f32x4*)(adaf + (size_t)b * ADAW + sc_off + col); shv[i] = *(const f32x4*)(adaf + (size_t)b * ADAW + sh_off + col); }
            }
#pragma unroll
            for (int i = 0; i < 4; ++i) { const f32x4 g = *(const f32x4*)(gw + i * 256 + lane * 4); G[i] = g * (scv[i] + 1.0f); S[i] = shv[i]; }
        }
        f32x4 x[4]; float ss = 0.f;
#pragma unroll
        for (int i = 0; i < 4; ++i) { x[i] = xn[i]; ss += x[i][0] * x[i][0] + x[i][1] * x[i][1] + x[i][2] * x[i][2] + x[i][3] * x[i][3]; }
        if (rr + 1 < nrows) { const int rown = rr + 1 < 8 ? row + 1 : r_extra;
            const float* srcn = mode == 0 ? (rown < NPR ? p.x_p + (size_t)rown * DM : p.x_s + (size_t)(rown - NPR) * DM) : p.out + (size_t)rown * DM;
#pragma unroll
            for (int i = 0; i < 4; ++i) xn[i] = *(const f32x4*)(srcn + i * 256 + lane * 4); }
        ss = wave_sum(ss);
        const float rstd = rsqrtf(ss * (1.0f / DM) + EPS);
        if (mode == 2) {
#pragma unroll
            for (int i = 0; i < 4; ++i) { const f32x4 g = *(const f32x4*)(p.g_final + i * 256 + lane * 4); __builtin_nontemporal_store(x[i] * rstd * g, (f32x4*)(p.out + (size_t)row * DM + i * 256 + lane * 4)); }
            continue;
        }
        f32x4 hv[4];
#pragma unroll
        for (int i = 0; i < 4; ++i) { hv[i] = x[i] * rstd * G[i] + S[i];
            u32x2 wv; wv.x = pk_bf16(hv[i][0], hv[i][1]); wv.y = pk_bf16(hv[i][2], hv[i][3]);
            *(u32x2*)(hbuf + (size_t)row * DM + i * 256 + lane * 4) = wv; }
        if (mode == 0) {
            float d[8];
#pragma unroll
            for (int j = 0; j < 8; ++j) d[j] = 0.f;
#pragma unroll
            for (int i = 0; i < 4; ++i)
#pragma unroll
                for (int e = 0; e < 4; ++e) {
                    const int k = i * 256 + lane * 4 + e;
                    const f32x4 w0 = *(const f32x4*)(lds + k * 8), w1 = *(const f32x4*)(lds + k * 8 + 4);
                    const float hvv = hv[i][e];
                    d[0] += hvv * w0[0]; d[1] += hvv * w0[1]; d[2] += hvv * w0[2]; d[3] += hvv * w0[3];
                    d[4] += hvv * w1[0]; d[5] += hvv * w1[1]; d[6] += hvv * w1[2]; d[7] += hvv * w1[3];
                }
#pragma unroll
            for (int j = 0; j < 8; ++j) d[j] = wave_sum(d[j]);
            if (lane < 4) {
                float di = lane == 0 ? d[0] : lane == 1 ? d[1] : lane == 2 ? d[2] : d[3];
                float df = lane == 0 ? d[4] : lane == 1 ? d[5] : lane == 2 ? d[6] : d[7];
                di += p.b_i[lane];
                const float z = df + p.b_f[lane];
                const float lf = fminf(z, 0.f) - log1pf(__expf(-fabsf(z)));
                ((float*)(p.ws + WS_GI))[(size_t)row * 4 + lane] = di;
                ((float*)(p.ws + WS_GF))[(size_t)row * 4 + lane] = lf;
            }
        }
    }
    if (mode == 0) __syncthreads();
}

__device__ __forceinline__ void ada_final_slice(const Params& p, int blk) {
    const float* adap = (const float*)(p.ws + WS_ADAP);
    float* adaf = (float*)(p.ws + WS_ADA);
    for (int e = threadIdx.x; e < 816; e += NTH) {
        const size_t idx = ((size_t)blk * 816 + e) * 4;
        f32x4 v = *(const f32x4*)(p.b_ada + (idx % ADAW));
#pragma unroll
        for (int q = 0; q < 8; ++q) v += *(const f32x4*)(adap + (size_t)q * NBATCH * ADAW + idx);
        *(f32x4*)(adaf + idx) = v;
    }
}

__device__ __forceinline__ void scan_item(const Params& p, int item, unsigned char* lds) {
    const int tid = otid(), lane = tid & 63, w = tid >> 6, fr = lane & 15, fq = lane >> 4;
    const int bh = item >> 2, j = item & 3, b = bh >> 2, hd = bh & 3, dv0 = j * 64;
    const float* gi = (const float*)(p.ws + WS_GI); const float* gf = (const float*)(p.ws + WS_GF);
    const bf16_t* kbuf = (const bf16_t*)(p.ws + WS_QKV) + (size_t)1 * MROWS * DM;
    const bf16_t* vbuf = (const bf16_t*)(p.ws + WS_QKV) + (size_t)2 * MROWS * DM;
    bf16_t* cst = (bf16_t*)(p.ws + WS_CST) + (size_t)bh * 31 * 65536;
    float* nst = (float*)(p.ws + WS_NST) + (size_t)bh * 32 * 256;
    float* mst = (float*)(p.ws + WS_MST) + (size_t)bh * 64;
    constexpr int KROW = 144;
    unsigned char* kimg[2] = {lds, lds + 256 * KROW};
    unsigned char* vimg[2] = {lds + 2 * 256 * KROW, lds + 2 * 256 * KROW + 64 * KROW};
    float* aA = (float*)(lds + 2 * 256 * KROW + 2 * 64 * KROW);
    float* bLs = aA + 2048;
    float* amx = bLs + 32;
    float* mch = amx + 32;
    float* dcy = mch + 40;
    for (int c = w * 4; c < w * 4 + 4; ++c) {
        const size_t tok = (size_t)b * SEQ + c * 64 + lane;
        const float lf = gf[tok * 4 + hd], il = gi[tok * 4 + hd];
        const float bs = wave_scan_add(lf, lane);
        const float bL = __shfl(bs, 63);
        const float a = bL - bs + il;
        const float am = wave_max(a);
        aA[c * 64 + lane] = a;
        if (lane == 0) { bLs[c] = bL; amx[c] = am; }
    }
    __syncthreads();
    if (tid == 0) {
        float m = 0.f; mch[0] = 0.f;
        for (int c = 0; c < 32; ++c) { const float mn = fmaxf(bLs[c] + m, amx[c]); dcy[c] = __expf(bLs[c] + m - mn); m = mn; mch[c + 1] = mn; }
    }
    __syncthreads();
    if (j == 0 && tid < 33) mst[tid] = mch[tid];
    if (j == 0 && tid == 0) p.out[O_MP + bh] = mch[32];
    f32x4 acc[2][4] = {};
    float nacc = 0.f;
    u32x4 krA[4], krB[4]; u32x4 vrA, vrB;
#define SCAN_GLOAD(KR, VR, cc) do { const size_t tok_ = (size_t)b * SEQ + (cc) * 64 + lane; const bf16_t* kp_ = kbuf + tok_ * DM + hd * 256 + w * 32; \
        _Pragma("unroll") for (int i_ = 0; i_ < 4; ++i_) KR[i_] = *(const u32x4*)(kp_ + i_ * 8); \
        VR = *(const u32x4*)(vbuf + tok_ * DM + hd * 256 + dv0 + w * 8); } while (0)
#define SCAN_WRITE(KR, VR, cc, ki, vi) do { const float wsv = __expf(aA[(cc) * 64 + lane] - mch[(cc) + 1]); \
        _Pragma("unroll") for (int i_ = 0; i_ < 4; ++i_) { const unsigned uu[4] = {KR[i_].x, KR[i_].y, KR[i_].z, KR[i_].w}; \
            _Pragma("unroll") for (int e_ = 0; e_ < 4; ++e_) { const int dk_ = w * 32 + i_ * 8 + e_ * 2; \
                *(bf16_t*)(ki + dk_ * KROW + lane * 2) = f2bf(bflo(uu[e_]) * wsv); *(bf16_t*)(ki + (dk_ + 1) * KROW + lane * 2) = f2bf(bfhi(uu[e_]) * wsv); } } \
        const int dv_ = w * 8; \
        *(bf16_t*)(vi + (dv_ + 0) * KROW + lane * 2) = (bf16_t)(VR.x & 0xffffu); *(bf16_t*)(vi + (dv_ + 1) * KROW + lane * 2) = (bf16_t)(VR.x >> 16); \
        *(bf16_t*)(vi + (dv_ + 2) * KROW + lane * 2) = (bf16_t)(VR.y & 0xffffu); *(bf16_t*)(vi + (dv_ + 3) * KROW + lane * 2) = (bf16_t)(VR.y >> 16); \
        *(bf16_t*)(vi + (dv_ + 4) * KROW + lane * 2) = (bf16_t)(VR.z & 0xffffu); *(bf16_t*)(vi + (dv_ + 5) * KROW + lane * 2) = (bf16_t)(VR.z >> 16); \
        *(bf16_t*)(vi + (dv_ + 6) * KROW + lane * 2) = (bf16_t)(VR.w & 0xffffu); *(bf16_t*)(vi + (dv_ + 7) * KROW + lane * 2) = (bf16_t)(VR.w >> 16); } while (0)
    SCAN_GLOAD(krA, vrA, 0);
    SCAN_GLOAD(krB, vrB, 1);
    for (int c = 0; c < 32; ++c) {
        unsigned char* ki = kimg[c & 1]; unsigned char* vi = vimg[c & 1];
        if ((c & 1) == 0) { SCAN_WRITE(krA, vrA, c, ki, vi); if (c + 2 < 32) SCAN_GLOAD(krA, vrA, c + 2); }
        else { SCAN_WRITE(krB, vrB, c, ki, vi); if (c + 2 < 32) SCAN_GLOAD(krB, vrB, c + 2); }
        __syncthreads();
        const float dc = dcy[c];
        bf16x8 af[2][2], bfr[4][2];
#pragma unroll
        for (int a = 0; a < 2; ++a)
#pragma unroll
            for (int k = 0; k < 2; ++k) af[a][k] = *(const bf16x8*)(ki + ((w * 2 + a) * 16 + fr) * KROW + (k * 32 + fq * 8) * 2);
#pragma unroll
        for (int a = 0; a < 4; ++a)
#pragma unroll
            for (int k = 0; k < 2; ++k) bfr[a][k] = *(const bf16x8*)(vi + (a * 16 + fr) * KROW + (k * 32 + fq * 8) * 2);
#pragma unroll
        for (int a = 0; a < 2; ++a)
#pragma unroll
            for (int q = 0; q < 4; ++q) {
                acc[a][q] *= dc;
#pragma unroll
                for (int k = 0; k < 2; ++k) acc[a][q] = MFMA16(af[a][k], bfr[q][k], acc[a][q]);
            }
        if (j == 0) {
            const int dk = tid >> 1, hf = tid & 1;
            float s = 0.f;
#pragma unroll
            for (int i = 0; i < 4; ++i) {
                const u32x4 v = *(const u32x4*)(ki + dk * KROW + hf * 64 + i * 16);
                s += bflo(v.x) + bfhi(v.x) + bflo(v.y) + bfhi(v.y) + bflo(v.z) + bfhi(v.z) + bflo(v.w) + bfhi(v.w);
            }
            s += __shfl_xor(s, 1);
            nacc = nacc * dc + s;
            if (hf == 0) { if (c < 31) nst[(c + 1) * 256 + dk] = nacc; else p.out[O_NP + (size_t)bh * 256 + dk] = nacc; }
        }
        if (c < 31) {
            bf16_t* cs = cst + (size_t)c * 65536;
#pragma unroll
            for (int a = 0; a < 2; ++a)
#pragma unroll
                for (int q = 0; q < 4; ++q) {
                    u32x2 wv; wv.x = pk_bf16(acc[a][q][0], acc[a][q][1]); wv.y = pk_bf16(acc[a][q][2], acc[a][q][3]);
                    *(u32x2*)(cs + (size_t)(dv0 + q * 16 + fr) * 256 + (w * 2 + a) * 16 + fq * 4) = wv;
                }
        } else {
            float* co = p.out + O_CP + (size_t)bh * 65536;
#pragma unroll
            for (int a = 0; a < 2; ++a)
#pragma unroll
                for (int q = 0; q < 4; ++q)
#pragma unroll
                    for (int jj = 0; jj < 4; ++jj) co[(size_t)((w * 2 + a) * 16 + fq * 4 + jj) * 256 + dv0 + q * 16 + fr] = acc[a][q][jj];
        }
    }
    __syncthreads();
}

__device__ __forceinline__ void sample_item(const Params& p, int item, unsigned char* ldsb) {
    const int tid = otid(), lane = tid & 63, w = tid >> 6;
    const int b = item >> 2, hd = item & 3, bh = item;
    const int r0 = NPR + b * 4;
    const bf16_t* qb = (const bf16_t*)(p.ws + WS_QKV);
    const bf16_t* kb = qb + (size_t)MROWS * DM; const bf16_t* vb = kb + (size_t)MROWS * DM; const bf16_t* ob = vb + (size_t)MROWS * DM;
    const float* gi = (const float*)(p.ws + WS_GI); const float* gf = (const float*)(p.ws + WS_GF);
    float* lds = (float*)ldsb;
    float* qf = lds;
    float* kf = qf + 1024;
    float* vf = kf + 1024;
    float* Sm = vf + 1024;
    float* sc = Sm + 16;
    float* red = sc + 64;
    float* ssq = red + 8192;
    const int dv4 = lane * 4;
    const float* C0 = p.st_C + (size_t)bh * 65536;
    float* Cn = p.out + O_CS + (size_t)bh * 65536;
    f32x4 cpre[8];
#pragma unroll
    for (int r = 0; r < 8; ++r) cpre[r] = __builtin_nontemporal_load((const f32x4*)(C0 + (size_t)(w * 32 + r) * 256 + dv4));
    float* n0s = ssq + 8;
    const int ft = tid >> 7, fdv = (tid & 127) * 2;
    const size_t foidx = (size_t)(r0 + ft) * DM + hd * 256 + fdv;
    const unsigned fog = *(const unsigned*)(ob + foidx);
    const float fm0 = p.m_norm[hd * 256 + fdv], fm1 = p.m_norm[hd * 256 + fdv + 1];
    if (tid < 256) n0s[tid] = p.st_n[(size_t)bh * 256 + tid];
    for (int e = tid; e < 3 * 4 * 256; e += NTH) {
        const int which = e >> 10, t = (e >> 8) & 3, d = e & 255;
        const bf16_t* src = which == 0 ? qb : which == 1 ? kb : vb;
        lds[which * 1024 + t * 256 + d] = bf2f(src[(size_t)(r0 + t) * DM + hd * 256 + d]);
    }
    if (tid == 0) {
        float lf[4], il[4], bs[4];
        for (int t = 0; t < 4; ++t) { lf[t] = gf[(size_t)(r0 + t) * 4 + hd]; il[t] = gi[(size_t)(r0 + t) * 4 + hd]; }
        bs[0] = lf[0]; bs[1] = bs[0] + lf[1]; bs[2] = bs[1] + lf[2]; bs[3] = bs[2] + lf[3];
        const float m0 = p.st_m[bh];
        for (int t = 0; t < 4; ++t) {
            const float g = bs[t] + m0; float mt = g;
            for (int s = 0; s <= t; ++s) mt = fmaxf(mt, bs[t] - bs[s] + il[s]);
            sc[t] = __expf(g - mt); sc[4 + t] = __expf(-mt);
            for (int s = 0; s < 4; ++s) sc[16 + t * 4 + s] = s <= t ? __expf(bs[t] - bs[s] + il[s] - mt) : 0.f;
        }
        const float bL = bs[3]; float mn = bL + m0;
        for (int s = 0; s < 4; ++s) mn = fmaxf(mn, bL - bs[s] + il[s]);
        sc[12] = __expf(bL + m0 - mn);
        for (int s = 0; s < 4; ++s) sc[8 + s] = __expf(bL - bs[s] + il[s] - mn);
        p.out[O_MS + bh] = mn;
    }
    __syncthreads();
    {
        const int g = tid >> 5, l32 = tid & 31;
        {
            const int t = g >> 2, s = g & 3; float a = 0.f;
#pragma unroll
            for (int d = l32; d < 256; d += 32) a += qf[t * 256 + d] * kf[s * 256 + d];
#pragma unroll
            for (int dd = 16; dd >= 1; dd >>= 1) a += __shfl_xor(a, dd);
            if (l32 == 0) Sm[g] = a * sc[16 + g];
        }
        if (g < 4) {
            float a = 0.f;
#pragma unroll
            for (int d = l32; d < 256; d += 32) a += qf[g * 256 + d] * n0s[d];
#pragma unroll
            for (int dd = 16; dd >= 1; dd >>= 1) a += __shfl_xor(a, dd);
            if (l32 == 0) sc[32 + g] = a;
        }
    }
    const float decay = sc[12];
    const float ws0 = sc[8], ws1 = sc[9], ws2 = sc[10], ws3 = sc[11];
    if (tid < 256) {
        const float nn = decay * n0s[tid] + ws0 * kf[tid] + ws1 * kf[256 + tid] + ws2 * kf[512 + tid] + ws3 * kf[768 + tid];
        p.out[O_NS + (size_t)bh * 256 + tid] = nn;
    }
    {
        f32x4 vv[4], num[4];
        vv[0] = *(const f32x4*)(vf + dv4) * ws0; vv[1] = *(const f32x4*)(vf + 256 + dv4) * ws1; vv[2] = *(const f32x4*)(vf + 512 + dv4) * ws2; vv[3] = *(const f32x4*)(vf + 768 + dv4) * ws3;
#pragma unroll
        for (int s = 0; s < 4; ++s) num[s] = (f32x4){0.f, 0.f, 0.f, 0.f};
#pragma unroll
        for (int r = 0; r < 8; ++r) {
            const int dk = w * 32 + r;
            const f32x4 cv = cpre[r];
            f32x4 cn = cv * decay;
#pragma unroll
            for (int s = 0; s < 4; ++s) { num[s] += cv * qf[s * 256 + dk]; cn += vv[s] * kf[s * 256 + dk]; }
            __builtin_nontemporal_store(cn, (f32x4*)(Cn + (size_t)dk * 256 + dv4));
        }
#pragma unroll 8
        for (int r = 8; r < 32; ++r) {
            const int dk = w * 32 + r;
            const f32x4 cv = __builtin_nontemporal_load((const f32x4*)(C0 + (size_t)dk * 256 + dv4));
            f32x4 cn = cv * decay;
#pragma unroll
            for (int s = 0; s < 4; ++s) { num[s] += cv * qf[s * 256 + dk]; cn += vv[s] * kf[s * 256 + dk]; }
            __builtin_nontemporal_store(cn, (f32x4*)(Cn + (size_t)dk * 256 + dv4));
        }
        __syncthreads();
#pragma unroll
        for (int t = 0; t < 4; ++t) *(f32x4*)(red + (w * 4 + t) * 256 + dv4) = num[t];
    }
    __syncthreads();
    {
        const int t = tid >> 7, dv = (tid & 127) * 2;
        float n0_ = 0.f, n1_ = 0.f;
#pragma unroll
        for (int ww = 0; ww < 8; ++ww) { n0_ += red[(ww * 4 + t) * 256 + dv]; n1_ += red[(ww * 4 + t) * 256 + dv + 1]; }
        const float wint = sc[t];
        n0_ *= wint; n1_ *= wint;
        float rs = 0.f;
#pragma unroll
        for (int s = 0; s < 4; ++s) { const float sv = Sm[t * 4 + s]; rs += sv; n0_ += sv * vf[s * 256 + dv]; n1_ += sv * vf[s * 256 + dv + 1]; }
        const float den = wint * sc[32 + t] + rs;
        const float dinv = 1.0f / fmaxf(fabsf(den), sc[4 + t]);
        const float h0 = n0_ * dinv, h1 = n1_ * dinv;
        float q2 = wave_sum(h0 * h0 + h1 * h1);
        if (lane == 0) ssq[t * 2 + (w & 1)] = q2;
        __syncthreads();
        const float rstd = rsqrtf((ssq[t * 2] + ssq[t * 2 + 1]) * (1.0f / 256.f) + EPS);
        const float o0 = h0 * rstd * fm0 * bflo(fog), o1 = h1 * rstd * fm1 * bfhi(fog);
        *(unsigned*)((bf16_t*)(p.ws + WS_HM) + foidx) = pk_bf16(o0, o1);
    }
    __syncthreads();
}

__device__ __forceinline__ void pool_item(const Params& p, int item, unsigned char* lds) {
    const int tid = otid(), lane = tid & 63, w = tid >> 6, fr = lane & 15, fq = lane >> 4;
    const int r0 = item < 256 ? item * 64 : NPR + (item - 256) * 16;
    const int nm = item < 256 ? 4 : 1;
    const float* u = (const float*)(p.ws + WS_U);
    constexpr int AROW = 1040;
    {
        const int c = tid, gidx = c >> 7, win = 2 << gidx;
        float hist[31];
        if (r0 < NPR) {
            const int t0 = r0 & (SEQ - 1);
#pragma unroll
            for (int j = 0; j < 15; ++j) hist[j] = (t0 - 15 + j) >= 0 ? u[(size_t)(r0 - 15 + j) * 512 + c] : 0.f;
#pragma unroll 1
            for (int ch = 0; ch < 4; ++ch) {
#pragma unroll
                for (int j = 0; j < 16; ++j) hist[15 + j] = u[(size_t)(r0 + ch * 16 + j) * 512 + c];
#pragma unroll
                for (int j = 0; j < 16; ++j) {
                    const int i = ch * 16 + j, t = t0 + i, q = 15 + j;
                    const float s2 = hist[q] + hist[q - 1];
                    const float s4 = s2 + hist[q - 2] + hist[q - 3];
                    const float s8 = s4 + (hist[q - 4] + hist[q - 5]) + (hist[q - 6] + hist[q - 7]);
                    const float s16 = s8 + ((hist[q - 8] + hist[q - 9]) + (hist[q - 10] + hist[q - 11])) + ((hist[q - 12] + hist[q - 13]) + (hist[q - 14] + hist[q - 15]));
                    const float s = gidx == 0 ? s2 : gidx == 1 ? s4 : gidx == 2 ? s8 : s16;
                    const float rc = __builtin_amdgcn_rcpf((float)min(t + 1, win));
                    *(bf16_t*)(lds + i * AROW + c * 2) = f2bf(s * rc - hist[q]);
                }
#pragma unroll
                for (int j = 0; j < 15; ++j) hist[j] = hist[16 + j];
            }
        } else {
#pragma unroll 1
            for (int bi = 0; bi < 4; ++bi) {
                const int bb = ((r0 - NPR) >> 2) + bi;
#pragma unroll
                for (int j = 0; j < 15; ++j) hist[j] = p.st_pool[((size_t)bb * 15 + j) * 512 + c];
#pragma unroll
                for (int j = 0; j < 4; ++j) hist[15 + j] = u[((size_t)NPR + bb * 4 + j) * 512 + c];
#pragma unroll
                for (int j = 0; j < 4; ++j) {
                    const int i = bi * 4 + j, q = 15 + j;
                    const float s2 = hist[q] + hist[q - 1];
                    const float s4 = s2 + hist[q - 2] + hist[q - 3];
                    const float s8 = s4 + (hist[q - 4] + hist[q - 5]) + (hist[q - 6] + hist[q - 7]);
                    const float s16 = s8 + ((hist[q - 8] + hist[q - 9]) + (hist[q - 10] + hist[q - 11])) + ((hist[q - 12] + hist[q - 13]) + (hist[q - 14] + hist[q - 15]));
                    const float s = gidx == 0 ? s2 : gidx == 1 ? s4 : gidx == 2 ? s8 : s16;
                    *(bf16_t*)(lds + i * AROW + c * 2) = f2bf(s * (1.0f / (float)win) - hist[q]);
                }
            }
        }
    }
    __syncthreads();
    {
        const int g = w >> 1, nh = w & 1;
        const bf16_t* wt = (const bf16_t*)(p.ws + WS_WPG) + (size_t)g * 128 * 128;
        f32x4 acc[4][4] = {};
#pragma unroll
        for (int k = 0; k < 4; ++k) {
            bf16x8 af[4], bfr[4];
#pragma unroll
            for (int m = 0; m < 4; ++m) if (m < nm) af[m] = *(const bf16x8*)(lds + (m * 16 + fr) * AROW + (g * 128 + k * 32 + fq * 8) * 2);
#pragma unroll
            for (int n = 0; n < 4; ++n) bfr[n] = *(const bf16x8*)(wt + (size_t)((nh * 4 + n) * 16 + fr) * 128 + k * 32 + fq * 8);
#pragma unroll
            for (int m = 0; m < 4; ++m) if (m < nm) {
#pragma unroll
                for (int n = 0; n < 4; ++n) acc[m][n] = MFMA16(bfr[n], af[m], acc[m][n]); }
        }
        bf16_t* yp = (bf16_t*)(p.ws + WS_YP);
#pragma unroll
        for (int m = 0; m < 4; ++m) if (m < nm)
#pragma unroll
            for (int n = 0; n < 4; ++n) {
                const int col = g * 128 + (nh * 4 + n) * 16 + fq * 4;
                const f32x4 scv = *(const f32x4*)(p.pool_scale + col);
                const f32x4 v = acc[m][n] * scv;
                u32x2 wv; wv.x = pk_bf16(v[0], v[1]); wv.y = pk_bf16(v[2], v[3]);
                *(u32x2*)(yp + (size_t)(r0 + m * 16 + fr) * 512 + col) = wv;
            }
    }
    __syncthreads();
}

__device__ __forceinline__ void poolout_item(const Params& p, int item) {
    const float* u = (const float*)(p.ws + WS_U);
    for (int e = threadIdx.x; e < 15 * 512; e += NTH) {
        const int jj = e >> 9, c = e & 511;
        if (item < 8) p.out[O_POOLP + (size_t)item * 7680 + e] = u[((size_t)item * SEQ + 2033 + jj) * 512 + c];
        else { const int bb = item - 8;
            p.out[O_POOLS + (size_t)bb * 7680 + e] = jj < 11 ? p.st_pool[((size_t)bb * 15 + jj + 4) * 512 + c] : u[((size_t)NPR + bb * 4 + (jj - 11)) * 512 + c]; }
    }
}

__device__ __forceinline__ void mout_item(const Params& p, int item, unsigned char* lds) {
    const int tid = otid(), lane = tid & 63, w = tid >> 6, fr = lane & 15, fq = lane >> 4;
    const int bh = item >> 5, c = item & 31, b = bh >> 2, hd = bh & 3;
    const size_t tok0 = (size_t)b * SEQ + c * 64;
    const bf16_t* qb = (const bf16_t*)(p.ws + WS_QKV);
    const bf16_t* kb = qb + (size_t)MROWS * DM; const bf16_t* vb = kb + (size_t)MROWS * DM; const bf16_t* ob = vb + (size_t)MROWS * DM;
    const float* gi = (const float*)(p.ws + WS_GI); const float* gf = (const float*)(p.ws + WS_GF);
    constexpr int QROW = 528, VROW = 144;
    unsigned char* Qs = lds;
    unsigned char* Ks = Qs + 64 * QROW;
    unsigned char* Vt = Ks + 64 * QROW;
    unsigned char* Sp = Vt + 256 * VROW;
    float* scal = (float*)(Sp + 64 * VROW);
    float* rt = scal, *ct = scal + 64, *wint = scal + 128, *emt = scal + 192, *rowsum = scal + 256  , *qn = scal + 384, *ssq = scal + 448  , *ncs = scal + 960  ;
    bf16x8 cfr[8][2];
    if (c > 0) {
        const bf16_t* cs = (const bf16_t*)(p.ws + WS_CST) + ((size_t)bh * 31 + (c - 1)) * 65536;
#pragma unroll
        for (int k = 0; k < 8; ++k)
#pragma unroll
            for (int n = 0; n < 2; ++n) cfr[k][n] = *(const bf16x8*)(cs + (size_t)(w * 32 + n * 16 + fr) * 256 + k * 32 + fq * 8);
    }
    u32x2 ogv[4][2]; f32x4 mnv[2];
#pragma unroll
    for (int n = 0; n < 2; ++n) { const int dvg = hd * 256 + w * 32 + n * 16 + fq * 4; mnv[n] = *(const f32x4*)(p.m_norm + dvg);
#pragma unroll
        for (int m = 0; m < 4; ++m) ogv[m][n] = *(const u32x2*)(ob + (tok0 + m * 16 + fr) * DM + dvg); }
#pragma unroll
    for (int i = 0; i < 4; ++i) {
        const int pc = tid + NTH * i, row = pc >> 5, c8 = pc & 31;
        *(u32x4*)(Qs + row * QROW + c8 * 16) = *(const u32x4*)(qb + (tok0 + row) * DM + hd * 256 + c8 * 8);
        *(u32x4*)(Ks + row * QROW + c8 * 16) = *(const u32x4*)(kb + (tok0 + row) * DM + hd * 256 + c8 * 8);
    }
    {
        const bf16_t* vp = vb + (tok0 + lane) * DM + hd * 256 + w * 32;
#pragma unroll
        for (int i = 0; i < 4; ++i) {
            const u32x4 v = *(const u32x4*)(vp + i * 8);
            const unsigned uu[4] = {v.x, v.y, v.z, v.w};
#pragma unroll
            for (int e = 0; e < 4; ++e) {
                const int dv = w * 32 + i * 8 + e * 2;
                *(bf16_t*)(Vt + dv * VROW + lane * 2) = (bf16_t)(uu[e] & 0xffffu);
                *(bf16_t*)(Vt + (dv + 1) * VROW + lane * 2) = (bf16_t)(uu[e] >> 16);
            }
        }
    }
    if (c > 0 && tid >= 256) ncs[tid - 256] = ((const float*)(p.ws + WS_NST))[((size_t)bh * 32 + c) * 256 + tid - 256];
    if (w == 0) {
        const float lf = gf[(tok0 + lane) * 4 + hd], il = gi[(tok0 + lane) * 4 + hd];
        const float bs = wave_scan_add(lf, lane);
        const float mc = ((const float*)(p.ws + WS_MST))[bh * 64 + c];
        const float g = bs + mc, xx = il - bs;
        const float pm = wave_scan_max(xx, lane);
        const float mt = fmaxf(g, bs + pm);
        rt[lane] = bs - mt; ct[lane] = xx; wint[lane] = __expf(g - mt); emt[lane] = __expf(-mt);
    }
    __syncthreads();
    {
        const int tt = w >> 1, sh = w & 1;
        f32x4 sa[2] = {};
#pragma unroll
        for (int k = 0; k < 8; ++k) {
            const bf16x8 qf = *(const bf16x8*)(Qs + (tt * 16 + fr) * QROW + (k * 32 + fq * 8) * 2);
#pragma unroll
            for (int s2 = 0; s2 < 2; ++s2) {
                const bf16x8 kf = *(const bf16x8*)(Ks + ((sh * 2 + s2) * 16 + fr) * QROW + (k * 32 + fq * 8) * 2);
                sa[s2] = MFMA16(kf, qf, sa[s2]);
            }
        }
        const int t = tt * 16 + fr;
        const float rtt = rt[t];
        float rs = 0.f;
#pragma unroll
        for (int s2 = 0; s2 < 2; ++s2) {
            const int s0 = (sh * 2 + s2) * 16 + fq * 4;
            float v[4];
#pragma unroll
            for (int jj = 0; jj < 4; ++jj) { const int s = s0 + jj; v[jj] = s <= t ? sa[s2][jj] * __expf(rtt + ct[s]) : 0.f; rs += v[jj]; }
            u32x2 wv; wv.x = pk_bf16(v[0], v[1]); wv.y = pk_bf16(v[2], v[3]);
            *(u32x2*)(Sp + t * VROW + s0 * 2) = wv;
        }
        rs += __shfl_xor(rs, 16); rs += __shfl_xor(rs, 32);
        if (fq == 0) rowsum[t * 2 + sh] = rs;
    }
    {
        const int t = tid >> 3, part = tid & 7;
        float a = 0.f;
        if (c > 0) {
            const float* nc = ncs + part * 32;
            const unsigned char* qp = Qs + t * QROW + part * 64;
#pragma unroll
            for (int i = 0; i < 4; ++i) {
                const u32x4 qv = *(const u32x4*)(qp + i * 16);
                const f32x4 n0 = *(const f32x4*)(nc + i * 8), n1 = *(const f32x4*)(nc + i * 8 + 4);
                a += bflo(qv.x) * n0[0] + bfhi(qv.x) * n0[1] + bflo(qv.y) * n0[2] + bfhi(qv.y) * n0[3] + bflo(qv.z) * n1[0] + bfhi(qv.z) * n1[1] + bflo(qv.w) * n1[2] + bfhi(qv.w) * n1[3];
            }
        }
        a += __shfl_xor(a, 1); a += __shfl_xor(a, 2); a += __shfl_xor(a, 4);
        if (part == 0) qn[t] = a;
    }
    __syncthreads();
    f32x4 acc[4][2] = {};
    if (c > 0) {
#pragma unroll
        for (int k = 0; k < 8; ++k) {
            bf16x8 qf[4];
#pragma unroll
            for (int m = 0; m < 4; ++m) qf[m] = *(const bf16x8*)(Qs + (m * 16 + fr) * QROW + (k * 32 + fq * 8) * 2);
#pragma unroll
            for (int m = 0; m < 4; ++m)
#pragma unroll
                for (int n = 0; n < 2; ++n) acc[m][n] = MFMA16(cfr[k][n], qf[m], acc[m][n]);
        }
#pragma unroll
        for (int m = 0; m < 4; ++m) { const float wi = wint[m * 16 + fr]; acc[m][0] *= wi; acc[m][1] *= wi; }
    }
#pragma unroll
    for (int k = 0; k < 2; ++k) {
        bf16x8 vfr[2], sf[4];
#pragma unroll
        for (int n = 0; n < 2; ++n) vfr[n] = *(const bf16x8*)(Vt + (w * 32 + n * 16 + fr) * VROW + (k * 32 + fq * 8) * 2);
#pragma unroll
        for (int m = 0; m < 4; ++m) sf[m] = *(const bf16x8*)(Sp + (m * 16 + fr) * VROW + (k * 32 + fq * 8) * 2);
#pragma unroll
        for (int m = 0; m < 4; ++m)
#pragma unroll
            for (int n = 0; n < 2; ++n) acc[m][n] = MFMA16(vfr[n], sf[m], acc[m][n]);
    }
#pragma unroll
    for (int m = 0; m < 4; ++m) {
        const int t = m * 16 + fr;
        const float den = wint[t] * qn[t] + rowsum[t * 2] + rowsum[t * 2 + 1];
        const float dinv = 1.0f / fmaxf(fabsf(den), emt[t]);
        acc[m][0] *= dinv; acc[m][1] *= dinv;
        float q2 = 0.f;
#pragma unroll
        for (int n = 0; n < 2; ++n)
#pragma unroll
            for (int jj = 0; jj < 4; ++jj) q2 += acc[m][n][jj] * acc[m][n][jj];
        q2 += __shfl_xor(q2, 16); q2 += __shfl_xor(q2, 32);
        if (fq == 0) ssq[t * 8 + w] = q2;
    }
    __syncthreads();
#pragma unroll
    for (int m = 0; m < 4; ++m) {
        const int t = m * 16 + fr;
        float tot = 0.f;
#pragma unroll
        for (int ww = 0; ww < 8; ++ww) tot += ssq[t * 8 + ww];
        const float rstd = rsqrtf(tot * (1.0f / 256.f) + EPS);
#pragma unroll
        for (int n = 0; n < 2; ++n) {
            const int dvg = hd * 256 + w * 32 + n * 16 + fq * 4;
            const size_t oidx = (tok0 + t) * DM + dvg;
            const u32x2 og = ogv[m][n];
            const f32x4 v = acc[m][n] * rstd * mnv[n];
            u32x2 wv; wv.x = pk_bf16(v[0] * bflo(og.x), v[1] * bfhi(og.x)); wv.y = pk_bf16(v[2] * bflo(og.y), v[3] * bfhi(og.y));
            *(u32x2*)((bf16_t*)(p.ws + WS_HM) + oidx) = wv;
        }
    }
    __syncthreads();
}

__device__ __forceinline__ void grid_barrier(unsigned* bar, unsigned k) {
    asm volatile("s_waitcnt vmcnt(0)" ::: "memory");
    __syncthreads();
    if (threadIdx.x == 0) {
        const unsigned g = blockIdx.x & 7u, gsz = (gridDim.x + 7u - g) >> 3;
        __builtin_amdgcn_fence(__ATOMIC_RELEASE, "agent");
        asm volatile("s_waitcnt vmcnt(0)" ::: "memory");
        unsigned* sub = bar + 64u * (1u + g);
        const unsigned prev = __hip_atomic_fetch_add(sub, 1u, __ATOMIC_RELAXED, __HIP_MEMORY_SCOPE_AGENT);
        if (prev + 1u == k * gsz) __hip_atomic_fetch_add(bar, 1u, __ATOMIC_RELAXED, __HIP_MEMORY_SCOPE_AGENT);
        const unsigned ngroups = gridDim.x < 8u ? gridDim.x : 8u;
        unsigned spins = 0;
        while (__hip_atomic_load(bar, __ATOMIC_RELAXED, __HIP_MEMORY_SCOPE_AGENT) < k * ngroups) { __builtin_amdgcn_s_sleep(1); if (++spins > (1u << 24)) break; }
        __builtin_amdgcn_fence(__ATOMIC_ACQUIRE, "agent");
        asm volatile("s_waitcnt vmcnt(0)" ::: "memory");
    }
    __syncthreads();
}

__global__ void __launch_bounds__(NTH) hybrid_fwd(Params p) {
    extern __shared__ __attribute__((aligned(16))) unsigned char lds[];
    cg::grid_group grid = cg::this_grid();
    const int lo = p.ph_lo, hi = p.ph_hi;
#ifndef PHMASK
#define PHMASK 0x7ff
#endif
#define IN(k) (((PHMASK >> (k)) & 1) && lo <= (k) && (k) < hi)
#define SEAMN(n) do { grid_barrier((unsigned*)(p.ws + WS_CTR) + 64, (unsigned)(n)); } while (0)
    if (lo < 0) grid.sync();
    LAS unsigned char* ldsl = (LAS unsigned char*)lds;
    unsigned char* ws = p.ws;
    if (IN(0)) phase0(p, (float*)lds);
    SEAMN(1);
    if (IN(1)) {
        for (int it = blockIdx.x; it < 256; it += gridDim.x) { ada_final_slice(p, it); norm_item(p, it, 0, (float*)lds); }
    }
    SEAMN(2);
    if (IN(2)) { EpiG1 e{(float*)(ws + WS_U), (bf16_t*)(ws + WS_QKV)}; gemm_phase(ldsl, (const bf16_t*)(ws + WS_H), (const bf16_t*)(ws + WS_WIN), NIN, DM, e);
        { const int c = blockIdx.x; const int tb = c < 128 ? c * 2 : 256 + (c - 128) * 11;
          small_gemm_phase(lds, (const bf16_t*)(ws + WS_H), (const bf16_t*)(ws + WS_WIN), NIN, DM, e, tb, tb + (c < 128 ? 2 : 11)); } }
    SEAMN(3);
    if (IN(3)) {
        if (blockIdx.x < 128) { const int x = blockIdx.x & 7, r = blockIdx.x >> 3;
            scan_item(p, ((x + 8 * (r >> 2)) << 2) | (r & 3), lds); }
        {
            unsigned* ctr = (unsigned*)(ws + WS_CTR);
            volatile unsigned* slot = (volatile unsigned*)(lds + LDS_BYTES - 16);
            for (;;) {
                if (threadIdx.x == 0) *slot = atomicAdd(ctr, 1u);
                __syncthreads();
                const int it = (int)*slot;
                __syncthreads();
                if (it >= 512 + 288 + NBATCH) break;
                if (it < 512) sample_item(p, it, lds);
                else if (it < 800) pool_item(p, it - 512, lds);
                else poolout_item(p, it - 800);
            }
        }
    }
    SEAMN(4);
    if (IN(4)) { for (int it = blockIdx.x; it < 1024; it += gridDim.x) mout_item(p, it, lds); }
    if (IN(5)) {

        bf16_t* merged = (bf16_t*)(ws + WS_U);
        const bf16_t* sga = (const bf16_t*)(ws + WS_QKV) + (size_t)4 * MROWS * DM;
        const bf16_t* sgb = sga + (size_t)MROWS * DM;
        { EpiMerge e0{merged, sga, 0}; gemm_phase(ldsl, (const bf16_t*)(ws + WS_YP), (const bf16_t*)(ws + WS_WPO), DM, 512, e0);
          small_gemm_phase(lds, (const bf16_t*)(ws + WS_YP), (const bf16_t*)(ws + WS_WPO), DM, 512, e0, blockIdx.x, blockIdx.x + 1); }
        SEAMN(5);
        { EpiMerge e1{merged, sgb, 1}; gemm_phase(ldsl, (const bf16_t*)(ws + WS_HM), (const bf16_t*)(ws + WS_WMO), DM, DM, e1);
          small_gemm_phase(lds, (const bf16_t*)(ws + WS_HM), (const bf16_t*)(ws + WS_WMO), DM, DM, e1, blockIdx.x, blockIdx.x + 1); }
    }
    SEAMN(6);
    if (IN(6)) {
        EpiMid e{p.out, p.x_p, p.x_s, (const float*)(ws + WS_ADA), p.g_ffn, (bf16_t*)(ws + WS_H), (float*)(ws + WS_RSB), (unsigned*)(ws + WS_XCNT), (float*)(ws + WS_RSS), (unsigned*)(ws + WS_XCNT) + 64 * 64};
        gemm_phase<EpiMid, true>(ldsl, (const bf16_t*)(ws + WS_U), (const bf16_t*)(ws + WS_WOUT), DM, DM, e, lds);
        small_gemm_phase<EpiMid, 2>(lds, (const bf16_t*)(ws + WS_U), (const bf16_t*)(ws + WS_WOUT), DM, DM, e, blockIdx.x, blockIdx.x + 1);
    }
    SEAMN(7);
    if (IN(8)) { EpiAct e{(bf16_t*)(ws + WS_CST)}; gemm_phase(ldsl, (const bf16_t*)(ws + WS_H), (const bf16_t*)(ws + WS_W1), DFF, DM, e);
        small_gemm_phase(lds, (const bf16_t*)(ws + WS_H), (const bf16_t*)(ws + WS_W1), DFF, DM, e, blockIdx.x * 4, blockIdx.x * 4 + 4); }
    SEAMN(8);
    if (IN(9)) {
        EpiFinal e{p.out, (const float*)(ws + WS_ADA), p.g_final, (float*)(ws + WS_RSB), (unsigned*)(ws + WS_XCNT), (float*)(ws + WS_RSS), (unsigned*)(ws + WS_XCNT) + 64 * 64};
        gemm_phase<EpiFinal, true>(ldsl, (const bf16_t*)(ws + WS_CST), (const bf16_t*)(ws + WS_W2), DM, DFF, e, lds);
        small_gemm_phase<EpiFinal, 1>(lds, (const bf16_t*)(ws + WS_CST), (const bf16_t*)(ws + WS_W2), DM, DFF, e, blockIdx.x, blockIdx.x + 1);
    }
#undef IN
#undef SEAMN
}

extern "C" void kernel_launch(void* const* d_in, const int* in_sizes, int n_in, void* d_out, int out_size, void* d_ws, size_t ws_size, hipStream_t stream) {
    static int grid_blocks = 0;
    if (grid_blocks == 0) {
        if (ws_size < WS_END) { fprintf(stderr, "kernel_launch: workspace too small: %zu < %zu\n", ws_size, (size_t)WS_END); grid_blocks = -1; return; }
        int dev = 0, cus = 0, per_cu = 0;
        hipGetDevice(&dev);
        hipDeviceGetAttribute(&cus, hipDeviceAttributeMultiprocessorCount, dev);
        hipFuncSetAttribute((const void*)hybrid_fwd, hipFuncAttributeMaxDynamicSharedMemorySize, LDS_BYTES);
        hipOccupancyMaxActiveBlocksPerMultiprocessor(&per_cu, (const void*)hybrid_fwd, NTH, LDS_BYTES);
        if (per_cu < 1) per_cu = 1;
        if (per_cu > 1) per_cu = 1;
        grid_blocks = cus * per_cu;
    }
    if (grid_blocks < 0) return;
    hipMemsetAsync((char*)d_ws + WS_CTR, 0, 4096 + 80 * 256, stream);
    Params p{};
    const float** f = (const float**)&p;
    for (int i = 0; i < 24; ++i) f[i] = (const float*)d_in[i];
    p.out = (float*)d_out; p.ws = (unsigned char*)d_ws; p.ph_lo = 0; p.ph_hi = 11;
    void* args[] = {&p};
    hipError_t e = hipLaunchCooperativeKernel((const void*)hybrid_fwd, dim3(grid_blocks), dim3(NTH), args, LDS_BYTES, stream);
    if (e != hipSuccess) fprintf(stderr, "cooperative launch failed: %s (grid %d)\n", hipGetErrorString(e), grid_blocks);
}
```

```cpp
#include <hip/hip_runtime.h>
#include <hip/hip_cooperative_groups.h>
#include <cstdio>
#include <cstdint>
namespace cg = cooperative_groups;

typedef unsigned short bf16_t;
typedef short bf16x8 __attribute__((ext_vector_type(8)));
typedef float f32x4 __attribute__((ext_vector_type(4)));
typedef unsigned u32x4 __attribute__((ext_vector_type(4)));
typedef unsigned u32x2 __attribute__((ext_vector_type(2)));

constexpr int NTH = 512;
constexpr int DM = 1024, NPR = 16384, NSA = 512, MROWS = 16896, NBATCH = 136, SEQ = 2048;
constexpr int NIN = 6656, DFF = 4096, ADAW = 6144, INW = 6664;
constexpr int LDS_BYTES = 131072;
constexpr float EPS = 1e-6f;

constexpr size_t O_Y = 0;
constexpr size_t O_POOLP = 17301504;
constexpr size_t O_CP = 17362944;
constexpr size_t O_NP = 19460096;
constexpr size_t O_MP = 19468288;
constexpr size_t O_POOLS = 19468320;
constexpr size_t O_CS = 20451360;
constexpr size_t O_NS = 54005792;
constexpr size_t O_MS = 54136864;

constexpr size_t AL(size_t x) { return (x + 255) & ~(size_t)255; }
constexpr size_t WS_WIN = 0;
constexpr size_t WS_WPG = WS_WIN + AL((size_t)NIN * DM * 2);
constexpr size_t WS_WPO = WS_WPG + AL((size_t)4 * 128 * 128 * 2);
constexpr size_t WS_WMO = WS_WPO + AL((size_t)1024 * 512 * 2);
constexpr size_t WS_WOUT = WS_WMO + AL((size_t)1024 * 1024 * 2);
constexpr size_t WS_W1 = WS_WOUT + AL((size_t)1024 * 1024 * 2);
constexpr size_t WS_W2 = WS_W1 + AL((size_t)4096 * 1024 * 2);
constexpr size_t WS_ADAP = WS_W2 + AL((size_t)4096 * 1024 * 2);
constexpr size_t WS_ADA = WS_ADAP + AL((size_t)8 * NBATCH * ADAW * 4);
constexpr size_t WS_H = WS_ADA + AL((size_t)NBATCH * ADAW * 4);
constexpr size_t WS_GI = WS_H + AL((size_t)MROWS * DM * 2);
constexpr size_t WS_GF = WS_GI + AL((size_t)MROWS * 4 * 4);
constexpr size_t WS_U = WS_GF + AL((size_t)MROWS * 4 * 4);
constexpr size_t WS_QKV = WS_U + AL((size_t)MROWS * 512 * 4);
constexpr size_t WS_CST = WS_QKV + AL((size_t)6 * MROWS * DM * 2);
constexpr size_t WS_NST = WS_CST + AL((size_t)MROWS * DFF * 2);
constexpr size_t WS_MST = WS_NST + AL((size_t)32 * 32 * 256 * 4);
constexpr size_t WS_YP = WS_MST + AL((size_t)32 * 64 * 4);
constexpr size_t WS_HM = WS_YP + AL((size_t)MROWS * 512 * 2);
constexpr size_t WS_GW = WS_HM + AL((size_t)MROWS * DM * 2);
constexpr size_t WS_CTR = WS_GW + AL((size_t)1024 * 8 * 4);
constexpr size_t WS_XCNT = WS_CTR + 4096;
constexpr size_t WS_RSB = WS_XCNT + 80 * 256;
constexpr size_t WS_RSS = WS_RSB + AL((size_t)NPR * 4 * 4);
constexpr size_t WS_END = WS_RSS + AL((size_t)NSA * 16 * 4);
static_assert((size_t)32 * 31 * 65536 * 2 <= (size_t)MROWS * DFF * 2, "Cst fits in act region");
static_assert(WS_END <= (size_t)536870912, "workspace map exceeds 512 MiB");

struct Params {
    const float *x_p, *x_s, *st_pool, *st_C, *st_n, *st_m, *c_p, *c_s, *g_mix, *g_ffn, *w_ada, *b_ada, *w_in, *b_i, *b_f, *w_pg, *pool_scale, *w_po, *m_norm, *w_mo, *w_out, *w1, *w2, *g_final;
    float* out; unsigned char* ws; int ph_lo, ph_hi;
};

typedef float f32x2 __attribute__((ext_vector_type(2)));
typedef __bf16 bf16x2_t __attribute__((ext_vector_type(2)));
__device__ __forceinline__ unsigned pk_bf16(float lo, float hi) { f32x2 v = {lo, hi}; bf16x2_t b = __builtin_convertvector(v, bf16x2_t); return __builtin_bit_cast(unsigned, b); }
__device__ __forceinline__ float bf2f(unsigned v) { return __uint_as_float(v << 16); }
__device__ __forceinline__ float bflo(unsigned v) { return __uint_as_float(v << 16); }
__device__ __forceinline__ float bfhi(unsigned v) { return __uint_as_float(v & 0xffff0000u); }
__device__ __forceinline__ bf16_t f2bf(float f) { return (bf16_t)(pk_bf16(f, 0.f) & 0xffffu); }
__device__ __forceinline__ float sigmoidf_(float x) { return __builtin_amdgcn_rcpf(1.f + __expf(-x)); }
__device__ __forceinline__ int row_batch(int row) { return row < NPR ? (row >> 11) : 8 + ((row - NPR) >> 2); }
__device__ __forceinline__ float wave_sum(float v) {
#pragma unroll
    for (int d = 32; d >= 1; d >>= 1) v += __shfl_xor(v, d);
    return v;
}
__device__ __forceinline__ float wave_max(float v) {
#pragma unroll
    for (int d = 32; d >= 1; d >>= 1) v = fmaxf(v, __shfl_xor(v, d));
    return v;
}
__device__ __forceinline__ float wave_scan_add(float v, int lane) {
#pragma unroll
    for (int d = 1; d < 64; d <<= 1) { float t = __shfl_up(v, d); if (lane >= d) v += t; }
    return v;
}
__device__ __forceinline__ float wave_scan_max(float v, int lane) {
#pragma unroll
    for (int d = 1; d < 64; d <<= 1) { float t = __shfl_up(v, d); if (lane >= d) v = fmaxf(v, t); }
    return v;
}
__device__ __forceinline__ int otid() { int t = threadIdx.x; asm volatile("" : "+v"(t)); return t; }
#define MFMA16(a, b, c) __builtin_amdgcn_mfma_f32_16x16x32_bf16((a), (b), (c), 0, 0, 0)

#define LAS __attribute__((address_space(3)))
constexpr int BM = 256, BK = 64, HALF = 128, HTB = HALF * BK * 2, NXCD = 8, WGM = 8;
__device__ __forceinline__ int lds_byte(int r, int c) {
    const int st = (r >> 4) * 2 + (c >> 5), rr = r & 15, cc = c & 31, ob = rr * 64 + cc * 2;
    return st * 1024 + (ob ^ (((ob >> 9) & 1) << 5));
}
__device__ __forceinline__ void stage_rc(int b, int& R, int& C) {
    const int st = b / 1024, sb = b % 1024, swz = sb ^ (((sb >> 9) & 1) << 5);
    R = (st >> 1) * 16 + swz / 64; C = (st & 1) * 32 + (swz % 64) / 2;
}
__device__ __forceinline__ int perm32(int rho) { const int n = rho >> 4, i = rho & 15; return 8 * (i >> 2) + 4 * n + (i & 3); }
struct Unit { int pm, pn; };
struct StaticOrder {
    int nM, nN, nwg, G, c;
    __device__ void init(int M, int N, int G_, int c_) { nM = M / BM; nN = N / BM; nwg = nM * nN; G = G_; c = c_; }
    __device__ bool next(int i, Unit& u) const {
        const long L = (long)i * G + c; if (L >= nwg) return false;
        int wgid = (int)L; { const int q = nwg / NXCD, r = nwg % NXCD, xcd = wgid % NXCD, off = wgid / NXCD; wgid = (xcd < r ? xcd * (q + 1) : r * (q + 1) + (xcd - r) * q) + off; }
        const int nig = WGM * nN, gid = wgid / nig, fm = gid * WGM, gsz = (nM - fm) < WGM ? (nM - fm) : WGM;
        u.pm = fm + ((wgid % nig) % gsz); u.pn = (wgid % nig) / gsz; return true;
    }
};

template <class Epi, bool FUSED = false>
__device__ __forceinline__ void gemm_phase(LAS unsigned char* lds, const bf16_t* gA, const bf16_t* gBt, const int N, const int K, const Epi& E, unsigned char* lds_gen = nullptr) {
    const int tid = otid(), wid = __builtin_amdgcn_readfirstlane(tid >> 6), lane = tid & 63, wr = wid >> 2, wc = wid & 3, fr = lane & 15, fq = lane >> 4;
    const int nt = K / BK;
    StaticOrder S; S.init(NPR, N, gridDim.x, blockIdx.x);
    unsigned voffA[2], voffB[2];
#pragma unroll
    for (int i = 0; i < 2; ++i) { int R, C; stage_rc(tid * 16 + i * 8192, R, C); const int Rb = (R & ~31) + perm32(R & 31); voffA[i] = (unsigned)(R * K + C) * 2u; voffB[i] = (unsigned)(Rb * K + C) * 2u; }
    const size_t kstep = (size_t)(BK * 2);
    const size_t hstep = (size_t)HALF * K * 2;
    const size_t tstep = 2 * hstep;
    const unsigned ldsw = (unsigned)wid * 1024u;
    const int aoff = lds_byte(wr * 64 + fr, fq * 8), boff = lds_byte(wc * 32 + fr, fq * 8);
#define PG8_SA(b, h) (((b) * 2 + (h)) * HTB)
#define PG8_SB(b, h) ((4 + (b) * 2 + (h)) * HTB)
#define PG8_STAGE(bufoff, gbase) PG8_STAGEV(bufoff, gbase, voffA)
#define PG8_STAGEB(bufoff, gbase) PG8_STAGEV(bufoff, gbase, voffB)
#define PG8_STAGEV(bufoff, gbase, voff) do { _Pragma("unroll") for (int _i = 0; _i < 2; ++_i) \
        __builtin_amdgcn_global_load_lds((const unsigned*)((const char*)(gbase) + (voff)[_i]), (LAS unsigned*)(lds + (bufoff) + ldsw + _i * 8192), 16, 0, 0); } while (0)
#define PG8_LDA(dst, b, h) do { _Pragma("unroll") for (int m = 0; m < 4; ++m) _Pragma("unroll") for (int k = 0; k < 2; ++k) dst[m][k] = *(const LAS bf16x8*)(lds + PG8_SA(b, h) + aoff + m * 2048 + k * 1024); } while (0)
#define PG8_LDB(dst, b, h) do { _Pragma("unroll") for (int n = 0; n < 2; ++n) _Pragma("unroll") for (int k = 0; k < 2; ++k) dst[n][k] = *(const LAS bf16x8*)(lds + PG8_SB(b, h) + boff + n * 2048 + k * 1024); } while (0)
#define PG8_MMA(ai, bj, At, Bt) do { __builtin_amdgcn_s_setprio(1); _Pragma("unroll") for (int m = 0; m < 4; ++m) _Pragma("unroll") for (int n = 0; n < 2; ++n) _Pragma("unroll") for (int k = 0; k < 2; ++k) \
        acc[ai][bj][m][n] = __builtin_amdgcn_mfma_f32_16x16x32_bf16(Bt[n][k], At[m][k], acc[ai][bj][m][n], 0, 0, 0); __builtin_amdgcn_s_setprio(0); } while (0)
#define PG8_WAIT_V(n) asm volatile("s_waitcnt vmcnt(" #n ")" ::: "memory")
#define PG8_WAIT_L(n) asm volatile("s_waitcnt lgkmcnt(" #n ")" ::: "memory")
#define PG8_BAR __builtin_amdgcn_s_barrier()
#define PG8_SCHED __builtin_amdgcn_sched_barrier(0)
    Unit cur, nxt; int ui = 0;
    if (!S.next(0, cur)) return;
    f32x4 acc[2][2][4][2];
#pragma unroll
    for (int a = 0; a < 2; ++a)
#pragma unroll
        for (int b = 0; b < 2; ++b)
#pragma unroll
            for (int m = 0; m < 4; ++m)
#pragma unroll
                for (int n = 0; n < 2; ++n) acc[a][b][m][n] = (f32x4){0.f, 0.f, 0.f, 0.f};
    bf16x8 At[4][2], B0[2][2], B1[2][2];
    const char* cA = (const char*)gA + (size_t)cur.pm * tstep; const char* cB = (const char*)gBt + (size_t)cur.pn * tstep;
    PG8_STAGEB(PG8_SB(0, 0), cB); PG8_STAGE(PG8_SA(0, 0), cA); PG8_STAGEB(PG8_SB(0, 1), cB + hstep); PG8_STAGE(PG8_SA(0, 1), cA + hstep);
    if (wr == 1) PG8_BAR;
    PG8_WAIT_V(4); PG8_BAR;
    PG8_STAGEB(PG8_SB(1, 0), cB + kstep); PG8_STAGE(PG8_SA(1, 0), cA + kstep); PG8_STAGEB(PG8_SB(1, 1), cB + hstep + kstep);
    PG8_WAIT_V(6); PG8_BAR;
    for (;;) {
        const bool has_next = S.next(ui + 1, nxt);
        const char* nA = has_next ? (const char*)gA + (size_t)nxt.pm * tstep : cA; const char* nB = has_next ? (const char*)gBt + (size_t)nxt.pn * tstep : cB;
        for (int t = 0; t < nt; t += 2) {
            const bool last = (t == nt - 2);
            const char* a1 = cA + (size_t)(t + 1) * kstep;
            const char* a2 = last ? nA : cA + (size_t)(t + 2) * kstep; const char* b2 = last ? nB : cB + (size_t)(t + 2) * kstep;
            const char* a3 = a2 + kstep; const char* b3 = b2 + kstep;
            PG8_LDB(B0, 0, 0); PG8_SCHED; PG8_LDA(At, 0, 0); PG8_STAGE(PG8_SA(1, 1), a1 + hstep);
            PG8_WAIT_L(8); PG8_BAR; PG8_WAIT_L(0); PG8_MMA(0, 0, At, B0); PG8_BAR; PG8_SCHED;
            PG8_LDB(B1, 0, 1); PG8_STAGEB(PG8_SB(0, 0), b2);
            PG8_BAR; PG8_WAIT_L(0); PG8_MMA(0, 1, At, B1); PG8_BAR;
            PG8_LDA(At, 0, 1); PG8_STAGE(PG8_SA(0, 0), a2);
            PG8_BAR; PG8_WAIT_L(0); PG8_MMA(1, 0, At, B0); PG8_BAR; PG8_SCHED;
            PG8_STAGEB(PG8_SB(0, 1), b2 + hstep);
            PG8_WAIT_V(6); PG8_BAR; PG8_MMA(1, 1, At, B1); PG8_BAR;
            PG8_LDB(B0, 1, 0); PG8_SCHED; PG8_LDA(At, 1, 0); PG8_STAGE(PG8_SA(0, 1), a2 + hstep);
            PG8_WAIT_L(8); PG8_BAR; PG8_WAIT_L(0); PG8_MMA(0, 0, At, B0); PG8_BAR; PG8_SCHED;
            PG8_LDB(B1, 1, 1); PG8_STAGEB(PG8_SB(1, 0), b3);
            PG8_BAR; PG8_WAIT_L(0); PG8_MMA(0, 1, At, B1); PG8_BAR;
            PG8_LDA(At, 1, 1); PG8_STAGE(PG8_SA(1, 0), a3);
            PG8_BAR; PG8_WAIT_L(0); PG8_MMA(1, 0, At, B0); PG8_BAR; PG8_SCHED;
            PG8_STAGEB(PG8_SB(1, 1), b3 + hstep);
            PG8_WAIT_V(6); PG8_BAR; PG8_MMA(1, 1, At, B1); PG8_BAR;
        }
        if constexpr (!FUSED) { const int r0 = cur.pm * BM + wr * 64 + fr, c0 = cur.pn * BM + wc * 32 + fq * 8;
#pragma unroll
          for (int ai = 0; ai < 2; ++ai)
#pragma unroll
            for (int m = 0; m < 4; ++m)
#pragma unroll
              for (int bj = 0; bj < 2; ++bj) E.apply8(r0 + ai * 128 + m * 16, c0 + bj * 128, acc[ai][bj][m][0], acc[ai][bj][m][1]); }
        if (!has_next) break;
#pragma unroll
        for (int a = 0; a < 2; ++a)
#pragma unroll
            for (int b = 0; b < 2; ++b)
#pragma unroll
                for (int m = 0; m < 4; ++m)
#pragma unroll
                    for (int n = 0; n < 2; ++n) acc[a][b][m][n] = (f32x4){0.f, 0.f, 0.f, 0.f};
        cur = nxt; cA = nA; cB = nB; ++ui;
    }
    PG8_WAIT_V(0);
    if (wr == 0) PG8_BAR;
    PG8_BAR;
    if constexpr (FUSED) E.fused(acc, cur, wr, wc, fr, fq, lds_gen);
#undef PG8_SA
#undef PG8_SB
#undef PG8_STAGE
#undef PG8_STAGEB
#undef PG8_STAGEV
#undef PG8_LDA
#undef PG8_LDB
#undef PG8_MMA
#undef PG8_WAIT_V
#undef PG8_WAIT_L
#undef PG8_BAR
#undef PG8_SCHED
}

struct EpiG1 {
    float* u; bf16_t* qkv;
    __device__ __forceinline__ void apply(int row, int col, f32x4 v) const {
        const int bcol = col & ~255;
        const int seg = bcol < 512 ? 0 : 1 + ((bcol - 512) >> 10);
        if (seg == 0) { *(f32x4*)(u + (size_t)row * 512 + col) = v; }
        else {
            const int cc = col - 512 - (seg - 1) * 1024;
            if (seg == 2) v *= 0.0625f;
            if (seg >= 4) { v[0] = sigmoidf_(v[0]); v[1] = sigmoidf_(v[1]); v[2] = sigmoidf_(v[2]); v[3] = sigmoidf_(v[3]); }
            u32x2 w; w.x = pk_bf16(v[0], v[1]); w.y = pk_bf16(v[2], v[3]);
            *(u32x2*)(qkv + (size_t)(seg - 1) * MROWS * DM + (size_t)row * DM + cc) = w;
        }
    }
    __device__ __forceinline__ void apply8(int row, int col, f32x4 v0, f32x4 v1) const {
        const int bcol = col & ~255;
        const int seg = bcol < 512 ? 0 : 1 + ((bcol - 512) >> 10);
        if (seg == 0) { *(f32x4*)(u + (size_t)row * 512 + col) = v0; *(f32x4*)(u + (size_t)row * 512 + col + 4) = v1; }
        else {
            const int cc = col - 512 - (seg - 1) * 1024;
            if (seg == 2) { v0 *= 0.0625f; v1 *= 0.0625f; }
            if (seg >= 4) {
#pragma unroll
                for (int j = 0; j < 4; ++j) { v0[j] = sigmoidf_(v0[j]); v1[j] = sigmoidf_(v1[j]); } }
            u32x4 w; w.x = pk_bf16(v0[0], v0[1]); w.y = pk_bf16(v0[2], v0[3]); w.z = pk_bf16(v1[0], v1[1]); w.w = pk_bf16(v1[2], v1[3]);
            *(u32x4*)(qkv + (size_t)(seg - 1) * MROWS * DM + (size_t)row * DM + cc) = w;
        }
    }
};
struct EpiMerge {
    bf16_t* merged; const bf16_t* sg; int mode;
    __device__ __forceinline__ void apply(int row, int col, f32x4 v) const {
        const size_t idx = (size_t)row * DM + col;
        const u32x2 g = *(const u32x2*)(sg + idx);
        v[0] *= bflo(g.x); v[1] *= bfhi(g.x); v[2] *= bflo(g.y); v[3] *= bfhi(g.y);
        if (mode) { const u32x2 o = *(const u32x2*)(merged + idx); v[0] += bflo(o.x); v[1] += bfhi(o.x); v[2] += bflo(o.y); v[3] += bfhi(o.y); }
        u32x2 w; w.x = pk_bf16(v[0], v[1]); w.y = pk_bf16(v[2], v[3]);
        *(u32x2*)(merged + idx) = w;
    }
    __device__ __forceinline__ void apply8(int row, int col, f32x4 v0, f32x4 v1) const {
        const size_t idx = (size_t)row * DM + col;
        const u32x4 g = *(const u32x4*)(sg + idx);
        v0[0] *= bflo(g.x); v0[1] *= bfhi(g.x); v0[2] *= bflo(g.y); v0[3] *= bfhi(g.y); v1[0] *= bflo(g.z); v1[1] *= bfhi(g.z); v1[2] *= bflo(g.w); v1[3] *= bfhi(g.w);
        if (mode) { const u32x4 o = *(const u32x4*)(merged + idx); v0[0] += bflo(o.x); v0[1] += bfhi(o.x); v0[2] += bflo(o.y); v0[3] += bfhi(o.y); v1[0] += bflo(o.z); v1[1] += bfhi(o.z); v1[2] += bflo(o.w); v1[3] += bfhi(o.w); }
        u32x4 w; w.x = pk_bf16(v0[0], v0[1]); w.y = pk_bf16(v0[2], v0[3]); w.z = pk_bf16(v1[0], v1[1]); w.w = pk_bf16(v1[2], v1[3]);
        *(u32x4*)(merged + idx) = w;
    }
};
struct EpiRes {
    float* out; const float* xp; const float* xs; const float* ada; int gate_off; int xin;
    __device__ __forceinline__ void apply(int row, int col, f32x4 v) const {
        const f32x4 g = *(const f32x4*)(ada + (size_t)row_batch(row) * ADAW + gate_off + col);
        const float* bp = xin ? (row < NPR ? xp + (size_t)row * DM : xs + (size_t)(row - NPR) * DM) : out + (size_t)row * DM;
        const f32x4 b = *(const f32x4*)(bp + col);
        *(f32x4*)(out + (size_t)row * DM + col) = b + g * v;
    }
    __device__ __forceinline__ void apply8(int row, int col, f32x4 v0, f32x4 v1) const { apply(row, col, v0); apply(row, col + 4, v1); }
};
struct EpiAct {
    bf16_t* act;
    __device__ __forceinline__ void apply(int row, int col, f32x4 v) const {
#pragma unroll
        for (int j = 0; j < 4; ++j) { float t = fmaxf(v[j], 0.f); v[j] = t * t; }
        u32x2 w; w.x = pk_bf16(v[0], v[1]); w.y = pk_bf16(v[2], v[3]);
        *(u32x2*)(act + (size_t)row * DFF + col) = w;
    }
    __device__ __forceinline__ void apply8(int row, int col, f32x4 v0, f32x4 v1) const {
#pragma unroll
        for (int j = 0; j < 4; ++j) { float t0 = fmaxf(v0[j], 0.f); v0[j] = t0 * t0; float t1 = fmaxf(v1[j], 0.f); v1[j] = t1 * t1; }
        u32x4 w; w.x = pk_bf16(v0[0], v0[1]); w.y = pk_bf16(v0[2], v0[3]); w.z = pk_bf16(v1[0], v1[1]); w.w = pk_bf16(v1[2], v1[3]);
        *(u32x4*)(act + (size_t)row * DFF + col) = w;
    }
};

__device__ __forceinline__ void xchg_publish_wait(unsigned* cnt, unsigned need) {
    asm volatile("s_waitcnt vmcnt(0)" ::: "memory");
    __syncthreads();
    if (threadIdx.x == 0) {
        __builtin_amdgcn_fence(__ATOMIC_RELEASE, "agent");
        asm volatile("s_waitcnt vmcnt(0)" ::: "memory");
        __hip_atomic_fetch_add(cnt, 1u, __ATOMIC_RELAXED, __HIP_MEMORY_SCOPE_AGENT);
        unsigned spins = 0;
        while (__hip_atomic_load(cnt, __ATOMIC_RELAXED, __HIP_MEMORY_SCOPE_AGENT) < need) { __builtin_amdgcn_s_sleep(1); if (++spins > (1u << 24)) break; }
        __builtin_amdgcn_fence(__ATOMIC_ACQUIRE, "agent");
        asm volatile("s_waitcnt vmcnt(0)" ::: "memory");
    }
    __syncthreads();
}
extern __shared__ __attribute__((aligned(16))) unsigned char g_dyn_lds[];
struct EpiFinal {
    float* out; const float* ada; const float* gfin; float* rowpart; unsigned* cnt; float* rowpartS; unsigned* cntS;
    __device__ __forceinline__ void apply(int, int, f32x4) const {}
    __device__ __forceinline__ void apply8(int, int, f32x4, f32x4) const {}
    __device__ __forceinline__ void fused(f32x4 (&acc)[2][2][4][2], const Unit& u, int wr, int wc, int fr, int fq, unsigned char* lds) const {
        const int tid = otid();
        (void)lds;
        float* P = (float*)g_dyn_lds;
        float* S = P + 1024;
        const int r0 = u.pm * BM + wr * 64 + fr, c0 = u.pn * BM + wc * 32 + fq * 8;
#pragma unroll
        for (int ai = 0; ai < 2; ++ai)
#pragma unroll
            for (int m = 0; m < 4; ++m) {
                const int row = r0 + ai * 128 + m * 16;
                const float* ga = ada + (size_t)row_batch(row) * ADAW + 5120;
                float ss = 0.f;
#pragma unroll
                for (int bj = 0; bj < 2; ++bj)
#pragma unroll
                    for (int n = 0; n < 2; ++n) {
                        const int col = c0 + bj * 128 + n * 4;
                        const f32x4 g = *(const f32x4*)(ga + col);
                        const f32x4 b = *(const f32x4*)(out + (size_t)row * DM + col);
                        const f32x4 v = b + g * acc[ai][bj][m][n];
                        acc[ai][bj][m][n] = v;
                        ss += v[0] * v[0] + v[1] * v[1] + v[2] * v[2] + v[3] * v[3];
                    }
                ss += __shfl_xor(ss, 16); ss += __shfl_xor(ss, 32);
                if (fq == 0) P[(ai * 128 + wr * 64 + m * 16 + fr) * 4 + wc] = ss;
                asm volatile("" ::: "memory");
            }
        __syncthreads();
        if (tid < 256) rowpart[((size_t)u.pm * BM + tid) * 4 + u.pn] = (P[tid * 4] + P[tid * 4 + 1]) + (P[tid * 4 + 2] + P[tid * 4 + 3]);
        xchg_publish_wait(cnt + u.pm * 64, 8u);
        if (tid < 256) { const f32x4 rp = *(const f32x4*)(rowpart + ((size_t)u.pm * BM + tid) * 4); S[tid] = rsqrtf(((rp[0] + rp[1]) + (rp[2] + rp[3])) * (1.0f / DM) + EPS); }
        __syncthreads();
#pragma unroll
        for (int ai = 0; ai < 2; ++ai)
#pragma unroll
            for (int m = 0; m < 4; ++m) {
                const int row = r0 + ai * 128 + m * 16;
                const float rs = S[ai * 128 + wr * 64 + m * 16 + fr];
#pragma unroll
                for (int bj = 0; bj < 2; ++bj)
#pragma unroll
                    for (int n = 0; n < 2; ++n) {
                        const int col = c0 + bj * 128 + n * 4;
                        const f32x4 gf = *(const f32x4*)(gfin + col);
                        __builtin_nontemporal_store(acc[ai][bj][m][n] * rs * gf, (f32x4*)(out + (size_t)row * DM + col));
                    }
            }
        __syncthreads();
    }
};

struct EpiMid {
    float* out; const float* xp; const float* xs; const float* ada; const float* gffn; bf16_t* hbuf; float* rowpart; unsigned* cnt; float* rowpartS; unsigned* cntS;
    __device__ __forceinline__ void apply(int, int, f32x4) const {}
    __device__ __forceinline__ void apply8(int, int, f32x4, f32x4) const {}
    __device__ __forceinline__ void fused(f32x4 (&acc)[2][2][4][2], const Unit& u, int wr, int wc, int fr, int fq, unsigned char*) const {
        const int tid = otid();
        float* P = (float*)g_dyn_lds;
        float* S = P + 1024;
        const int r0 = u.pm * BM + wr * 64 + fr, c0 = u.pn * BM + wc * 32 + fq * 8;
#pragma unroll
        for (int ai = 0; ai < 2; ++ai)
#pragma unroll
            for (int m = 0; m < 4; ++m) {
                const int row = r0 + ai * 128 + m * 16;
                const float* ga = ada + (size_t)(row >> 11) * ADAW + 2048;
                float ss = 0.f;
#pragma unroll
                for (int bj = 0; bj < 2; ++bj)
#pragma unroll
                    for (int n = 0; n < 2; ++n) {
                        const int col = c0 + bj * 128 + n * 4;
                        const f32x4 g = *(const f32x4*)(ga + col);
                        const f32x4 b = *(const f32x4*)(xp + (size_t)row * DM + col);
                        const f32x4 v = b + g * acc[ai][bj][m][n];
                        acc[ai][bj][m][n] = v;
                        *(f32x4*)(out + (size_t)row * DM + col) = v;
                        ss += v[0] * v[0] + v[1] * v[1] + v[2] * v[2] + v[3] * v[3];
                    }
                ss += __shfl_xor(ss, 16); ss += __shfl_xor(ss, 32);
                if (fq == 0) P[(ai * 128 + wr * 64 + m * 16 + fr) * 4 + wc] = ss;
                asm volatile("" ::: "memory");
            }
        __syncthreads();
        if (tid < 256) rowpart[((size_t)u.pm * BM + tid) * 4 + u.pn] = (P[tid * 4] + P[tid * 4 + 1]) + (P[tid * 4 + 2] + P[tid * 4 + 3]);
        xchg_publish_wait(cnt + u.pm * 64, 4u);
        if (tid < 256) { const f32x4 rp = *(const f32x4*)(rowpart + ((size_t)u.pm * BM + tid) * 4); S[tid] = rsqrtf(((rp[0] + rp[1]) + (rp[2] + rp[3])) * (1.0f / DM) + EPS); }
        __syncthreads();
        const float* ab = ada + (size_t)(r0 >> 11) * ADAW;
#pragma unroll
        for (int bj = 0; bj < 2; ++bj) {
            const int col = c0 + bj * 128;
            f32x4 G0 = *(const f32x4*)(gffn + col), G1 = *(const f32x4*)(gffn + col + 4);
            G0 *= (*(const f32x4*)(ab + 4096 + col) + 1.0f); G1 *= (*(const f32x4*)(ab + 4096 + col + 4) + 1.0f);
            const f32x4 S0 = *(const f32x4*)(ab + 3072 + col), S1 = *(const f32x4*)(ab + 3072 + col + 4);
#pragma unroll
            for (int ai = 0; ai < 2; ++ai)
#pragma unroll
                for (int m = 0; m < 4; ++m) {
                    const int row = r0 + ai * 128 + m * 16;
                    const float rs = S[ai * 128 + wr * 64 + m * 16 + fr];
                    const f32x4 h0 = acc[ai][bj][m][0] * rs * G0 + S0, h1 = acc[ai][bj][m][1] * rs * G1 + S1;
                    u32x4 w; w.x = pk_bf16(h0[0], h0[1]); w.y = pk_bf16(h0[2], h0[3]); w.z = pk_bf16(h1[0], h1[1]); w.w = pk_bf16(h1[2], h1[3]);
                    *(u32x4*)(hbuf + (size_t)row * DM + col) = w;
                }
        }
        __syncthreads();
    }
};

template <class Epi, int FIN = 0>
__device__ __forceinline__ void small_gemm_phase(unsigned char* lds, const bf16_t* gA, const bf16_t* gBt, const int N, const int K, const Epi& E, const int t_begin, const int t_end) {
    int tid_ = threadIdx.x; asm volatile("" : "+v"(tid_));
    const int tid = tid_, lane = tid & 63, w = tid >> 6, fr = lane & 15, fq = lane >> 4;
    const int kw = K / 8;
    float* red = (float*)lds;
    for (int t = t_begin; t < t_end; ++t) {
        const int rt = t & 15, ct = t >> 4;
        const int row0 = NPR + rt * 32, col0 = ct * 64;
        const bf16_t* ap = gA + (size_t)(row0 + fr) * K + w * kw + fq * 8;
        const bf16_t* bp = gBt + (size_t)(col0 + fr) * K + w * kw + fq * 8;
        f32x4 acc[2][4] = {};
#pragma unroll 2
        for (int k0 = 0; k0 < kw; k0 += 64) {
            bf16x8 af[2][2], bfm[2][4];
#pragma unroll
            for (int s2 = 0; s2 < 2; ++s2) {
#pragma unroll
                for (int m = 0; m < 2; ++m) af[s2][m] = *(const bf16x8*)(ap + (size_t)m * 16 * K + k0 + s2 * 32);
#pragma unroll
                for (int n = 0; n < 4; ++n) bfm[s2][n] = *(const bf16x8*)(bp + (size_t)n * 16 * K + k0 + s2 * 32);
            }
#pragma unroll
            for (int s2 = 0; s2 < 2; ++s2)
#pragma unroll
                for (int m = 0; m < 2; ++m)
#pragma unroll
                    for (int n = 0; n < 4; ++n) acc[m][n] = MFMA16(bfm[s2][n], af[s2][m], acc[m][n]);
        }
#pragma unroll
        for (int m = 0; m < 2; ++m)
#pragma unroll
            for (int n = 0; n < 4; ++n) *(f32x4*)(red + ((w * 32 + m * 16 + fr) * 64 + n * 16 + fq * 4)) = acc[m][n];
        __syncthreads();
        {
            const int r = tid >> 4, c4 = (tid & 15) * 4;
            f32x4 v = *(const f32x4*)(red + (r * 64 + c4));
#pragma unroll
            for (int ww = 1; ww < 8; ++ww) v += *(const f32x4*)(red + ((ww * 32 + r) * 64 + c4));
            if constexpr (FIN == 0) E.apply(row0 + r, col0 + c4, v);
            else if constexpr (FIN == 2) {
                const int row = row0 + r, col = col0 + c4;
                const float* ab = E.ada + (size_t)row_batch(row) * ADAW;
                const f32x4 g = *(const f32x4*)(ab + 2048 + col);
                const f32x4 b = *(const f32x4*)(E.xs + (size_t)(row - NPR) * DM + col);
                const f32x4 x1 = b + g * v;
                *(f32x4*)(E.out + (size_t)row * DM + col) = x1;
                float ss = x1[0] * x1[0] + x1[1] * x1[1] + x1[2] * x1[2] + x1[3] * x1[3];
                ss += __shfl_xor(ss, 1); ss += __shfl_xor(ss, 2); ss += __shfl_xor(ss, 4); ss += __shfl_xor(ss, 8);
                if ((tid & 15) == 0) E.rowpartS[(size_t)(row - NPR) * 16 + ct] = ss;
                xchg_publish_wait(E.cntS + rt * 64, 16u);
                const float* rp = E.rowpartS + (size_t)(row - NPR) * 16;
                float tot = 0.f;
#pragma unroll
                for (int q = 0; q < 16; q += 4) { const f32x4 t4 = *(const f32x4*)(rp + q); tot += (t4[0] + t4[1]) + (t4[2] + t4[3]); }
                const float rs = rsqrtf(tot * (1.0f / DM) + EPS);
                const f32x4 G = *(const f32x4*)(E.gffn + col) * (*(const f32x4*)(ab + 4096 + col) + 1.0f);
                const f32x4 h = x1 * rs * G + *(const f32x4*)(ab + 3072 + col);
                u32x2 wv; wv.x = pk_bf16(h[0], h[1]); wv.y = pk_bf16(h[2], h[3]);
                *(u32x2*)(E.hbuf + (size_t)row * DM + col) = wv;
            }
            else {
                const int row = row0 + r, col = col0 + c4;
                const f32x4 g = *(const f32x4*)(E.ada + (size_t)row_batch(row) * ADAW + 5120 + col);
                const f32x4 b = *(const f32x4*)(E.out + (size_t)row * DM + col);
                const f32x4 x2 = b + g * v;
                float ss = x2[0] * x2[0] + x2[1] * x2[1] + x2[2] * x2[2] + x2[3] * x2[3];
                ss += __shfl_xor(ss, 1); ss += __shfl_xor(ss, 2); ss += __shfl_xor(ss, 4); ss += __shfl_xor(ss, 8);
                if ((tid & 15) == 0) E.rowpartS[(size_t)(row - NPR) * 16 + ct] = ss;
                xchg_publish_wait(E.cntS + rt * 64, 32u);
                const float* rp = E.rowpartS + (size_t)(row - NPR) * 16;
                float tot = 0.f;
#pragma unroll
                for (int q = 0; q < 16; q += 4) { const f32x4 t4 = *(const f32x4*)(rp + q); tot += (t4[0] + t4[1]) + (t4[2] + t4[3]); }
                const float rs = rsqrtf(tot * (1.0f / DM) + EPS);
                const f32x4 gf = *(const f32x4*)(E.gfin + col);
                *(f32x4*)(E.out + (size_t)row * DM + col) = x2 * rs * gf;
            }
        }
        __syncthreads();
    }
}

__device__ __forceinline__ void conv_tile(const float* __restrict__ src, int ld, int K, bf16_t* __restrict__ dst, int kt, int ntile, int src_col0, float* lds) {
    const int tid = otid();
    const int k0 = kt * 64, n0 = ntile * 64;
#pragma unroll
    for (int i = 0; i < 2; ++i) {
        const int r = (tid >> 4) + i * 32, c4 = (tid & 15) * 4;
        const f32x4 v = *(const f32x4*)(src + (size_t)(k0 + r) * ld + src_col0 + c4);
        lds[r * 65 + c4 + 0] = v[0]; lds[r * 65 + c4 + 1] = v[1]; lds[r * 65 + c4 + 2] = v[2]; lds[r * 65 + c4 + 3] = v[3];
    }
    __syncthreads();
    {
        const int n = tid >> 3, k8 = (tid & 7) * 8;
        float v[8];
#pragma unroll
        for (int i = 0; i < 8; ++i) v[i] = lds[(k8 + i) * 65 + n];
        u32x4 w; w.x = pk_bf16(v[0], v[1]); w.y = pk_bf16(v[2], v[3]); w.z = pk_bf16(v[4], v[5]); w.w = pk_bf16(v[6], v[7]);
        *(u32x4*)(dst + (size_t)(n0 + n) * K + k0 + k8) = w;
    }
    __syncthreads();
}

__device__ __forceinline__ void conv_strip(const float* __restrict__ src, int ld, int K, bf16_t* __restrict__ dst, int kt, int nt4, int src_col0, float* lds) {
    const int tid = otid();
    const int k0 = kt * 64, n0 = nt4 * 256;
    f32x4 v[8];
#pragma unroll
    for (int i = 0; i < 8; ++i) { const int r = (tid >> 6) + i * 8, c4 = (tid & 63) * 4; v[i] = __builtin_nontemporal_load((const f32x4*)(src + (size_t)(k0 + r) * ld + src_col0 + c4)); }
#pragma unroll
    for (int i = 0; i < 8; ++i) { const int r = (tid >> 6) + i * 8, c4 = (tid & 63) * 4;
        lds[r * 257 + c4 + 0] = v[i][0]; lds[r * 257 + c4 + 1] = v[i][1]; lds[r * 257 + c4 + 2] = v[i][2]; lds[r * 257 + c4 + 3] = v[i][3]; }
    __syncthreads();
#pragma unroll
    for (int j = 0; j < 4; ++j) {
        const int n = (tid >> 3) + j * 64, k8 = (tid & 7) * 8;
        float x[8];
#pragma unroll
        for (int i = 0; i < 8; ++i) x[i] = lds[(k8 + i) * 257 + n];
        u32x4 w; w.x = pk_bf16(x[0], x[1]); w.y = pk_bf16(x[2], x[3]); w.z = pk_bf16(x[4], x[5]); w.w = pk_bf16(x[6], x[7]);
        *(u32x4*)(dst + (size_t)(n0 + n) * K + k0 + k8) = w;
    }
    __syncthreads();
}

__device__ __forceinline__ void ada_item(const Params& p, int item, float* lds) {
    const int tid = otid(), lane = tid & 63, w = tid >> 6;
    const int cg_ = item >> 3, kq = item & 7;
    const int n0 = cg_ * 128 + lane * 2;
    const int kbase = kq * 128;
    f32x2 acc[17];
#pragma unroll
    for (int r = 0; r < 17; ++r) acc[r] = (f32x2){0.f, 0.f};
    f32x2 wv[16];
#pragma unroll
    for (int j = 0; j < 16; ++j) wv[j] = __builtin_nontemporal_load((const f32x2*)(p.w_ada + (size_t)(kbase + j) * ADAW + n0));
    for (int e = tid; e < NBATCH * 32; e += NTH) {
        const int r = e >> 5, k4 = (e & 31) * 4;
        const float* cp = r < 8 ? p.c_p + (size_t)r * DM : p.c_s + (size_t)(r - 8) * DM;
        f32x4 v = *(const f32x4*)(cp + kbase + k4);
#pragma unroll
        for (int j = 0; j < 4; ++j) v[j] = v[j] * sigmoidf_(v[j]);
        *(f32x4*)(lds + r * 128 + k4) = v;
    }
    __syncthreads();
#pragma unroll 1
    for (int kb = 0; kb < 128; kb += 16) {
        f32x2 wn[16];
        if (kb + 16 < 128) {
#pragma unroll
            for (int j = 0; j < 16; ++j) wn[j] = __builtin_nontemporal_load((const f32x2*)(p.w_ada + (size_t)(kbase + kb + 16 + j) * ADAW + n0));
        }
#pragma unroll
        for (int r = 0; r < 17; ++r) {
#pragma unroll
            for (int k4 = 0; k4 < 16; k4 += 4) {
                const f32x4 sv = *(const f32x4*)(lds + (w * 17 + r) * 128 + kb + k4);
                acc[r] += wv[k4] * sv[0]; acc[r] += wv[k4 + 1] * sv[1]; acc[r] += wv[k4 + 2] * sv[2]; acc[r] += wv[k4 + 3] * sv[3];
            }
        }
        if (kb + 16 < 128) {
#pragma unroll
            for (int j = 0; j < 16; ++j) wv[j] = wn[j];
        }
    }
    __syncthreads();
    float* part = (float*)(p.ws + WS_ADAP) + (size_t)kq * NBATCH * ADAW;
#pragma unroll
    for (int r = 0; r < 17; ++r) *(f32x2*)(part + (size_t)(w * 17 + r) * ADAW + n0) = acc[r];
}

__device__ __forceinline__ void phase0(const Params& p, float* lds) {
    const int NADA = 48 * 8;
    const int T_IN = 16 * 26, T_PG = 16, T_PO = 8 * 4, T_MO = 64, T_OUT = 64, T_W1 = 16 * 16, T_W2 = 64 * 4;
    const int total = NADA + T_IN + T_PG + T_PO + T_MO + T_OUT + T_W1 + T_W2 + 1;
    unsigned* qctr = (unsigned*)(p.ws + WS_CTR) + 16;
    volatile unsigned* slot = (volatile unsigned*)((unsigned char*)lds + LDS_BYTES - 16);
    for (;;) {
        if (threadIdx.x == 0) *slot = atomicAdd(qctr, 1u);
        __syncthreads();
        const int it = (int)*slot;
        __syncthreads();
        if (it >= total) break;
        int t = it;
        if (t < NADA) { ada_item(p, t, lds); continue; }
        t -= NADA;
        if (t < T_IN) { const int kt = t / 26, nt_ = t % 26; const int n0 = nt_ * 256; const int sc = n0 < 4608 ? n0 : n0 + 8;
            conv_strip(p.w_in, INW, DM, (bf16_t*)(p.ws + WS_WIN), kt, nt_, sc, lds); continue; }
        t -= T_IN;
        if (t < T_PG) { const int g = t >> 2, kt = (t >> 1) & 1, nt_ = t & 1;
            conv_tile(p.w_pg + (size_t)g * 128 * 128, 128, 128, (bf16_t*)(p.ws + WS_WPG) + (size_t)g * 128 * 128, kt, nt_, nt_ * 64, lds); continue; }
        t -= T_PG;
        if (t < T_PO) { const int kt = t / 4, nt_ = t % 4; conv_strip(p.w_po, 1024, 512, (bf16_t*)(p.ws + WS_WPO), kt, nt_, nt_ * 256, lds); continue; }
        t -= T_PO;
        if (t < T_MO) { const int kt = t / 4, nt_ = t % 4; conv_strip(p.w_mo, 1024, 1024, (bf16_t*)(p.ws + WS_WMO), kt, nt_, nt_ * 256, lds); continue; }
        t -= T_MO;
        if (t < T_OUT) { const int kt = t / 4, nt_ = t % 4; conv_strip(p.w_out, 1024, 1024, (bf16_t*)(p.ws + WS_WOUT), kt, nt_, nt_ * 256, lds); continue; }
        t -= T_OUT;
        if (t < T_W1) { const int kt = t / 16, nt_ = t % 16; conv_strip(p.w1, 4096, 1024, (bf16_t*)(p.ws + WS_W1), kt, nt_, nt_ * 256, lds); continue; }
        t -= T_W1;
        if (t < T_W2) { const int kt = t / 4, nt_ = t % 4; conv_strip(p.w2, 1024, 4096, (bf16_t*)(p.ws + WS_W2), kt, nt_, nt_ * 256, lds); continue; }
        for (int e = threadIdx.x; e < 1024 * 2; e += NTH) { const int k = e >> 1, hf = e & 1;
            *(f32x4*)((float*)(p.ws + WS_GW) + k * 8 + hf * 4) = *(const f32x4*)(p.w_in + (size_t)k * INW + 4608 + hf * 4); }
    }
}

__device__ __forceinline__ void norm_item(const Params& p, int item, int mode, float* lds) {
    const int tid = otid(), lane = tid & 63, w = tid >> 6;
    const float* adap = (const float*)(p.ws + WS_ADAP);
    const float* adaf = (const float*)(p.ws + WS_ADA);
    bf16_t* hbuf = (bf16_t*)(p.ws + WS_H);
    if (mode == 0) {
        for (int e = tid; e < 1024 * 2; e += NTH) *(f32x4*)(lds + e * 4) = *(const f32x4*)((const float*)(p.ws + WS_GW) + e * 4);
        __syncthreads();
    }
    const int r_begin = item * 64 + w * 8;
    const int r_extra = NPR + item * 2 + w;
    const int nrows = w < 2 ? 9 : 8;
    int cur_b = -1;
    f32x4 G[4], S[4], xn[4];
    { const int row = r_begin; const float* src0 = mode == 0 ? (row < NPR ? p.x_p + (size_t)row * DM : p.x_s + (size_t)(row - NPR) * DM) : p.out + (size_t)row * DM;
#pragma unroll
      for (int i = 0; i < 4; ++i) xn[i] = *(const f32x4*)(src0 + i * 256 + lane * 4); }
    for (int rr = 0; rr < nrows; ++rr) {
        const int row = rr < 8 ? r_begin + rr : r_extra;
        const int b = row_batch(row);
        if (mode != 2 && b != cur_b) {
            cur_b = b;
            const float* gw = mode == 0 ? p.g_mix : p.g_ffn;
            const int sh_off = mode == 0 ? 0 : 3072, sc_off = mode == 0 ? 1024 : 4096;
            f32x4 scv[4], shv[4];
            if (mode == 0) {
#pragma unroll
                for (int i = 0; i < 4; ++i) { const int col = i * 256 + lane * 4; scv[i] = *(const f32x4*)(p.b_ada + sc_off + col); shv[i] = *(const f32x4*)(p.b_ada + sh_off + col); }
#pragma unroll 2
                for (int q = 0; q < 8; ++q) {
                    const float* ap = adap + ((size_t)q * NBATCH + b) * ADAW;
#pragma unroll
                    for (int i = 0; i < 4; ++i) { const int col = i * 256 + lane * 4; scv[i] += *(const f32x4*)(ap + sc_off + col); shv[i] += *(const f32x4*)(ap + sh_off + col); }
                }
            } else {
#pragma unroll
                for (int i = 0; i < 4; ++i) { const int col = i * 256 + lane * 4; scv[i] = *(const f32x4*)(adaf + (size_t)b * ADAW + sc_off + col); shv[i] = *(const f32x4*)(adaf + (size_t)b * ADAW + sh_off + col); }
            }
#pragma unroll
            for (int i = 0; i < 4; ++i) { const f32x4 g = *(const f32x4*)(gw + i * 256 + lane * 4); G[i] = g * (scv[i] + 1.0f); S[i] = shv[i]; }
        }
        f32x4 x[4]; float ss = 0.f;
#pragma unroll
        for (int i = 0; i < 4; ++i) { x[i] = xn[i]; ss += x[i][0] * x[i][0] + x[i][1] * x[i][1] + x[i][2] * x[i][2] + x[i][3] * x[i][3]; }
        if (rr + 1 < nrows) { const int rown = rr + 1 < 8 ? row + 1 : r_extra;
            const float* srcn = mode == 0 ? (rown < NPR ? p.x_p + (size_t)rown * DM : p.x_s + (size_t)(rown - NPR) * DM) : p.out + (size_t)rown * DM;
#pragma unroll
            for (int i = 0; i < 4; ++i) xn[i] = *(const f32x4*)(srcn + i * 256 + lane * 4); }
        ss = wave_sum(ss);
        const float rstd = rsqrtf(ss * (1.0f / DM) + EPS);
        if (mode == 2) {
#pragma unroll
            for (int i = 0; i < 4; ++i) { const f32x4 g = *(const f32x4*)(p.g_final + i * 256 + lane * 4); __builtin_nontemporal_store(x[i] * rstd * g, (f32x4*)(p.out + (size_t)row * DM + i * 256 + lane * 4)); }
            continue;
        }
        f32x4 hv[4];
#pragma unroll
        for (int i = 0; i < 4; ++i) { hv[i] = x[i] * rstd * G[i] + S[i];
            u32x2 wv; wv.x = pk_bf16(hv[i][0], hv[i][1]); wv.y = pk_bf16(hv[i][2], hv[i][3]);
            *(u32x2*)(hbuf + (size_t)row * DM + i * 256 + lane * 4) = wv; }
        if (mode == 0) {
            float d[8];
#pragma unroll
            for (int j = 0; j < 8; ++j) d[j] = 0.f;
#pragma unroll
            for (int i = 0; i < 4; ++i)
#pragma unroll
                for (int e = 0; e < 4; ++e) {
                    const int k = i * 256 + lane * 4 + e;
                    const f32x4 w0 = *(const f32x4*)(lds + k * 8), w1 = *(const f32x4*)(lds + k * 8 + 4);
                    const float hvv = hv[i][e];
                    d[0] += hvv * w0[0]; d[1] += hvv * w0[1]; d[2] += hvv * w0[2]; d[3] += hvv * w0[3];
                    d[4] += hvv * w1[0]; d[5] += hvv * w1[1]; d[6] += hvv * w1[2]; d[7] += hvv * w1[3];
                }
#pragma unroll
            for (int j = 0; j < 8; ++j) d[j] = wave_sum(d[j]);
            if (lane < 4) {
                float di = lane == 0 ? d[0] : lane == 1 ? d[1] : lane == 2 ? d[2] : d[3];
                float df = lane == 0 ? d[4] : lane == 1 ? d[5] : lane == 2 ? d[6] : d[7];
                di += p.b_i[lane];
                const float z = df + p.b_f[lane];
                const float lf = fminf(z, 0.f) - log1pf(__expf(-fabsf(z)));
                ((float*)(p.ws + WS_GI))[(size_t)row * 4 + lane] = di;
                ((float*)(p.ws + WS_GF))[(size_t)row * 4 + lane] = lf;
            }
        }
    }
    if (mode == 0) __syncthreads();
}

__device__ __forceinline__ void ada_final_slice(const Params& p, int blk) {
    const float* adap = (const float*)(p.ws + WS_ADAP);
    float* adaf = (float*)(p.ws + WS_ADA);
    for (int e = threadIdx.x; e < 816; e += NTH) {
        const size_t idx = ((size_t)blk * 816 + e) * 4;
        f32x4 v = *(const f32x4*)(p.b_ada + (idx % ADAW));
#pragma unroll
        for (int q = 0; q < 8; ++q) v += *(const f32x4*)(adap + (size_t)q * NBATCH * ADAW + idx);
        *(f32x4*)(adaf + idx) = v;
    }
}

__device__ __forceinline__ void scan_item(const Params& p, int item, unsigned char* lds) {
    const int tid = otid(), lane = tid & 63, w = tid >> 6, fr = lane & 15, fq = lane >> 4;
    const int bh = item >> 2, j = item & 3, b = bh >> 2, hd = bh & 3, dv0 = j * 64;
    const float* gi = (const float*)(p.ws + WS_GI); const float* gf = (const float*)(p.ws + WS_GF);
    const bf16_t* kbuf = (const bf16_t*)(p.ws + WS_QKV) + (size_t)1 * MROWS * DM;
    const bf16_t* vbuf = (const bf16_t*)(p.ws + WS_QKV) + (size_t)2 * MROWS * DM;
    bf16_t* cst = (bf16_t*)(p.ws + WS_CST) + (size_t)bh * 31 * 65536;
    float* nst = (float*)(p.ws + WS_NST) + (size_t)bh * 32 * 256;
    float* mst = (float*)(p.ws + WS_MST) + (size_t)bh * 64;
    constexpr int KROW = 144;
    unsigned char* kimg[2] = {lds, lds + 256 * KROW};
    unsigned char* vimg[2] = {lds + 2 * 256 * KROW, lds + 2 * 256 * KROW + 64 * KROW};
    float* aA = (float*)(lds + 2 * 256 * KROW + 2 * 64 * KROW);
    float* bLs = aA + 2048;
    float* amx = bLs + 32;
    float* mch = amx + 32;
    float* dcy = mch + 40;
    for (int c = w * 4; c < w * 4 + 4; ++c) {
        const size_t tok = (size_t)b * SEQ + c * 64 + lane;
        const float lf = gf[tok * 4 + hd], il = gi[tok * 4 + hd];
        const float bs = wave_scan_add(lf, lane);
        const float bL = __shfl(bs, 63);
        const float a = bL - bs + il;
        const float am = wave_max(a);
        aA[c * 64 + lane] = a;
        if (lane == 0) { bLs[c] = bL; amx[c] = am; }
    }
    __syncthreads();
    if (tid == 0) {
        float m = 0.f; mch[0] = 0.f;
        for (int c = 0; c < 32; ++c) { const float mn = fmaxf(bLs[c] + m, amx[c]); dcy[c] = __expf(bLs[c] + m - mn); m = mn; mch[c + 1] = mn; }
    }
    __syncthreads();
    if (j == 0 && tid < 33) mst[tid] = mch[tid];
    if (j == 0 && tid == 0) p.out[O_MP + bh] = mch[32];
    f32x4 acc[2][4] = {};
    float nacc = 0.f;
    u32x4 krA[4], krB[4]; u32x4 vrA, vrB;
#define SCAN_GLOAD(KR, VR, cc) do { const size_t tok_ = (size_t)b * SEQ + (cc) * 64 + lane; const bf16_t* kp_ = kbuf + tok_ * DM + hd * 256 + w * 32; \
        _Pragma("unroll") for (int i_ = 0; i_ < 4; ++i_) KR[i_] = *(const u32x4*)(kp_ + i_ * 8); \
        VR = *(const u32x4*)(vbuf + tok_ * DM + hd * 256 + dv0 + w * 8); } while (0)
#define SCAN_WRITE(KR, VR, cc, ki, vi) do { const float wsv = __expf(aA[(cc) * 64 + lane] - mch[(cc) + 1]); \
        _Pragma("unroll") for (int i_ = 0; i_ < 4; ++i_) { const unsigned uu[4] = {KR[i_].x, KR[i_].y, KR[i_].z, KR[i_].w}; \
            _Pragma("unroll") for (int e_ = 0; e_ < 4; ++e_) { const int dk_ = w * 32 + i_ * 8 + e_ * 2; \
                *(bf16_t*)(ki + dk_ * KROW + lane * 2) = f2bf(bflo(uu[e_]) * wsv); *(bf16_t*)(ki + (dk_ + 1) * KROW + lane * 2) = f2bf(bfhi(uu[e_]) * wsv); } } \
        const int dv_ = w * 8; \
        *(bf16_t*)(vi + (dv_ + 0) * KROW + lane * 2) = (bf16_t)(VR.x & 0xffffu); *(bf16_t*)(vi + (dv_ + 1) * KROW + lane * 2) = (bf16_t)(VR.x >> 16); \
        *(bf16_t*)(vi + (dv_ + 2) * KROW + lane * 2) = (bf16_t)(VR.y & 0xffffu); *(bf16_t*)(vi + (dv_ + 3) * KROW + lane * 2) = (bf16_t)(VR.y >> 16); \
        *(bf16_t*)(vi + (dv_ + 4) * KROW + lane * 2) = (bf16_t)(VR.z & 0xffffu); *(bf16_t*)(vi + (dv_ + 5) * KROW + lane * 2) = (bf16_t)(VR.z >> 16); \
        *(bf16_t*)(vi + (dv_ + 6) * KROW + lane * 2) = (bf16_t)(VR.w & 0xffffu); *(bf16_t*)(vi + (dv_ + 7) * KROW + lane * 2) = (bf16_t)(VR.w >> 16); } while (0)
    SCAN_GLOAD(krA, vrA, 0);
    SCAN_GLOAD(krB, vrB, 1);
    for (int c = 0; c < 32; ++c) {
        unsigned char* ki = kimg[c & 1]; unsigned char* vi = vimg[c & 1];
        if ((c & 1) == 0) { SCAN_WRITE(krA, vrA, c, ki, vi); if (c + 2 < 32) SCAN_GLOAD(krA, vrA, c + 2); }
        else { SCAN_WRITE(krB, vrB, c, ki, vi); if (c + 2 < 32) SCAN_GLOAD(krB, vrB, c + 2); }
        __syncthreads();
        const float dc = dcy[c];
        bf16x8 af[2][2], bfr[4][2];
#pragma unroll
        for (int a = 0; a < 2; ++a)
#pragma unroll
            for (int k = 0; k < 2; ++k) af[a][k] = *(const bf16x8*)(ki + ((w * 2 + a) * 16 + fr) * KROW + (k * 32 + fq * 8) * 2);
#pragma unroll
        for (int a = 0; a < 4; ++a)
#pragma unroll
            for (int k = 0; k < 2; ++k) bfr[a][k] = *(const bf16x8*)(vi + (a * 16 + fr) * KROW + (k * 32 + fq * 8) * 2);
#pragma unroll
        for (int a = 0; a < 2; ++a)
#pragma unroll
            for (int q = 0; q < 4; ++q) {
                acc[a][q] *= dc;
#pragma unroll
                for (int k = 0; k < 2; ++k) acc[a][q] = MFMA16(af[a][k], bfr[q][k], acc[a][q]);
            }
        if (j == 0) {
            const int dk = tid >> 1, hf = tid & 1;
            float s = 0.f;
#pragma unroll
            for (int i = 0; i < 4; ++i) {
                const u32x4 v = *(const u32x4*)(ki + dk * KROW + hf * 64 + i * 16);
                s += bflo(v.x) + bfhi(v.x) + bflo(v.y) + bfhi(v.y) + bflo(v.z) + bfhi(v.z) + bflo(v.w) + bfhi(v.w);
            }
            s += __shfl_xor(s, 1);
            nacc = nacc * dc + s;
            if (hf == 0) { if (c < 31) nst[(c + 1) * 256 + dk] = nacc; else p.out[O_NP + (size_t)bh * 256 + dk] = nacc; }
        }
        if (c < 31) {
            bf16_t* cs = cst + (size_t)c * 65536;
#pragma unroll
            for (int a = 0; a < 2; ++a)
#pragma unroll
                for (int q = 0; q < 4; ++q) {
                    u32x2 wv; wv.x = pk_bf16(acc[a][q][0], acc[a][q][1]); wv.y = pk_bf16(acc[a][q][2], acc[a][q][3]);
                    *(u32x2*)(cs + (size_t)(dv0 + q * 16 + fr) * 256 + (w * 2 + a) * 16 + fq * 4) = wv;
                }
        } else {
            float* co = p.out + O_CP + (size_t)bh * 65536;
#pragma unroll
            for (int a = 0; a < 2; ++a)
#pragma unroll
                for (int q = 0; q < 4; ++q)
#pragma unroll
                    for (int jj = 0; jj < 4; ++jj) co[(size_t)((w * 2 + a) * 16 + fq * 4 + jj) * 256 + dv0 + q * 16 + fr] = acc[a][q][jj];
        }
    }
    __syncthreads();
}

__device__ __forceinline__ void sample_item(const Params& p, int item, unsigned char* ldsb) {
    const int tid = otid(), lane = tid & 63, w = tid >> 6;
    const int b = item >> 2, hd = item & 3, bh = item;
    const int r0 = NPR + b * 4;
    const bf16_t* qb = (const bf16_t*)(p.ws + WS_QKV);
    const bf16_t* kb = qb + (size_t)MROWS * DM; const bf16_t* vb = kb + (size_t)MROWS * DM; const bf16_t* ob = vb + (size_t)MROWS * DM;
    const float* gi = (const float*)(p.ws + WS_GI); const float* gf = (const float*)(p.ws + WS_GF);
    float* lds = (float*)ldsb;
    float* qf = lds;
    float* kf = qf + 1024;
    float* vf = kf + 1024;
    float* Sm = vf + 1024;
    float* sc = Sm + 16;
    float* red = sc + 64;
    float* ssq = red + 8192;
    const int dv4 = lane * 4;
    const float* C0 = p.st_C + (size_t)bh * 65536;
    float* Cn = p.out + O_CS + (size_t)bh * 65536;
    f32x4 cpre[8];
#pragma unroll
    for (int r = 0; r < 8; ++r) cpre[r] = __builtin_nontemporal_load((const f32x4*)(C0 + (size_t)(w * 32 + r) * 256 + dv4));
    float* n0s = ssq + 8;
    const int ft = tid >> 7, fdv = (tid & 127) * 2;
    const size_t foidx = (size_t)(r0 + ft) * DM + hd * 256 + fdv;
    const unsigned fog = *(const unsigned*)(ob + foidx);
    const float fm0 = p.m_norm[hd * 256 + fdv], fm1 = p.m_norm[hd * 256 + fdv + 1];
    if (tid < 256) n0s[tid] = p.st_n[(size_t)bh * 256 + tid];
    for (int e = tid; e < 3 * 4 * 256; e += NTH) {
        const int which = e >> 10, t = (e >> 8) & 3, d = e & 255;
        const bf16_t* src = which == 0 ? qb : which == 1 ? kb : vb;
        lds[which * 1024 + t * 256 + d] = bf2f(src[(size_t)(r0 + t) * DM + hd * 256 + d]);
    }
    if (tid == 0) {
        float lf[4], il[4], bs[4];
        for (int t = 0; t < 4; ++t) { lf[t] = gf[(size_t)(r0 + t) * 4 + hd]; il[t] = gi[(size_t)(r0 + t) * 4 + hd]; }
        bs[0] = lf[0]; bs[1] = bs[0] + lf[1]; bs[2] = bs[1] + lf[2]; bs[3] = bs[2] + lf[3];
        const float m0 = p.st_m[bh];
        for (int t = 0; t < 4; ++t) {
            const float g = bs[t] + m0; float mt = g;
            for (int s = 0; s <= t; ++s) mt = fmaxf(mt, bs[t] - bs[s] + il[s]);
            sc[t] = __expf(g - mt); sc[4 + t] = __expf(-mt);
            for (int s = 0; s < 4; ++s) sc[16 + t * 4 + s] = s <= t ? __expf(bs[t] - bs[s] + il[s] - mt) : 0.f;
        }
        const float bL = bs[3]; float mn = bL + m0;
        for (int s = 0; s < 4; ++s) mn = fmaxf(mn, bL - bs[s] + il[s]);
        sc[12] = __expf(bL + m0 - mn);
        for (int s = 0; s < 4; ++s) sc[8 + s] = __expf(bL - bs[s] + il[s] - mn);
        p.out[O_MS + bh] = mn;
    }
    __syncthreads();
    {
        const int g = tid >> 5, l32 = tid & 31;
        {
            const int t = g >> 2, s = g & 3; float a = 0.f;
#pragma unroll
            for (int d = l32; d < 256; d += 32) a += qf[t * 256 + d] * kf[s * 256 + d];
#pragma unroll
            for (int dd = 16; dd >= 1; dd >>= 1) a += __shfl_xor(a, dd);
            if (l32 == 0) Sm[g] = a * sc[16 + g];
        }
        if (g < 4) {
            float a = 0.f;
#pragma unroll
            for (int d = l32; d < 256; d += 32) a += qf[g * 256 + d] * n0s[d];
#pragma unroll
            for (int dd = 16; dd >= 1; dd >>= 1) a += __shfl_xor(a, dd);
            if (l32 == 0) sc[32 + g] = a;
        }
    }
    const float decay = sc[12];
    const float ws0 = sc[8], ws1 = sc[9], ws2 = sc[10], ws3 = sc[11];
    if (tid < 256) {
        const float nn = decay * n0s[tid] + ws0 * kf[tid] + ws1 * kf[256 + tid] + ws2 * kf[512 + tid] + ws3 * kf[768 + tid];
        p.out[O_NS + (size_t)bh * 256 + tid] = nn;
    }
    {
        f32x4 vv[4], num[4];
        vv[0] = *(const f32x4*)(vf + dv4) * ws0; vv[1] = *(const f32x4*)(vf + 256 + dv4) * ws1; vv[2] = *(const f32x4*)(vf + 512 + dv4) * ws2; vv[3] = *(const f32x4*)(vf + 768 + dv4) * ws3;
#pragma unroll
        for (int s = 0; s < 4; ++s) num[s] = (f32x4){0.f, 0.f, 0.f, 0.f};
#pragma unroll
        for (int r = 0; r < 8; ++r) {
            const int dk = w * 32 + r;
            const f32x4 cv = cpre[r];
            f32x4 cn = cv * decay;
#pragma unroll
            for (int s = 0; s < 4; ++s) { num[s] += cv * qf[s * 256 + dk]; cn += vv[s] * kf[s * 256 + dk]; }
            __builtin_nontemporal_store(cn, (f32x4*)(Cn + (size_t)dk * 256 + dv4));
        }
#pragma unroll 8
        for (int r = 8; r < 32; ++r) {
            const int dk = w * 32 + r;
            const f32x4 cv = __builtin_nontemporal_load((const f32x4*)(C0 + (size_t)dk * 256 + dv4));
            f32x4 cn = cv * decay;
#pragma unroll
            for (int s = 0; s < 4; ++s) { num[s] += cv * qf[s * 256 + dk]; cn += vv[s] * kf[s * 256 + dk]; }
            __builtin_nontemporal_store(cn, (f32x4*)(Cn + (size_t)dk * 256 + dv4));
        }
        __syncthreads();
#pragma unroll
        for (int t = 0; t < 4; ++t) *(f32x4*)(red + (w * 4 + t) * 256 + dv4) = num[t];
    }
    __syncthreads();
    {
        const int t = tid >> 7, dv = (tid & 127) * 2;
        float n0_ = 0.f, n1_ = 0.f;
#pragma unroll
        for (int ww = 0; ww < 8; ++ww) { n0_ += red[(ww * 4 + t) * 256 + dv]; n1_ += red[(ww * 4 + t) * 256 + dv + 1]; }
        const float wint = sc[t];
        n0_ *= wint; n1_ *= wint;
        float rs = 0.f;
#pragma unroll
        for (int s = 0; s < 4; ++s) { const float sv = Sm[t * 4 + s]; rs += sv; n0_ += sv * vf[s * 256 + dv]; n1_ += sv * vf[s * 256 + dv + 1]; }
        const float den = wint * sc[32 + t] + rs;
        const float dinv = 1.0f / fmaxf(fabsf(den), sc[4 + t]);
        const float h0 = n0_ * dinv, h1 = n1_ * dinv;
        float q2 = wave_sum(h0 * h0 + h1 * h1);
        if (lane == 0) ssq[t * 2 + (w & 1)] = q2;
        __syncthreads();
        const float rstd = rsqrtf((ssq[t * 2] + ssq[t * 2 + 1]) * (1.0f / 256.f) + EPS);
        const float o0 = h0 * rstd * fm0 * bflo(fog), o1 = h1 * rstd * fm1 * bfhi(fog);
        *(unsigned*)((bf16_t*)(p.ws + WS_HM) + foidx) = pk_bf16(o0, o1);
    }
    __syncthreads();
}

__device__ __forceinline__ void pool_item(const Params& p, int item, unsigned char* lds) {
    const int tid = otid(), lane = tid & 63, w = tid >> 6, fr = lane & 15, fq = lane >> 4;
    const int r0 = item < 256 ? item * 64 : NPR + (item - 256) * 16;
    const int nm = item < 256 ? 4 : 1;
    const float* u = (const float*)(p.ws + WS_U);
    constexpr int AROW = 1040;
    bf16x8 bw[4][4];
    {
        const bf16_t* wt0 = (const bf16_t*)(p.ws + WS_WPG) + (size_t)(w >> 1) * 128 * 128;
#pragma unroll
        for (int k = 0; k < 4; ++k)
#pragma unroll
            for (int n = 0; n < 4; ++n) bw[k][n] = *(const bf16x8*)(wt0 + (size_t)(((w & 1) * 4 + n) * 16 + fr) * 128 + k * 32 + fq * 8);
    }
    {
        const int c = tid, gidx = c >> 7, win = 2 << gidx;
        float hist[31];
        if (r0 < NPR) {
            const int t0 = r0 & (SEQ - 1);
#pragma unroll
            for (int j = 0; j < 15; ++j) hist[j] = (t0 - 15 + j) >= 0 ? u[(size_t)(r0 - 15 + j) * 512 + c] : 0.f;
            float nxt[16];
#pragma unroll
            for (int j = 0; j < 16; ++j) nxt[j] = u[(size_t)(r0 + j) * 512 + c];
#pragma unroll 1
            for (int ch = 0; ch < 4; ++ch) {
#pragma unroll
                for (int j = 0; j < 16; ++j) hist[15 + j] = nxt[j];
                if (ch < 3) {
#pragma unroll
                    for (int j = 0; j < 16; ++j) nxt[j] = u[(size_t)(r0 + (ch + 1) * 16 + j) * 512 + c];
                }
#pragma unroll
                for (int j = 0; j < 16; ++j) {
                    const int i = ch * 16 + j, t = t0 + i, q = 15 + j;
                    const float s2 = hist[q] + hist[q - 1];
                    const float s4 = s2 + hist[q - 2] + hist[q - 3];
                    const float s8 = s4 + (hist[q - 4] + hist[q - 5]) + (hist[q - 6] + hist[q - 7]);
                    const float s16 = s8 + ((hist[q - 8] + hist[q - 9]) + (hist[q - 10] + hist[q - 11])) + ((hist[q - 12] + hist[q - 13]) + (hist[q - 14] + hist[q - 15]));
                    const float s = gidx == 0 ? s2 : gidx == 1 ? s4 : gidx == 2 ? s8 : s16;
                    const float rc = __builtin_amdgcn_rcpf((float)min(t + 1, win));
                    *(bf16_t*)(lds + i * AROW + c * 2) = f2bf(s * rc - hist[q]);
                }
#pragma unroll
                for (int j = 0; j < 15; ++j) hist[j] = hist[16 + j];
            }
        } else {
#pragma unroll 1
            for (int bi = 0; bi < 4; ++bi) {
                const int bb = ((r0 - NPR) >> 2) + bi;
#pragma unroll
                for (int j = 0; j < 15; ++j) hist[j] = p.st_pool[((size_t)bb * 15 + j) * 512 + c];
#pragma unroll
                for (int j = 0; j < 4; ++j) hist[15 + j] = u[((size_t)NPR + bb * 4 + j) * 512 + c];
#pragma unroll
                for (int j = 0; j < 4; ++j) {
                    const int i = bi * 4 + j, q = 15 + j;
                    const float s2 = hist[q] + hist[q - 1];
                    const float s4 = s2 + hist[q - 2] + hist[q - 3];
                    const float s8 = s4 + (hist[q - 4] + hist[q - 5]) + (hist[q - 6] + hist[q - 7]);
                    const float s16 = s8 + ((hist[q - 8] + hist[q - 9]) + (hist[q - 10] + hist[q - 11])) + ((hist[q - 12] + hist[q - 13]) + (hist[q - 14] + hist[q - 15]));
                    const float s = gidx == 0 ? s2 : gidx == 1 ? s4 : gidx == 2 ? s8 : s16;
                    *(bf16_t*)(lds + i * AROW + c * 2) = f2bf(s * (1.0f / (float)win) - hist[q]);
                }
            }
        }
    }
    __syncthreads();
    {
        const int g = w >> 1, nh = w & 1;
        f32x4 acc[4][4] = {};
#pragma unroll
        for (int k = 0; k < 4; ++k) {
            bf16x8 af[4];
#pragma unroll
            for (int m = 0; m < 4; ++m) if (m < nm) af[m] = *(const bf16x8*)(lds + (m * 16 + fr) * AROW + (g * 128 + k * 32 + fq * 8) * 2);
#pragma unroll
            for (int m = 0; m < 4; ++m) if (m < nm) {
#pragma unroll
                for (int n = 0; n < 4; ++n) acc[m][n] = MFMA16(bw[k][n], af[m], acc[m][n]); }
        }
        bf16_t* yp = (bf16_t*)(p.ws + WS_YP);
#pragma unroll
        for (int m = 0; m < 4; ++m) if (m < nm)
#pragma unroll
            for (int n = 0; n < 4; ++n) {
                const int col = g * 128 + (nh * 4 + n) * 16 + fq * 4;
                const f32x4 scv = *(const f32x4*)(p.pool_scale + col);
                const f32x4 v = acc[m][n] * scv;
                u32x2 wv; wv.x = pk_bf16(v[0], v[1]); wv.y = pk_bf16(v[2], v[3]);
                *(u32x2*)(yp + (size_t)(r0 + m * 16 + fr) * 512 + col) = wv;
            }
    }
    __syncthreads();
}

__device__ __forceinline__ void poolout_item(const Params& p, int item) {
    const float* u = (const float*)(p.ws + WS_U);
    for (int e = threadIdx.x; e < 15 * 512; e += NTH) {
        const int jj = e >> 9, c = e & 511;
        if (item < 8) p.out[O_POOLP + (size_t)item * 7680 + e] = u[((size_t)item * SEQ + 2033 + jj) * 512 + c];
        else { const int bb = item - 8;
            p.out[O_POOLS + (size_t)bb * 7680 + e] = jj < 11 ? p.st_pool[((size_t)bb * 15 + jj + 4) * 512 + c] : u[((size_t)NPR + bb * 4 + (jj - 11)) * 512 + c]; }
    }
}

__device__ __forceinline__ void mout_item(const Params& p, int item, unsigned char* lds) {
    const int tid = otid(), lane = tid & 63, w = tid >> 6, fr = lane & 15, fq = lane >> 4;
    const int bh = item >> 5, c = item & 31, b = bh >> 2, hd = bh & 3;
    const size_t tok0 = (size_t)b * SEQ + c * 64;
    const bf16_t* qb = (const bf16_t*)(p.ws + WS_QKV);
    const bf16_t* kb = qb + (size_t)MROWS * DM; const bf16_t* vb = kb + (size_t)MROWS * DM; const bf16_t* ob = vb + (size_t)MROWS * DM;
    const float* gi = (const float*)(p.ws + WS_GI); const float* gf = (const float*)(p.ws + WS_GF);
    constexpr int QROW = 528, VROW = 144;
    unsigned char* Qs = lds;
    unsigned char* Ks = Qs + 64 * QROW;
    unsigned char* Vt = Ks + 64 * QROW;
    unsigned char* Sp = Vt + 256 * VROW;
    float* scal = (float*)(Sp + 64 * VROW);
    float* rt = scal, *ct = scal + 64, *wint = scal + 128, *emt = scal + 192, *rowsum = scal + 256  , *qn = scal + 384, *ssq = scal + 448  , *ncs = scal + 960  ;
    bf16x8 cfr[8][2];
    if (c > 0) {
        const bf16_t* cs = (const bf16_t*)(p.ws + WS_CST) + ((size_t)bh * 31 + (c - 1)) * 65536;
#pragma unroll
        for (int k = 0; k < 8; ++k)
#pragma unroll
            for (int n = 0; n < 2; ++n) cfr[k][n] = *(const bf16x8*)(cs + (size_t)(w * 32 + n * 16 + fr) * 256 + k * 32 + fq * 8);
    }
    u32x2 ogv[4][2]; f32x4 mnv[2];
#pragma unroll
    for (int n = 0; n < 2; ++n) { const int dvg = hd * 256 + w * 32 + n * 16 + fq * 4; mnv[n] = *(const f32x4*)(p.m_norm + dvg);
#pragma unroll
        for (int m = 0; m < 4; ++m) ogv[m][n] = *(const u32x2*)(ob + (tok0 + m * 16 + fr) * DM + dvg); }
#pragma unroll
    for (int i = 0; i < 4; ++i) {
        const int pc = tid + NTH * i, row = pc >> 5, c8 = pc & 31;
        *(u32x4*)(Qs + row * QROW + c8 * 16) = *(const u32x4*)(qb + (tok0 + row) * DM + hd * 256 + c8 * 8);
        *(u32x4*)(Ks + row * QROW + c8 * 16) = *(const u32x4*)(kb + (tok0 + row) * DM + hd * 256 + c8 * 8);
    }
    {
        const bf16_t* vp = vb + (tok0 + lane) * DM + hd * 256 + w * 32;
#pragma unroll
        for (int i = 0; i < 4; ++i) {
            const u32x4 v = *(const u32x4*)(vp + i * 8);
            const unsigned uu[4] = {v.x, v.y, v.z, v.w};
#pragma unroll
            for (int e = 0; e < 4; ++e) {
                const int dv = w * 32 + i * 8 + e * 2;
                *(bf16_t*)(Vt + dv * VROW + lane * 2) = (bf16_t)(uu[e] & 0xffffu);
                *(bf16_t*)(Vt + (dv + 1) * VROW + lane * 2) = (bf16_t)(uu[e] >> 16);
            }
        }
    }
    if (c > 0 && tid >= 256) ncs[tid - 256] = ((const float*)(p.ws + WS_NST))[((size_t)bh * 32 + c) * 256 + tid - 256];
    if (w == 0) {
        const float lf = gf[(tok0 + lane) * 4 + hd], il = gi[(tok0 + lane) * 4 + hd];
        const float bs = wave_scan_add(lf, lane);
        const float mc = ((const float*)(p.ws + WS_MST))[bh * 64 + c];
        const float g = bs + mc, xx = il - bs;
        const float pm = wave_scan_max(xx, lane);
        const float mt = fmaxf(g, bs + pm);
        rt[lane] = bs - mt; ct[lane] = xx; wint[lane] = __expf(g - mt); emt[lane] = __expf(-mt);
    }
    __syncthreads();
    {
        const int tt = w >> 1, sh = w & 1;
        f32x4 sa[2] = {};
#pragma unroll
        for (int k = 0; k < 8; ++k) {
            const bf16x8 qf = *(const bf16x8*)(Qs + (tt * 16 + fr) * QROW + (k * 32 + fq * 8) * 2);
#pragma unroll
            for (int s2 = 0; s2 < 2; ++s2) {
                const bf16x8 kf = *(const bf16x8*)(Ks + ((sh * 2 + s2) * 16 + fr) * QROW + (k * 32 + fq * 8) * 2);
                sa[s2] = MFMA16(kf, qf, sa[s2]);
            }
        }
        const int t = tt * 16 + fr;
        const float rtt = rt[t];
        float rs = 0.f;
#pragma unroll
        for (int s2 = 0; s2 < 2; ++s2) {
            const int s0 = (sh * 2 + s2) * 16 + fq * 4;
            float v[4];
#pragma unroll
            for (int jj = 0; jj < 4; ++jj) { const int s = s0 + jj; v[jj] = s <= t ? sa[s2][jj] * __expf(rtt + ct[s]) : 0.f; rs += v[jj]; }
            u32x2 wv; wv.x = pk_bf16(v[0], v[1]); wv.y = pk_bf16(v[2], v[3]);
            *(u32x2*)(Sp + t * VROW + s0 * 2) = wv;
        }
        rs += __shfl_xor(rs, 16); rs += __shfl_xor(rs, 32);
        if (fq == 0) rowsum[t * 2 + sh] = rs;
    }
    {
        const int t = tid >> 3, part = tid & 7;
        float a = 0.f;
        if (c > 0) {
            const float* nc = ncs + part * 32;
            const unsigned char* qp = Qs + t * QROW + part * 64;
#pragma unroll
            for (int i = 0; i < 4; ++i) {
                const u32x4 qv = *(const u32x4*)(qp + i * 16);
                const f32x4 n0 = *(const f32x4*)(nc + i * 8), n1 = *(const f32x4*)(nc + i * 8 + 4);
                a += bflo(qv.x) * n0[0] + bfhi(qv.x) * n0[1] + bflo(qv.y) * n0[2] + bfhi(qv.y) * n0[3] + bflo(qv.z) * n1[0] + bfhi(qv.z) * n1[1] + bflo(qv.w) * n1[2] + bfhi(qv.w) * n1[3];
            }
        }
        a += __shfl_xor(a, 1); a += __shfl_xor(a, 2); a += __shfl_xor(a, 4);
        if (part == 0) qn[t] = a;
    }
    __syncthreads();
    f32x4 acc[4][2] = {};
    if (c > 0) {
#pragma unroll
        for (int k = 0; k < 8; ++k) {
            bf16x8 qf[4];
#pragma unroll
            for (int m = 0; m < 4; ++m) qf[m] = *(const bf16x8*)(Qs + (m * 16 + fr) * QROW + (k * 32 + fq * 8) * 2);
#pragma unroll
            for (int m = 0; m < 4; ++m)
#pragma unroll
                for (int n = 0; n < 2; ++n) acc[m][n] = MFMA16(cfr[k][n], qf[m], acc[m][n]);
        }
#pragma unroll
        for (int m = 0; m < 4; ++m) { const float wi = wint[m * 16 + fr]; acc[m][0] *= wi; acc[m][1] *= wi; }
    }
#pragma unroll
    for (int k = 0; k < 2; ++k) {
        bf16x8 vfr[2], sf[4];
#pragma unroll
        for (int n = 0; n < 2; ++n) vfr[n] = *(const bf16x8*)(Vt + (w * 32 + n * 16 + fr) * VROW + (k * 32 + fq * 8) * 2);
#pragma unroll
        for (int m = 0; m < 4; ++m) sf[m] = *(const bf16x8*)(Sp + (m * 16 + fr) * VROW + (k * 32 + fq * 8) * 2);
#pragma unroll
        for (int m = 0; m < 4; ++m)
#pragma unroll
            for (int n = 0; n < 2; ++n) acc[m][n] = MFMA16(vfr[n], sf[m], acc[m][n]);
    }
#pragma unroll
    for (int m = 0; m < 4; ++m) {
        const int t = m * 16 + fr;
        const float den = wint[t] * qn[t] + rowsum[t * 2] + rowsum[t * 2 + 1];
        const float dinv = 1.0f / fmaxf(fabsf(den), emt[t]);
        acc[m][0] *= dinv; acc[m][1] *= dinv;
        float q2 = 0.f;
#pragma unroll
        for (int n = 0; n < 2; ++n)
#pragma unroll
            for (int jj = 0; jj < 4; ++jj) q2 += acc[m][n][jj] * acc[m][n][jj];
        q2 += __shfl_xor(q2, 16); q2 += __shfl_xor(q2, 32);
        if (fq == 0) ssq[t * 8 + w] = q2;
    }
    __syncthreads();
#pragma unroll
    for (int m = 0; m < 4; ++m) {
        const int t = m * 16 + fr;
        float tot = 0.f;
#pragma unroll
        for (int ww = 0; ww < 8; ++ww) tot += ssq[t * 8 + ww];
        const float rstd = rsqrtf(tot * (1.0f / 256.f) + EPS);
#pragma unroll
        for (int n = 0; n < 2; ++n) {
            const int dvg = hd * 256 + w * 32 + n * 16 + fq * 4;
            const size_t oidx = (tok0 + t) * DM + dvg;
            const u32x2 og = ogv[m][n];
            const f32x4 v = acc[m][n] * rstd * mnv[n];
            u32x2 wv; wv.x = pk_bf16(v[0] * bflo(og.x), v[1] * bfhi(og.x)); wv.y = pk_bf16(v[2] * bflo(og.y), v[3] * bfhi(og.y));
            *(u32x2*)((bf16_t*)(p.ws + WS_HM) + oidx) = wv;
        }
    }
    __syncthreads();
}

__device__ __forceinline__ void grid_barrier(unsigned* bar, unsigned k) {
    asm volatile("s_waitcnt vmcnt(0)" ::: "memory");
    __syncthreads();
    if (threadIdx.x == 0) {
        const unsigned g = blockIdx.x & 7u, gsz = (gridDim.x + 7u - g) >> 3;
        __builtin_amdgcn_fence(__ATOMIC_RELEASE, "agent");
        asm volatile("s_waitcnt vmcnt(0)" ::: "memory");
        unsigned* sub = bar + 64u * (1u + g);
        const unsigned prev = __hip_atomic_fetch_add(sub, 1u, __ATOMIC_RELAXED, __HIP_MEMORY_SCOPE_AGENT);
        if (prev + 1u == k * gsz) __hip_atomic_fetch_add(bar, 1u, __ATOMIC_RELAXED, __HIP_MEMORY_SCOPE_AGENT);
        const unsigned ngroups = gridDim.x < 8u ? gridDim.x : 8u;
        unsigned spins = 0;
        while (__hip_atomic_load(bar, __ATOMIC_RELAXED, __HIP_MEMORY_SCOPE_AGENT) < k * ngroups) { __builtin_amdgcn_s_sleep(1); if (++spins > (1u << 24)) break; }
        __builtin_amdgcn_fence(__ATOMIC_ACQUIRE, "agent");
        asm volatile("s_waitcnt vmcnt(0)" ::: "memory");
    }
    __syncthreads();
}

__global__ void __launch_bounds__(NTH) hybrid_fwd(Params p) {
    extern __shared__ __attribute__((aligned(16))) unsigned char lds[];
    cg::grid_group grid = cg::this_grid();
    const int lo = p.ph_lo, hi = p.ph_hi;
#ifndef PHMASK
#define PHMASK 0x7ff
#endif
#define IN(k) (((PHMASK >> (k)) & 1) && lo <= (k) && (k) < hi)
#define SEAMN(n) do { grid_barrier((unsigned*)(p.ws + WS_CTR) + 64, (unsigned)(n)); } while (0)
    if (lo < 0) grid.sync();
    LAS unsigned char* ldsl = (LAS unsigned char*)lds;
    unsigned char* ws = p.ws;
    if (IN(0)) phase0(p, (float*)lds);
    SEAMN(1);
    if (IN(1)) {
        for (int it = blockIdx.x; it < 256; it += gridDim.x) { ada_final_slice(p, it); norm_item(p, it, 0, (float*)lds); }
    }
    SEAMN(2);
    if (IN(2)) { EpiG1 e{(float*)(ws + WS_U), (bf16_t*)(ws + WS_QKV)}; gemm_phase(ldsl, (const bf16_t*)(ws + WS_H), (const bf16_t*)(ws + WS_WIN), NIN, DM, e);
        { const int c = blockIdx.x; const int tb = c < 128 ? c * 2 : 256 + (c - 128) * 11;
          small_gemm_phase(lds, (const bf16_t*)(ws + WS_H), (const bf16_t*)(ws + WS_WIN), NIN, DM, e, tb, tb + (c < 128 ? 2 : 11)); } }
    SEAMN(3);
    if (IN(3)) {
        if (blockIdx.x < 128) { const int x = blockIdx.x & 7, r = blockIdx.x >> 3;
            scan_item(p, ((x + 8 * (r >> 2)) << 2) | (r & 3), lds); }
        {
            unsigned* ctr = (unsigned*)(ws + WS_CTR);
            volatile unsigned* slot = (volatile unsigned*)(lds + LDS_BYTES - 16);
            for (;;) {
                if (threadIdx.x == 0) *slot = atomicAdd(ctr, 1u);
                __syncthreads();
                const int it = (int)*slot;
                __syncthreads();
                if (it >= 512 + 288 + NBATCH) break;
                if (it < 512) sample_item(p, it, lds);
                else if (it < 800) pool_item(p, it - 512, lds);
                else poolout_item(p, it - 800);
            }
        }
    }
    SEAMN(4);
    if (IN(4)) { for (int it = blockIdx.x; it < 1024; it += gridDim.x) mout_item(p, it, lds); }
    if (IN(5)) {

        bf16_t* merged = (bf16_t*)(ws + WS_U);
        const bf16_t* sga = (const bf16_t*)(ws + WS_QKV) + (size_t)4 * MROWS * DM;
        const bf16_t* sgb = sga + (size_t)MROWS * DM;
        { EpiMerge e0{merged, sga, 0}; gemm_phase(ldsl, (const bf16_t*)(ws + WS_YP), (const bf16_t*)(ws + WS_WPO), DM, 512, e0);
          small_gemm_phase(lds, (const bf16_t*)(ws + WS_YP), (const bf16_t*)(ws + WS_WPO), DM, 512, e0, blockIdx.x, blockIdx.x + 1); }
        SEAMN(5);
        { EpiMerge e1{merged, sgb, 1}; gemm_phase(ldsl, (const bf16_t*)(ws + WS_HM), (const bf16_t*)(ws + WS_WMO), DM, DM, e1);
          small_gemm_phase(lds, (const bf16_t*)(ws + WS_HM), (const bf16_t*)(ws + WS_WMO), DM, DM, e1, blockIdx.x, blockIdx.x + 1); }
    }
    SEAMN(6);
    if (IN(6)) {
        EpiMid e{p.out, p.x_p, p.x_s, (const float*)(ws + WS_ADA), p.g_ffn, (bf16_t*)(ws + WS_H), (float*)(ws + WS_RSB), (unsigned*)(ws + WS_XCNT), (float*)(ws + WS_RSS), (unsigned*)(ws + WS_XCNT) + 64 * 64};
        gemm_phase<EpiMid, true>(ldsl, (const bf16_t*)(ws + WS_U), (const bf16_t*)(ws + WS_WOUT), DM, DM, e, lds);
        small_gemm_phase<EpiMid, 2>(lds, (const bf16_t*)(ws + WS_U), (const bf16_t*)(ws + WS_WOUT), DM, DM, e, blockIdx.x, blockIdx.x + 1);
    }
    SEAMN(7);
    if (IN(8)) { EpiAct e{(bf16_t*)(ws + WS_CST)}; gemm_phase(ldsl, (const bf16_t*)(ws + WS_H), (const bf16_t*)(ws + WS_W1), DFF, DM, e);
        small_gemm_phase(lds, (const bf16_t*)(ws + WS_H), (const bf16_t*)(ws + WS_W1), DFF, DM, e, blockIdx.x * 4, blockIdx.x * 4 + 4); }
    SEAMN(8);
    if (IN(9)) {
        EpiFinal e{p.out, (const float*)(ws + WS_ADA), p.g_final, (float*)(ws + WS_RSB), (unsigned*)(ws + WS_XCNT), (float*)(ws + WS_RSS), (unsigned*)(ws + WS_XCNT) + 64 * 64};
        gemm_phase<EpiFinal, true>(ldsl, (const bf16_t*)(ws + WS_CST), (const bf16_t*)(ws + WS_W2), DM, DFF, e, lds);
        small_gemm_phase<EpiFinal, 1>(lds, (const bf16_t*)(ws + WS_CST), (const bf16_t*)(ws + WS_W2), DM, DFF, e, blockIdx.x, blockIdx.x + 1);
    }
#undef IN
#undef SEAMN
}

extern "C" void kernel_launch(void* const* d_in, const int* in_sizes, int n_in, void* d_out, int out_size, void* d_ws, size_t ws_size, hipStream_t stream) {
    static int grid_blocks = 0;
    if (grid_blocks == 0) {
        if (ws_size < WS_END) { fprintf(stderr, "kernel_launch: workspace too small: %zu < %zu\n", ws_size, (size_t)WS_END); grid_blocks = -1; return; }
        int dev = 0, cus = 0, per_cu = 0;
        hipGetDevice(&dev);
        hipDeviceGetAttribute(&cus, hipDeviceAttributeMultiprocessorCount, dev);
        hipFuncSetAttribute((const void*)hybrid_fwd, hipFuncAttributeMaxDynamicSharedMemorySize, LDS_BYTES);
        hipOccupancyMaxActiveBlocksPerMultiprocessor(&per_cu, (const void*)hybrid_fwd, NTH, LDS_BYTES);
        if (per_cu < 1) per_cu = 1;
        if (per_cu > 1) per_cu = 1;
        grid_blocks = cus * per_cu;
    }
    if (grid_blocks < 0) return;
    hipMemsetAsync((char*)d_ws + WS_CTR, 0, 4096 + 80 * 256, stream);
    Params p{};
    const float** f = (const float**)&p;
    for (int i = 0; i < 24; ++i) f[i] = (const float*)d_in[i];
    p.out = (float*)d_out; p.ws = (unsigned char*)d_ws; p.ph_lo = 0; p.ph_hi = 11;
    void* args[] = {&p};
    hipError_t e = hipLaunchCooperativeKernel((const void*)hybrid_fwd, dim3(grid_blocks), dim3(NTH), args, LDS_BYTES, stream);
    if (e != hipSuccess) fprintf(stderr, "cooperative launch failed: %s (grid %d)\n", hipGetErrorString(e), grid_blocks);
}
```

```cpp
#include <hip/hip_runtime.h>
#include <hip/hip_cooperative_groups.h>
#include <cstdio>
#include <cstdint>
namespace cg = cooperative_groups;

typedef unsigned short bf16_t;
typedef short bf16x8 __attribute__((ext_vector_type(8)));
typedef float f32x4 __attribute__((ext_vector_type(4)));
typedef unsigned u32x4 __attribute__((ext_vector_type(4)));
typedef unsigned u32x2 __attribute__((ext_vector_type(2)));

constexpr int NTH = 512;
constexpr int DM = 1024, NPR = 16384, NSA = 512, MROWS = 16896, NBATCH = 136, SEQ = 2048;
constexpr int NIN = 6656, DFF = 4096, ADAW = 6144, INW = 6664;
constexpr int LDS_BYTES = 131072;
constexpr float EPS = 1e-6f;

constexpr size_t O_Y = 0;
constexpr size_t O_POOLP = 17301504;
constexpr size_t O_CP = 17362944;
constexpr size_t O_NP = 19460096;
constexpr size_t O_MP = 19468288;
constexpr size_t O_POOLS = 19468320;
constexpr size_t O_CS = 20451360;
constexpr size_t O_NS = 54005792;
constexpr size_t O_MS = 54136864;

constexpr size_t AL(size_t x) { return (x + 255) & ~(size_t)255; }
constexpr size_t WS_WIN = 0;
constexpr size_t WS_WPG = WS_WIN + AL((size_t)NIN * DM * 2);
constexpr size_t WS_WPO = WS_WPG + AL((size_t)4 * 128 * 128 * 2);
constexpr size_t WS_WMO = WS_WPO + AL((size_t)1024 * 512 * 2);
constexpr size_t WS_WOUT = WS_WMO + AL((size_t)1024 * 1024 * 2);
constexpr size_t WS_W1 = WS_WOUT + AL((size_t)1024 * 1024 * 2);
constexpr size_t WS_W2 = WS_W1 + AL((size_t)4096 * 1024 * 2);
constexpr size_t WS_ADAP = WS_W2 + AL((size_t)4096 * 1024 * 2);
constexpr size_t WS_ADA = WS_ADAP + AL((size_t)8 * NBATCH * ADAW * 4);
constexpr size_t WS_H = WS_ADA + AL((size_t)NBATCH * ADAW * 4);
constexpr size_t WS_GI = WS_H + AL((size_t)MROWS * DM * 2);
constexpr size_t WS_GF = WS_GI + AL((size_t)MROWS * 4 * 4);
constexpr size_t WS_U = WS_GF + AL((size_t)MROWS * 4 * 4);
constexpr size_t WS_QKV = WS_U + AL((size_t)MROWS * 512 * 4);
constexpr size_t WS_CST = WS_QKV + AL((size_t)6 * MROWS * DM * 2);
constexpr size_t WS_NST = WS_CST + AL((size_t)MROWS * DFF * 2);
constexpr size_t WS_MST = WS_NST + AL((size_t)32 * 32 * 256 * 4);
constexpr size_t WS_YP = WS_MST + AL((size_t)32 * 64 * 4);
constexpr size_t WS_HM = WS_YP + AL((size_t)MROWS * 512 * 2);
constexpr size_t WS_GW = WS_HM + AL((size_t)MROWS * DM * 2);
constexpr size_t WS_CTR = WS_GW + AL((size_t)1024 * 8 * 4);
constexpr size_t WS_XCNT = WS_CTR + 4096;
constexpr size_t WS_RSB = WS_XCNT + 80 * 256;
constexpr size_t WS_RSS = WS_RSB + AL((size_t)NPR * 4 * 4);
constexpr size_t WS_END = WS_RSS + AL((size_t)NSA * 16 * 4);
static_assert((size_t)32 * 31 * 65536 * 2 <= (size_t)MROWS * DFF * 2, "Cst fits in act region");
static_assert(WS_END <= (size_t)536870912, "workspace map exceeds 512 MiB");

struct Params {
    const float *x_p, *x_s, *st_pool, *st_C, *st_n, *st_m, *c_p, *c_s, *g_mix, *g_ffn, *w_ada, *b_ada, *w_in, *b_i, *b_f, *w_pg, *pool_scale, *w_po, *m_norm, *w_mo, *w_out, *w1, *w2, *g_final;
    float* out; unsigned char* ws; int ph_lo, ph_hi;
};

typedef float f32x2 __attribute__((ext_vector_type(2)));
typedef __bf16 bf16x2_t __attribute__((ext_vector_type(2)));
__device__ __forceinline__ unsigned pk_bf16(float lo, float hi) { f32x2 v = {lo, hi}; bf16x2_t b = __builtin_convertvector(v, bf16x2_t); return __builtin_bit_cast(unsigned, b); }
__device__ __forceinline__ float bf2f(unsigned v) { return __uint_as_float(v << 16); }
__device__ __forceinline__ float bflo(unsigned v) { return __uint_as_float(v << 16); }
__device__ __forceinline__ float bfhi(unsigned v) { return __uint_as_float(v & 0xffff0000u); }
__device__ __forceinline__ bf16_t f2bf(float f) { return (bf16_t)(pk_bf16(f, 0.f) & 0xffffu); }
__device__ __forceinline__ float sigmoidf_(float x) { return __builtin_amdgcn_rcpf(1.f + __expf(-x)); }
__device__ __forceinline__ int row_batch(int row) { return row < NPR ? (row >> 11) : 8 + ((row - NPR) >> 2); }
__device__ __forceinline__ float wave_sum(float v) {
#pragma unroll
    for (int d = 32; d >= 1; d >>= 1) v += __shfl_xor(v, d);
    return v;
}
__device__ __forceinline__ float wave_max(float v) {
#pragma unroll
    for (int d = 32; d >= 1; d >>= 1) v = fmaxf(v, __shfl_xor(v, d));
    return v;
}
__device__ __forceinline__ float wave_scan_add(float v, int lane) {
#pragma unroll
    for (int d = 1; d < 64; d <<= 1) { float t = __shfl_up(v, d); if (lane >= d) v += t; }
    return v;
}
__device__ __forceinline__ float wave_scan_max(float v, int lane) {
#pragma unroll
    for (int d = 1; d < 64; d <<= 1) { float t = __shfl_up(v, d); if (lane >= d) v = fmaxf(v, t); }
    return v;
}
__device__ __forceinline__ int otid() { int t = threadIdx.x; asm volatile("" : "+v"(t)); return t; }
#define MFMA16(a, b, c) __builtin_amdgcn_mfma_f32_16x16x32_bf16((a), (b), (c), 0, 0, 0)

#define LAS __attribute__((address_space(3)))
constexpr int BM = 256, BK = 64, HALF = 128, HTB = HALF * BK * 2, NXCD = 8, WGM = 8;
__device__ __forceinline__ int lds_byte(int r, int c) {
    const int st = (r >> 4) * 2 + (c >> 5), rr = r & 15, cc = c & 31, ob = rr * 64 + cc * 2;
    return st * 1024 + (ob ^ (((ob >> 9) & 1) << 5));
}
__device__ __forceinline__ void stage_rc(int b, int& R, int& C) {
    const int st = b / 1024, sb = b % 1024, swz = sb ^ (((sb >> 9) & 1) << 5);
    R = (st >> 1) * 16 + swz / 64; C = (st & 1) * 32 + (swz % 64) / 2;
}
__device__ __forceinline__ int perm32(int rho) { const int n = rho >> 4, i = rho & 15; return 8 * (i >> 2) + 4 * n + (i & 3); }
struct Unit { int pm, pn; };
struct StaticOrder {
    int nM, nN, nwg, G, c;
    __device__ void init(int M, int N, int G_, int c_) { nM = M / BM; nN = N / BM; nwg = nM * nN; G = G_; c = c_; }
    __device__ bool next(int i, Unit& u) const {
        const long L = (long)i * G + c; if (L >= nwg) return false;
        int wgid = (int)L; { const int q = nwg / NXCD, r = nwg % NXCD, xcd = wgid % NXCD, off = wgid / NXCD; wgid = (xcd < r ? xcd * (q + 1) : r * (q + 1) + (xcd - r) * q) + off; }
        const int nig = WGM * nN, gid = wgid / nig, fm = gid * WGM, gsz = (nM - fm) < WGM ? (nM - fm) : WGM;
        u.pm = fm + ((wgid % nig) % gsz); u.pn = (wgid % nig) / gsz; return true;
    }
};

#ifndef GEMM_SP2
#define GEMM_SP2 1
#endif
#ifndef GEMM_ALIGN
#define GEMM_ALIGN 1
#endif
template <class Epi, bool FUSED = false, bool SP2 = (GEMM_SP2 != 0), bool ALIGN_EPI = (GEMM_ALIGN != 0)>
__device__ __forceinline__ void gemm_phase(LAS unsigned char* lds, const bf16_t* gA, const bf16_t* gBt, const int N, const int K, const Epi& E, unsigned char* lds_gen = nullptr) {
    const int tid = otid(), wid = __builtin_amdgcn_readfirstlane(tid >> 6), lane = tid & 63, wr = wid >> 2, wc = wid & 3, fr = lane & 15, fq = lane >> 4;
    const int nt = K / BK;
    StaticOrder S; S.init(NPR, N, gridDim.x, blockIdx.x);
    unsigned voffA[2], voffB[2];
#pragma unroll
    for (int i = 0; i < 2; ++i) { int R, C; stage_rc(tid * 16 + i * 8192, R, C); const int Rb = (R & ~31) + perm32(R & 31); voffA[i] = (unsigned)(R * K + C) * 2u; voffB[i] = (unsigned)(Rb * K + C) * 2u; }
    const size_t kstep = (size_t)(BK * 2);
    const size_t hstep = (size_t)HALF * K * 2;
    const size_t tstep = 2 * hstep;
    const unsigned ldsw = (unsigned)wid * 1024u;
    const int aoff = lds_byte(wr * 64 + fr, fq * 8), boff = lds_byte(wc * 32 + fr, fq * 8);
#define PG8_SA(b, h) (((b) * 2 + (h)) * HTB)
#define PG8_SB(b, h) ((4 + (b) * 2 + (h)) * HTB)
#define PG8_STAGE(bufoff, gbase) PG8_STAGEV(bufoff, gbase, voffA)
#define PG8_STAGEB(bufoff, gbase) PG8_STAGEV(bufoff, gbase, voffB)
#define PG8_STAGEV(bufoff, gbase, voff) do { _Pragma("unroll") for (int _i = 0; _i < 2; ++_i) \
        __builtin_amdgcn_global_load_lds((const unsigned*)((const char*)(gbase) + (voff)[_i]), (LAS unsigned*)(lds + (bufoff) + ldsw + _i * 8192), 16, 0, 0); } while (0)
#define PG8_LDA(dst, b, h) do { _Pragma("unroll") for (int m = 0; m < 4; ++m) _Pragma("unroll") for (int k = 0; k < 2; ++k) dst[m][k] = *(const LAS bf16x8*)(lds + PG8_SA(b, h) + aoff + m * 2048 + k * 1024); } while (0)
#define PG8_LDB(dst, b, h) do { _Pragma("unroll") for (int n = 0; n < 2; ++n) _Pragma("unroll") for (int k = 0; k < 2; ++k) dst[n][k] = *(const LAS bf16x8*)(lds + PG8_SB(b, h) + boff + n * 2048 + k * 1024); } while (0)
#define PG8_MMA(ai, bj, At, Bt) do { __builtin_amdgcn_s_setprio(1); _Pragma("unroll") for (int m = 0; m < 4; ++m) _Pragma("unroll") for (int n = 0; n < 2; ++n) _Pragma("unroll") for (int k = 0; k < 2; ++k) \
        acc[ai][bj][m][n] = __builtin_amdgcn_mfma_f32_16x16x32_bf16(Bt[n][k], At[m][k], acc[ai][bj][m][n], 0, 0, 0); __builtin_amdgcn_s_setprio(0); } while (0)
#define PG8_WAIT_V(n) asm volatile("s_waitcnt vmcnt(" #n ")" ::: "memory")
#define PG8_WAIT_L(n) asm volatile("s_waitcnt lgkmcnt(" #n ")" ::: "memory")
#define PG8_BAR __builtin_amdgcn_s_barrier()
#define PG8_SCHED __builtin_amdgcn_sched_barrier(0)
    Unit cur, nxt; int ui = 0;
    if (!S.next(0, cur)) return;
    f32x4 acc[2][2][4][2];
#pragma unroll
    for (int a = 0; a < 2; ++a)
#pragma unroll
        for (int b = 0; b < 2; ++b)
#pragma unroll
            for (int m = 0; m < 4; ++m)
#pragma unroll
                for (int n = 0; n < 2; ++n) acc[a][b][m][n] = (f32x4){0.f, 0.f, 0.f, 0.f};
    bf16x8 At[4][2], B0[2][2], B1[2][2];
    const char* cA = (const char*)gA + (size_t)cur.pm * tstep; const char* cB = (const char*)gBt + (size_t)cur.pn * tstep;
    constexpr bool ALIGN = ALIGN_EPI && !FUSED;
    if constexpr (SP2) {
        PG8_STAGEB(PG8_SB(0, 0), cB); PG8_STAGEB(PG8_SB(0, 1), cB + hstep); PG8_STAGE(PG8_SA(0, 0), cA); PG8_STAGE(PG8_SA(0, 1), cA + hstep);
        if (wr == 1) PG8_BAR;
        PG8_WAIT_V(2); PG8_BAR;
        PG8_STAGEB(PG8_SB(1, 0), cB + kstep); PG8_STAGE(PG8_SA(1, 0), cA + kstep); PG8_STAGEB(PG8_SB(1, 1), cB + hstep + kstep);
        PG8_WAIT_V(6); PG8_BAR;
    } else {
        PG8_STAGEB(PG8_SB(0, 0), cB); PG8_STAGE(PG8_SA(0, 0), cA); PG8_STAGEB(PG8_SB(0, 1), cB + hstep); PG8_STAGE(PG8_SA(0, 1), cA + hstep);
        if (wr == 1) PG8_BAR;
        PG8_WAIT_V(4); PG8_BAR;
        PG8_STAGEB(PG8_SB(1, 0), cB + kstep); PG8_STAGE(PG8_SA(1, 0), cA + kstep); PG8_STAGEB(PG8_SB(1, 1), cB + hstep + kstep);
        PG8_WAIT_V(6); PG8_BAR;
    }
    for (;;) {
        const bool has_next = S.next(ui + 1, nxt);
        const char* nA = has_next ? (const char*)gA + (size_t)nxt.pm * tstep : cA; const char* nB = has_next ? (const char*)gBt + (size_t)nxt.pn * tstep : cB;
        for (int t = 0; t < nt; t += 2) {
            const bool last = (t == nt - 2);
            const char* a1 = cA + (size_t)(t + 1) * kstep;
            const char* a2 = last ? nA : cA + (size_t)(t + 2) * kstep; const char* b2 = last ? nB : cB + (size_t)(t + 2) * kstep;
            const char* a3 = a2 + kstep; const char* b3 = b2 + kstep;
            if constexpr (SP2) {
            PG8_LDB(B0, 0, 0); PG8_LDB(B1, 0, 1); PG8_SCHED; PG8_LDA(At, 0, 0); PG8_STAGE(PG8_SA(1, 1), a1 + hstep);
            PG8_WAIT_V(8); PG8_WAIT_L(0); PG8_BAR; PG8_MMA(0, 0, At, B0); PG8_MMA(0, 1, At, B1); PG8_BAR; PG8_SCHED;
            PG8_LDA(At, 0, 1); PG8_STAGEB(PG8_SB(0, 0), b2); PG8_STAGEB(PG8_SB(0, 1), b2 + hstep); PG8_STAGE(PG8_SA(0, 0), a2);
            PG8_WAIT_V(8); PG8_WAIT_L(0); PG8_BAR; PG8_MMA(1, 0, At, B0); PG8_MMA(1, 1, At, B1); PG8_BAR; PG8_SCHED;
            PG8_LDB(B0, 1, 0); PG8_LDB(B1, 1, 1); PG8_SCHED; PG8_LDA(At, 1, 0); PG8_STAGE(PG8_SA(0, 1), a2 + hstep);
            PG8_WAIT_V(8); PG8_WAIT_L(0); PG8_BAR; PG8_MMA(0, 0, At, B0); PG8_MMA(0, 1, At, B1); PG8_BAR; PG8_SCHED;
            PG8_LDA(At, 1, 1); PG8_STAGEB(PG8_SB(1, 0), b3); PG8_STAGEB(PG8_SB(1, 1), b3 + hstep); PG8_STAGE(PG8_SA(1, 0), a3);
            PG8_WAIT_V(8); PG8_WAIT_L(0); PG8_BAR; PG8_MMA(1, 0, At, B0); PG8_MMA(1, 1, At, B1); PG8_BAR; PG8_SCHED;
            } else {
            PG8_LDB(B0, 0, 0); PG8_SCHED; PG8_LDA(At, 0, 0); PG8_STAGE(PG8_SA(1, 1), a1 + hstep);
            PG8_WAIT_L(8); PG8_BAR; PG8_WAIT_L(0); PG8_MMA(0, 0, At, B0); PG8_BAR; PG8_SCHED;
            PG8_LDB(B1, 0, 1); PG8_STAGEB(PG8_SB(0, 0), b2);
            PG8_BAR; PG8_WAIT_L(0); PG8_MMA(0, 1, At, B1); PG8_BAR;
            PG8_LDA(At, 0, 1); PG8_STAGE(PG8_SA(0, 0), a2);
            PG8_BAR; PG8_WAIT_L(0); PG8_MMA(1, 0, At, B0); PG8_BAR; PG8_SCHED;
            PG8_STAGEB(PG8_SB(0, 1), b2 + hstep);
            PG8_WAIT_V(6); PG8_BAR; PG8_MMA(1, 1, At, B1); PG8_BAR;
            PG8_LDB(B0, 1, 0); PG8_SCHED; PG8_LDA(At, 1, 0); PG8_STAGE(PG8_SA(0, 1), a2 + hstep);
            PG8_WAIT_L(8); PG8_BAR; PG8_WAIT_L(0); PG8_MMA(0, 0, At, B0); PG8_BAR; PG8_SCHED;
            PG8_LDB(B1, 1, 1); PG8_STAGEB(PG8_SB(1, 0), b3);
            PG8_BAR; PG8_WAIT_L(0); PG8_MMA(0, 1, At, B1); PG8_BAR;
            PG8_LDA(At, 1, 1); PG8_STAGE(PG8_SA(1, 0), a3);
            PG8_BAR; PG8_WAIT_L(0); PG8_MMA(1, 0, At, B0); PG8_BAR; PG8_SCHED;
            PG8_STAGEB(PG8_SB(1, 1), b3 + hstep);
            PG8_WAIT_V(6); PG8_BAR; PG8_MMA(1, 1, At, B1); PG8_BAR;
            }
        }
        if constexpr (ALIGN) { if (wr == 0) PG8_BAR; }
        if constexpr (!FUSED) { const int r0 = cur.pm * BM + wr * 64 + fr, c0 = cur.pn * BM + wc * 32 + fq * 8;
#pragma unroll
          for (int ai = 0; ai < 2; ++ai)
#pragma unroll
            for (int m = 0; m < 4; ++m)
#pragma unroll
              for (int bj = 0; bj < 2; ++bj) E.apply8(r0 + ai * 128 + m * 16, c0 + bj * 128, acc[ai][bj][m][0], acc[ai][bj][m][1]); }
        if (!has_next) break;
#pragma unroll
        for (int a = 0; a < 2; ++a)
#pragma unroll
            for (int b = 0; b < 2; ++b)
#pragma unroll
                for (int m = 0; m < 4; ++m)
#pragma unroll
                    for (int n = 0; n < 2; ++n) acc[a][b][m][n] = (f32x4){0.f, 0.f, 0.f, 0.f};
        cur = nxt; cA = nA; cB = nB; ++ui;
        if constexpr (ALIGN) { if (wr == 1) PG8_BAR; }
    }
    PG8_WAIT_V(0);
    if constexpr (!ALIGN) { if (wr == 0) PG8_BAR; }
    PG8_BAR;
    if constexpr (FUSED) E.fused(acc, cur, wr, wc, fr, fq, lds_gen);
#undef PG8_SA
#undef PG8_SB
#undef PG8_STAGE
#undef PG8_STAGEB
#undef PG8_STAGEV
#undef PG8_LDA
#undef PG8_LDB
#undef PG8_MMA
#undef PG8_WAIT_V
#undef PG8_WAIT_L
#undef PG8_BAR
#undef PG8_SCHED
}

struct EpiG1 {
    float* u; bf16_t* qkv;
    __device__ __forceinline__ void apply(int row, int col, f32x4 v) const {
        const int bcol = col & ~255;
        const int seg = bcol < 512 ? 0 : 1 + ((bcol - 512) >> 10);
        if (seg == 0) { *(f32x4*)(u + (size_t)row * 512 + col) = v; }
        else {
            const int cc = col - 512 - (seg - 1) * 1024;
            if (seg == 2) v *= 0.0625f;
            if (seg >= 4) { v[0] = sigmoidf_(v[0]); v[1] = sigmoidf_(v[1]); v[2] = sigmoidf_(v[2]); v[3] = sigmoidf_(v[3]); }
            u32x2 w; w.x = pk_bf16(v[0], v[1]); w.y = pk_bf16(v[2], v[3]);
            *(u32x2*)(qkv + (size_t)(seg - 1) * MROWS * DM + (size_t)row * DM + cc) = w;
        }
    }
    __device__ __forceinline__ void apply8(int row, int col, f32x4 v0, f32x4 v1) const {
        const int bcol = col & ~255;
        const int seg = bcol < 512 ? 0 : 1 + ((bcol - 512) >> 10);
        if (seg == 0) { *(f32x4*)(u + (size_t)row * 512 + col) = v0; *(f32x4*)(u + (size_t)row * 512 + col + 4) = v1; }
        else {
            const int cc = col - 512 - (seg - 1) * 1024;
            if (seg == 2) { v0 *= 0.0625f; v1 *= 0.0625f; }
            if (seg >= 4) {
#pragma unroll
                for (int j = 0; j < 4; ++j) { v0[j] = sigmoidf_(v0[j]); v1[j] = sigmoidf_(v1[j]); } }
            u32x4 w; w.x = pk_bf16(v0[0], v0[1]); w.y = pk_bf16(v0[2], v0[3]); w.z = pk_bf16(v1[0], v1[1]); w.w = pk_bf16(v1[2], v1[3]);
            *(u32x4*)(qkv + (size_t)(seg - 1) * MROWS * DM + (size_t)row * DM + cc) = w;
        }
    }
};
struct EpiMerge {
    bf16_t* merged; const bf16_t* sg; int mode;
    __device__ __forceinline__ void apply(int row, int col, f32x4 v) const {
        const size_t idx = (size_t)row * DM + col;
        const u32x2 g = *(const u32x2*)(sg + idx);
        v[0] *= bflo(g.x); v[1] *= bfhi(g.x); v[2] *= bflo(g.y); v[3] *= bfhi(g.y);
        if (mode) { const u32x2 o = *(const u32x2*)(merged + idx); v[0] += bflo(o.x); v[1] += bfhi(o.x); v[2] += bflo(o.y); v[3] += bfhi(o.y); }
        u32x2 w; w.x = pk_bf16(v[0], v[1]); w.y = pk_bf16(v[2], v[3]);
        *(u32x2*)(merged + idx) = w;
    }
    __device__ __forceinline__ void apply8(int row, int col, f32x4 v0, f32x4 v1) const {
        const size_t idx = (size_t)row * DM + col;
        const u32x4 g = *(const u32x4*)(sg + idx);
        v0[0] *= bflo(g.x); v0[1] *= bfhi(g.x); v0[2] *= bflo(g.y); v0[3] *= bfhi(g.y); v1[0] *= bflo(g.z); v1[1] *= bfhi(g.z); v1[2] *= bflo(g.w); v1[3] *= bfhi(g.w);
        if (mode) { const u32x4 o = *(const u32x4*)(merged + idx); v0[0] += bflo(o.x); v0[1] += bfhi(o.x); v0[2] += bflo(o.y); v0[3] += bfhi(o.y); v1[0] += bflo(o.z); v1[1] += bfhi(o.z); v1[2] += bflo(o.w); v1[3] += bfhi(o.w); }
        u32x4 w; w.x = pk_bf16(v0[0], v0[1]); w.y = pk_bf16(v0[2], v0[3]); w.z = pk_bf16(v1[0], v1[1]); w.w = pk_bf16(v1[2], v1[3]);
        *(u32x4*)(merged + idx) = w;
    }
};
struct EpiRes {
    float* out; const float* xp; const float* xs; const float* ada; int gate_off; int xin;
    __device__ __forceinline__ void apply(int row, int col, f32x4 v) const {
        const f32x4 g = *(const f32x4*)(ada + (size_t)row_batch(row) * ADAW + gate_off + col);
        const float* bp = xin ? (row < NPR ? xp + (size_t)row * DM : xs + (size_t)(row - NPR) * DM) : out + (size_t)row * DM;
        const f32x4 b = *(const f32x4*)(bp + col);
        *(f32x4*)(out + (size_t)row * DM + col) = b + g * v;
    }
    __device__ __forceinline__ void apply8(int row, int col, f32x4 v0, f32x4 v1) const { apply(row, col, v0); apply(row, col + 4, v1); }
};
struct EpiAct {
    bf16_t* act;
    __device__ __forceinline__ void apply(int row, int col, f32x4 v) const {
#pragma unroll
        for (int j = 0; j < 4; ++j) { float t = fmaxf(v[j], 0.f); v[j] = t * t; }
        u32x2 w; w.x = pk_bf16(v[0], v[1]); w.y = pk_bf16(v[2], v[3]);
        *(u32x2*)(act + (size_t)row * DFF + col) = w;
    }
    __device__ __forceinline__ void apply8(int row, int col, f32x4 v0, f32x4 v1) const {
#pragma unroll
        for (int j = 0; j < 4; ++j) { float t0 = fmaxf(v0[j], 0.f); v0[j] = t0 * t0; float t1 = fmaxf(v1[j], 0.f); v1[j] = t1 * t1; }
        u32x4 w; w.x = pk_bf16(v0[0], v0[1]); w.y = pk_bf16(v0[2], v0[3]); w.z = pk_bf16(v1[0], v1[1]); w.w = pk_bf16(v1[2], v1[3]);
        *(u32x4*)(act + (size_t)row * DFF + col) = w;
    }
};

__device__ __forceinline__ void xchg_publish_wait(unsigned* cnt, unsigned need) {
    asm volatile("s_waitcnt vmcnt(0)" ::: "memory");
    __syncthreads();
    if (threadIdx.x == 0) {
        __builtin_amdgcn_fence(__ATOMIC_RELEASE, "agent");
        asm volatile("s_waitcnt vmcnt(0)" ::: "memory");
        __hip_atomic_fetch_add(cnt, 1u, __ATOMIC_RELAXED, __HIP_MEMORY_SCOPE_AGENT);
        unsigned spins = 0;
        while (__hip_atomic_load(cnt, __ATOMIC_RELAXED, __HIP_MEMORY_SCOPE_AGENT) < need) { __builtin_amdgcn_s_sleep(1); if (++spins > (1u << 24)) break; }
        __builtin_amdgcn_fence(__ATOMIC_ACQUIRE, "agent");
        asm volatile("s_waitcnt vmcnt(0)" ::: "memory");
    }
    __syncthreads();
}
extern __shared__ __attribute__((aligned(16))) unsigned char g_dyn_lds[];
struct EpiFinal {
    float* out; const float* ada; const float* gfin; float* rowpart; unsigned* cnt; float* rowpartS; unsigned* cntS;
    __device__ __forceinline__ void apply(int, int, f32x4) const {}
    __device__ __forceinline__ void apply8(int, int, f32x4, f32x4) const {}
    __device__ __forceinline__ void fused(f32x4 (&acc)[2][2][4][2], const Unit& u, int wr, int wc, int fr, int fq, unsigned char* lds) const {
        const int tid = otid();
        (void)lds;
        float* P = (float*)g_dyn_lds;
        float* S = P + 1024;
        const int r0 = u.pm * BM + wr * 64 + fr, c0 = u.pn * BM + wc * 32 + fq * 8;
#pragma unroll
        for (int ai = 0; ai < 2; ++ai)
#pragma unroll
            for (int m = 0; m < 4; ++m) {
                const int row = r0 + ai * 128 + m * 16;
                const float* ga = ada + (size_t)row_batch(row) * ADAW + 5120;
                float ss = 0.f;
#pragma unroll
                for (int bj = 0; bj < 2; ++bj)
#pragma unroll
                    for (int n = 0; n < 2; ++n) {
                        const int col = c0 + bj * 128 + n * 4;
                        const f32x4 g = *(const f32x4*)(ga + col);
                        const f32x4 b = *(const f32x4*)(out + (size_t)row * DM + col);
                        const f32x4 v = b + g * acc[ai][bj][m][n];
                        acc[ai][bj][m][n] = v;
                        ss += v[0] * v[0] + v[1] * v[1] + v[2] * v[2] + v[3] * v[3];
                    }
                ss += __shfl_xor(ss, 16); ss += __shfl_xor(ss, 32);
                if (fq == 0) P[(ai * 128 + wr * 64 + m * 16 + fr) * 4 + wc] = ss;
                asm volatile("" ::: "memory");
            }
        __syncthreads();
        if (tid < 256) rowpart[((size_t)u.pm * BM + tid) * 4 + u.pn] = (P[tid * 4] + P[tid * 4 + 1]) + (P[tid * 4 + 2] + P[tid * 4 + 3]);
        xchg_publish_wait(cnt + u.pm * 64, 8u);
        if (tid < 256) { const f32x4 rp = *(const f32x4*)(rowpart + ((size_t)u.pm * BM + tid) * 4); S[tid] = rsqrtf(((rp[0] + rp[1]) + (rp[2] + rp[3])) * (1.0f / DM) + EPS); }
        __syncthreads();
#pragma unroll
        for (int ai = 0; ai < 2; ++ai)
#pragma unroll
            for (int m = 0; m < 4; ++m) {
                const int row = r0 + ai * 128 + m * 16;
                const float rs = S[ai * 128 + wr * 64 + m * 16 + fr];
#pragma unroll
                for (int bj = 0; bj < 2; ++bj)
#pragma unroll
                    for (int n = 0; n < 2; ++n) {
                        const int col = c0 + bj * 128 + n * 4;
                        const f32x4 gf = *(const f32x4*)(gfin + col);
                        __builtin_nontemporal_store(acc[ai][bj][m][n] * rs * gf, (f32x4*)(out + (size_t)row * DM + col));
                    }
            }
        __syncthreads();
    }
};

struct EpiMid {
    float* out; const float* xp; const float* xs; const float* ada; const float* gffn; bf16_t* hbuf; float* rowpart; unsigned* cnt; float* rowpartS; unsigned* cntS;
    __device__ __forceinline__ void apply(int, int, f32x4) const {}
    __device__ __forceinline__ void apply8(int, int, f32x4, f32x4) const {}
    __device__ __forceinline__ void fused(f32x4 (&acc)[2][2][4][2], const Unit& u, int wr, int wc, int fr, int fq, unsigned char*) const {
        const int tid = otid();
        float* P = (float*)g_dyn_lds;
        float* S = P + 1024;
        const int r0 = u.pm * BM + wr * 64 + fr, c0 = u.pn * BM + wc * 32 + fq * 8;
#pragma unroll
        for (int ai = 0; ai < 2; ++ai)
#pragma unroll
            for (int m = 0; m < 4; ++m) {
                const int row = r0 + ai * 128 + m * 16;
                const float* ga = ada + (size_t)(row >> 11) * ADAW + 2048;
                float ss = 0.f;
#pragma unroll
                for (int bj = 0; bj < 2; ++bj)
#pragma unroll
                    for (int n = 0; n < 2; ++n) {
                        const int col = c0 + bj * 128 + n * 4;
                        const f32x4 g = *(const f32x4*)(ga + col);
                        const f32x4 b = *(const f32x4*)(xp + (size_t)row * DM + col);
                        const f32x4 v = b + g * acc[ai][bj][m][n];
                        acc[ai][bj][m][n] = v;
                        *(f32x4*)(out + (size_t)row * DM + col) = v;
                        ss += v[0] * v[0] + v[1] * v[1] + v[2] * v[2] + v[3] * v[3];
                    }
                ss += __shfl_xor(ss, 16); ss += __shfl_xor(ss, 32);
                if (fq == 0) P[(ai * 128 + wr * 64 + m * 16 + fr) * 4 + wc] = ss;
                asm volatile("" ::: "memory");
            }
        __syncthreads();
        if (tid < 256) rowpart[((size_t)u.pm * BM + tid) * 4 + u.pn] = (P[tid * 4] + P[tid * 4 + 1]) + (P[tid * 4 + 2] + P[tid * 4 + 3]);
        xchg_publish_wait(cnt + u.pm * 64, 4u);
        if (tid < 256) { const f32x4 rp = *(const f32x4*)(rowpart + ((size_t)u.pm * BM + tid) * 4); S[tid] = rsqrtf(((rp[0] + rp[1]) + (rp[2] + rp[3])) * (1.0f / DM) + EPS); }
        __syncthreads();
        const float* ab = ada + (size_t)(r0 >> 11) * ADAW;
#pragma unroll
        for (int bj = 0; bj < 2; ++bj) {
            const int col = c0 + bj * 128;
            f32x4 G0 = *(const f32x4*)(gffn + col), G1 = *(const f32x4*)(gffn + col + 4);
            G0 *= (*(const f32x4*)(ab + 4096 + col) + 1.0f); G1 *= (*(const f32x4*)(ab + 4096 + col + 4) + 1.0f);
            const f32x4 S0 = *(const f32x4*)(ab + 3072 + col), S1 = *(const f32x4*)(ab + 3072 + col + 4);
#pragma unroll
            for (int ai = 0; ai < 2; ++ai)
#pragma unroll
                for (int m = 0; m < 4; ++m) {
                    const int row = r0 + ai * 128 + m * 16;
                    const float rs = S[ai * 128 + wr * 64 + m * 16 + fr];
                    const f32x4 h0 = acc[ai][bj][m][0] * rs * G0 + S0, h1 = acc[ai][bj][m][1] * rs * G1 + S1;
                    u32x4 w; w.x = pk_bf16(h0[0], h0[1]); w.y = pk_bf16(h0[2], h0[3]); w.z = pk_bf16(h1[0], h1[1]); w.w = pk_bf16(h1[2], h1[3]);
                    *(u32x4*)(hbuf + (size_t)row * DM + col) = w;
                }
        }
        __syncthreads();
    }
};

template <class Epi, int FIN = 0>
__device__ __forceinline__ void small_gemm_phase(unsigned char* lds, const bf16_t* gA, const bf16_t* gBt, const int N, const int K, const Epi& E, const int t_begin, const int t_end) {
    int tid_ = threadIdx.x; asm volatile("" : "+v"(tid_));
    const int tid = tid_, lane = tid & 63, w = tid >> 6, fr = lane & 15, fq = lane >> 4;
    const int kw = K / 8;
    float* red = (float*)lds;
    for (int t = t_begin; t < t_end; ++t) {
        const int rt = t & 15, ct = t >> 4;
        const int row0 = NPR + rt * 32, col0 = ct * 64;
        const bf16_t* ap = gA + (size_t)(row0 + fr) * K + w * kw + fq * 8;
        const bf16_t* bp = gBt + (size_t)(col0 + fr) * K + w * kw + fq * 8;
        f32x4 acc[2][4] = {};
#pragma unroll 2
        for (int k0 = 0; k0 < kw; k0 += 64) {
            bf16x8 af[2][2], bfm[2][4];
#pragma unroll
            for (int s2 = 0; s2 < 2; ++s2) {
#pragma unroll
                for (int m = 0; m < 2; ++m) af[s2][m] = *(const bf16x8*)(ap + (size_t)m * 16 * K + k0 + s2 * 32);
#pragma unroll
                for (int n = 0; n < 4; ++n) bfm[s2][n] = *(const bf16x8*)(bp + (size_t)n * 16 * K + k0 + s2 * 32);
            }
#pragma unroll
            for (int s2 = 0; s2 < 2; ++s2)
#pragma unroll
                for (int m = 0; m < 2; ++m)
#pragma unroll
                    for (int n = 0; n < 4; ++n) acc[m][n] = MFMA16(bfm[s2][n], af[s2][m], acc[m][n]);
        }
#pragma unroll
        for (int m = 0; m < 2; ++m)
#pragma unroll
            for (int n = 0; n < 4; ++n) *(f32x4*)(red + ((w * 32 + m * 16 + fr) * 64 + n * 16 + fq * 4)) = acc[m][n];
        __syncthreads();
        {
            const int r = tid >> 4, c4 = (tid & 15) * 4;
            f32x4 v = *(const f32x4*)(red + (r * 64 + c4));
#pragma unroll
            for (int ww = 1; ww < 8; ++ww) v += *(const f32x4*)(red + ((ww * 32 + r) * 64 + c4));
            if constexpr (FIN == 0) E.apply(row0 + r, col0 + c4, v);
            else if constexpr (FIN == 2) {
                const int row = row0 + r, col = col0 + c4;
                const float* ab = E.ada + (size_t)row_batch(row) * ADAW;
                const f32x4 g = *(const f32x4*)(ab + 2048 + col);
                const f32x4 b = *(const f32x4*)(E.xs + (size_t)(row - NPR) * DM + col);
                const f32x4 x1 = b + g * v;
                *(f32x4*)(E.out + (size_t)row * DM + col) = x1;
                float ss = x1[0] * x1[0] + x1[1] * x1[1] + x1[2] * x1[2] + x1[3] * x1[3];
                ss += __shfl_xor(ss, 1); ss += __shfl_xor(ss, 2); ss += __shfl_xor(ss, 4); ss += __shfl_xor(ss, 8);
                if ((tid & 15) == 0) E.rowpartS[(size_t)(row - NPR) * 16 + ct] = ss;
                xchg_publish_wait(E.cntS + rt * 64, 16u);
                const float* rp = E.rowpartS + (size_t)(row - NPR) * 16;
                float tot = 0.f;
#pragma unroll
                for (int q = 0; q < 16; q += 4) { const f32x4 t4 = *(const f32x4*)(rp + q); tot += (t4[0] + t4[1]) + (t4[2] + t4[3]); }
                const float rs = rsqrtf(tot * (1.0f / DM) + EPS);
                const f32x4 G = *(const f32x4*)(E.gffn + col) * (*(const f32x4*)(ab + 4096 + col) + 1.0f);
                const f32x4 h = x1 * rs * G + *(const f32x4*)(ab + 3072 + col);
                u32x2 wv; wv.x = pk_bf16(h[0], h[1]); wv.y = pk_bf16(h[2], h[3]);
                *(u32x2*)(E.hbuf + (size_t)row * DM + col) = wv;
            }
            else {
                const int row = row0 + r, col = col0 + c4;
                const f32x4 g = *(const f32x4*)(E.ada + (size_t)row_batch(row) * ADAW + 5120 + col);
                const f32x4 b = *(const f32x4*)(E.out + (size_t)row * DM + col);
                const f32x4 x2 = b + g * v;
                float ss = x2[0] * x2[0] + x2[1] * x2[1] + x2[2] * x2[2] + x2[3] * x2[3];
                ss += __shfl_xor(ss, 1); ss += __shfl_xor(ss, 2); ss += __shfl_xor(ss, 4); ss += __shfl_xor(ss, 8);
                if ((tid & 15) == 0) E.rowpartS[(size_t)(row - NPR) * 16 + ct] = ss;
                xchg_publish_wait(E.cntS + rt * 64, 32u);
                const float* rp = E.rowpartS + (size_t)(row - NPR) * 16;
                float tot = 0.f;
#pragma unroll
                for (int q = 0; q < 16; q += 4) { const f32x4 t4 = *(const f32x4*)(rp + q); tot += (t4[0] + t4[1]) + (t4[2] + t4[3]); }
                const float rs = rsqrtf(tot * (1.0f / DM) + EPS);
                const f32x4 gf = *(const f32x4*)(E.gfin + col);
                *(f32x4*)(E.out + (size_t)row * DM + col) = x2 * rs * gf;
            }
        }
        __syncthreads();
    }
}

__device__ __forceinline__ void conv_tile(const float* __restrict__ src, int ld, int K, bf16_t* __restrict__ dst, int kt, int ntile, int src_col0, float* lds) {
    const int tid = otid();
    const int k0 = kt * 64, n0 = ntile * 64;
#pragma unroll
    for (int i = 0; i < 2; ++i) {
        const int r = (tid >> 4) + i * 32, c4 = (tid & 15) * 4;
        const f32x4 v = *(const f32x4*)(src + (size_t)(k0 + r) * ld + src_col0 + c4);
        lds[r * 65 + c4 + 0] = v[0]; lds[r * 65 + c4 + 1] = v[1]; lds[r * 65 + c4 + 2] = v[2]; lds[r * 65 + c4 + 3] = v[3];
    }
    __syncthreads();
    {
        const int n = tid >> 3, k8 = (tid & 7) * 8;
        float v[8];
#pragma unroll
        for (int i = 0; i < 8; ++i) v[i] = lds[(k8 + i) * 65 + n];
        u32x4 w; w.x = pk_bf16(v[0], v[1]); w.y = pk_bf16(v[2], v[3]); w.z = pk_bf16(v[4], v[5]); w.w = pk_bf16(v[6], v[7]);
        *(u32x4*)(dst + (size_t)(n0 + n) * K + k0 + k8) = w;
    }
    __syncthreads();
}

__device__ __forceinline__ void conv_strip(const float* __restrict__ src, int ld, int K, bf16_t* __restrict__ dst, int kt, int nt4, int src_col0, float* lds) {
    const int tid = otid();
    const int k0 = kt * 64, n0 = nt4 * 256;
    f32x4 v[8];
#pragma unroll
    for (int i = 0; i < 8; ++i) { const int r = (tid >> 6) + i * 8, c4 = (tid & 63) * 4; v[i] = __builtin_nontemporal_load((const f32x4*)(src + (size_t)(k0 + r) * ld + src_col0 + c4)); }
#pragma unroll
    for (int i = 0; i < 8; ++i) { const int r = (tid >> 6) + i * 8, c4 = (tid & 63) * 4;
        lds[r * 257 + c4 + 0] = v[i][0]; lds[r * 257 + c4 + 1] = v[i][1]; lds[r * 257 + c4 + 2] = v[i][2]; lds[r * 257 + c4 + 3] = v[i][3]; }
    __syncthreads();
#pragma unroll
    for (int j = 0; j < 4; ++j) {
        const int n = (tid >> 3) + j * 64, k8 = (tid & 7) * 8;
        float x[8];
#pragma unroll
        for (int i = 0; i < 8; ++i) x[i] = lds[(k8 + i) * 257 + n];
        u32x4 w; w.x = pk_bf16(x[0], x[1]); w.y = pk_bf16(x[2], x[3]); w.z = pk_bf16(x[4], x[5]); w.w = pk_bf16(x[6], x[7]);
        *(u32x4*)(dst + (size_t)(n0 + n) * K + k0 + k8) = w;
    }
    __syncthreads();
}

__device__ __forceinline__ void ada_item(const Params& p, int item, float* lds) {
    const int tid = otid(), lane = tid & 63, w = tid >> 6;
    const int cg_ = item >> 3, kq = item & 7;
    const int n0 = cg_ * 128 + lane * 2;
    const int kbase = kq * 128;
    f32x2 acc[17];
#pragma unroll
    for (int r = 0; r < 17; ++r) acc[r] = (f32x2){0.f, 0.f};
    f32x2 wv[16];
#pragma unroll
    for (int j = 0; j < 16; ++j) wv[j] = __builtin_nontemporal_load((const f32x2*)(p.w_ada + (size_t)(kbase + j) * ADAW + n0));
    for (int e = tid; e < NBATCH * 32; e += NTH) {
        const int r = e >> 5, k4 = (e & 31) * 4;
        const float* cp = r < 8 ? p.c_p + (size_t)r * DM : p.c_s + (size_t)(r - 8) * DM;
        f32x4 v = *(const f32x4*)(cp + kbase + k4);
#pragma unroll
        for (int j = 0; j < 4; ++j) v[j] = v[j] * sigmoidf_(v[j]);
        *(f32x4*)(lds + r * 128 + k4) = v;
    }
    __syncthreads();
#pragma unroll 1
    for (int kb = 0; kb < 128; kb += 16) {
        f32x2 wn[16];
        if (kb + 16 < 128) {
#pragma unroll
            for (int j = 0; j < 16; ++j) wn[j] = __builtin_nontemporal_load((const f32x2*)(p.w_ada + (size_t)(kbase + kb + 16 + j) * ADAW + n0));
        }
#pragma unroll
        for (int r = 0; r < 17; ++r) {
#pragma unroll
            for (int k4 = 0; k4 < 16; k4 += 4) {
                const f32x4 sv = *(const f32x4*)(lds + (w * 17 + r) * 128 + kb + k4);
                acc[r] += wv[k4] * sv[0]; acc[r] += wv[k4 + 1] * sv[1]; acc[r] += wv[k4 + 2] * sv[2]; acc[r] += wv[k4 + 3] * sv[3];
            }
        }
        if (kb + 16 < 128) {
#pragma unroll
            for (int j = 0; j < 16; ++j) wv[j] = wn[j];
        }
    }
    __syncthreads();
    float* part = (float*)(p.ws + WS_ADAP) + (size_t)kq * NBATCH * ADAW;
#pragma unroll
    for (int r = 0; r < 17; ++r) *(f32x2*)(part + (size_t)(w * 17 + r) * ADAW + n0) = acc[r];
}

__device__ __forceinline__ void phase0(const Params& p, float* lds) {
    const int NADA = 48 * 8;
    const int T_IN = 16 * 26, T_PG = 16, T_PO = 8 * 4, T_MO = 64, T_OUT = 64, T_W1 = 16 * 16, T_W2 = 64 * 4;
    const int total = NADA + T_IN + T_PG + T_PO + T_MO + T_OUT + T_W1 + T_W2 + 1;
    unsigned* qctr = (unsigned*)(p.ws + WS_CTR) + 16;
    volatile unsigned* slot = (volatile unsigned*)((unsigned char*)lds + LDS_BYTES - 16);
    for (;;) {
        if (threadIdx.x == 0) *slot = atomicAdd(qctr, 1u);
        __syncthreads();
        const int it = (int)*slot;
        __syncthreads();
        if (it >= total) break;
        int t = it;
        if (t < NADA) { ada_item(p, t, lds); continue; }
        t -= NADA;
        if (t < T_IN) { const int kt = t / 26, nt_ = t % 26; const int n0 = nt_ * 256; const int sc = n0 < 4608 ? n0 : n0 + 8;
            conv_strip(p.w_in, INW, DM, (bf16_t*)(p.ws + WS_WIN), kt, nt_, sc, lds); continue; }
        t -= T_IN;
        if (t < T_PG) { const int g = t >> 2, kt = (t >> 1) & 1, nt_ = t & 1;
            conv_tile(p.w_pg + (size_t)g * 128 * 128, 128, 128, (bf16_t*)(p.ws + WS_WPG) + (size_t)g * 128 * 128, kt, nt_, nt_ * 64, lds); continue; }
        t -= T_PG;
        if (t < T_PO) { const int kt = t / 4, nt_ = t % 4; conv_strip(p.w_po, 1024, 512, (bf16_t*)(p.ws + WS_WPO), kt, nt_, nt_ * 256, lds); continue; }
        t -= T_PO;
        if (t < T_MO) { const int kt = t / 4, nt_ = t % 4; conv_strip(p.w_mo, 1024, 1024, (bf16_t*)(p.ws + WS_WMO), kt, nt_, nt_ * 256, lds); continue; }
        t -= T_MO;
        if (t < T_OUT) { const int kt = t / 4, nt_ = t % 4; conv_strip(p.w_out, 1024, 1024, (bf16_t*)(p.ws + WS_WOUT), kt, nt_, nt_ * 256, lds); continue; }
        t -= T_OUT;
        if (t < T_W1) { const int kt = t / 16, nt_ = t % 16; conv_strip(p.w1, 4096, 1024, (bf16_t*)(p.ws + WS_W1), kt, nt_, nt_ * 256, lds); continue; }
        t -= T_W1;
        if (t < T_W2) { const int kt = t / 4, nt_ = t % 4; conv_strip(p.w2, 1024, 4096, (bf16_t*)(p.ws + WS_W2), kt, nt_, nt_ * 256, lds); continue; }
        for (int e = threadIdx.x; e < 1024 * 2; e += NTH) { const int k = e >> 1, hf = e & 1;
            *(f32x4*)((float*)(p.ws + WS_GW) + k * 8 + hf * 4) = *(const f32x4*)(p.w_in + (size_t)k * INW + 4608 + hf * 4); }
    }
}

__device__ __forceinline__ void norm_item(const Params& p, int item, int mode, float* lds) {
    const int tid = otid(), lane = tid & 63, w = tid >> 6;
    const float* adap = (const float*)(p.ws + WS_ADAP);
    const float* adaf = (const float*)(p.ws + WS_ADA);
    bf16_t* hbuf = (bf16_t*)(p.ws + WS_H);
    if (mode == 0) {
        for (int e = tid; e < 1024 * 2; e += NTH) *(f32x4*)(lds + e * 4) = *(const f32x4*)((const float*)(p.ws + WS_GW) + e * 4);
        __syncthreads();
    }
    const int r_begin = item * 64 + w * 8;
    const int r_extra = NPR + item * 2 + w;
    const int nrows = w < 2 ? 9 : 8;
    int cur_b = -1;
    f32x4 G[4], S[4], xn[4];
    { const int row = r_begin; const float* src0 = mode == 0 ? (row < NPR ? p.x_p + (size_t)row * DM : p.x_s + (size_t)(row - NPR) * DM) : p.out + (size_t)row * DM;
#pragma unroll
      for (int i = 0; i < 4; ++i) xn[i] = *(const f32x4*)(src0 + i * 256 + lane * 4); }
    for (int rr = 0; rr < nrows; ++rr) {
        const int row = rr < 8 ? r_begin + rr : r_extra;
        const int b = row_batch(row);
        if (mode != 2 && b != cur_b) {
            cur_b = b;
            const float* gw = mode == 0 ? p.g_mix : p.g_ffn;
            const int sh_off = mode == 0 ? 0 : 3072, sc_off = mode == 0 ? 1024 : 4096;
            f32x4 scv[4], shv[4];
            if (mode == 0) {
#pragma unroll
                for (int i = 0; i < 4; ++i) { const int col = i * 256 + lane * 4; scv[i] = *(const f32x4*)(p.b_ada + sc_off + col); shv[i] = *(const f32x4*)(p.b_ada + sh_off + col); }
#pragma unroll 2
                for (int q = 0; q < 8; ++q) {
                    const float* ap = adap + ((size_t)q * NBATCH + b) * ADAW;
#pragma unroll
                    for (int i = 0; i < 4; ++i) { const int col = i * 256 + lane * 4; scv[i] += *(const f32x4*)(ap + sc_off + col); shv[i] += *(const f32x4*)(ap + sh_off + col); }
                }
            } else {
#pragma unroll
                for (int i = 0; i < 4; ++i) { const int col = i * 256 + lane * 4; scv[i] = *(const f32x4*)(adaf + (size_t)b * ADAW + sc_off + col); shv[i] = *(const f32x4*)(adaf + (size_t)b * ADAW + sh_off + col); }
            }
#pragma unroll
            for (int i = 0; i < 4; ++i) { const f32x4 g = *(const f32x4*)(gw + i * 256 + lane * 4); G[i] = g * (scv[i] + 1.0f); S[i] = shv[i]; }
        }
        f32x4 x[4]; float ss = 0.f;
#pragma unroll
        for (int i = 0; i < 4; ++i) { x[i] = xn[i]; ss += x[i][0] * x[i][0] + x[i][1] * x[i][1] + x[i][2] * x[i][2] + x[i][3] * x[i][3]; }
        if (rr + 1 < nrows) { const int rown = rr + 1 < 8 ? row + 1 : r_extra;
            const float* srcn = mode == 0 ? (rown < NPR ? p.x_p + (size_t)rown * DM : p.x_s + (size_t)(rown - NPR) * DM) : p.out + (size_t)rown * DM;
#pragma unroll
            for (int i = 0; i < 4; ++i) xn[i] = *(const f32x4*)(srcn + i * 256 + lane * 4); }
        ss = wave_sum(ss);
        const float rstd = rsqrtf(ss * (1.0f / DM) + EPS);
        if (mode == 2) {
#pragma unroll
            for (int i = 0; i < 4; ++i) { const f32x4 g = *(const f32x4*)(p.g_final + i * 256 + lane * 4); __builtin_nontemporal_store(x[i] * rstd * g, (f32x4*)(p.out + (size_t)row * DM + i * 256 + lane * 4)); }
            continue;
        }
        f32x4 hv[4];
#pragma unroll
        for (int i = 0; i < 4; ++i) { hv[i] = x[i] * rstd * G[i] + S[i];
            u32x2 wv; wv.x = pk_bf16(hv[i][0], hv[i][1]); wv.y = pk_bf16(hv[i][2], hv[i][3]);
            *(u32x2*)(hbuf + (size_t)row * DM + i * 256 + lane * 4) = wv; }
        if (mode == 0) {
            float d[8];
#pragma unroll
            for (int j = 0; j < 8; ++j) d[j] = 0.f;
#pragma unroll
            for (int i = 0; i < 4; ++i)
#pragma unroll
                for (int e = 0; e < 4; ++e) {
                    const int k = i * 256 + lane * 4 + e;
                    const f32x4 w0 = *(const f32x4*)(lds + k * 8), w1 = *(const f32x4*)(lds + k * 8 + 4);
                    const float hvv = hv[i][e];
                    d[0] += hvv * w0[0]; d[1] += hvv * w0[1]; d[2] += hvv * w0[2]; d[3] += hvv * w0[3];
                    d[4] += hvv * w1[0]; d[5] += hvv * w1[1]; d[6] += hvv * w1[2]; d[7] += hvv * w1[3];
                }
#pragma unroll
            for (int j = 0; j < 8; ++j) d[j] = wave_sum(d[j]);
            if (lane < 4) {
                float di = lane == 0 ? d[0] : lane == 1 ? d[1] : lane == 2 ? d[2] : d[3];
                float df = lane == 0 ? d[4] : lane == 1 ? d[5] : lane == 2 ? d[6] : d[7];
                di += p.b_i[lane];
                const float z = df + p.b_f[lane];
                const float lf = fminf(z, 0.f) - log1pf(__expf(-fabsf(z)));
                ((float*)(p.ws + WS_GI))[(size_t)row * 4 + lane] = di;
                ((float*)(p.ws + WS_GF))[(size_t)row * 4 + lane] = lf;
            }
        }
    }
    if (mode == 0) __syncthreads();
}

__device__ __forceinline__ void ada_final_slice(const Params& p, int blk) {
    const float* adap = (const float*)(p.ws + WS_ADAP);
    float* adaf = (float*)(p.ws + WS_ADA);
    for (int e = threadIdx.x; e < 816; e += NTH) {
        const size_t idx = ((size_t)blk * 816 + e) * 4;
        f32x4 v = *(const f32x4*)(p.b_ada + (idx % ADAW));
#pragma unroll
        for (int q = 0; q < 8; ++q) v += *(const f32x4*)(adap + (size_t)q * NBATCH * ADAW + idx);
        *(f32x4*)(adaf + idx) = v;
    }
}

__device__ __forceinline__ void scan_item(const Params& p, int item, unsigned char* lds) {
    const int tid = otid(), lane = tid & 63, w = tid >> 6, fr = lane & 15, fq = lane >> 4;
    const int bh = item >> 2, j = item & 3, b = bh >> 2, hd = bh & 3, dv0 = j * 64;
    const float* gi = (const float*)(p.ws + WS_GI); const float* gf = (const float*)(p.ws + WS_GF);
    const bf16_t* kbuf = (const bf16_t*)(p.ws + WS_QKV) + (size_t)1 * MROWS * DM;
    const bf16_t* vbuf = (const bf16_t*)(p.ws + WS_QKV) + (size_t)2 * MROWS * DM;
    bf16_t* cst = (bf16_t*)(p.ws + WS_CST) + (size_t)bh * 31 * 65536;
    float* nst = (float*)(p.ws + WS_NST) + (size_t)bh * 32 * 256;
    float* mst = (float*)(p.ws + WS_MST) + (size_t)bh * 64;
    constexpr int KROW = 144;
    unsigned char* kimg[2] = {lds, lds + 256 * KROW};
    unsigned char* vimg[2] = {lds + 2 * 256 * KROW, lds + 2 * 256 * KROW + 64 * KROW};
    float* aA = (float*)(lds + 2 * 256 * KROW + 2 * 64 * KROW);
    float* bLs = aA + 2048;
    float* amx = bLs + 32;
    float* mch = amx + 32;
    float* dcy = mch + 40;
    for (int c = w * 4; c < w * 4 + 4; ++c) {
        const size_t tok = (size_t)b * SEQ + c * 64 + lane;
        const float lf = gf[tok * 4 + hd], il = gi[tok * 4 + hd];
        const float bs = wave_scan_add(lf, lane);
        const float bL = __shfl(bs, 63);
        const float a = bL - bs + il;
        const float am = wave_max(a);
        aA[c * 64 + lane] = a;
        if (lane == 0) { bLs[c] = bL; amx[c] = am; }
    }
    __syncthreads();
    if (tid == 0) {
        float m = 0.f; mch[0] = 0.f;
        for (int c = 0; c < 32; ++c) { const float mn = fmaxf(bLs[c] + m, amx[c]); dcy[c] = __expf(bLs[c] + m - mn); m = mn; mch[c + 1] = mn; }
    }
    __syncthreads();
    if (j == 0 && tid < 33) mst[tid] = mch[tid];
    if (j == 0 && tid == 0) p.out[O_MP + bh] = mch[32];
    f32x4 acc[2][4] = {};
    float nacc = 0.f;
    u32x4 krA[4], krB[4]; u32x4 vrA, vrB;
#define SCAN_GLOAD(KR, VR, cc) do { const size_t tok_ = (size_t)b * SEQ + (cc) * 64 + lane; const bf16_t* kp_ = kbuf + tok_ * DM + hd * 256 + w * 32; \
        _Pragma("unroll") for (int i_ = 0; i_ < 4; ++i_) KR[i_] = *(const u32x4*)(kp_ + i_ * 8); \
        VR = *(const u32x4*)(vbuf + tok_ * DM + hd * 256 + dv0 + w * 8); } while (0)
#define SCAN_WRITE(KR, VR, cc, ki, vi) do { const float wsv = __expf(aA[(cc) * 64 + lane] - mch[(cc) + 1]); \
        _Pragma("unroll") for (int i_ = 0; i_ < 4; ++i_) { const unsigned uu[4] = {KR[i_].x, KR[i_].y, KR[i_].z, KR[i_].w}; \
            _Pragma("unroll") for (int e_ = 0; e_ < 4; ++e_) { const int dk_ = w * 32 + i_ * 8 + e_ * 2; \
                *(bf16_t*)(ki + dk_ * KROW + lane * 2) = f2bf(bflo(uu[e_]) * wsv); *(bf16_t*)(ki + (dk_ + 1) * KROW + lane * 2) = f2bf(bfhi(uu[e_]) * wsv); } } \
        const int dv_ = w * 8; \
        *(bf16_t*)(vi + (dv_ + 0) * KROW + lane * 2) = (bf16_t)(VR.x & 0xffffu); *(bf16_t*)(vi + (dv_ + 1) * KROW + lane * 2) = (bf16_t)(VR.x >> 16); \
        *(bf16_t*)(vi + (dv_ + 2) * KROW + lane * 2) = (bf16_t)(VR.y & 0xffffu); *(bf16_t*)(vi + (dv_ + 3) * KROW + lane * 2) = (bf16_t)(VR.y >> 16); \
        *(bf16_t*)(vi + (dv_ + 4) * KROW + lane * 2) = (bf16_t)(VR.z & 0xffffu); *(bf16_t*)(vi + (dv_ + 5) * KROW + lane * 2) = (bf16_t)(VR.z >> 16); \
        *(bf16_t*)(vi + (dv_ + 6) * KROW + lane * 2) = (bf16_t)(VR.w & 0xffffu); *(bf16_t*)(vi + (dv_ + 7) * KROW + lane * 2) = (bf16_t)(VR.w >> 16); } while (0)
    SCAN_GLOAD(krA, vrA, 0);
    SCAN_GLOAD(krB, vrB, 1);
    for (int c = 0; c < 32; ++c) {
        unsigned char* ki = kimg[c & 1]; unsigned char* vi = vimg[c & 1];
        if ((c & 1) == 0) { SCAN_WRITE(krA, vrA, c, ki, vi); if (c + 2 < 32) SCAN_GLOAD(krA, vrA, c + 2); }
        else { SCAN_WRITE(krB, vrB, c, ki, vi); if (c + 2 < 32) SCAN_GLOAD(krB, vrB, c + 2); }
        __syncthreads();
        const float dc = dcy[c];
        bf16x8 af[2][2], bfr[4][2];
#pragma unroll
        for (int a = 0; a < 2; ++a)
#pragma unroll
            for (int k = 0; k < 2; ++k) af[a][k] = *(const bf16x8*)(ki + ((w * 2 + a) * 16 + fr) * KROW + (k * 32 + fq * 8) * 2);
#pragma unroll
        for (int a = 0; a < 4; ++a)
#pragma unroll
            for (int k = 0; k < 2; ++k) bfr[a][k] = *(const bf16x8*)(vi + (a * 16 + fr) * KROW + (k * 32 + fq * 8) * 2);
#pragma unroll
        for (int a = 0; a < 2; ++a)
#pragma unroll
            for (int q = 0; q < 4; ++q) {
                acc[a][q] *= dc;
#pragma unroll
                for (int k = 0; k < 2; ++k) acc[a][q] = MFMA16(af[a][k], bfr[q][k], acc[a][q]);
            }
        if (j == 0) {
            const int dk = tid >> 1, hf = tid & 1;
            float s = 0.f;
#pragma unroll
            for (int i = 0; i < 4; ++i) {
                const u32x4 v = *(const u32x4*)(ki + dk * KROW + hf * 64 + i * 16);
                s += bflo(v.x) + bfhi(v.x) + bflo(v.y) + bfhi(v.y) + bflo(v.z) + bfhi(v.z) + bflo(v.w) + bfhi(v.w);
            }
            s += __shfl_xor(s, 1);
            nacc = nacc * dc + s;
            if (hf == 0) { if (c < 31) nst[(c + 1) * 256 + dk] = nacc; else p.out[O_NP + (size_t)bh * 256 + dk] = nacc; }
        }
        if (c < 31) {
            bf16_t* cs = cst + (size_t)c * 65536;
#pragma unroll
            for (int a = 0; a < 2; ++a)
#pragma unroll
                for (int q = 0; q < 4; ++q) {
                    u32x2 wv; wv.x = pk_bf16(acc[a][q][0], acc[a][q][1]); wv.y = pk_bf16(acc[a][q][2], acc[a][q][3]);
                    *(u32x2*)(cs + (size_t)(dv0 + q * 16 + fr) * 256 + (w * 2 + a) * 16 + fq * 4) = wv;
                }
        } else {
            float* co = p.out + O_CP + (size_t)bh * 65536;
#pragma unroll
            for (int a = 0; a < 2; ++a)
#pragma unroll
                for (int q = 0; q < 4; ++q)
#pragma unroll
                    for (int jj = 0; jj < 4; ++jj) co[(size_t)((w * 2 + a) * 16 + fq * 4 + jj) * 256 + dv0 + q * 16 + fr] = acc[a][q][jj];
        }
    }
    __syncthreads();
}

__device__ __forceinline__ void sample_item(const Params& p, int item, unsigned char* ldsb) {
    const int tid = otid(), lane = tid & 63, w = tid >> 6;
    const int b = item >> 2, hd = item & 3, bh = item;
    const int r0 = NPR + b * 4;
    const bf16_t* qb = (const bf16_t*)(p.ws + WS_QKV);
    const bf16_t* kb = qb + (size_t)MROWS * DM; const bf16_t* vb = kb + (size_t)MROWS * DM; const bf16_t* ob = vb + (size_t)MROWS * DM;
    const float* gi = (const float*)(p.ws + WS_GI); const float* gf = (const float*)(p.ws + WS_GF);
    float* lds = (float*)ldsb;
    float* qf = lds;
    float* kf = qf + 1024;
    float* vf = kf + 1024;
    float* Sm = vf + 1024;
    float* sc = Sm + 16;
    float* red = sc + 64;
    float* ssq = red + 8192;
    const int dv4 = lane * 4;
    const float* C0 = p.st_C + (size_t)bh * 65536;
    float* Cn = p.out + O_CS + (size_t)bh * 65536;
    f32x4 cpre[8];
#pragma unroll
    for (int r = 0; r < 8; ++r) cpre[r] = __builtin_nontemporal_load((const f32x4*)(C0 + (size_t)(w * 32 + r) * 256 + dv4));
    float* n0s = ssq + 8;
    const int ft = tid >> 7, fdv = (tid & 127) * 2;
    const size_t foidx = (size_t)(r0 + ft) * DM + hd * 256 + fdv;
    const unsigned fog = *(const unsigned*)(ob + foidx);
    const float fm0 = p.m_norm[hd * 256 + fdv], fm1 = p.m_norm[hd * 256 + fdv + 1];
    if (tid < 256) n0s[tid] = p.st_n[(size_t)bh * 256 + tid];
    for (int e = tid; e < 3 * 4 * 256; e += NTH) {
        const int which = e >> 10, t = (e >> 8) & 3, d = e & 255;
        const bf16_t* src = which == 0 ? qb : which == 1 ? kb : vb;
        lds[which * 1024 + t * 256 + d] = bf2f(src[(size_t)(r0 + t) * DM + hd * 256 + d]);
    }
    if (tid == 0) {
        float lf[4], il[4], bs[4];
        for (int t = 0; t < 4; ++t) { lf[t] = gf[(size_t)(r0 + t) * 4 + hd]; il[t] = gi[(size_t)(r0 + t) * 4 + hd]; }
        bs[0] = lf[0]; bs[1] = bs[0] + lf[1]; bs[2] = bs[1] + lf[2]; bs[3] = bs[2] + lf[3];
        const float m0 = p.st_m[bh];
        for (int t = 0; t < 4; ++t) {
            const float g = bs[t] + m0; float mt = g;
            for (int s = 0; s <= t; ++s) mt = fmaxf(mt, bs[t] - bs[s] + il[s]);
            sc[t] = __expf(g - mt); sc[4 + t] = __expf(-mt);
            for (int s = 0; s < 4; ++s) sc[16 + t * 4 + s] = s <= t ? __expf(bs[t] - bs[s] + il[s] - mt) : 0.f;
        }
        const float bL = bs[3]; float mn = bL + m0;
        for (int s = 0; s < 4; ++s) mn = fmaxf(mn, bL - bs[s] + il[s]);
        sc[12] = __expf(bL + m0 - mn);
        for (int s = 0; s < 4; ++s) sc[8 + s] = __expf(bL - bs[s] + il[s] - mn);
        p.out[O_MS + bh] = mn;
    }
    __syncthreads();
    {
        const int g = tid >> 5, l32 = tid & 31;
        {
            const int t = g >> 2, s = g & 3; float a = 0.f;
#pragma unroll
            for (int d = l32; d < 256; d += 32) a += qf[t * 256 + d] * kf[s * 256 + d];
#pragma unroll
            for (int dd = 16; dd >= 1; dd >>= 1) a += __shfl_xor(a, dd);
            if (l32 == 0) Sm[g] = a * sc[16 + g];
        }
        if (g < 4) {
            float a = 0.f;
#pragma unroll
            for (int d = l32; d < 256; d += 32) a += qf[g * 256 + d] * n0s[d];
#pragma unroll
            for (int dd = 16; dd >= 1; dd >>= 1) a += __shfl_xor(a, dd);
            if (l32 == 0) sc[32 + g] = a;
        }
    }
    const float decay = sc[12];
    const float ws0 = sc[8], ws1 = sc[9], ws2 = sc[10], ws3 = sc[11];
    if (tid < 256) {
        const float nn = decay * n0s[tid] + ws0 * kf[tid] + ws1 * kf[256 + tid] + ws2 * kf[512 + tid] + ws3 * kf[768 + tid];
        p.out[O_NS + (size_t)bh * 256 + tid] = nn;
    }
    {
        f32x4 vv[4], num[4];
        vv[0] = *(const f32x4*)(vf + dv4) * ws0; vv[1] = *(const f32x4*)(vf + 256 + dv4) * ws1; vv[2] = *(const f32x4*)(vf + 512 + dv4) * ws2; vv[3] = *(const f32x4*)(vf + 768 + dv4) * ws3;
#pragma unroll
        for (int s = 0; s < 4; ++s) num[s] = (f32x4){0.f, 0.f, 0.f, 0.f};
#pragma unroll
        for (int r = 0; r < 8; ++r) {
            const int dk = w * 32 + r;
            const f32x4 cv = cpre[r];
            f32x4 cn = cv * decay;
#pragma unroll
            for (int s = 0; s < 4; ++s) { num[s] += cv * qf[s * 256 + dk]; cn += vv[s] * kf[s * 256 + dk]; }
            __builtin_nontemporal_store(cn, (f32x4*)(Cn + (size_t)dk * 256 + dv4));
        }
#pragma unroll 8
        for (int r = 8; r < 32; ++r) {
            const int dk = w * 32 + r;
            const f32x4 cv = __builtin_nontemporal_load((const f32x4*)(C0 + (size_t)dk * 256 + dv4));
            f32x4 cn = cv * decay;
#pragma unroll
            for (int s = 0; s < 4; ++s) { num[s] += cv * qf[s * 256 + dk]; cn += vv[s] * kf[s * 256 + dk]; }
            __builtin_nontemporal_store(cn, (f32x4*)(Cn + (size_t)dk * 256 + dv4));
        }
        __syncthreads();
#pragma unroll
        for (int t = 0; t < 4; ++t) *(f32x4*)(red + (w * 4 + t) * 256 + dv4) = num[t];
    }
    __syncthreads();
    {
        const int t = tid >> 7, dv = (tid & 127) * 2;
        float n0_ = 0.f, n1_ = 0.f;
#pragma unroll
        for (int ww = 0; ww < 8; ++ww) { n0_ += red[(ww * 4 + t) * 256 + dv]; n1_ += red[(ww * 4 + t) * 256 + dv + 1]; }
        const float wint = sc[t];
        n0_ *= wint; n1_ *= wint;
        float rs = 0.f;
#pragma unroll
        for (int s = 0; s < 4; ++s) { const float sv = Sm[t * 4 + s]; rs += sv; n0_ += sv * vf[s * 256 + dv]; n1_ += sv * vf[s * 256 + dv + 1]; }
        const float den = wint * sc[32 + t] + rs;
        const float dinv = 1.0f / fmaxf(fabsf(den), sc[4 + t]);
        const float h0 = n0_ * dinv, h1 = n1_ * dinv;
        float q2 = wave_sum(h0 * h0 + h1 * h1);
        if (lane == 0) ssq[t * 2 + (w & 1)] = q2;
        __syncthreads();
        const float rstd = rsqrtf((ssq[t * 2] + ssq[t * 2 + 1]) * (1.0f / 256.f) + EPS);
        const float o0 = h0 * rstd * fm0 * bflo(fog), o1 = h1 * rstd * fm1 * bfhi(fog);
        *(unsigned*)((bf16_t*)(p.ws + WS_HM) + foidx) = pk_bf16(o0, o1);
    }
    __syncthreads();
}

__device__ __forceinline__ void pool_item(const Params& p, int item, unsigned char* lds) {
    const int tid = otid(), lane = tid & 63, w = tid >> 6, fr = lane & 15, fq = lane >> 4;
    const int r0 = item < 256 ? item * 64 : NPR + (item - 256) * 16;
    const int nm = item < 256 ? 4 : 1;
    const float* u = (const float*)(p.ws + WS_U);
    constexpr int AROW = 1040;
    bf16x8 bw[4][4];
    {
        const bf16_t* wt0 = (const bf16_t*)(p.ws + WS_WPG) + (size_t)(w >> 1) * 128 * 128;
#pragma unroll
        for (int k = 0; k < 4; ++k)
#pragma unroll
            for (int n = 0; n < 4; ++n) bw[k][n] = *(const bf16x8*)(wt0 + (size_t)(((w & 1) * 4 + n) * 16 + fr) * 128 + k * 32 + fq * 8);
    }
    {
        const int c = tid, gidx = c >> 7, win = 2 << gidx;
        float hist[31];
        if (r0 < NPR) {
            const int t0 = r0 & (SEQ - 1);
#pragma unroll
            for (int j = 0; j < 15; ++j) hist[j] = (t0 - 15 + j) >= 0 ? u[(size_t)(r0 - 15 + j) * 512 + c] : 0.f;
            float nxt[16];
#pragma unroll
            for (int j = 0; j < 16; ++j) nxt[j] = u[(size_t)(r0 + j) * 512 + c];
#pragma unroll 1
            for (int ch = 0; ch < 4; ++ch) {
#pragma unroll
                for (int j = 0; j < 16; ++j) hist[15 + j] = nxt[j];
                if (ch < 3) {
#pragma unroll
                    for (int j = 0; j < 16; ++j) nxt[j] = u[(size_t)(r0 + (ch + 1) * 16 + j) * 512 + c];
                }
#pragma unroll
                for (int j = 0; j < 16; ++j) {
                    const int i = ch * 16 + j, t = t0 + i, q = 15 + j;
                    const float s2 = hist[q] + hist[q - 1];
                    const float s4 = s2 + hist[q - 2] + hist[q - 3];
                    const float s8 = s4 + (hist[q - 4] + hist[q - 5]) + (hist[q - 6] + hist[q - 7]);
                    const float s16 = s8 + ((hist[q - 8] + hist[q - 9]) + (hist[q - 10] + hist[q - 11])) + ((hist[q - 12] + hist[q - 13]) + (hist[q - 14] + hist[q - 15]));
                    const float s = gidx == 0 ? s2 : gidx == 1 ? s4 : gidx == 2 ? s8 : s16;
                    const float rc = __builtin_amdgcn_rcpf((float)min(t + 1, win));
                    *(bf16_t*)(lds + i * AROW + c * 2) = f2bf(s * rc - hist[q]);
                }
#pragma unroll
                for (int j = 0; j < 15; ++j) hist[j] = hist[16 + j];
            }
        } else {
#pragma unroll 1
            for (int bi = 0; bi < 4; ++bi) {
                const int bb = ((r0 - NPR) >> 2) + bi;
#pragma unroll
                for (int j = 0; j < 15; ++j) hist[j] = p.st_pool[((size_t)bb * 15 + j) * 512 + c];
#pragma unroll
                for (int j = 0; j < 4; ++j) hist[15 + j] = u[((size_t)NPR + bb * 4 + j) * 512 + c];
#pragma unroll
                for (int j = 0; j < 4; ++j) {
                    const int i = bi * 4 + j, q = 15 + j;
                    const float s2 = hist[q] + hist[q - 1];
                    const float s4 = s2 + hist[q - 2] + hist[q - 3];
                    const float s8 = s4 + (hist[q - 4] + hist[q - 5]) + (hist[q - 6] + hist[q - 7]);
                    const float s16 = s8 + ((hist[q - 8] + hist[q - 9]) + (hist[q - 10] + hist[q - 11])) + ((hist[q - 12] + hist[q - 13]) + (hist[q - 14] + hist[q - 15]));
                    const float s = gidx == 0 ? s2 : gidx == 1 ? s4 : gidx == 2 ? s8 : s16;
                    *(bf16_t*)(lds + i * AROW + c * 2) = f2bf(s * (1.0f / (float)win) - hist[q]);
                }
            }
        }
    }
    __syncthreads();
    {
        const int g = w >> 1, nh = w & 1;
        f32x4 acc[4][4] = {};
#pragma unroll
        for (int k = 0; k < 4; ++k) {
            bf16x8 af[4];
#pragma unroll
            for (int m = 0; m < 4; ++m) if (m < nm) af[m] = *(const bf16x8*)(lds + (m * 16 + fr) * AROW + (g * 128 + k * 32 + fq * 8) * 2);
#pragma unroll
            for (int m = 0; m < 4; ++m) if (m < nm) {
#pragma unroll
                for (int n = 0; n < 4; ++n) acc[m][n] = MFMA16(bw[k][n], af[m], acc[m][n]); }
        }
        bf16_t* yp = (bf16_t*)(p.ws + WS_YP);
#pragma unroll
        for (int m = 0; m < 4; ++m) if (m < nm)
#pragma unroll
            for (int n = 0; n < 4; ++n) {
                const int col = g * 128 + (nh * 4 + n) * 16 + fq * 4;
                const f32x4 scv = *(const f32x4*)(p.pool_scale + col);
                const f32x4 v = acc[m][n] * scv;
                u32x2 wv; wv.x = pk_bf16(v[0], v[1]); wv.y = pk_bf16(v[2], v[3]);
                *(u32x2*)(yp + (size_t)(r0 + m * 16 + fr) * 512 + col) = wv;
            }
    }
    __syncthreads();
}

__device__ __forceinline__ void poolout_item(const Params& p, int item) {
    const float* u = (const float*)(p.ws + WS_U);
    for (int e = threadIdx.x; e < 15 * 512; e += NTH) {
        const int jj = e >> 9, c = e & 511;
        if (item < 8) p.out[O_POOLP + (size_t)item * 7680 + e] = u[((size_t)item * SEQ + 2033 + jj) * 512 + c];
        else { const int bb = item - 8;
            p.out[O_POOLS + (size_t)bb * 7680 + e] = jj < 11 ? p.st_pool[((size_t)bb * 15 + jj + 4) * 512 + c] : u[((size_t)NPR + bb * 4 + (jj - 11)) * 512 + c]; }
    }
}

__device__ __forceinline__ void mout_item(const Params& p, int item, unsigned char* lds) {
    const int tid = otid(), lane = tid & 63, w = tid >> 6, fr = lane & 15, fq = lane >> 4;
    const int bh = item >> 5, c = item & 31, b = bh >> 2, hd = bh & 3;
    const size_t tok0 = (size_t)b * SEQ + c * 64;
    const bf16_t* qb = (const bf16_t*)(p.ws + WS_QKV);
    const bf16_t* kb = qb + (size_t)MROWS * DM; const bf16_t* vb = kb + (size_t)MROWS * DM; const bf16_t* ob = vb + (size_t)MROWS * DM;
    const float* gi = (const float*)(p.ws + WS_GI); const float* gf = (const float*)(p.ws + WS_GF);
    constexpr int QROW = 528, VROW = 144;
    unsigned char* Qs = lds;
    unsigned char* Ks = Qs + 64 * QROW;
    unsigned char* Vt = Ks + 64 * QROW;
    unsigned char* Sp = Vt + 256 * VROW;
    float* scal = (float*)(Sp + 64 * VROW);
    float* rt = scal, *ct = scal + 64, *wint = scal + 128, *emt = scal + 192, *rowsum = scal + 256  , *qn = scal + 384, *ssq = scal + 448  , *ncs = scal + 960  ;
    bf16x8 cfr[8][2];
    if (c > 0) {
        const bf16_t* cs = (const bf16_t*)(p.ws + WS_CST) + ((size_t)bh * 31 + (c - 1)) * 65536;
#pragma unroll
        for (int k = 0; k < 8; ++k)
#pragma unroll
            for (int n = 0; n < 2; ++n) cfr[k][n] = *(const bf16x8*)(cs + (size_t)(w * 32 + n * 16 + fr) * 256 + k * 32 + fq * 8);
    }
    u32x2 ogv[4][2]; f32x4 mnv[2];
#pragma unroll
    for (int n = 0; n < 2; ++n) { const int dvg = hd * 256 + w * 32 + n * 16 + fq * 4; mnv[n] = *(const f32x4*)(p.m_norm + dvg);
#pragma unroll
        for (int m = 0; m < 4; ++m) ogv[m][n] = *(const u32x2*)(ob + (tok0 + m * 16 + fr) * DM + dvg); }
#pragma unroll
    for (int i = 0; i < 4; ++i) {
        const int pc = tid + NTH * i, row = pc >> 5, c8 = pc & 31;
        *(u32x4*)(Qs + row * QROW + c8 * 16) = *(const u32x4*)(qb + (tok0 + row) * DM + hd * 256 + c8 * 8);
        *(u32x4*)(Ks + row * QROW + c8 * 16) = *(const u32x4*)(kb + (tok0 + row) * DM + hd * 256 + c8 * 8);
    }
    {
        const bf16_t* vp = vb + (tok0 + lane) * DM + hd * 256 + w * 32;
#pragma unroll
        for (int i = 0; i < 4; ++i) {
            const u32x4 v = *(const u32x4*)(vp + i * 8);
            const unsigned uu[4] = {v.x, v.y, v.z, v.w};
#pragma unroll
            for (int e = 0; e < 4; ++e) {
                const int dv = w * 32 + i * 8 + e * 2;
                *(bf16_t*)(Vt + dv * VROW + lane * 2) = (bf16_t)(uu[e] & 0xffffu);
                *(bf16_t*)(Vt + (dv + 1) * VROW + lane * 2) = (bf16_t)(uu[e] >> 16);
            }
        }
    }
    if (c > 0 && tid >= 256) ncs[tid - 256] = ((const float*)(p.ws + WS_NST))[((size_t)bh * 32 + c) * 256 + tid - 256];
    if (w == 0) {
        const float lf = gf[(tok0 + lane) * 4 + hd], il = gi[(tok0 + lane) * 4 + hd];
        const float bs = wave_scan_add(lf, lane);
        const float mc = ((const float*)(p.ws + WS_MST))[bh * 64 + c];
        const float g = bs + mc, xx = il - bs;
        const float pm = wave_scan_max(xx, lane);
        const float mt = fmaxf(g, bs + pm);
        rt[lane] = bs - mt; ct[lane] = xx; wint[lane] = __expf(g - mt); emt[lane] = __expf(-mt);
    }
    __syncthreads();
    {
        const int tt = w >> 1, sh = w & 1;
        f32x4 sa[2] = {};
#pragma unroll
        for (int k = 0; k < 8; ++k) {
            const bf16x8 qf = *(const bf16x8*)(Qs + (tt * 16 + fr) * QROW + (k * 32 + fq * 8) * 2);
#pragma unroll
            for (int s2 = 0; s2 < 2; ++s2) {
                const bf16x8 kf = *(const bf16x8*)(Ks + ((sh * 2 + s2) * 16 + fr) * QROW + (k * 32 + fq * 8) * 2);
                sa[s2] = MFMA16(kf, qf, sa[s2]);
            }
        }
        const int t = tt * 16 + fr;
        const float rtt = rt[t];
        float rs = 0.f;
#pragma unroll
        for (int s2 = 0; s2 < 2; ++s2) {
            const int s0 = (sh * 2 + s2) * 16 + fq * 4;
            float v[4];
#pragma unroll
            for (int jj = 0; jj < 4; ++jj) { const int s = s0 + jj; v[jj] = s <= t ? sa[s2][jj] * __expf(rtt + ct[s]) : 0.f; rs += v[jj]; }
            u32x2 wv; wv.x = pk_bf16(v[0], v[1]); wv.y = pk_bf16(v[2], v[3]);
            *(u32x2*)(Sp + t * VROW + s0 * 2) = wv;
        }
        rs += __shfl_xor(rs, 16); rs += __shfl_xor(rs, 32);
        if (fq == 0) rowsum[t * 2 + sh] = rs;
    }
    {
        const int t = tid >> 3, part = tid & 7;
        float a = 0.f;
        if (c > 0) {
            const float* nc = ncs + part * 32;
            const unsigned char* qp = Qs + t * QROW + part * 64;
#pragma unroll
            for (int i = 0; i < 4; ++i) {
                const u32x4 qv = *(const u32x4*)(qp + i * 16);
                const f32x4 n0 = *(const f32x4*)(nc + i * 8), n1 = *(const f32x4*)(nc + i * 8 + 4);
                a += bflo(qv.x) * n0[0] + bfhi(qv.x) * n0[1] + bflo(qv.y) * n0[2] + bfhi(qv.y) * n0[3] + bflo(qv.z) * n1[0] + bfhi(qv.z) * n1[1] + bflo(qv.w) * n1[2] + bfhi(qv.w) * n1[3];
            }
        }
        a += __shfl_xor(a, 1); a += __shfl_xor(a, 2); a += __shfl_xor(a, 4);
        if (part == 0) qn[t] = a;
    }
    __syncthreads();
    f32x4 acc[4][2] = {};
    if (c > 0) {
#pragma unroll
        for (int k = 0; k < 8; ++k) {
            bf16x8 qf[4];
#pragma unroll
            for (int m = 0; m < 4; ++m) qf[m] = *(const bf16x8*)(Qs + (m * 16 + fr) * QROW + (k * 32 + fq * 8) * 2);
#pragma unroll
            for (int m = 0; m < 4; ++m)
#pragma unroll
                for (int n = 0; n < 2; ++n) acc[m][n] = MFMA16(cfr[k][n], qf[m], acc[m][n]);
        }
#pragma unroll
        for (int m = 0; m < 4; ++m) { const float wi = wint[m * 16 + fr]; acc[m][0] *= wi; acc[m][1] *= wi; }
    }
#pragma unroll
    for (int k = 0; k < 2; ++k) {
        bf16x8 vfr[2], sf[4];
#pragma unroll
        for (int n = 0; n < 2; ++n) vfr[n] = *(const bf16x8*)(Vt + (w * 32 + n * 16 + fr) * VROW + (k * 32 + fq * 8) * 2);
#pragma unroll
        for (int m = 0; m < 4; ++m) sf[m] = *(const bf16x8*)(Sp + (m * 16 + fr) * VROW + (k * 32 + fq * 8) * 2);
#pragma unroll
        for (int m = 0; m < 4; ++m)
#pragma unroll
            for (int n = 0; n < 2; ++n) acc[m][n] = MFMA16(vfr[n], sf[m], acc[m][n]);
    }
#pragma unroll
    for (int m = 0; m < 4; ++m) {
        const int t = m * 16 + fr;
        const float den = wint[t] * qn[t] + rowsum[t * 2] + rowsum[t * 2 + 1];
        const float dinv = 1.0f / fmaxf(fabsf(den), emt[t]);
        acc[m][0] *= dinv; acc[m][1] *= dinv;
        float q2 = 0.f;
#pragma unroll
        for (int n = 0; n < 2; ++n)
#pragma unroll
            for (int jj = 0; jj < 4; ++jj) q2 += acc[m][n][jj] * acc[m][n][jj];
        q2 += __shfl_xor(q2, 16); q2 += __shfl_xor(q2, 32);
        if (fq == 0) ssq[t * 8 + w] = q2;
    }
    __syncthreads();
#pragma unroll
    for (int m = 0; m < 4; ++m) {
        const int t = m * 16 + fr;
        float tot = 0.f;
#pragma unroll
        for (int ww = 0; ww < 8; ++ww) tot += ssq[t * 8 + ww];
        const float rstd = rsqrtf(tot * (1.0f / 256.f) + EPS);
#pragma unroll
        for (int n = 0; n < 2; ++n) {
            const int dvg = hd * 256 + w * 32 + n * 16 + fq * 4;
            const size_t oidx = (tok0 + t) * DM + dvg;
            const u32x2 og = ogv[m][n];
            const f32x4 v = acc[m][n] * rstd * mnv[n];
            u32x2 wv; wv.x = pk_bf16(v[0] * bflo(og.x), v[1] * bfhi(og.x)); wv.y = pk_bf16(v[2] * bflo(og.y), v[3] * bfhi(og.y));
            *(u32x2*)((bf16_t*)(p.ws + WS_HM) + oidx) = wv;
        }
    }
    __syncthreads();
}

__device__ __forceinline__ void grid_barrier(unsigned* bar, unsigned k) {
    asm volatile("s_waitcnt vmcnt(0)" ::: "memory");
    __syncthreads();
    if (threadIdx.x == 0) {
        const unsigned g = blockIdx.x & 7u, gsz = (gridDim.x + 7u - g) >> 3;
        __builtin_amdgcn_fence(__ATOMIC_RELEASE, "agent");
        asm volatile("s_waitcnt vmcnt(0)" ::: "memory");
        unsigned* sub = bar + 64u * (1u + g);
        const unsigned prev = __hip_atomic_fetch_add(sub, 1u, __ATOMIC_RELAXED, __HIP_MEMORY_SCOPE_AGENT);
        if (prev + 1u == k * gsz) __hip_atomic_fetch_add(bar, 1u, __ATOMIC_RELAXED, __HIP_MEMORY_SCOPE_AGENT);
        const unsigned ngroups = gridDim.x < 8u ? gridDim.x : 8u;
        unsigned spins = 0;
        while (__hip_atomic_load(bar, __ATOMIC_RELAXED, __HIP_MEMORY_SCOPE_AGENT) < k * ngroups) { __builtin_amdgcn_s_sleep(1); if (++spins > (1u << 24)) break; }
        __builtin_amdgcn_fence(__ATOMIC_ACQUIRE, "agent");
        asm volatile("s_waitcnt vmcnt(0)" ::: "memory");
    }
    __syncthreads();
}

__global__ void __launch_bounds__(NTH) hybrid_fwd(Params p) {
    extern __shared__ __attribute__((aligned(16))) unsigned char lds[];
    cg::grid_group grid = cg::this_grid();
    const int lo = p.ph_lo, hi = p.ph_hi;
#ifndef PHMASK
#define PHMASK 0x7ff
#endif
#define IN(k) (((PHMASK >> (k)) & 1) && lo <= (k) && (k) < hi)
#define SEAMN(n) do { grid_barrier((unsigned*)(p.ws + WS_CTR) + 64, (unsigned)(n)); } while (0)
    if (lo < 0) grid.sync();
    LAS unsigned char* ldsl = (LAS unsigned char*)lds;
    unsigned char* ws = p.ws;
    if (IN(0)) phase0(p, (float*)lds);
    SEAMN(1);
    if (IN(1)) {
        for (int it = blockIdx.x; it < 256; it += gridDim.x) { ada_final_slice(p, it); norm_item(p, it, 0, (float*)lds); }
    }
    SEAMN(2);
    if (IN(2)) { EpiG1 e{(float*)(ws + WS_U), (bf16_t*)(ws + WS_QKV)}; gemm_phase(ldsl, (const bf16_t*)(ws + WS_H), (const bf16_t*)(ws + WS_WIN), NIN, DM, e);
        { const int c = blockIdx.x; const int tb = c < 128 ? c * 2 : 256 + (c - 128) * 11;
          small_gemm_phase(lds, (const bf16_t*)(ws + WS_H), (const bf16_t*)(ws + WS_WIN), NIN, DM, e, tb, tb + (c < 128 ? 2 : 11)); } }
    SEAMN(3);
    if (IN(3)) {
        if (blockIdx.x < 128) { const int x = blockIdx.x & 7, r = blockIdx.x >> 3;
            scan_item(p, ((x + 8 * (r >> 2)) << 2) | (r & 3), lds); }
        {
            unsigned* ctr = (unsigned*)(ws + WS_CTR);
            volatile unsigned* slot = (volatile unsigned*)(lds + LDS_BYTES - 16);
            for (;;) {
                if (threadIdx.x == 0) *slot = atomicAdd(ctr, 1u);
                __syncthreads();
                const int it = (int)*slot;
                __syncthreads();
                if (it >= 512 + 288 + NBATCH) break;
                if (it < 512) sample_item(p, it, lds);
                else if (it < 800) pool_item(p, it - 512, lds);
                else poolout_item(p, it - 800);
            }
        }
    }
    SEAMN(4);
    if (IN(4)) { for (int it = blockIdx.x; it < 1024; it += gridDim.x) mout_item(p, it, lds); }
    if (IN(5)) {

        bf16_t* merged = (bf16_t*)(ws + WS_U);
        const bf16_t* sga = (const bf16_t*)(ws + WS_QKV) + (size_t)4 * MROWS * DM;
        const bf16_t* sgb = sga + (size_t)MROWS * DM;
        { EpiMerge e0{merged, sga, 0}; gemm_phase(ldsl, (const bf16_t*)(ws + WS_YP), (const bf16_t*)(ws + WS_WPO), DM, 512, e0);
          small_gemm_phase(lds, (const bf16_t*)(ws + WS_YP), (const bf16_t*)(ws + WS_WPO), DM, 512, e0, blockIdx.x, blockIdx.x + 1); }
        SEAMN(5);
        { EpiMerge e1{merged, sgb, 1}; gemm_phase(ldsl, (const bf16_t*)(ws + WS_HM), (const bf16_t*)(ws + WS_WMO), DM, DM, e1);
          small_gemm_phase(lds, (const bf16_t*)(ws + WS_HM), (const bf16_t*)(ws + WS_WMO), DM, DM, e1, blockIdx.x, blockIdx.x + 1); }
    }
    SEAMN(6);
    if (IN(6)) {
        EpiMid e{p.out, p.x_p, p.x_s, (const float*)(ws + WS_ADA), p.g_ffn, (bf16_t*)(ws + WS_H), (float*)(ws + WS_RSB), (unsigned*)(ws + WS_XCNT), (float*)(ws + WS_RSS), (unsigned*)(ws + WS_XCNT) + 64 * 64};
        gemm_phase<EpiMid, true>(ldsl, (const bf16_t*)(ws + WS_U), (const bf16_t*)(ws + WS_WOUT), DM, DM, e, lds);
        small_gemm_phase<EpiMid, 2>(lds, (const bf16_t*)(ws + WS_U), (const bf16_t*)(ws + WS_WOUT), DM, DM, e, blockIdx.x, blockIdx.x + 1);
    }
    SEAMN(7);
    if (IN(8)) { EpiAct e{(bf16_t*)(ws + WS_CST)}; gemm_phase(ldsl, (const bf16_t*)(ws + WS_H), (const bf16_t*)(ws + WS_W1), DFF, DM, e);
        small_gemm_phase(lds, (const bf16_t*)(ws + WS_H), (const bf16_t*)(ws + WS_W1), DFF, DM, e, blockIdx.x * 4, blockIdx.x * 4 + 4); }
    SEAMN(8);
    if (IN(9)) {
        EpiFinal e{p.out, (const float*)(ws + WS_ADA), p.g_final, (float*)(ws + WS_RSB), (unsigned*)(ws + WS_XCNT), (float*)(ws + WS_RSS), (unsigned*)(ws + WS_XCNT) + 64 * 64};
        gemm_phase<EpiFinal, true>(ldsl, (const bf16_t*)(ws + WS_CST), (const bf16_t*)(ws + WS_W2), DM, DFF, e, lds);
        small_gemm_phase<EpiFinal, 1>(lds, (const bf16_t*)(ws + WS_CST), (const bf16_t*)(ws + WS_W2), DM, DFF, e, blockIdx.x, blockIdx.x + 1);
    }
#undef IN
#undef SEAMN
}

extern "C" void kernel_launch(void* const* d_in, const int* in_sizes, int n_in, void* d_out, int out_size, void* d_ws, size_t ws_size, hipStream_t stream) {
    static int grid_blocks = 0;
    if (grid_blocks == 0) {
        if (ws_size < WS_END) { fprintf(stderr, "kernel_launch: workspace too small: %zu < %zu\n", ws_size, (size_t)WS_END); grid_blocks = -1; return; }
        int dev = 0, cus = 0, per_cu = 0;
        hipGetDevice(&dev);
        hipDeviceGetAttribute(&cus, hipDeviceAttributeMultiprocessorCount, dev);
        hipFuncSetAttribute((const void*)hybrid_fwd, hipFuncAttributeMaxDynamicSharedMemorySize, LDS_BYTES);
        hipOccupancyMaxActiveBlocksPerMultiprocessor(&per_cu, (const void*)hybrid_fwd, NTH, LDS_BYTES);
        if (per_cu < 1) per_cu = 1;
        if (per_cu > 1) per_cu = 1;
        grid_blocks = cus * per_cu;
    }
    if (grid_blocks < 0) return;
    hipMemsetAsync((char*)d_ws + WS_CTR, 0, 4096 + 80 * 256, stream);
    Params p{};
    const float** f = (const float**)&p;
    for (int i = 0; i < 24; ++i) f[i] = (const float*)d_in[i];
    p.out = (float*)d_out; p.ws = (unsigned char*)d_ws; p.ph_lo = 0; p.ph_hi = 11;
    void* args[] = {&p};
    hipError_t e = hipLaunchCooperativeKernel((const void*)hybrid_fwd, dim3(grid_blocks), dim3(NTH), args, LDS_BYTES, stream);
    if (e != hipSuccess) fprintf(stderr, "cooperative launch failed: %s (grid %d)\n", hipGetErrorString(e), grid_blocks);
}
```

```cpp
#include <hip/hip_runtime.h>
#include <hip/hip_cooperative_groups.h>
#include <cstdio>
#include <cstdint>
namespace cg = cooperative_groups;

typedef unsigned short bf16_t;
typedef short bf16x8 __attribute__((ext_vector_type(8)));
typedef float f32x4 __attribute__((ext_vector_type(4)));
typedef unsigned u32x4 __attribute__((ext_vector_type(4)));
typedef unsigned u32x2 __attribute__((ext_vector_type(2)));

constexpr int NTH = 512;
constexpr int DM = 1024, NPR = 16384, NSA = 512, MROWS = 16896, NBATCH = 136, SEQ = 2048;
constexpr int NIN = 6656, DFF = 4096, ADAW = 6144, INW = 6664;
constexpr int LDS_BYTES = 131072;
constexpr float EPS = 1e-6f;

constexpr size_t O_Y = 0;
constexpr size_t O_POOLP = 17301504;
constexpr size_t O_CP = 17362944;
constexpr size_t O_NP = 19460096;
constexpr size_t O_MP = 19468288;
constexpr size_t O_POOLS = 19468320;
constexpr size_t O_CS = 20451360;
constexpr size_t O_NS = 54005792;
constexpr size_t O_MS = 54136864;

constexpr size_t AL(size_t x) { return (x + 255) & ~(size_t)255; }
constexpr size_t WS_WIN = 0;
constexpr size_t WS_WPG = WS_WIN + AL((size_t)NIN * DM * 2);
constexpr size_t WS_WPO = WS_WPG + AL((size_t)4 * 128 * 128 * 2);
constexpr size_t WS_WMO = WS_WPO + AL((size_t)1024 * 512 * 2);
constexpr size_t WS_WOUT = WS_WMO + AL((size_t)1024 * 1024 * 2);
constexpr size_t WS_W1 = WS_WOUT + AL((size_t)1024 * 1024 * 2);
constexpr size_t WS_W2 = WS_W1 + AL((size_t)4096 * 1024 * 2);
constexpr size_t WS_ADAP = WS_W2 + AL((size_t)4096 * 1024 * 2);
constexpr size_t WS_ADA = WS_ADAP + AL((size_t)8 * NBATCH * ADAW * 4);
constexpr size_t WS_H = WS_ADA + AL((size_t)NBATCH * ADAW * 4);
constexpr size_t WS_GI = WS_H + AL((size_t)MROWS * DM * 2);
constexpr size_t WS_GF = WS_GI + AL((size_t)MROWS * 4 * 4);
constexpr size_t WS_U = WS_GF + AL((size_t)MROWS * 4 * 4);
constexpr size_t WS_QKV = WS_U + AL((size_t)MROWS * 512 * 4);
constexpr size_t WS_CST = WS_QKV + AL((size_t)6 * MROWS * DM * 2);
constexpr size_t WS_NST = WS_CST + AL((size_t)MROWS * DFF * 2);
constexpr size_t WS_MST = WS_NST + AL((size_t)32 * 32 * 256 * 4);
constexpr size_t WS_YP = WS_MST + AL((size_t)32 * 64 * 4);
constexpr size_t WS_HM = WS_YP + AL((size_t)MROWS * 512 * 2);
constexpr size_t WS_GW = WS_HM + AL((size_t)MROWS * DM * 2);
constexpr size_t WS_CTR = WS_GW + AL((size_t)1024 * 8 * 4);
constexpr size_t WS_XCNT = WS_CTR + 4096;
constexpr size_t WS_RSB = WS_XCNT + 80 * 256;
constexpr size_t WS_RSS = WS_RSB + AL((size_t)NPR * 4 * 4);
constexpr size_t WS_END = WS_RSS + AL((size_t)NSA * 16 * 4);
static_assert((size_t)32 * 31 * 65536 * 2 <= (size_t)MROWS * DFF * 2, "Cst fits in act region");
static_assert(WS_END <= (size_t)536870912, "workspace map exceeds 512 MiB");

struct Params {
    const float *x_p, *x_s, *st_pool, *st_C, *st_n, *st_m, *c_p, *c_s, *g_mix, *g_ffn, *w_ada, *b_ada, *w_in, *b_i, *b_f, *w_pg, *pool_scale, *w_po, *m_norm, *w_mo, *w_out, *w1, *w2, *g_final;
    float* out; unsigned char* ws; int ph_lo, ph_hi;
};

typedef float f32x2 __attribute__((ext_vector_type(2)));
typedef __bf16 bf16x2_t __attribute__((ext_vector_type(2)));
__device__ __forceinline__ unsigned pk_bf16(float lo, float hi) { f32x2 v = {lo, hi}; bf16x2_t b = __builtin_convertvector(v, bf16x2_t); return __builtin_bit_cast(unsigned, b); }
__device__ __forceinline__ float bf2f(unsigned v) { return __uint_as_float(v << 16); }
__device__ __forceinline__ float bflo(unsigned v) { return __uint_as_float(v << 16); }
__device__ __forceinline__ float bfhi(unsigned v) { return __uint_as_float(v & 0xffff0000u); }
__device__ __forceinline__ bf16_t f2bf(float f) { return (bf16_t)(pk_bf16(f, 0.f) & 0xffffu); }
__device__ __forceinline__ float sigmoidf_(float x) { return __builtin_amdgcn_rcpf(1.f + __expf(-x)); }
__device__ __forceinline__ int row_batch(int row) { return row < NPR ? (row >> 11) : 8 + ((row - NPR) >> 2); }
__device__ __forceinline__ float wave_sum(float v) {
#pragma unroll
    for (int d = 32; d >= 1; d >>= 1) v += __shfl_xor(v, d);
    return v;
}
__device__ __forceinline__ float wave_max(float v) {
#pragma unroll
    for (int d = 32; d >= 1; d >>= 1) v = fmaxf(v, __shfl_xor(v, d));
    return v;
}
__device__ __forceinline__ float wave_scan_add(float v, int lane) {
#pragma unroll
    for (int d = 1; d < 64; d <<= 1) { float t = __shfl_up(v, d); if (lane >= d) v += t; }
    return v;
}
__device__ __forceinline__ float wave_scan_max(float v, int lane) {
#pragma unroll
    for (int d = 1; d < 64; d <<= 1) { float t = __shfl_up(v, d); if (lane >= d) v = fmaxf(v, t); }
    return v;
}
__device__ __forceinline__ int otid() { int t = threadIdx.x; asm volatile("" : "+v"(t)); return t; }
#define MFMA16(a, b, c) __builtin_amdgcn_mfma_f32_16x16x32_bf16((a), (b), (c), 0, 0, 0)

#define LAS __attribute__((address_space(3)))
constexpr int BM = 256, BK = 64, HALF = 128, HTB = HALF * BK * 2, NXCD = 8, WGM = 8;
__device__ __forceinline__ int lds_byte(int r, int c) {
    const int st = (r >> 4) * 2 + (c >> 5), rr = r & 15, cc = c & 31, ob = rr * 64 + cc * 2;
    return st * 1024 + (ob ^ (((ob >> 9) & 1) << 5));
}
__device__ __forceinline__ void stage_rc(int b, int& R, int& C) {
    const int st = b / 1024, sb = b % 1024, swz = sb ^ (((sb >> 9) & 1) << 5);
    R = (st >> 1) * 16 + swz / 64; C = (st & 1) * 32 + (swz % 64) / 2;
}
__device__ __forceinline__ int perm32(int rho) { const int n = rho >> 4, i = rho & 15; return 8 * (i >> 2) + 4 * n + (i & 3); }
struct Unit { int pm, pn; };
struct StaticOrder {
    int nM, nN, nwg, G, c;
    __device__ void init(int M, int N, int G_, int c_) { nM = M / BM; nN = N / BM; nwg = nM * nN; G = G_; c = c_; }
    __device__ bool next(int i, Unit& u) const {
        const long L = (long)i * G + c; if (L >= nwg) return false;
        int wgid = (int)L; { const int q = nwg / NXCD, r = nwg % NXCD, xcd = wgid % NXCD, off = wgid / NXCD; wgid = (xcd < r ? xcd * (q + 1) : r * (q + 1) + (xcd - r) * q) + off; }
        const int nig = WGM * nN, gid = wgid / nig, fm = gid * WGM, gsz = (nM - fm) < WGM ? (nM - fm) : WGM;
        u.pm = fm + ((wgid % nig) % gsz); u.pn = (wgid % nig) / gsz; return true;
    }
};

#ifndef GEMM_SP2
#define GEMM_SP2 1
#endif
#ifndef GEMM_ALIGN
#define GEMM_ALIGN 1
#endif
template <class Epi, bool FUSED = false, bool SP2 = (GEMM_SP2 != 0), bool ALIGN_EPI = (GEMM_ALIGN != 0)>
__device__ __forceinline__ void gemm_phase(LAS unsigned char* lds, const bf16_t* gA, const bf16_t* gBt, const int N, const int K, const Epi& E, unsigned char* lds_gen = nullptr) {
    const int tid = otid(), wid = __builtin_amdgcn_readfirstlane(tid >> 6), lane = tid & 63, wr = wid >> 2, wc = wid & 3, fr = lane & 15, fq = lane >> 4;
    const int nt = K / BK;
    StaticOrder S; S.init(NPR, N, gridDim.x, blockIdx.x);
    unsigned voffA[2], voffB[2];
#pragma unroll
    for (int i = 0; i < 2; ++i) { int R, C; stage_rc(tid * 16 + i * 8192, R, C); const int Rb = (R & ~31) + perm32(R & 31); voffA[i] = (unsigned)(R * K + C) * 2u; voffB[i] = (unsigned)(Rb * K + C) * 2u; }
    const size_t kstep = (size_t)(BK * 2);
    const size_t hstep = (size_t)HALF * K * 2;
    const size_t tstep = 2 * hstep;
    const unsigned ldsw = (unsigned)wid * 1024u;
    const int aoff = lds_byte(wr * 64 + fr, fq * 8), boff = lds_byte(wc * 32 + fr, fq * 8);
#define PG8_SA(b, h) (((b) * 2 + (h)) * HTB)
#define PG8_SB(b, h) ((4 + (b) * 2 + (h)) * HTB)
#define PG8_STAGE(bufoff, gbase) PG8_STAGEV(bufoff, gbase, voffA)
#define PG8_STAGEB(bufoff, gbase) PG8_STAGEV(bufoff, gbase, voffB)
#define PG8_STAGEV(bufoff, gbase, voff) do { _Pragma("unroll") for (int _i = 0; _i < 2; ++_i) \
        __builtin_amdgcn_global_load_lds((const unsigned*)((const char*)(gbase) + (voff)[_i]), (LAS unsigned*)(lds + (bufoff) + ldsw + _i * 8192), 16, 0, 0); } while (0)
#define PG8_LDA(dst, b, h) do { _Pragma("unroll") for (int m = 0; m < 4; ++m) _Pragma("unroll") for (int k = 0; k < 2; ++k) dst[m][k] = *(const LAS bf16x8*)(lds + PG8_SA(b, h) + aoff + m * 2048 + k * 1024); } while (0)
#define PG8_LDB(dst, b, h) do { _Pragma("unroll") for (int n = 0; n < 2; ++n) _Pragma("unroll") for (int k = 0; k < 2; ++k) dst[n][k] = *(const LAS bf16x8*)(lds + PG8_SB(b, h) + boff + n * 2048 + k * 1024); } while (0)
#define PG8_MMA(ai, bj, At, Bt) do { __builtin_amdgcn_s_setprio(1); _Pragma("unroll") for (int m = 0; m < 4; ++m) _Pragma("unroll") for (int n = 0; n < 2; ++n) _Pragma("unroll") for (int k = 0; k < 2; ++k) \
        acc[ai][bj][m][n] = __builtin_amdgcn_mfma_f32_16x16x32_bf16(Bt[n][k], At[m][k], acc[ai][bj][m][n], 0, 0, 0); __builtin_amdgcn_s_setprio(0); } while (0)
#define PG8_WAIT_V(n) asm volatile("s_waitcnt vmcnt(" #n ")" ::: "memory")
#define PG8_WAIT_L(n) asm volatile("s_waitcnt lgkmcnt(" #n ")" ::: "memory")
#define PG8_BAR __builtin_amdgcn_s_barrier()
#define PG8_SCHED __builtin_amdgcn_sched_barrier(0)
    Unit cur, nxt; int ui = 0;
    if (!S.next(0, cur)) return;
    f32x4 acc[2][2][4][2];
#pragma unroll
    for (int a = 0; a < 2; ++a)
#pragma unroll
        for (int b = 0; b < 2; ++b)
#pragma unroll
            for (int m = 0; m < 4; ++m)
#pragma unroll
                for (int n = 0; n < 2; ++n) acc[a][b][m][n] = (f32x4){0.f, 0.f, 0.f, 0.f};
    bf16x8 At[4][2], B0[2][2], B1[2][2];
    const char* cA = (const char*)gA + (size_t)cur.pm * tstep; const char* cB = (const char*)gBt + (size_t)cur.pn * tstep;
    constexpr bool ALIGN = ALIGN_EPI && !FUSED;
    if constexpr (SP2) {
        PG8_STAGEB(PG8_SB(0, 0), cB); PG8_STAGEB(PG8_SB(0, 1), cB + hstep); PG8_STAGE(PG8_SA(0, 0), cA); PG8_STAGE(PG8_SA(0, 1), cA + hstep);
        if (wr == 1) PG8_BAR;
        PG8_WAIT_V(2); PG8_BAR;
        PG8_STAGEB(PG8_SB(1, 0), cB + kstep); PG8_STAGE(PG8_SA(1, 0), cA + kstep); PG8_STAGEB(PG8_SB(1, 1), cB + hstep + kstep);
        PG8_WAIT_V(6); PG8_BAR;
    } else {
        PG8_STAGEB(PG8_SB(0, 0), cB); PG8_STAGE(PG8_SA(0, 0), cA); PG8_STAGEB(PG8_SB(0, 1), cB + hstep); PG8_STAGE(PG8_SA(0, 1), cA + hstep);
        if (wr == 1) PG8_BAR;
        PG8_WAIT_V(4); PG8_BAR;
        PG8_STAGEB(PG8_SB(1, 0), cB + kstep); PG8_STAGE(PG8_SA(1, 0), cA + kstep); PG8_STAGEB(PG8_SB(1, 1), cB + hstep + kstep);
        PG8_WAIT_V(6); PG8_BAR;
    }
    for (;;) {
        const bool has_next = S.next(ui + 1, nxt);
        const char* nA = has_next ? (const char*)gA + (size_t)nxt.pm * tstep : cA; const char* nB = has_next ? (const char*)gBt + (size_t)nxt.pn * tstep : cB;
        for (int t = 0; t < nt; t += 2) {
            const bool last = (t == nt - 2);
            const char* a1 = cA + (size_t)(t + 1) * kstep;
            const char* a2 = last ? nA : cA + (size_t)(t + 2) * kstep; const char* b2 = last ? nB : cB + (size_t)(t + 2) * kstep;
            const char* a3 = a2 + kstep; const char* b3 = b2 + kstep;
            if constexpr (SP2) {
            PG8_LDB(B0, 0, 0); PG8_LDB(B1, 0, 1); PG8_SCHED; PG8_LDA(At, 0, 0); PG8_STAGE(PG8_SA(1, 1), a1 + hstep);
            PG8_WAIT_V(8); PG8_WAIT_L(0); PG8_BAR; PG8_MMA(0, 0, At, B0); PG8_MMA(0, 1, At, B1); PG8_BAR; PG8_SCHED;
            PG8_LDA(At, 0, 1); PG8_STAGEB(PG8_SB(0, 0), b2); PG8_STAGEB(PG8_SB(0, 1), b2 + hstep); PG8_STAGE(PG8_SA(0, 0), a2);
            PG8_WAIT_V(8); PG8_WAIT_L(0); PG8_BAR; PG8_MMA(1, 0, At, B0); PG8_MMA(1, 1, At, B1); PG8_BAR; PG8_SCHED;
            PG8_LDB(B0, 1, 0); PG8_LDB(B1, 1, 1); PG8_SCHED; PG8_LDA(At, 1, 0); PG8_STAGE(PG8_SA(0, 1), a2 + hstep);
            PG8_WAIT_V(8); PG8_WAIT_L(0); PG8_BAR; PG8_MMA(0, 0, At, B0); PG8_MMA(0, 1, At, B1); PG8_BAR; PG8_SCHED;
            PG8_LDA(At, 1, 1); PG8_STAGEB(PG8_SB(1, 0), b3); PG8_STAGEB(PG8_SB(1, 1), b3 + hstep); PG8_STAGE(PG8_SA(1, 0), a3);
            PG8_WAIT_V(8); PG8_WAIT_L(0); PG8_BAR; PG8_MMA(1, 0, At, B0); PG8_MMA(1, 1, At, B1); PG8_BAR; PG8_SCHED;
            } else {
            PG8_LDB(B0, 0, 0); PG8_SCHED; PG8_LDA(At, 0, 0); PG8_STAGE(PG8_SA(1, 1), a1 + hstep);
            PG8_WAIT_L(8); PG8_BAR; PG8_WAIT_L(0); PG8_MMA(0, 0, At, B0); PG8_BAR; PG8_SCHED;
            PG8_LDB(B1, 0, 1); PG8_STAGEB(PG8_SB(0, 0), b2);
            PG8_BAR; PG8_WAIT_L(0); PG8_MMA(0, 1, At, B1); PG8_BAR;
            PG8_LDA(At, 0, 1); PG8_STAGE(PG8_SA(0, 0), a2);
            PG8_BAR; PG8_WAIT_L(0); PG8_MMA(1, 0, At, B0); PG8_BAR; PG8_SCHED;
            PG8_STAGEB(PG8_SB(0, 1), b2 + hstep);
            PG8_WAIT_V(6); PG8_BAR; PG8_MMA(1, 1, At, B1); PG8_BAR;
            PG8_LDB(B0, 1, 0); PG8_SCHED; PG8_LDA(At, 1, 0); PG8_STAGE(PG8_SA(0, 1), a2 + hstep);
            PG8_WAIT_L(8); PG8_BAR; PG8_WAIT_L(0); PG8_MMA(0, 0, At, B0); PG8_BAR; PG8_SCHED;
            PG8_LDB(B1, 1, 1); PG8_STAGEB(PG8_SB(1, 0), b3);
            PG8_BAR; PG8_WAIT_L(0); PG8_MMA(0, 1, At, B1); PG8_BAR;
            PG8_LDA(At, 1, 1); PG8_STAGE(PG8_SA(1, 0), a3);
            PG8_BAR; PG8_WAIT_L(0); PG8_MMA(1, 0, At, B0); PG8_BAR; PG8_SCHED;
            PG8_STAGEB(PG8_SB(1, 1), b3 + hstep);
            PG8_WAIT_V(6); PG8_BAR; PG8_MMA(1, 1, At, B1); PG8_BAR;
            }
        }
        if constexpr (ALIGN) { if (wr == 0) PG8_BAR; }
        if constexpr (!FUSED) { const int r0 = cur.pm * BM + wr * 64 + fr, c0 = cur.pn * BM + wc * 32 + fq * 8;
#pragma unroll
          for (int ai = 0; ai < 2; ++ai)
#pragma unroll
            for (int m = 0; m < 4; ++m)
#pragma unroll
              for (int bj = 0; bj < 2; ++bj) E.apply8(r0 + ai * 128 + m * 16, c0 + bj * 128, acc[ai][bj][m][0], acc[ai][bj][m][1]); }
        if (!has_next) break;
#pragma unroll
        for (int a = 0; a < 2; ++a)
#pragma unroll
            for (int b = 0; b < 2; ++b)
#pragma unroll
                for (int m = 0; m < 4; ++m)
#pragma unroll
                    for (int n = 0; n < 2; ++n) acc[a][b][m][n] = (f32x4){0.f, 0.f, 0.f, 0.f};
        cur = nxt; cA = nA; cB = nB; ++ui;
        if constexpr (ALIGN) { if (wr == 1) PG8_BAR; }
    }
    PG8_WAIT_V(0);
    if constexpr (!ALIGN) { if (wr == 0) PG8_BAR; }
    PG8_BAR;
    if constexpr (FUSED) E.fused(acc, cur, wr, wc, fr, fq, lds_gen);
#undef PG8_SA
#undef PG8_SB
#undef PG8_STAGE
#undef PG8_STAGEB
#undef PG8_STAGEV
#undef PG8_LDA
#undef PG8_LDB
#undef PG8_MMA
#undef PG8_WAIT_V
#undef PG8_WAIT_L
#undef PG8_BAR
#undef PG8_SCHED
}

struct EpiG1 {
    float* u; bf16_t* qkv;
    __device__ __forceinline__ void apply(int row, int col, f32x4 v) const {
        const int bcol = col & ~255;
        const int seg = bcol < 512 ? 0 : 1 + ((bcol - 512) >> 10);
        if (seg == 0) { *(f32x4*)(u + (size_t)row * 512 + col) = v; }
        else {
            const int cc = col - 512 - (seg - 1) * 1024;
            if (seg == 2) v *= 0.0625f;
            if (seg >= 4) { v[0] = sigmoidf_(v[0]); v[1] = sigmoidf_(v[1]); v[2] = sigmoidf_(v[2]); v[3] = sigmoidf_(v[3]); }
            u32x2 w; w.x = pk_bf16(v[0], v[1]); w.y = pk_bf16(v[2], v[3]);
            *(u32x2*)(qkv + (size_t)(seg - 1) * MROWS * DM + (size_t)row * DM + cc) = w;
        }
    }
    __device__ __forceinline__ void apply8(int row, int col, f32x4 v0, f32x4 v1) const {
        const int bcol = col & ~255;
        const int seg = bcol < 512 ? 0 : 1 + ((bcol - 512) >> 10);
        if (seg == 0) { *(f32x4*)(u + (size_t)row * 512 + col) = v0; *(f32x4*)(u + (size_t)row * 512 + col + 4) = v1; }
        else {
            const int cc = col - 512 - (seg - 1) * 1024;
            if (seg == 2) { v0 *= 0.0625f; v1 *= 0.0625f; }
            if (seg >= 4) {
#pragma unroll
                for (int j = 0; j < 4; ++j) { v0[j] = sigmoidf_(v0[j]); v1[j] = sigmoidf_(v1[j]); } }
            u32x4 w; w.x = pk_bf16(v0[0], v0[1]); w.y = pk_bf16(v0[2], v0[3]); w.z = pk_bf16(v1[0], v1[1]); w.w = pk_bf16(v1[2], v1[3]);
            *(u32x4*)(qkv + (size_t)(seg - 1) * MROWS * DM + (size_t)row * DM + cc) = w;
        }
    }
};
struct EpiMerge {
    bf16_t* merged; const bf16_t* sg; int mode;
    __device__ __forceinline__ void apply(int row, int col, f32x4 v) const {
        const size_t idx = (size_t)row * DM + col;
        const u32x2 g = *(const u32x2*)(sg + idx);
        v[0] *= bflo(g.x); v[1] *= bfhi(g.x); v[2] *= bflo(g.y); v[3] *= bfhi(g.y);
        if (mode) { const u32x2 o = *(const u32x2*)(merged + idx); v[0] += bflo(o.x); v[1] += bfhi(o.x); v[2] += bflo(o.y); v[3] += bfhi(o.y); }
        u32x2 w; w.x = pk_bf16(v[0], v[1]); w.y = pk_bf16(v[2], v[3]);
        *(u32x2*)(merged + idx) = w;
    }
    __device__ __forceinline__ void apply8(int row, int col, f32x4 v0, f32x4 v1) const {
        const size_t idx = (size_t)row * DM + col;
        const u32x4 g = *(const u32x4*)(sg + idx);
        v0[0] *= bflo(g.x); v0[1] *= bfhi(g.x); v0[2] *= bflo(g.y); v0[3] *= bfhi(g.y); v1[0] *= bflo(g.z); v1[1] *= bfhi(g.z); v1[2] *= bflo(g.w); v1[3] *= bfhi(g.w);
        if (mode) { const u32x4 o = *(const u32x4*)(merged + idx); v0[0] += bflo(o.x); v0[1] += bfhi(o.x); v0[2] += bflo(o.y); v0[3] += bfhi(o.y); v1[0] += bflo(o.z); v1[1] += bfhi(o.z); v1[2] += bflo(o.w); v1[3] += bfhi(o.w); }
        u32x4 w; w.x = pk_bf16(v0[0], v0[1]); w.y = pk_bf16(v0[2], v0[3]); w.z = pk_bf16(v1[0], v1[1]); w.w = pk_bf16(v1[2], v1[3]);
        *(u32x4*)(merged + idx) = w;
    }
};
struct EpiRes {
    float* out; const float* xp; const float* xs; const float* ada; int gate_off; int xin;
    __device__ __forceinline__ void apply(int row, int col, f32x4 v) const {
        const f32x4 g = *(const f32x4*)(ada + (size_t)row_batch(row) * ADAW + gate_off + col);
        const float* bp = xin ? (row < NPR ? xp + (size_t)row * DM : xs + (size_t)(row - NPR) * DM) : out + (size_t)row * DM;
        const f32x4 b = *(const f32x4*)(bp + col);
        *(f32x4*)(out + (size_t)row * DM + col) = b + g * v;
    }
    __device__ __forceinline__ void apply8(int row, int col, f32x4 v0, f32x4 v1) const { apply(row, col, v0); apply(row, col + 4, v1); }
};
struct EpiAct {
    bf16_t* act;
    __device__ __forceinline__ void apply(int row, int col, f32x4 v) const {
#pragma unroll
        for (int j = 0; j < 4; ++j) { float t = fmaxf(v[j], 0.f); v[j] = t * t; }
        u32x2 w; w.x = pk_bf16(v[0], v[1]); w.y = pk_bf16(v[2], v[3]);
        *(u32x2*)(act + (size_t)row * DFF + col) = w;
    }
    __device__ __forceinline__ void apply8(int row, int col, f32x4 v0, f32x4 v1) const {
#pragma unroll
        for (int j = 0; j < 4; ++j) { float t0 = fmaxf(v0[j], 0.f); v0[j] = t0 * t0; float t1 = fmaxf(v1[j], 0.f); v1[j] = t1 * t1; }
        u32x4 w; w.x = pk_bf16(v0[0], v0[1]); w.y = pk_bf16(v0[2], v0[3]); w.z = pk_bf16(v1[0], v1[1]); w.w = pk_bf16(v1[2], v1[3]);
        *(u32x4*)(act + (size_t)row * DFF + col) = w;
    }
};

__device__ __forceinline__ void xchg_publish_wait(unsigned* cnt, unsigned need) {
    asm volatile("s_waitcnt vmcnt(0)" ::: "memory");
    __syncthreads();
    if (threadIdx.x == 0) {
        __builtin_amdgcn_fence(__ATOMIC_RELEASE, "agent");
        asm volatile("s_waitcnt vmcnt(0)" ::: "memory");
        __hip_atomic_fetch_add(cnt, 1u, __ATOMIC_RELAXED, __HIP_MEMORY_SCOPE_AGENT);
        unsigned spins = 0;
        while (__hip_atomic_load(cnt, __ATOMIC_RELAXED, __HIP_MEMORY_SCOPE_AGENT) < need) { __builtin_amdgcn_s_sleep(1); if (++spins > (1u << 24)) break; }
        __builtin_amdgcn_fence(__ATOMIC_ACQUIRE, "agent");
        asm volatile("s_waitcnt vmcnt(0)" ::: "memory");
    }
    __syncthreads();
}
extern __shared__ __attribute__((aligned(16))) unsigned char g_dyn_lds[];
struct EpiFinal {
    float* out; const float* ada; const float* gfin; float* rowpart; unsigned* cnt; float* rowpartS; unsigned* cntS;
    __device__ __forceinline__ void apply(int, int, f32x4) const {}
    __device__ __forceinline__ void apply8(int, int, f32x4, f32x4) const {}
    __device__ __forceinline__ void fused(f32x4 (&acc)[2][2][4][2], const Unit& u, int wr, int wc, int fr, int fq, unsigned char* lds) const {
        const int tid = otid();
        (void)lds;
        float* P = (float*)g_dyn_lds;
        float* S = P + 1024;
        const int r0 = u.pm * BM + wr * 64 + fr, c0 = u.pn * BM + wc * 32 + fq * 8;
#pragma unroll
        for (int ai = 0; ai < 2; ++ai)
#pragma unroll
            for (int m = 0; m < 4; ++m) {
                const int row = r0 + ai * 128 + m * 16;
                const float* ga = ada + (size_t)row_batch(row) * ADAW + 5120;
                float ss = 0.f;
#pragma unroll
                for (int bj = 0; bj < 2; ++bj)
#pragma unroll
                    for (int n = 0; n < 2; ++n) {
                        const int col = c0 + bj * 128 + n * 4;
                        const f32x4 g = *(const f32x4*)(ga + col);
                        const f32x4 b = *(const f32x4*)(out + (size_t)row * DM + col);
                        const f32x4 v = b + g * acc[ai][bj][m][n];
                        acc[ai][bj][m][n] = v;
                        ss += v[0] * v[0] + v[1] * v[1] + v[2] * v[2] + v[3] * v[3];
                    }
                ss += __shfl_xor(ss, 16); ss += __shfl_xor(ss, 32);
                if (fq == 0) P[(ai * 128 + wr * 64 + m * 16 + fr) * 4 + wc] = ss;
                asm volatile("" ::: "memory");
            }
        __syncthreads();
        if (tid < 256) rowpart[((size_t)u.pm * BM + tid) * 4 + u.pn] = (P[tid * 4] + P[tid * 4 + 1]) + (P[tid * 4 + 2] + P[tid * 4 + 3]);
        xchg_publish_wait(cnt + u.pm * 64, 8u);
        if (tid < 256) { const f32x4 rp = *(const f32x4*)(rowpart + ((size_t)u.pm * BM + tid) * 4); S[tid] = rsqrtf(((rp[0] + rp[1]) + (rp[2] + rp[3])) * (1.0f / DM) + EPS); }
        __syncthreads();
#pragma unroll
        for (int ai = 0; ai < 2; ++ai)
#pragma unroll
            for (int m = 0; m < 4; ++m) {
                const int row = r0 + ai * 128 + m * 16;
                const float rs = S[ai * 128 + wr * 64 + m * 16 + fr];
#pragma unroll
                for (int bj = 0; bj < 2; ++bj)
#pragma unroll
                    for (int n = 0; n < 2; ++n) {
                        const int col = c0 + bj * 128 + n * 4;
                        const f32x4 gf = *(const f32x4*)(gfin + col);
                        __builtin_nontemporal_store(acc[ai][bj][m][n] * rs * gf, (f32x4*)(out + (size_t)row * DM + col));
                    }
            }
        __syncthreads();
    }
};

struct EpiMid {
    float* out; const float* xp; const float* xs; const float* ada; const float* gffn; bf16_t* hbuf; float* rowpart; unsigned* cnt; float* rowpartS; unsigned* cntS;
    __device__ __forceinline__ void apply(int, int, f32x4) const {}
    __device__ __forceinline__ void apply8(int, int, f32x4, f32x4) const {}
    __device__ __forceinline__ void fused(f32x4 (&acc)[2][2][4][2], const Unit& u, int wr, int wc, int fr, int fq, unsigned char*) const {
        const int tid = otid();
        float* P = (float*)g_dyn_lds;
        float* S = P + 1024;
        const int r0 = u.pm * BM + wr * 64 + fr, c0 = u.pn * BM + wc * 32 + fq * 8;
#pragma unroll
        for (int ai = 0; ai < 2; ++ai)
#pragma unroll
            for (int m = 0; m < 4; ++m) {
                const int row = r0 + ai * 128 + m * 16;
                const float* ga = ada + (size_t)(row >> 11) * ADAW + 2048;
                float ss = 0.f;
#pragma unroll
                for (int bj = 0; bj < 2; ++bj)
#pragma unroll
                    for (int n = 0; n < 2; ++n) {
                        const int col = c0 + bj * 128 + n * 4;
                        const f32x4 g = *(const f32x4*)(ga + col);
                        const f32x4 b = *(const f32x4*)(xp + (size_t)row * DM + col);
                        const f32x4 v = b + g * acc[ai][bj][m][n];
                        acc[ai][bj][m][n] = v;
                        *(f32x4*)(out + (size_t)row * DM + col) = v;
                        ss += v[0] * v[0] + v[1] * v[1] + v[2] * v[2] + v[3] * v[3];
                    }
                ss += __shfl_xor(ss, 16); ss += __shfl_xor(ss, 32);
                if (fq == 0) P[(ai * 128 + wr * 64 + m * 16 + fr) * 4 + wc] = ss;
                asm volatile("" ::: "memory");
            }
        __syncthreads();
        if (tid < 256) rowpart[((size_t)u.pm * BM + tid) * 4 + u.pn] = (P[tid * 4] + P[tid * 4 + 1]) + (P[tid * 4 + 2] + P[tid * 4 + 3]);
        xchg_publish_wait(cnt + u.pm * 64, 4u);
        if (tid < 256) { const f32x4 rp = *(const f32x4*)(rowpart + ((size_t)u.pm * BM + tid) * 4); S[tid] = rsqrtf(((rp[0] + rp[1]) + (rp[2] + rp[3])) * (1.0f / DM) + EPS); }
        __syncthreads();
        const float* ab = ada + (size_t)(r0 >> 11) * ADAW;
#pragma unroll
        for (int bj = 0; bj < 2; ++bj) {
            const int col = c0 + bj * 128;
            f32x4 G0 = *(const f32x4*)(gffn + col), G1 = *(const f32x4*)(gffn + col + 4);
            G0 *= (*(const f32x4*)(ab + 4096 + col) + 1.0f); G1 *= (*(const f32x4*)(ab + 4096 + col + 4) + 1.0f);
            const f32x4 S0 = *(const f32x4*)(ab + 3072 + col), S1 = *(const f32x4*)(ab + 3072 + col + 4);
#pragma unroll
            for (int ai = 0; ai < 2; ++ai)
#pragma unroll
                for (int m = 0; m < 4; ++m) {
                    const int row = r0 + ai * 128 + m * 16;
                    const float rs = S[ai * 128 + wr * 64 + m * 16 + fr];
                    const f32x4 h0 = acc[ai][bj][m][0] * rs * G0 + S0, h1 = acc[ai][bj][m][1] * rs * G1 + S1;
                    u32x4 w; w.x = pk_bf16(h0[0], h0[1]); w.y = pk_bf16(h0[2], h0[3]); w.z = pk_bf16(h1[0], h1[1]); w.w = pk_bf16(h1[2], h1[3]);
                    *(u32x4*)(hbuf + (size_t)row * DM + col) = w;
                }
        }
        __syncthreads();
    }
};

template <class Epi, int FIN = 0>
__device__ __forceinline__ void small_gemm_phase(unsigned char* lds, const bf16_t* gA, const bf16_t* gBt, const int N, const int K, const Epi& E, const int t_begin, const int t_end) {
    int tid_ = threadIdx.x; asm volatile("" : "+v"(tid_));
    const int tid = tid_, lane = tid & 63, w = tid >> 6, fr = lane & 15, fq = lane >> 4;
    const int kw = K / 8;
    float* red = (float*)lds;
    for (int t = t_begin; t < t_end; ++t) {
        const int rt = t & 15, ct = t >> 4;
        const int row0 = NPR + rt * 32, col0 = ct * 64;
        const bf16_t* ap = gA + (size_t)(row0 + fr) * K + w * kw + fq * 8;
        const bf16_t* bp = gBt + (size_t)(col0 + fr) * K + w * kw + fq * 8;
        f32x4 acc[2][4] = {};
#pragma unroll 2
        for (int k0 = 0; k0 < kw; k0 += 64) {
            bf16x8 af[2][2], bfm[2][4];
#pragma unroll
            for (int s2 = 0; s2 < 2; ++s2) {
#pragma unroll
                for (int m = 0; m < 2; ++m) af[s2][m] = *(const bf16x8*)(ap + (size_t)m * 16 * K + k0 + s2 * 32);
#pragma unroll
                for (int n = 0; n < 4; ++n) bfm[s2][n] = *(const bf16x8*)(bp + (size_t)n * 16 * K + k0 + s2 * 32);
            }
#pragma unroll
            for (int s2 = 0; s2 < 2; ++s2)
#pragma unroll
                for (int m = 0; m < 2; ++m)
#pragma unroll
                    for (int n = 0; n < 4; ++n) acc[m][n] = MFMA16(bfm[s2][n], af[s2][m], acc[m][n]);
        }
#pragma unroll
        for (int m = 0; m < 2; ++m)
#pragma unroll
            for (int n = 0; n < 4; ++n) *(f32x4*)(red + ((w * 32 + m * 16 + fr) * 64 + n * 16 + fq * 4)) = acc[m][n];
        __syncthreads();
        {
            const int r = tid >> 4, c4 = (tid & 15) * 4;
            f32x4 v = *(const f32x4*)(red + (r * 64 + c4));
#pragma unroll
            for (int ww = 1; ww < 8; ++ww) v += *(const f32x4*)(red + ((ww * 32 + r) * 64 + c4));
            if constexpr (FIN == 0) E.apply(row0 + r, col0 + c4, v);
            else if constexpr (FIN == 2) {
                const int row = row0 + r, col = col0 + c4;
                const float* ab = E.ada + (size_t)row_batch(row) * ADAW;
                const f32x4 g = *(const f32x4*)(ab + 2048 + col);
                const f32x4 b = *(const f32x4*)(E.xs + (size_t)(row - NPR) * DM + col);
                const f32x4 x1 = b + g * v;
                *(f32x4*)(E.out + (size_t)row * DM + col) = x1;
                float ss = x1[0] * x1[0] + x1[1] * x1[1] + x1[2] * x1[2] + x1[3] * x1[3];
                ss += __shfl_xor(ss, 1); ss += __shfl_xor(ss, 2); ss += __shfl_xor(ss, 4); ss += __shfl_xor(ss, 8);
                if ((tid & 15) == 0) E.rowpartS[(size_t)(row - NPR) * 16 + ct] = ss;
                xchg_publish_wait(E.cntS + rt * 64, 16u);
                const float* rp = E.rowpartS + (size_t)(row - NPR) * 16;
                float tot = 0.f;
#pragma unroll
                for (int q = 0; q < 16; q += 4) { const f32x4 t4 = *(const f32x4*)(rp + q); tot += (t4[0] + t4[1]) + (t4[2] + t4[3]); }
                const float rs = rsqrtf(tot * (1.0f / DM) + EPS);
                const f32x4 G = *(const f32x4*)(E.gffn + col) * (*(const f32x4*)(ab + 4096 + col) + 1.0f);
                const f32x4 h = x1 * rs * G + *(const f32x4*)(ab + 3072 + col);
                u32x2 wv; wv.x = pk_bf16(h[0], h[1]); wv.y = pk_bf16(h[2], h[3]);
                *(u32x2*)(E.hbuf + (size_t)row * DM + col) = wv;
            }
            else {
                const int row = row0 + r, col = col0 + c4;
                const f32x4 g = *(const f32x4*)(E.ada + (size_t)row_batch(row) * ADAW + 5120 + col);
                const f32x4 b = *(const f32x4*)(E.out + (size_t)row * DM + col);
                const f32x4 x2 = b + g * v;
                float ss = x2[0] * x2[0] + x2[1] * x2[1] + x2[2] * x2[2] + x2[3] * x2[3];
                ss += __shfl_xor(ss, 1); ss += __shfl_xor(ss, 2); ss += __shfl_xor(ss, 4); ss += __shfl_xor(ss, 8);
                if ((tid & 15) == 0) E.rowpartS[(size_t)(row - NPR) * 16 + ct] = ss;
                xchg_publish_wait(E.cntS + rt * 64, 32u);
                const float* rp = E.rowpartS + (size_t)(row - NPR) * 16;
                float tot = 0.f;
#pragma unroll
                for (int q = 0; q < 16; q += 4) { const f32x4 t4 = *(const f32x4*)(rp + q); tot += (t4[0] + t4[1]) + (t4[2] + t4[3]); }
                const float rs = rsqrtf(tot * (1.0f / DM) + EPS);
                const f32x4 gf = *(const f32x4*)(E.gfin + col);
                *(f32x4*)(E.out + (size_t)row * DM + col) = x2 * rs * gf;
            }
        }
        __syncthreads();
    }
}

__device__ __forceinline__ void conv_tile(const float* __restrict__ src, int ld, int K, bf16_t* __restrict__ dst, int kt, int ntile, int src_col0, float* lds) {
    const int tid = otid();
    const int k0 = kt * 64, n0 = ntile * 64;
#pragma unroll
    for (int i = 0; i < 2; ++i) {
        const int r = (tid >> 4) + i * 32, c4 = (tid & 15) * 4;
        const f32x4 v = *(const f32x4*)(src + (size_t)(k0 + r) * ld + src_col0 + c4);
        lds[r * 65 + c4 + 0] = v[0]; lds[r * 65 + c4 + 1] = v[1]; lds[r * 65 + c4 + 2] = v[2]; lds[r * 65 + c4 + 3] = v[3];
    }
    __syncthreads();
    {
        const int n = tid >> 3, k8 = (tid & 7) * 8;
        float v[8];
#pragma unroll
        for (int i = 0; i < 8; ++i) v[i] = lds[(k8 + i) * 65 + n];
        u32x4 w; w.x = pk_bf16(v[0], v[1]); w.y = pk_bf16(v[2], v[3]); w.z = pk_bf16(v[4], v[5]); w.w = pk_bf16(v[6], v[7]);
        *(u32x4*)(dst + (size_t)(n0 + n) * K + k0 + k8) = w;
    }
    __syncthreads();
}

__device__ __forceinline__ void conv_strip(const float* __restrict__ src, int ld, int K, bf16_t* __restrict__ dst, int kt, int nt4, int src_col0, float* lds) {
    const int tid = otid();
    const int k0 = kt * 64, n0 = nt4 * 256;
    f32x4 v[8];
#pragma unroll
    for (int i = 0; i < 8; ++i) { const int r = (tid >> 6) + i * 8, c4 = (tid & 63) * 4; v[i] = __builtin_nontemporal_load((const f32x4*)(src + (size_t)(k0 + r) * ld + src_col0 + c4)); }
#pragma unroll
    for (int i = 0; i < 8; ++i) { const int r = (tid >> 6) + i * 8, c4 = (tid & 63) * 4;
        lds[r * 257 + c4 + 0] = v[i][0]; lds[r * 257 + c4 + 1] = v[i][1]; lds[r * 257 + c4 + 2] = v[i][2]; lds[r * 257 + c4 + 3] = v[i][3]; }
    __syncthreads();
#pragma unroll
    for (int j = 0; j < 4; ++j) {
        const int n = (tid >> 3) + j * 64, k8 = (tid & 7) * 8;
        float x[8];
#pragma unroll
        for (int i = 0; i < 8; ++i) x[i] = lds[(k8 + i) * 257 + n];
        u32x4 w; w.x = pk_bf16(x[0], x[1]); w.y = pk_bf16(x[2], x[3]); w.z = pk_bf16(x[4], x[5]); w.w = pk_bf16(x[6], x[7]);
        *(u32x4*)(dst + (size_t)(n0 + n) * K + k0 + k8) = w;
    }
    __syncthreads();
}

__device__ __forceinline__ void ada_item(const Params& p, int item, float* lds) {
    const int tid = otid(), lane = tid & 63, w = tid >> 6;
    const int cg_ = item >> 3, kq = item & 7;
    const int n0 = cg_ * 128 + lane * 2;
    const int kbase = kq * 128;
    f32x2 acc[17];
#pragma unroll
    for (int r = 0; r < 17; ++r) acc[r] = (f32x2){0.f, 0.f};
    f32x2 wv[16];
#pragma unroll
    for (int j = 0; j < 16; ++j) wv[j] = __builtin_nontemporal_load((const f32x2*)(p.w_ada + (size_t)(kbase + j) * ADAW + n0));
    for (int e = tid; e < NBATCH * 32; e += NTH) {
        const int r = e >> 5, k4 = (e & 31) * 4;
        const float* cp = r < 8 ? p.c_p + (size_t)r * DM : p.c_s + (size_t)(r - 8) * DM;
        f32x4 v = *(const f32x4*)(cp + kbase + k4);
#pragma unroll
        for (int j = 0; j < 4; ++j) v[j] = v[j] * sigmoidf_(v[j]);
        *(f32x4*)(lds + r * 128 + k4) = v;
    }
    __syncthreads();
#pragma unroll 1
    for (int kb = 0; kb < 128; kb += 16) {
        f32x2 wn[16];
        if (kb + 16 < 128) {
#pragma unroll
            for (int j = 0; j < 16; ++j) wn[j] = __builtin_nontemporal_load((const f32x2*)(p.w_ada + (size_t)(kbase + kb + 16 + j) * ADAW + n0));
        }
#pragma unroll
        for (int r = 0; r < 17; ++r) {
#pragma unroll
            for (int k4 = 0; k4 < 16; k4 += 4) {
                const f32x4 sv = *(const f32x4*)(lds + (w * 17 + r) * 128 + kb + k4);
                acc[r] += wv[k4] * sv[0]; acc[r] += wv[k4 + 1] * sv[1]; acc[r] += wv[k4 + 2] * sv[2]; acc[r] += wv[k4 + 3] * sv[3];
            }
        }
        if (kb + 16 < 128) {
#pragma unroll
            for (int j = 0; j < 16; ++j) wv[j] = wn[j];
        }
    }
    __syncthreads();
    float* part = (float*)(p.ws + WS_ADAP) + (size_t)kq * NBATCH * ADAW;
#pragma unroll
    for (int r = 0; r < 17; ++r) *(f32x2*)(part + (size_t)(w * 17 + r) * ADAW + n0) = acc[r];
}

__device__ __forceinline__ void phase0(const Params& p, float* lds) {
    const int NADA = 48 * 8;
    const int T_IN = 16 * 26, T_PG = 16, T_PO = 8 * 4, T_MO = 64, T_OUT = 64, T_W1 = 16 * 16, T_W2 = 64 * 4;
    const int total = NADA + T_IN + T_PG + T_PO + T_MO + T_OUT + T_W1 + T_W2 + 1;
    unsigned* qctr = (unsigned*)(p.ws + WS_CTR) + 16;
    volatile unsigned* slot = (volatile unsigned*)((unsigned char*)lds + LDS_BYTES - 16);
    for (;;) {
        if (threadIdx.x == 0) *slot = atomicAdd(qctr, 1u);
        __syncthreads();
        const int it = (int)*slot;
        __syncthreads();
        if (it >= total) break;
        int t = it;
        if (t < NADA) { ada_item(p, t, lds); continue; }
        t -= NADA;
        if (t < T_IN) { const int kt = t / 26, nt_ = t % 26; const int n0 = nt_ * 256; const int sc = n0 < 4608 ? n0 : n0 + 8;
            conv_strip(p.w_in, INW, DM, (bf16_t*)(p.ws + WS_WIN), kt, nt_, sc, lds); continue; }
        t -= T_IN;
        if (t < T_PG) { const int g = t >> 2, kt = (t >> 1) & 1, nt_ = t & 1;
            conv_tile(p.w_pg + (size_t)g * 128 * 128, 128, 128, (bf16_t*)(p.ws + WS_WPG) + (size_t)g * 128 * 128, kt, nt_, nt_ * 64, lds); continue; }
        t -= T_PG;
        if (t < T_PO) { const int kt = t / 4, nt_ = t % 4; conv_strip(p.w_po, 1024, 512, (bf16_t*)(p.ws + WS_WPO), kt, nt_, nt_ * 256, lds); continue; }
        t -= T_PO;
        if (t < T_MO) { const int kt = t / 4, nt_ = t % 4; conv_strip(p.w_mo, 1024, 1024, (bf16_t*)(p.ws + WS_WMO), kt, nt_, nt_ * 256, lds); continue; }
        t -= T_MO;
        if (t < T_OUT) { const int kt = t / 4, nt_ = t % 4; conv_strip(p.w_out, 1024, 1024, (bf16_t*)(p.ws + WS_WOUT), kt, nt_, nt_ * 256, lds); continue; }
        t -= T_OUT;
        if (t < T_W1) { const int kt = t / 16, nt_ = t % 16; conv_strip(p.w1, 4096, 1024, (bf16_t*)(p.ws + WS_W1), kt, nt_, nt_ * 256, lds); continue; }
        t -= T_W1;
        if (t < T_W2) { const int kt = t / 4, nt_ = t % 4; conv_strip(p.w2, 1024, 4096, (bf16_t*)(p.ws + WS_W2), kt, nt_, nt_ * 256, lds); continue; }
        for (int e = threadIdx.x; e < 1024 * 2; e += NTH) { const int k = e >> 1, hf = e & 1;
            *(f32x4*)((float*)(p.ws + WS_GW) + k * 8 + hf * 4) = *(const f32x4*)(p.w_in + (size_t)k * INW + 4608 + hf * 4); }
    }
}

__device__ __forceinline__ void norm_item(const Params& p, int item, int mode, float* lds) {
    const int tid = otid(), lane = tid & 63, w = tid >> 6;
    const float* adap = (const float*)(p.ws + WS_ADAP);
    const float* adaf = (const float*)(p.ws + WS_ADA);
    bf16_t* hbuf = (bf16_t*)(p.ws + WS_H);
    if (mode == 0) {
        for (int e = tid; e < 1024 * 2; e += NTH) *(f32x4*)(lds + e * 4) = *(const f32x4*)((const float*)(p.ws + WS_GW) + e * 4);
        __syncthreads();
    }
    const int r_begin = item * 64 + w * 8;
    const int r_extra = NPR + item * 2 + w;
    const int nrows = w < 2 ? 9 : 8;
    int cur_b = -1;
    f32x4 G[4], S[4], xn[4];
    { const int row = r_begin; const float* src0 = mode == 0 ? (row < NPR ? p.x_p + (size_t)row * DM : p.x_s + (size_t)(row - NPR) * DM) : p.out + (size_t)row * DM;
#pragma unroll
      for (int i = 0; i < 4; ++i) xn[i] = *(const f32x4*)(src0 + i * 256 + lane * 4); }
    for (int rr = 0; rr < nrows; ++rr) {
        const int row = rr < 8 ? r_begin + rr : r_extra;
        const int b = row_batch(row);
        if (mode != 2 && b != cur_b) {
            cur_b = b;
            const float* gw = mode == 0 ? p.g_mix : p.g_ffn;
            const int sh_off = mode == 0 ? 0 : 3072, sc_off = mode == 0 ? 1024 : 4096;
            f32x4 scv[4], shv[4];
            if (mode == 0) {
#pragma unroll
                for (int i = 0; i < 4; ++i) { const int col = i * 256 + lane * 4; scv[i] = *(const f32x4*)(p.b_ada + sc_off + col); shv[i] = *(const f32x4*)(p.b_ada + sh_off + col); }
#pragma unroll 2
                for (int q = 0; q < 8; ++q) {
                    const float* ap = adap + ((size_t)q * NBATCH + b) * ADAW;
#pragma unroll
                    for (int i = 0; i < 4; ++i) { const int col = i * 256 + lane * 4; scv[i] += *(const f32x4*)(ap + sc_off + col); shv[i] += *(const f32x4*)(ap + sh_off + col); }
                }
            } else {
#pragma unroll
                for (int i = 0; i < 4; ++i) { const int col = i * 256 + lane * 4; scv[i] = *(const f32x4*)(adaf + (size_t)b * ADAW + sc_off + col); shv[i] = *(const f32x4*)(adaf + (size_t)b * ADAW + sh_off + col); }
            }
#pragma unroll
            for (int i = 0; i < 4; ++i) { const f32x4 g = *(const f32x4*)(gw + i * 256 + lane * 4); G[i] = g * (scv[i] + 1.0f); S[i] = shv[i]; }
        }
        f32x4 x[4]; float ss = 0.f;
#pragma unroll
        for (int i = 0; i < 4; ++i) { x[i] = xn[i]; ss += x[i][0] * x[i][0] + x[i][1] * x[i][1] + x[i][2] * x[i][2] + x[i][3] * x[i][3]; }
        if (rr + 1 < nrows) { const int rown = rr + 1 < 8 ? row + 1 : r_extra;
            const float* srcn = mode == 0 ? (rown < NPR ? p.x_p + (size_t)rown * DM : p.x_s + (size_t)(rown - NPR) * DM) : p.out + (size_t)rown * DM;
#pragma unroll
            for (int i = 0; i < 4; ++i) xn[i] = *(const f32x4*)(srcn + i * 256 + lane * 4); }
        ss = wave_sum(ss);
        const float rstd = rsqrtf(ss * (1.0f / DM) + EPS);
        if (mode == 2) {
#pragma unroll
            for (int i = 0; i < 4; ++i) { const f32x4 g = *(const f32x4*)(p.g_final + i * 256 + lane * 4); __builtin_nontemporal_store(x[i] * rstd * g, (f32x4*)(p.out + (size_t)row * DM + i * 256 + lane * 4)); }
            continue;
        }
        f32x4 hv[4];
#pragma unroll
        for (int i = 0; i < 4; ++i) { hv[i] = x[i] * rstd * G[i] + S[i];
            u32x2 wv; wv.x = pk_bf16(hv[i][0], hv[i][1]); wv.y = pk_bf16(hv[i][2], hv[i][3]);
            *(u32x2*)(hbuf + (size_t)row * DM + i * 256 + lane * 4) = wv; }
        if (mode == 0) {
            float d[8];
#pragma unroll
            for (int j = 0; j < 8; ++j) d[j] = 0.f;
#pragma unroll
            for (int i = 0; i < 4; ++i)
#pragma unroll
                for (int e = 0; e < 4; ++e) {
                    const int k = i * 256 + lane * 4 + e;
                    const f32x4 w0 = *(const f32x4*)(lds + k * 8), w1 = *(const f32x4*)(lds + k * 8 + 4);
                    const float hvv = hv[i][e];
                    d[0] += hvv * w0[0]; d[1] += hvv * w0[1]; d[2] += hvv * w0[2]; d[3] += hvv * w0[3];
                    d[4] += hvv * w1[0]; d[5] += hvv * w1[1]; d[6] += hvv * w1[2]; d[7] += hvv * w1[3];
                }
#pragma unroll
            for (int j = 0; j < 8; ++j) d[j] = wave_sum(d[j]);
            if (lane < 4) {
                float di = lane == 0 ? d[0] : lane == 1 ? d[1] : lane == 2 ? d[2] : d[3];
                float df = lane == 0 ? d[4] : lane == 1 ? d[5] : lane == 2 ? d[6] : d[7];
                di += p.b_i[lane];
                const float z = df + p.b_f[lane];
                const float lf = fminf(z, 0.f) - log1pf(__expf(-fabsf(z)));
                ((float*)(p.ws + WS_GI))[(size_t)row * 4 + lane] = di;
                ((float*)(p.ws + WS_GF))[(size_t)row * 4 + lane] = lf;
            }
        }
    }
    if (mode == 0) __syncthreads();
}

__device__ __forceinline__ void ada_final_slice(const Params& p, int blk) {
    const float* adap = (const float*)(p.ws + WS_ADAP);
    float* adaf = (float*)(p.ws + WS_ADA);
    for (int e = threadIdx.x; e < 816; e += NTH) {
        const size_t idx = ((size_t)blk * 816 + e) * 4;
        f32x4 v = *(const f32x4*)(p.b_ada + (idx % ADAW));
#pragma unroll
        for (int q = 0; q < 8; ++q) v += *(const f32x4*)(adap + (size_t)q * NBATCH * ADAW + idx);
        *(f32x4*)(adaf + idx) = v;
    }
}

__device__ __forceinline__ void scan_item(const Params& p, int item, unsigned char* lds) {
    const int tid = otid(), lane = tid & 63, w = tid >> 6, fr = lane & 15, fq = lane >> 4;
    const int bh = item >> 2, j = item & 3, b = bh >> 2, hd = bh & 3, dv0 = j * 64;
    const float* gi = (const float*)(p.ws + WS_GI); const float* gf = (const float*)(p.ws + WS_GF);
    const bf16_t* kbuf = (const bf16_t*)(p.ws + WS_QKV) + (size_t)1 * MROWS * DM;
    const bf16_t* vbuf = (const bf16_t*)(p.ws + WS_QKV) + (size_t)2 * MROWS * DM;
    bf16_t* cst = (bf16_t*)(p.ws + WS_CST) + (size_t)bh * 31 * 65536;
    float* nst = (float*)(p.ws + WS_NST) + (size_t)bh * 32 * 256;
    float* mst = (float*)(p.ws + WS_MST) + (size_t)bh * 64;
    constexpr int KROW = 144;
    unsigned char* kimg[2] = {lds, lds + 256 * KROW};
    unsigned char* vimg[2] = {lds + 2 * 256 * KROW, lds + 2 * 256 * KROW + 64 * KROW};
    float* aA = (float*)(lds + 2 * 256 * KROW + 2 * 64 * KROW);
    float* bLs = aA + 2048;
    float* amx = bLs + 32;
    float* mch = amx + 32;
    float* dcy = mch + 40;
    for (int c = w * 4; c < w * 4 + 4; ++c) {
        const size_t tok = (size_t)b * SEQ + c * 64 + lane;
        const float lf = gf[tok * 4 + hd], il = gi[tok * 4 + hd];
        const float bs = wave_scan_add(lf, lane);
        const float bL = __shfl(bs, 63);
        const float a = bL - bs + il;
        const float am = wave_max(a);
        aA[c * 64 + lane] = a;
        if (lane == 0) { bLs[c] = bL; amx[c] = am; }
    }
    __syncthreads();
    if (tid == 0) {
        float m = 0.f; mch[0] = 0.f;
        for (int c = 0; c < 32; ++c) { const float mn = fmaxf(bLs[c] + m, amx[c]); dcy[c] = __expf(bLs[c] + m - mn); m = mn; mch[c + 1] = mn; }
    }
    __syncthreads();
    if (j == 0 && tid < 33) mst[tid] = mch[tid];
    if (j == 0 && tid == 0) p.out[O_MP + bh] = mch[32];
    f32x4 acc[2][4] = {};
    float nacc = 0.f;
    u32x4 krA[4], krB[4]; u32x4 vrA, vrB;
#define SCAN_GLOAD(KR, VR, cc) do { const size_t tok_ = (size_t)b * SEQ + (cc) * 64 + lane; const bf16_t* kp_ = kbuf + tok_ * DM + hd * 256 + w * 32; \
        _Pragma("unroll") for (int i_ = 0; i_ < 4; ++i_) KR[i_] = *(const u32x4*)(kp_ + i_ * 8); \
        VR = *(const u32x4*)(vbuf + tok_ * DM + hd * 256 + dv0 + w * 8); } while (0)
#define SCAN_WRITE(KR, VR, cc, ki, vi) do { const float wsv = __expf(aA[(cc) * 64 + lane] - mch[(cc) + 1]); \
        _Pragma("unroll") for (int i_ = 0; i_ < 4; ++i_) { const unsigned uu[4] = {KR[i_].x, KR[i_].y, KR[i_].z, KR[i_].w}; \
            _Pragma("unroll") for (int e_ = 0; e_ < 4; ++e_) { const int dk_ = w * 32 + i_ * 8 + e_ * 2; \
                *(bf16_t*)(ki + dk_ * KROW + lane * 2) = f2bf(bflo(uu[e_]) * wsv); *(bf16_t*)(ki + (dk_ + 1) * KROW + lane * 2) = f2bf(bfhi(uu[e_]) * wsv); } } \
        const int dv_ = w * 8; \
        *(bf16_t*)(vi + (dv_ + 0) * KROW + lane * 2) = (bf16_t)(VR.x & 0xffffu); *(bf16_t*)(vi + (dv_ + 1) * KROW + lane * 2) = (bf16_t)(VR.x >> 16); \
        *(bf16_t*)(vi + (dv_ + 2) * KROW + lane * 2) = (bf16_t)(VR.y & 0xffffu); *(bf16_t*)(vi + (dv_ + 3) * KROW + lane * 2) = (bf16_t)(VR.y >> 16); \
        *(bf16_t*)(vi + (dv_ + 4) * KROW + lane * 2) = (bf16_t)(VR.z & 0xffffu); *(bf16_t*)(vi + (dv_ + 5) * KROW + lane * 2) = (bf16_t)(VR.z >> 16); \
        *(bf16_t*)(vi + (dv_ + 6) * KROW + lane * 2) = (bf16_t)(VR.w & 0xffffu); *(bf16_t*)(vi + (dv_ + 7) * KROW + lane * 2) = (bf16_t)(VR.w >> 16); } while (0)
    SCAN_GLOAD(krA, vrA, 0);
    SCAN_GLOAD(krB, vrB, 1);
    for (int c = 0; c < 32; ++c) {
        unsigned char* ki = kimg[c & 1]; unsigned char* vi = vimg[c & 1];
        if ((c & 1) == 0) { SCAN_WRITE(krA, vrA, c, ki, vi); if (c + 2 < 32) SCAN_GLOAD(krA, vrA, c + 2); }
        else { SCAN_WRITE(krB, vrB, c, ki, vi); if (c + 2 < 32) SCAN_GLOAD(krB, vrB, c + 2); }
        __syncthreads();
        const float dc = dcy[c];
        bf16x8 af[2][2], bfr[4][2];
#pragma unroll
        for (int a = 0; a < 2; ++a)
#pragma unroll
            for (int k = 0; k < 2; ++k) af[a][k] = *(const bf16x8*)(ki + ((w * 2 + a) * 16 + fr) * KROW + (k * 32 + fq * 8) * 2);
#pragma unroll
        for (int a = 0; a < 4; ++a)
#pragma unroll
            for (int k = 0; k < 2; ++k) bfr[a][k] = *(const bf16x8*)(vi + (a * 16 + fr) * KROW + (k * 32 + fq * 8) * 2);
#pragma unroll
        for (int a = 0; a < 2; ++a)
#pragma unroll
            for (int q = 0; q < 4; ++q) {
                acc[a][q] *= dc;
#pragma unroll
                for (int k = 0; k < 2; ++k) acc[a][q] = MFMA16(af[a][k], bfr[q][k], acc[a][q]);
            }
        if (j == 0) {
            const int dk = tid >> 1, hf = tid & 1;
            float s = 0.f;
#pragma unroll
            for (int i = 0; i < 4; ++i) {
                const u32x4 v = *(const u32x4*)(ki + dk * KROW + hf * 64 + i * 16);
                s += bflo(v.x) + bfhi(v.x) + bflo(v.y) + bfhi(v.y) + bflo(v.z) + bfhi(v.z) + bflo(v.w) + bfhi(v.w);
            }
            s += __shfl_xor(s, 1);
            nacc = nacc * dc + s;
            if (hf == 0) { if (c < 31) nst[(c + 1) * 256 + dk] = nacc; else p.out[O_NP + (size_t)bh * 256 + dk] = nacc; }
        }
        if (c < 31) {
            bf16_t* cs = cst + (size_t)c * 65536;
#pragma unroll
            for (int a = 0; a < 2; ++a)
#pragma unroll
                for (int q = 0; q < 4; ++q) {
                    u32x2 wv; wv.x = pk_bf16(acc[a][q][0], acc[a][q][1]); wv.y = pk_bf16(acc[a][q][2], acc[a][q][3]);
                    *(u32x2*)(cs + (size_t)(dv0 + q * 16 + fr) * 256 + (w * 2 + a) * 16 + fq * 4) = wv;
                }
        } else {
            float* co = p.out + O_CP + (size_t)bh * 65536;
#pragma unroll
            for (int a = 0; a < 2; ++a)
#pragma unroll
                for (int q = 0; q < 4; ++q)
#pragma unroll
                    for (int jj = 0; jj < 4; ++jj) co[(size_t)((w * 2 + a) * 16 + fq * 4 + jj) * 256 + dv0 + q * 16 + fr] = acc[a][q][jj];
        }
    }
    __syncthreads();
}

__device__ __forceinline__ void sample_item(const Params& p, int item, unsigned char* ldsb) {
    const int tid = otid(), lane = tid & 63, w = tid >> 6;
    const int b = item >> 2, hd = item & 3, bh = item;
    const int r0 = NPR + b * 4;
    const bf16_t* qb = (const bf16_t*)(p.ws + WS_QKV);
    const bf16_t* kb = qb + (size_t)MROWS * DM; const bf16_t* vb = kb + (size_t)MROWS * DM; const bf16_t* ob = vb + (size_t)MROWS * DM;
    const float* gi = (const float*)(p.ws + WS_GI); const float* gf = (const float*)(p.ws + WS_GF);
    float* lds = (float*)ldsb;
    float* qf = lds;
    float* kf = qf + 1024;
    float* vf = kf + 1024;
    float* Sm = vf + 1024;
    float* sc = Sm + 16;
    float* red = sc + 64;
    float* ssq = red + 8192;
    const int dv4 = lane * 4;
    const float* C0 = p.st_C + (size_t)bh * 65536;
    float* Cn = p.out + O_CS + (size_t)bh * 65536;
    f32x4 cpre[8];
#pragma unroll
    for (int r = 0; r < 8; ++r) cpre[r] = __builtin_nontemporal_load((const f32x4*)(C0 + (size_t)(w * 32 + r) * 256 + dv4));
    float* n0s = ssq + 8;
    const int ft = tid >> 7, fdv = (tid & 127) * 2;
    const size_t foidx = (size_t)(r0 + ft) * DM + hd * 256 + fdv;
    const unsigned fog = *(const unsigned*)(ob + foidx);
    const float fm0 = p.m_norm[hd * 256 + fdv], fm1 = p.m_norm[hd * 256 + fdv + 1];
    if (tid < 256) n0s[tid] = p.st_n[(size_t)bh * 256 + tid];
    for (int e = tid; e < 3 * 4 * 256; e += NTH) {
        const int which = e >> 10, t = (e >> 8) & 3, d = e & 255;
        const bf16_t* src = which == 0 ? qb : which == 1 ? kb : vb;
        lds[which * 1024 + t * 256 + d] = bf2f(src[(size_t)(r0 + t) * DM + hd * 256 + d]);
    }
    if (tid == 0) {
        float lf[4], il[4], bs[4];
        for (int t = 0; t < 4; ++t) { lf[t] = gf[(size_t)(r0 + t) * 4 + hd]; il[t] = gi[(size_t)(r0 + t) * 4 + hd]; }
        bs[0] = lf[0]; bs[1] = bs[0] + lf[1]; bs[2] = bs[1] + lf[2]; bs[3] = bs[2] + lf[3];
        const float m0 = p.st_m[bh];
        for (int t = 0; t < 4; ++t) {
            const float g = bs[t] + m0; float mt = g;
            for (int s = 0; s <= t; ++s) mt = fmaxf(mt, bs[t] - bs[s] + il[s]);
            sc[t] = __expf(g - mt); sc[4 + t] = __expf(-mt);
            for (int s = 0; s < 4; ++s) sc[16 + t * 4 + s] = s <= t ? __expf(bs[t] - bs[s] + il[s] - mt) : 0.f;
        }
        const float bL = bs[3]; float mn = bL + m0;
        for (int s = 0; s < 4; ++s) mn = fmaxf(mn, bL - bs[s] + il[s]);
        sc[12] = __expf(bL + m0 - mn);
        for (int s = 0; s < 4; ++s) sc[8 + s] = __expf(bL - bs[s] + il[s] - mn);
        p.out[O_MS + bh] = mn;
    }
    __syncthreads();
    {
        const int g = tid >> 5, l32 = tid & 31;
        {
            const int t = g >> 2, s = g & 3; float a = 0.f;
#pragma unroll
            for (int d = l32; d < 256; d += 32) a += qf[t * 256 + d] * kf[s * 256 + d];
#pragma unroll
            for (int dd = 16; dd >= 1; dd >>= 1) a += __shfl_xor(a, dd);
            if (l32 == 0) Sm[g] = a * sc[16 + g];
        }
        if (g < 4) {
            float a = 0.f;
#pragma unroll
            for (int d = l32; d < 256; d += 32) a += qf[g * 256 + d] * n0s[d];
#pragma unroll
            for (int dd = 16; dd >= 1; dd >>= 1) a += __shfl_xor(a, dd);
            if (l32 == 0) sc[32 + g] = a;
        }
    }
    const float decay = sc[12];
    const float ws0 = sc[8], ws1 = sc[9], ws2 = sc[10], ws3 = sc[11];
    if (tid < 256) {
        const float nn = decay * n0s[tid] + ws0 * kf[tid] + ws1 * kf[256 + tid] + ws2 * kf[512 + tid] + ws3 * kf[768 + tid];
        p.out[O_NS + (size_t)bh * 256 + tid] = nn;
    }
    {
        f32x4 vv[4], num[4];
        vv[0] = *(const f32x4*)(vf + dv4) * ws0; vv[1] = *(const f32x4*)(vf + 256 + dv4) * ws1; vv[2] = *(const f32x4*)(vf + 512 + dv4) * ws2; vv[3] = *(const f32x4*)(vf + 768 + dv4) * ws3;
#pragma unroll
        for (int s = 0; s < 4; ++s) num[s] = (f32x4){0.f, 0.f, 0.f, 0.f};
#pragma unroll
        for (int r = 0; r < 8; ++r) {
            const int dk = w * 32 + r;
            const f32x4 cv = cpre[r];
            f32x4 cn = cv * decay;
#pragma unroll
            for (int s = 0; s < 4; ++s) { num[s] += cv * qf[s * 256 + dk]; cn += vv[s] * kf[s * 256 + dk]; }
            __builtin_nontemporal_store(cn, (f32x4*)(Cn + (size_t)dk * 256 + dv4));
        }
#pragma unroll 8
        for (int r = 8; r < 32; ++r) {
            const int dk = w * 32 + r;
            const f32x4 cv = __builtin_nontemporal_load((const f32x4*)(C0 + (size_t)dk * 256 + dv4));
            f32x4 cn = cv * decay;
#pragma unroll
            for (int s = 0; s < 4; ++s) { num[s] += cv * qf[s * 256 + dk]; cn += vv[s] * kf[s * 256 + dk]; }
            __builtin_nontemporal_store(cn, (f32x4*)(Cn + (size_t)dk * 256 + dv4));
        }
        __syncthreads();
#pragma unroll
        for (int t = 0; t < 4; ++t) *(f32x4*)(red + (w * 4 + t) * 256 + dv4) = num[t];
    }
    __syncthreads();
    {
        const int t = tid >> 7, dv = (tid & 127) * 2;
        float n0_ = 0.f, n1_ = 0.f;
#pragma unroll
        for (int ww = 0; ww < 8; ++ww) { n0_ += red[(ww * 4 + t) * 256 + dv]; n1_ += red[(ww * 4 + t) * 256 + dv + 1]; }
        const float wint = sc[t];
        n0_ *= wint; n1_ *= wint;
        float rs = 0.f;
#pragma unroll
        for (int s = 0; s < 4; ++s) { const float sv = Sm[t * 4 + s]; rs += sv; n0_ += sv * vf[s * 256 + dv]; n1_ += sv * vf[s * 256 + dv + 1]; }
        const float den = wint * sc[32 + t] + rs;
        const float dinv = 1.0f / fmaxf(fabsf(den), sc[4 + t]);
        const float h0 = n0_ * dinv, h1 = n1_ * dinv;
        float q2 = wave_sum(h0 * h0 + h1 * h1);
        if (lane == 0) ssq[t * 2 + (w & 1)] = q2;
        __syncthreads();
        const float rstd = rsqrtf((ssq[t * 2] + ssq[t * 2 + 1]) * (1.0f / 256.f) + EPS);
        const float o0 = h0 * rstd * fm0 * bflo(fog), o1 = h1 * rstd * fm1 * bfhi(fog);
        *(unsigned*)((bf16_t*)(p.ws + WS_HM) + foidx) = pk_bf16(o0, o1);
    }
    __syncthreads();
}

__device__ __forceinline__ void pool_item(const Params& p, int item, unsigned char* lds) {
    const int tid = otid(), lane = tid & 63, w = tid >> 6, fr = lane & 15, fq = lane >> 4;
    const int r0 = item < 256 ? item * 64 : NPR + (item - 256) * 16;
    const int nm = item < 256 ? 4 : 1;
    const float* u = (const float*)(p.ws + WS_U);
    constexpr int AROW = 1040;
    bf16x8 bw[4][4];
    {
        const bf16_t* wt0 = (const bf16_t*)(p.ws + WS_WPG) + (size_t)(w >> 1) * 128 * 128;
#pragma unroll
        for (int k = 0; k < 4; ++k)
#pragma unroll
            for (int n = 0; n < 4; ++n) bw[k][n] = *(const bf16x8*)(wt0 + (size_t)(((w & 1) * 4 + n) * 16 + fr) * 128 + k * 32 + fq * 8);
    }
    {
        const int c = tid, gidx = c >> 7, win = 2 << gidx;
        float hist[31];
        if (r0 < NPR) {
            const int t0 = r0 & (SEQ - 1);
#pragma unroll
            for (int j = 0; j < 15; ++j) hist[j] = (t0 - 15 + j) >= 0 ? u[(size_t)(r0 - 15 + j) * 512 + c] : 0.f;
            float nxt[16];
#pragma unroll
            for (int j = 0; j < 16; ++j) nxt[j] = u[(size_t)(r0 + j) * 512 + c];
#pragma unroll 1
            for (int ch = 0; ch < 4; ++ch) {
#pragma unroll
                for (int j = 0; j < 16; ++j) hist[15 + j] = nxt[j];
                if (ch < 3) {
#pragma unroll
                    for (int j = 0; j < 16; ++j) nxt[j] = u[(size_t)(r0 + (ch + 1) * 16 + j) * 512 + c];
                }
#pragma unroll
                for (int j = 0; j < 16; ++j) {
                    const int i = ch * 16 + j, t = t0 + i, q = 15 + j;
                    const float s2 = hist[q] + hist[q - 1];
                    const float s4 = s2 + hist[q - 2] + hist[q - 3];
                    const float s8 = s4 + (hist[q - 4] + hist[q - 5]) + (hist[q - 6] + hist[q - 7]);
                    const float s16 = s8 + ((hist[q - 8] + hist[q - 9]) + (hist[q - 10] + hist[q - 11])) + ((hist[q - 12] + hist[q - 13]) + (hist[q - 14] + hist[q - 15]));
                    const float s = gidx == 0 ? s2 : gidx == 1 ? s4 : gidx == 2 ? s8 : s16;
                    const float rc = __builtin_amdgcn_rcpf((float)min(t + 1, win));
                    *(bf16_t*)(lds + i * AROW + c * 2) = f2bf(s * rc - hist[q]);
                }
#pragma unroll
                for (int j = 0; j < 15; ++j) hist[j] = hist[16 + j];
            }
        } else {
#pragma unroll 1
            for (int bi = 0; bi < 4; ++bi) {
                const int bb = ((r0 - NPR) >> 2) + bi;
#pragma unroll
                for (int j = 0; j < 15; ++j) hist[j] = p.st_pool[((size_t)bb * 15 + j) * 512 + c];
#pragma unroll
                for (int j = 0; j < 4; ++j) hist[15 + j] = u[((size_t)NPR + bb * 4 + j) * 512 + c];
#pragma unroll
                for (int j = 0; j < 4; ++j) {
                    const int i = bi * 4 + j, q = 15 + j;
                    const float s2 = hist[q] + hist[q - 1];
                    const float s4 = s2 + hist[q - 2] + hist[q - 3];
                    const float s8 = s4 + (hist[q - 4] + hist[q - 5]) + (hist[q - 6] + hist[q - 7]);
                    const float s16 = s8 + ((hist[q - 8] + hist[q - 9]) + (hist[q - 10] + hist[q - 11])) + ((hist[q - 12] + hist[q - 13]) + (hist[q - 14] + hist[q - 15]));
                    const float s = gidx == 0 ? s2 : gidx == 1 ? s4 : gidx == 2 ? s8 : s16;
                    *(bf16_t*)(lds + i * AROW + c * 2) = f2bf(s * (1.0f / (float)win) - hist[q]);
                }
            }
        }
    }
    __syncthreads();
    {
        const int g = w >> 1, nh = w & 1;
        f32x4 acc[4][4] = {};
#pragma unroll
        for (int k = 0; k < 4; ++k) {
            bf16x8 af[4];
#pragma unroll
            for (int m = 0; m < 4; ++m) if (m < nm) af[m] = *(const bf16x8*)(lds + (m * 16 + fr) * AROW + (g * 128 + k * 32 + fq * 8) * 2);
#pragma unroll
            for (int m = 0; m < 4; ++m) if (m < nm) {
#pragma unroll
                for (int n = 0; n < 4; ++n) acc[m][n] = MFMA16(bw[k][n], af[m], acc[m][n]); }
        }
        bf16_t* yp = (bf16_t*)(p.ws + WS_YP);
#pragma unroll
        for (int m = 0; m < 4; ++m) if (m < nm)
#pragma unroll
            for (int n = 0; n < 4; ++n) {
                const int col = g * 128 + (nh * 4 + n) * 16 + fq * 4;
                const f32x4 scv = *(const f32x4*)(p.pool_scale + col);
                const f32x4 v = acc[m][n] * scv;
                u32x2 wv; wv.x = pk_bf16(v[0], v[1]); wv.y = pk_bf16(v[2], v[3]);
                *(u32x2*)(yp + (size_t)(r0 + m * 16 + fr) * 512 + col) = wv;
            }
    }
    __syncthreads();
}

__device__ __forceinline__ void poolout_item(const Params& p, int item) {
    const float* u = (const float*)(p.ws + WS_U);
    for (int e = threadIdx.x; e < 15 * 512; e += NTH) {
        const int jj = e >> 9, c = e & 511;
        if (item < 8) p.out[O_POOLP + (size_t)item * 7680 + e] = u[((size_t)item * SEQ + 2033 + jj) * 512 + c];
        else { const int bb = item - 8;
            p.out[O_POOLS + (size_t)bb * 7680 + e] = jj < 11 ? p.st_pool[((size_t)bb * 15 + jj + 4) * 512 + c] : u[((size_t)NPR + bb * 4 + (jj - 11)) * 512 + c]; }
    }
}

__device__ __forceinline__ void mout_item(const Params& p, int item, unsigned char* lds) {
    const int tid = otid(), lane = tid & 63, w = tid >> 6, fr = lane & 15, fq = lane >> 4;
    const int bh = item >> 5, c = item & 31, b = bh >> 2, hd = bh & 3;
    const size_t tok0 = (size_t)b * SEQ + c * 64;
    const bf16_t* qb = (const bf16_t*)(p.ws + WS_QKV);
    const bf16_t* kb = qb + (size_t)MROWS * DM; const bf16_t* vb = kb + (size_t)MROWS * DM; const bf16_t* ob = vb + (size_t)MROWS * DM;
    const float* gi = (const float*)(p.ws + WS_GI); const float* gf = (const float*)(p.ws + WS_GF);
    constexpr int QROW = 528, VROW = 144;
    unsigned char* Qs = lds;
    unsigned char* Ks = Qs + 64 * QROW;
    unsigned char* Vt = Ks + 64 * QROW;
    unsigned char* Sp = Vt + 256 * VROW;
    float* scal = (float*)(Sp + 64 * VROW);
    float* rt = scal, *ct = scal + 64, *wint = scal + 128, *emt = scal + 192, *rowsum = scal + 256  , *qn = scal + 384, *ssq = scal + 448  , *ncs = scal + 960  ;
    const float lf_pre = gf[(tok0 + lane) * 4 + hd], il_pre = gi[(tok0 + lane) * 4 + hd];
    const float mc_pre = ((const float*)(p.ws + WS_MST))[bh * 64 + c];
    bf16x8 cfr[8][2];
    if (c > 0) {
        const bf16_t* cs = (const bf16_t*)(p.ws + WS_CST) + ((size_t)bh * 31 + (c - 1)) * 65536;
#pragma unroll
        for (int k = 0; k < 8; ++k)
#pragma unroll
            for (int n = 0; n < 2; ++n) cfr[k][n] = *(const bf16x8*)(cs + (size_t)(w * 32 + n * 16 + fr) * 256 + k * 32 + fq * 8);
    }
    u32x2 ogv[4][2]; f32x4 mnv[2];
#pragma unroll
    for (int n = 0; n < 2; ++n) { const int dvg = hd * 256 + w * 32 + n * 16 + fq * 4; mnv[n] = *(const f32x4*)(p.m_norm + dvg);
#pragma unroll
        for (int m = 0; m < 4; ++m) ogv[m][n] = *(const u32x2*)(ob + (tok0 + m * 16 + fr) * DM + dvg); }
    if (w == 0) {
        const float lf = lf_pre, il = il_pre;
        const float bs = wave_scan_add(lf, lane);
        const float mc = mc_pre;
        const float g = bs + mc, xx = il - bs;
        const float pm = wave_scan_max(xx, lane);
        const float mt = fmaxf(g, bs + pm);
        rt[lane] = bs - mt; ct[lane] = xx; wint[lane] = __expf(g - mt); emt[lane] = __expf(-mt);
    }
#pragma unroll
    for (int i = 0; i < 4; ++i) {
        const int pc = tid + NTH * i, row = pc >> 5, c8 = pc & 31;
        *(u32x4*)(Qs + row * QROW + c8 * 16) = *(const u32x4*)(qb + (tok0 + row) * DM + hd * 256 + c8 * 8);
        *(u32x4*)(Ks + row * QROW + c8 * 16) = *(const u32x4*)(kb + (tok0 + row) * DM + hd * 256 + c8 * 8);
    }
    {
        const bf16_t* vp = vb + (tok0 + lane) * DM + hd * 256 + w * 32;
#pragma unroll
        for (int i = 0; i < 4; ++i) {
            const u32x4 v = *(const u32x4*)(vp + i * 8);
            const unsigned uu[4] = {v.x, v.y, v.z, v.w};
#pragma unroll
            for (int e = 0; e < 4; ++e) {
                const int dv = w * 32 + i * 8 + e * 2;
                *(bf16_t*)(Vt + dv * VROW + lane * 2) = (bf16_t)(uu[e] & 0xffffu);
                *(bf16_t*)(Vt + (dv + 1) * VROW + lane * 2) = (bf16_t)(uu[e] >> 16);
            }
        }
    }
    if (c > 0 && tid >= 256) ncs[tid - 256] = ((const float*)(p.ws + WS_NST))[((size_t)bh * 32 + c) * 256 + tid - 256];
    __syncthreads();
    {
        const int tt = w >> 1, sh = w & 1;
        f32x4 sa[2] = {};
#pragma unroll
        for (int k = 0; k < 8; ++k) {
            const bf16x8 qf = *(const bf16x8*)(Qs + (tt * 16 + fr) * QROW + (k * 32 + fq * 8) * 2);
#pragma unroll
            for (int s2 = 0; s2 < 2; ++s2) {
                const bf16x8 kf = *(const bf16x8*)(Ks + ((sh * 2 + s2) * 16 + fr) * QROW + (k * 32 + fq * 8) * 2);
                sa[s2] = MFMA16(kf, qf, sa[s2]);
            }
        }
        const int t = tt * 16 + fr;
        const float rtt = rt[t];
        float rs = 0.f;
#pragma unroll
        for (int s2 = 0; s2 < 2; ++s2) {
            const int s0 = (sh * 2 + s2) * 16 + fq * 4;
            float v[4];
#pragma unroll
            for (int jj = 0; jj < 4; ++jj) { const int s = s0 + jj; v[jj] = s <= t ? sa[s2][jj] * __expf(rtt + ct[s]) : 0.f; rs += v[jj]; }
            u32x2 wv; wv.x = pk_bf16(v[0], v[1]); wv.y = pk_bf16(v[2], v[3]);
            *(u32x2*)(Sp + t * VROW + s0 * 2) = wv;
        }
        rs += __shfl_xor(rs, 16); rs += __shfl_xor(rs, 32);
        if (fq == 0) rowsum[t * 2 + sh] = rs;
    }
    {
        const int t = tid >> 3, part = tid & 7;
        float a = 0.f;
        if (c > 0) {
            const float* nc = ncs + part * 32;
            const unsigned char* qp = Qs + t * QROW + part * 64;
#pragma unroll
            for (int i = 0; i < 4; ++i) {
                const u32x4 qv = *(const u32x4*)(qp + i * 16);
                const f32x4 n0 = *(const f32x4*)(nc + i * 8), n1 = *(const f32x4*)(nc + i * 8 + 4);
                a += bflo(qv.x) * n0[0] + bfhi(qv.x) * n0[1] + bflo(qv.y) * n0[2] + bfhi(qv.y) * n0[3] + bflo(qv.z) * n1[0] + bfhi(qv.z) * n1[1] + bflo(qv.w) * n1[2] + bfhi(qv.w) * n1[3];
            }
        }
        a += __shfl_xor(a, 1); a += __shfl_xor(a, 2); a += __shfl_xor(a, 4);
        if (part == 0) qn[t] = a;
    }
    __syncthreads();
    f32x4 acc[4][2] = {};
    if (c > 0) {
#pragma unroll
        for (int k = 0; k < 8; ++k) {
            bf16x8 qf[4];
#pragma unroll
            for (int m = 0; m < 4; ++m) qf[m] = *(const bf16x8*)(Qs + (m * 16 + fr) * QROW + (k * 32 + fq * 8) * 2);
#pragma unroll
            for (int m = 0; m < 4; ++m)
#pragma unroll
                for (int n = 0; n < 2; ++n) acc[m][n] = MFMA16(cfr[k][n], qf[m], acc[m][n]);
        }
#pragma unroll
        for (int m = 0; m < 4; ++m) { const float wi = wint[m * 16 + fr]; acc[m][0] *= wi; acc[m][1] *= wi; }
    }
#pragma unroll
    for (int k = 0; k < 2; ++k) {
        bf16x8 vfr[2], sf[4];
#pragma unroll
        for (int n = 0; n < 2; ++n) vfr[n] = *(const bf16x8*)(Vt + (w * 32 + n * 16 + fr) * VROW + (k * 32 + fq * 8) * 2);
#pragma unroll
        for (int m = 0; m < 4; ++m) sf[m] = *(const bf16x8*)(Sp + (m * 16 + fr) * VROW + (k * 32 + fq * 8) * 2);
#pragma unroll
        for (int m = 0; m < 4; ++m)
#pragma unroll
            for (int n = 0; n < 2; ++n) acc[m][n] = MFMA16(vfr[n], sf[m], acc[m][n]);
    }
#pragma unroll
    for (int m = 0; m < 4; ++m) {
        const int t = m * 16 + fr;
        const float den = wint[t] * qn[t] + rowsum[t * 2] + rowsum[t * 2 + 1];
        const float dinv = 1.0f / fmaxf(fabsf(den), emt[t]);
        acc[m][0] *= dinv; acc[m][1] *= dinv;
        float q2 = 0.f;
#pragma unroll
        for (int n = 0; n < 2; ++n)
#pragma unroll
            for (int jj = 0; jj < 4; ++jj) q2 += acc[m][n][jj] * acc[m][n][jj];
        q2 += __shfl_xor(q2, 16); q2 += __shfl_xor(q2, 32);
        if (fq == 0) ssq[t * 8 + w] = q2;
    }
    __syncthreads();
#pragma unroll
    for (int m = 0; m < 4; ++m) {
        const int t = m * 16 + fr;
        float tot = 0.f;
#pragma unroll
        for (int ww = 0; ww < 8; ++ww) tot += ssq[t * 8 + ww];
        const float rstd = rsqrtf(tot * (1.0f / 256.f) + EPS);
#pragma unroll
        for (int n = 0; n < 2; ++n) {
            const int dvg = hd * 256 + w * 32 + n * 16 + fq * 4;
            const size_t oidx = (tok0 + t) * DM + dvg;
            const u32x2 og = ogv[m][n];
            const f32x4 v = acc[m][n] * rstd * mnv[n];
            u32x2 wv; wv.x = pk_bf16(v[0] * bflo(og.x), v[1] * bfhi(og.x)); wv.y = pk_bf16(v[2] * bflo(og.y), v[3] * bfhi(og.y));
            *(u32x2*)((bf16_t*)(p.ws + WS_HM) + oidx) = wv;
        }
    }
    __syncthreads();
}

__device__ __forceinline__ void grid_barrier(unsigned* bar, unsigned k) {
    asm volatile("s_waitcnt vmcnt(0)" ::: "memory");
    __syncthreads();
    if (threadIdx.x == 0) {
        const unsigned g = blockIdx.x & 7u, gsz = (gridDim.x + 7u - g) >> 3;
        __builtin_amdgcn_fence(__ATOMIC_RELEASE, "agent");
        asm volatile("s_waitcnt vmcnt(0)" ::: "memory");
        unsigned* sub = bar + 64u * (1u + g);
        const unsigned prev = __hip_atomic_fetch_add(sub, 1u, __ATOMIC_RELAXED, __HIP_MEMORY_SCOPE_AGENT);
        if (prev + 1u == k * gsz) __hip_atomic_fetch_add(bar, 1u, __ATOMIC_RELAXED, __HIP_MEMORY_SCOPE_AGENT);
        const unsigned ngroups = gridDim.x < 8u ? gridDim.x : 8u;
        unsigned spins = 0;
        while (__hip_atomic_load(bar, __ATOMIC_RELAXED, __HIP_MEMORY_SCOPE_AGENT) < k * ngroups) { __builtin_amdgcn_s_sleep(1); if (++spins > (1u << 24)) break; }
        __builtin_amdgcn_fence(__ATOMIC_ACQUIRE, "agent");
        asm volatile("s_waitcnt vmcnt(0)" ::: "memory");
    }
    __syncthreads();
}

__global__ void __launch_bounds__(NTH) hybrid_fwd(Params p) {
    extern __shared__ __attribute__((aligned(16))) unsigned char lds[];
    cg::grid_group grid = cg::this_grid();
    const int lo = p.ph_lo, hi = p.ph_hi;
#ifndef PHMASK
#define PHMASK 0x7ff
#endif
#define IN(k) (((PHMASK >> (k)) & 1) && lo <= (k) && (k) < hi)
#define SEAMN(n) do { grid_barrier((unsigned*)(p.ws + WS_CTR) + 64, (unsigned)(n)); } while (0)
    if (lo < 0) grid.sync();
    LAS unsigned char* ldsl = (LAS unsigned char*)lds;
    unsigned char* ws = p.ws;
    if (IN(0)) phase0(p, (float*)lds);
    SEAMN(1);
    if (IN(1)) {
        for (int it = blockIdx.x; it < 256; it += gridDim.x) { ada_final_slice(p, it); norm_item(p, it, 0, (float*)lds); }
    }
    SEAMN(2);
    if (IN(2)) { EpiG1 e{(float*)(ws + WS_U), (bf16_t*)(ws + WS_QKV)}; gemm_phase(ldsl, (const bf16_t*)(ws + WS_H), (const bf16_t*)(ws + WS_WIN), NIN, DM, e);
        { const int c = blockIdx.x; const int tb = c < 128 ? c * 2 : 256 + (c - 128) * 11;
          small_gemm_phase(lds, (const bf16_t*)(ws + WS_H), (const bf16_t*)(ws + WS_WIN), NIN, DM, e, tb, tb + (c < 128 ? 2 : 11)); } }
    SEAMN(3);
    if (IN(3)) {
        if (blockIdx.x < 128) { const int x = blockIdx.x & 7, r = blockIdx.x >> 3;
            scan_item(p, ((x + 8 * (r >> 2)) << 2) | (r & 3), lds); }
        {
            unsigned* ctr = (unsigned*)(ws + WS_CTR);
            volatile unsigned* slot = (volatile unsigned*)(lds + LDS_BYTES - 16);
            for (;;) {
                if (threadIdx.x == 0) *slot = atomicAdd(ctr, 1u);
                __syncthreads();
                const int it = (int)*slot;
                __syncthreads();
                if (it >= 512 + 288 + NBATCH) break;
                if (it < 512) sample_item(p, it, lds);
                else if (it < 800) pool_item(p, it - 512, lds);
                else poolout_item(p, it - 800);
            }
        }
    }
    SEAMN(4);
    if (IN(4)) { for (int it = blockIdx.x; it < 1024; it += gridDim.x) mout_item(p, it, lds); }
    if (IN(5)) {

        bf16_t* merged = (bf16_t*)(ws + WS_U);
        const bf16_t* sga = (const bf16_t*)(ws + WS_QKV) + (size_t)4 * MROWS * DM;
        const bf16_t* sgb = sga + (size_t)MROWS * DM;
        { EpiMerge e0{merged, sga, 0}; gemm_phase(ldsl, (const bf16_t*)(ws + WS_YP), (const bf16_t*)(ws + WS_WPO), DM, 512, e0);
          small_gemm_phase(lds, (const bf16_t*)(ws + WS_YP), (const bf16_t*)(ws + WS_WPO), DM, 512, e0, blockIdx.x, blockIdx.x + 1); }
        SEAMN(5);
        { EpiMerge e1{merged, sgb, 1}; gemm_phase(ldsl, (const bf16_t*)(ws + WS_HM), (const bf16_t*)(ws + WS_WMO), DM, DM, e1);
          small_gemm_phase(lds, (const bf16_t*)(ws + WS_HM), (const bf16_t*)(ws + WS_WMO), DM, DM, e1, blockIdx.x, blockIdx.x + 1); }
    }
    SEAMN(6);
    if (IN(6)) {
        EpiMid e{p.out, p.x_p, p.x_s, (const float*)(ws + WS_ADA), p.g_ffn, (bf16_t*)(ws + WS_H), (float*)(ws + WS_RSB), (unsigned*)(ws + WS_XCNT), (float*)(ws + WS_RSS), (unsigned*)(ws + WS_XCNT) + 64 * 64};
        gemm_phase<EpiMid, true>(ldsl, (const bf16_t*)(ws + WS_U), (const bf16_t*)(ws + WS_WOUT), DM, DM, e, lds);
        small_gemm_phase<EpiMid, 2>(lds, (const bf16_t*)(ws + WS_U), (const bf16_t*)(ws + WS_WOUT), DM, DM, e, blockIdx.x, blockIdx.x + 1);
    }
    SEAMN(7);
    if (IN(8)) { EpiAct e{(bf16_t*)(ws + WS_CST)}; gemm_phase(ldsl, (const bf16_t*)(ws + WS_H), (const bf16_t*)(ws + WS_W1), DFF, DM, e);
        small_gemm_phase(lds, (const bf16_t*)(ws + WS_H), (const bf16_t*)(ws + WS_W1), DFF, DM, e, blockIdx.x * 4, blockIdx.x * 4 + 4); }
    SEAMN(8);
    if (IN(9)) {
        EpiFinal e{p.out, (const float*)(ws + WS_ADA), p.g_final, (float*)(ws + WS_RSB), (unsigned*)(ws + WS_XCNT), (float*)(ws + WS_RSS), (unsigned*)(ws + WS_XCNT) + 64 * 64};
        gemm_phase<EpiFinal, true>(ldsl, (const bf16_t*)(ws + WS_CST), (const bf16_t*)(ws + WS_W2), DM, DFF, e, lds);
        small_gemm_phase<EpiFinal, 1>(lds, (const bf16_t*)(ws + WS_CST), (const bf16_t*)(ws + WS_W2), DM, DFF, e, blockIdx.x, blockIdx.x + 1);
    }
#undef IN
#undef SEAMN
}

extern "C" void kernel_launch(void* const* d_in, const int* in_sizes, int n_in, void* d_out, int out_size, void* d_ws, size_t ws_size, hipStream_t stream) {
    static int grid_blocks = 0;
    if (grid_blocks == 0) {
        if (ws_size < WS_END) { fprintf(stderr, "kernel_launch: workspace too small: %zu < %zu\n", ws_size, (size_t)WS_END); grid_blocks = -1; return; }
        int dev = 0, cus = 0, per_cu = 0;
        hipGetDevice(&dev);
        hipDeviceGetAttribute(&cus, hipDeviceAttributeMultiprocessorCount, dev);
        hipFuncSetAttribute((const void*)hybrid_fwd, hipFuncAttributeMaxDynamicSharedMemorySize, LDS_BYTES);
        hipOccupancyMaxActiveBlocksPerMultiprocessor(&per_cu, (const void*)hybrid_fwd, NTH, LDS_BYTES);
        if (per_cu < 1) per_cu = 1;
        if (per_cu > 1) per_cu = 1;
        grid_blocks = cus * per_cu;
    }
    if (grid_blocks < 0) return;
    hipMemsetAsync((char*)d_ws + WS_CTR, 0, 4096 + 80 * 256, stream);
    Params p{};
    const float** f = (const float**)&p;
    for (int i = 0; i < 24; ++i) f[i] = (const float*)d_in[i];
    p.out = (float*)d_out; p.ws = (unsigned char*)d_ws; p.ph_lo = 0; p.ph_hi = 11;
    void* args[] = {&p};
    hipError_t e = hipLaunchCooperativeKernel((const void*)hybrid_fwd, dim3(grid_blocks), dim3(NTH), args, LDS_BYTES, stream);
    if (e != hipSuccess) fprintf(stderr, "cooperative launch failed: %s (grid %d)\n", hipGetErrorString(e), grid_blocks);
}
```

```cpp
#include <hip/hip_runtime.h>
#include <hip/hip_cooperative_groups.h>
#include <cstdio>
#include <cstdint>
namespace cg = cooperative_groups;

typedef unsigned short bf16_t;
typedef short bf16x8 __attribute__((ext_vector_type(8)));
typedef float f32x4 __attribute__((ext_vector_type(4)));
typedef unsigned u32x4 __attribute__((ext_vector_type(4)));
typedef unsigned u32x2 __attribute__((ext_vector_type(2)));

constexpr int NTH = 512;
constexpr int DM = 1024, NPR = 16384, NSA = 512, MROWS = 16896, NBATCH = 136, SEQ = 2048;
constexpr int NIN = 6656, DFF = 4096, ADAW = 6144, INW = 6664;
constexpr int LDS_BYTES = 131072;
constexpr float EPS = 1e-6f;

constexpr size_t O_Y = 0;
constexpr size_t O_POOLP = 17301504;
constexpr size_t O_CP = 17362944;
constexpr size_t O_NP = 19460096;
constexpr size_t O_MP = 19468288;
constexpr size_t O_POOLS = 19468320;
constexpr size_t O_CS = 20451360;
constexpr size_t O_NS = 54005792;
constexpr size_t O_MS = 54136864;

constexpr size_t AL(size_t x) { return (x + 255) & ~(size_t)255; }
constexpr size_t WS_WIN = 0;
constexpr size_t WS_WPG = WS_WIN + AL((size_t)NIN * DM * 2);
constexpr size_t WS_WPO = WS_WPG + AL((size_t)4 * 128 * 128 * 2);
constexpr size_t WS_WMO = WS_WPO + AL((size_t)1024 * 512 * 2);
constexpr size_t WS_WOUT = WS_WMO + AL((size_t)1024 * 1024 * 2);
constexpr size_t WS_W1 = WS_WOUT + AL((size_t)1024 * 1024 * 2);
constexpr size_t WS_W2 = WS_W1 + AL((size_t)4096 * 1024 * 2);
constexpr size_t WS_ADAP = WS_W2 + AL((size_t)4096 * 1024 * 2);
constexpr size_t WS_ADA = WS_ADAP + AL((size_t)8 * NBATCH * ADAW * 4);
constexpr size_t WS_H = WS_ADA + AL((size_t)NBATCH * ADAW * 4);
constexpr size_t WS_GI = WS_H + AL((size_t)MROWS * DM * 2);
constexpr size_t WS_GF = WS_GI + AL((size_t)MROWS * 4 * 4);
constexpr size_t WS_U = WS_GF + AL((size_t)MROWS * 4 * 4);
constexpr size_t WS_QKV = WS_U + AL((size_t)MROWS * 512 * 4);
constexpr size_t WS_CST = WS_QKV + AL((size_t)6 * MROWS * DM * 2);
constexpr size_t WS_NST = WS_CST + AL((size_t)MROWS * DFF * 2);
constexpr size_t WS_MST = WS_NST + AL((size_t)32 * 32 * 256 * 4);
constexpr size_t WS_YP = WS_MST + AL((size_t)32 * 64 * 4);
constexpr size_t WS_HM = WS_YP + AL((size_t)MROWS * 512 * 2);
constexpr size_t WS_GW = WS_HM + AL((size_t)MROWS * DM * 2);
constexpr size_t WS_CTR = WS_GW + AL((size_t)1024 * 8 * 4);
constexpr size_t WS_XCNT = WS_CTR + 4096;
constexpr size_t WS_RSB = WS_XCNT + 80 * 256;
constexpr size_t WS_RSS = WS_RSB + AL((size_t)NPR * 4 * 4);
constexpr size_t WS_END = WS_RSS + AL((size_t)NSA * 16 * 4);
static_assert((size_t)32 * 31 * 65536 * 2 <= (size_t)MROWS * DFF * 2, "Cst fits in act region");
static_assert(WS_END <= (size_t)536870912, "workspace map exceeds 512 MiB");

struct Params {
    const float *x_p, *x_s, *st_pool, *st_C, *st_n, *st_m, *c_p, *c_s, *g_mix, *g_ffn, *w_ada, *b_ada, *w_in, *b_i, *b_f, *w_pg, *pool_scale, *w_po, *m_norm, *w_mo, *w_out, *w1, *w2, *g_final;
    float* out; unsigned char* ws; int ph_lo, ph_hi;
};

typedef float f32x2 __attribute__((ext_vector_type(2)));
typedef __bf16 bf16x2_t __attribute__((ext_vector_type(2)));
__device__ __forceinline__ unsigned pk_bf16(float lo, float hi) { f32x2 v = {lo, hi}; bf16x2_t b = __builtin_convertvector(v, bf16x2_t); return __builtin_bit_cast(unsigned, b); }
__device__ __forceinline__ float bf2f(unsigned v) { return __uint_as_float(v << 16); }
__device__ __forceinline__ float bflo(unsigned v) { return __uint_as_float(v << 16); }
__device__ __forceinline__ float bfhi(unsigned v) { return __uint_as_float(v & 0xffff0000u); }
__device__ __forceinline__ bf16_t f2bf(float f) { return (bf16_t)(pk_bf16(f, 0.f) & 0xffffu); }
__device__ __forceinline__ float sigmoidf_(float x) { return __builtin_amdgcn_rcpf(1.f + __expf(-x)); }
__device__ __forceinline__ int row_batch(int row) { return row < NPR ? (row >> 11) : 8 + ((row - NPR) >> 2); }
__device__ __forceinline__ float wave_sum(float v) {
#pragma unroll
    for (int d = 32; d >= 1; d >>= 1) v += __shfl_xor(v, d);
    return v;
}
__device__ __forceinline__ float wave_max(float v) {
#pragma unroll
    for (int d = 32; d >= 1; d >>= 1) v = fmaxf(v, __shfl_xor(v, d));
    return v;
}
__device__ __forceinline__ float wave_scan_add(float v, int lane) {
#pragma unroll
    for (int d = 1; d < 64; d <<= 1) { float t = __shfl_up(v, d); if (lane >= d) v += t; }
    return v;
}
__device__ __forceinline__ float wave_scan_max(float v, int lane) {
#pragma unroll
    for (int d = 1; d < 64; d <<= 1) { float t = __shfl_up(v, d); if (lane >= d) v = fmaxf(v, t); }
    return v;
}
__device__ __forceinline__ int otid() { int t = threadIdx.x; asm volatile("" : "+v"(t)); return t; }
#define MFMA16(a, b, c) __builtin_amdgcn_mfma_f32_16x16x32_bf16((a), (b), (c), 0, 0, 0)

#define LAS __attribute__((address_space(3)))
constexpr int BM = 256, BK = 64, HALF = 128, HTB = HALF * BK * 2, NXCD = 8, WGM = 8;
__device__ __forceinline__ int lds_byte(int r, int c) {
    const int st = (r >> 4) * 2 + (c >> 5), rr = r & 15, cc = c & 31, ob = rr * 64 + cc * 2;
    return st * 1024 + (ob ^ (((ob >> 9) & 1) << 5));
}
__device__ __forceinline__ void stage_rc(int b, int& R, int& C) {
    const int st = b / 1024, sb = b % 1024, swz = sb ^ (((sb >> 9) & 1) << 5);
    R = (st >> 1) * 16 + swz / 64; C = (st & 1) * 32 + (swz % 64) / 2;
}
__device__ __forceinline__ int perm32(int rho) { const int n = rho >> 4, i = rho & 15; return 8 * (i >> 2) + 4 * n + (i & 3); }
struct Unit { int pm, pn; };
struct StaticOrder {
    int nM, nN, nwg, G, c;
    __device__ void init(int M, int N, int G_, int c_) { nM = M / BM; nN = N / BM; nwg = nM * nN; G = G_; c = c_; }
    __device__ bool next(int i, Unit& u) const {
        const long L = (long)i * G + c; if (L >= nwg) return false;
        int wgid = (int)L; { const int q = nwg / NXCD, r = nwg % NXCD, xcd = wgid % NXCD, off = wgid / NXCD; wgid = (xcd < r ? xcd * (q + 1) : r * (q + 1) + (xcd - r) * q) + off; }
        const int nig = WGM * nN, gid = wgid / nig, fm = gid * WGM, gsz = (nM - fm) < WGM ? (nM - fm) : WGM;
        u.pm = fm + ((wgid % nig) % gsz); u.pn = (wgid % nig) / gsz; return true;
    }
};

#ifndef GEMM_SP2
#define GEMM_SP2 1
#endif
#ifndef GEMM_ALIGN
#define GEMM_ALIGN 1
#endif
template <class Epi, bool FUSED = false, bool SP2 = (GEMM_SP2 != 0), bool ALIGN_EPI = (GEMM_ALIGN != 0)>
__device__ __forceinline__ void gemm_phase(LAS unsigned char* lds, const bf16_t* gA, const bf16_t* gBt, const int N, const int K, const Epi& E, unsigned char* lds_gen = nullptr) {
    const int tid = otid(), wid = __builtin_amdgcn_readfirstlane(tid >> 6), lane = tid & 63, wr = wid >> 2, wc = wid & 3, fr = lane & 15, fq = lane >> 4;
    const int nt = K / BK;
    StaticOrder S; S.init(NPR, N, gridDim.x, blockIdx.x);
    unsigned voffA[2], voffB[2];
#pragma unroll
    for (int i = 0; i < 2; ++i) { int R, C; stage_rc(tid * 16 + i * 8192, R, C); const int Rb = (R & ~31) + perm32(R & 31); voffA[i] = (unsigned)(R * K + C) * 2u; voffB[i] = (unsigned)(Rb * K + C) * 2u; }
    const size_t kstep = (size_t)(BK * 2);
    const size_t hstep = (size_t)HALF * K * 2;
    const size_t tstep = 2 * hstep;
    const unsigned ldsw = (unsigned)wid * 1024u;
    const int aoff = lds_byte(wr * 64 + fr, fq * 8), boff = lds_byte(wc * 32 + fr, fq * 8);
#define PG8_SA(b, h) (((b) * 2 + (h)) * HTB)
#define PG8_SB(b, h) ((4 + (b) * 2 + (h)) * HTB)
#define PG8_STAGE(bufoff, gbase) PG8_STAGEV(bufoff, gbase, voffA)
#define PG8_STAGEB(bufoff, gbase) PG8_STAGEV(bufoff, gbase, voffB)
#define PG8_STAGEV(bufoff, gbase, voff) do { _Pragma("unroll") for (int _i = 0; _i < 2; ++_i) \
        __builtin_amdgcn_global_load_lds((const unsigned*)((const char*)(gbase) + (voff)[_i]), (LAS unsigned*)(lds + (bufoff) + ldsw + _i * 8192), 16, 0, 0); } while (0)
#define PG8_LDA(dst, b, h) do { _Pragma("unroll") for (int m = 0; m < 4; ++m) _Pragma("unroll") for (int k = 0; k < 2; ++k) dst[m][k] = *(const LAS bf16x8*)(lds + PG8_SA(b, h) + aoff + m * 2048 + k * 1024); } while (0)
#define PG8_LDB(dst, b, h) do { _Pragma("unroll") for (int n = 0; n < 2; ++n) _Pragma("unroll") for (int k = 0; k < 2; ++k) dst[n][k] = *(const LAS bf16x8*)(lds + PG8_SB(b, h) + boff + n * 2048 + k * 1024); } while (0)
#define PG8_MMA(ai, bj, At, Bt) do { __builtin_amdgcn_s_setprio(1); _Pragma("unroll") for (int m = 0; m < 4; ++m) _Pragma("unroll") for (int n = 0; n < 2; ++n) _Pragma("unroll") for (int k = 0; k < 2; ++k) \
        acc[ai][bj][m][n] = __builtin_amdgcn_mfma_f32_16x16x32_bf16(Bt[n][k], At[m][k], acc[ai][bj][m][n], 0, 0, 0); __builtin_amdgcn_s_setprio(0); } while (0)
#define PG8_WAIT_V(n) asm volatile("s_waitcnt vmcnt(" #n ")" ::: "memory")
#define PG8_WAIT_L(n) asm volatile("s_waitcnt lgkmcnt(" #n ")" ::: "memory")
#define PG8_BAR __builtin_amdgcn_s_barrier()
#define PG8_SCHED __builtin_amdgcn_sched_barrier(0)
    Unit cur, nxt; int ui = 0;
    if (!S.next(0, cur)) return;
    f32x4 acc[2][2][4][2];
#pragma unroll
    for (int a = 0; a < 2; ++a)
#pragma unroll
        for (int b = 0; b < 2; ++b)
#pragma unroll
            for (int m = 0; m < 4; ++m)
#pragma unroll
                for (int n = 0; n < 2; ++n) acc[a][b][m][n] = (f32x4){0.f, 0.f, 0.f, 0.f};
    bf16x8 At[4][2], B0[2][2], B1[2][2];
    const char* cA = (const char*)gA + (size_t)cur.pm * tstep; const char* cB = (const char*)gBt + (size_t)cur.pn * tstep;
    constexpr bool ALIGN = ALIGN_EPI && !FUSED;
    if constexpr (SP2) {
        PG8_STAGEB(PG8_SB(0, 0), cB); PG8_STAGEB(PG8_SB(0, 1), cB + hstep); PG8_STAGE(PG8_SA(0, 0), cA); PG8_STAGE(PG8_SA(0, 1), cA + hstep);
        if (wr == 1) PG8_BAR;
        PG8_WAIT_V(2); PG8_BAR;
        PG8_STAGEB(PG8_SB(1, 0), cB + kstep); PG8_STAGE(PG8_SA(1, 0), cA + kstep); PG8_STAGEB(PG8_SB(1, 1), cB + hstep + kstep);
        PG8_WAIT_V(6); PG8_BAR;
    } else {
        PG8_STAGEB(PG8_SB(0, 0), cB); PG8_STAGE(PG8_SA(0, 0), cA); PG8_STAGEB(PG8_SB(0, 1), cB + hstep); PG8_STAGE(PG8_SA(0, 1), cA + hstep);
        if (wr == 1) PG8_BAR;
        PG8_WAIT_V(4); PG8_BAR;
        PG8_STAGEB(PG8_SB(1, 0), cB + kstep); PG8_STAGE(PG8_SA(1, 0), cA + kstep); PG8_STAGEB(PG8_SB(1, 1), cB + hstep + kstep);
        PG8_WAIT_V(6); PG8_BAR;
    }
    for (;;) {
        const bool has_next = S.next(ui + 1, nxt);
        const char* nA = has_next ? (const char*)gA + (size_t)nxt.pm * tstep : cA; const char* nB = has_next ? (const char*)gBt + (size_t)nxt.pn * tstep : cB;
        for (int t = 0; t < nt; t += 2) {
            const bool last = (t == nt - 2);
            const char* a1 = cA + (size_t)(t + 1) * kstep;
            const char* a2 = last ? nA : cA + (size_t)(t + 2) * kstep; const char* b2 = last ? nB : cB + (size_t)(t + 2) * kstep;
            const char* a3 = a2 + kstep; const char* b3 = b2 + kstep;
            if constexpr (SP2) {
            PG8_LDB(B0, 0, 0); PG8_LDB(B1, 0, 1); PG8_SCHED; PG8_LDA(At, 0, 0); PG8_STAGE(PG8_SA(1, 1), a1 + hstep);
            PG8_WAIT_V(8); PG8_WAIT_L(0); PG8_BAR; PG8_MMA(0, 0, At, B0); PG8_MMA(0, 1, At, B1); PG8_BAR; PG8_SCHED;
            PG8_LDA(At, 0, 1); PG8_STAGEB(PG8_SB(0, 0), b2); PG8_STAGEB(PG8_SB(0, 1), b2 + hstep); PG8_STAGE(PG8_SA(0, 0), a2);
            PG8_WAIT_V(8); PG8_WAIT_L(0); PG8_BAR; PG8_MMA(1, 0, At, B0); PG8_MMA(1, 1, At, B1); PG8_BAR; PG8_SCHED;
            PG8_LDB(B0, 1, 0); PG8_LDB(B1, 1, 1); PG8_SCHED; PG8_LDA(At, 1, 0); PG8_STAGE(PG8_SA(0, 1), a2 + hstep);
            PG8_WAIT_V(8); PG8_WAIT_L(0); PG8_BAR; PG8_MMA(0, 0, At, B0); PG8_MMA(0, 1, At, B1); PG8_BAR; PG8_SCHED;
            PG8_LDA(At, 1, 1); PG8_STAGEB(PG8_SB(1, 0), b3); PG8_STAGEB(PG8_SB(1, 1), b3 + hstep); PG8_STAGE(PG8_SA(1, 0), a3);
            PG8_WAIT_V(8); PG8_WAIT_L(0); PG8_BAR; PG8_MMA(1, 0, At, B0); PG8_MMA(1, 1, At, B1); PG8_BAR; PG8_SCHED;
            } else {
            PG8_LDB(B0, 0, 0); PG8_SCHED; PG8_LDA(At, 0, 0); PG8_STAGE(PG8_SA(1, 1), a1 + hstep);
            PG8_WAIT_L(8); PG8_BAR; PG8_WAIT_L(0); PG8_MMA(0, 0, At, B0); PG8_BAR; PG8_SCHED;
            PG8_LDB(B1, 0, 1); PG8_STAGEB(PG8_SB(0, 0), b2);
            PG8_BAR; PG8_WAIT_L(0); PG8_MMA(0, 1, At, B1); PG8_BAR;
            PG8_LDA(At, 0, 1); PG8_STAGE(PG8_SA(0, 0), a2);
            PG8_BAR; PG8_WAIT_L(0); PG8_MMA(1, 0, At, B0); PG8_BAR; PG8_SCHED;
            PG8_STAGEB(PG8_SB(0, 1), b2 + hstep);
            PG8_WAIT_V(6); PG8_BAR; PG8_MMA(1, 1, At, B1); PG8_BAR;
            PG8_LDB(B0, 1, 0); PG8_SCHED; PG8_LDA(At, 1, 0); PG8_STAGE(PG8_SA(0, 1), a2 + hstep);
            PG8_WAIT_L(8); PG8_BAR; PG8_WAIT_L(0); PG8_MMA(0, 0, At, B0); PG8_BAR; PG8_SCHED;
            PG8_LDB(B1, 1, 1); PG8_STAGEB(PG8_SB(1, 0), b3);
            PG8_BAR; PG8_WAIT_L(0); PG8_MMA(0, 1, At, B1); PG8_BAR;
            PG8_LDA(At, 1, 1); PG8_STAGE(PG8_SA(1, 0), a3);
            PG8_BAR; PG8_WAIT_L(0); PG8_MMA(1, 0, At, B0); PG8_BAR; PG8_SCHED;
            PG8_STAGEB(PG8_SB(1, 1), b3 + hstep);
            PG8_WAIT_V(6); PG8_BAR; PG8_MMA(1, 1, At, B1); PG8_BAR;
            }
        }
        if constexpr (ALIGN) { if (wr == 0) PG8_BAR; }
        if constexpr (!FUSED) { const int r0 = cur.pm * BM + wr * 64 + fr, c0 = cur.pn * BM + wc * 32 + fq * 8;
#pragma unroll
          for (int ai = 0; ai < 2; ++ai)
#pragma unroll
            for (int m = 0; m < 4; ++m)
#pragma unroll
              for (int bj = 0; bj < 2; ++bj) E.apply8(r0 + ai * 128 + m * 16, c0 + bj * 128, acc[ai][bj][m][0], acc[ai][bj][m][1]); }
        if (!has_next) break;
#pragma unroll
        for (int a = 0; a < 2; ++a)
#pragma unroll
            for (int b = 0; b < 2; ++b)
#pragma unroll
                for (int m = 0; m < 4; ++m)
#pragma unroll
                    for (int n = 0; n < 2; ++n) acc[a][b][m][n] = (f32x4){0.f, 0.f, 0.f, 0.f};
        cur = nxt; cA = nA; cB = nB; ++ui;
        if constexpr (ALIGN) { if (wr == 1) PG8_BAR; }
    }
    PG8_WAIT_V(0);
    if constexpr (!ALIGN) { if (wr == 0) PG8_BAR; }
    PG8_BAR;
    if constexpr (FUSED) E.fused(acc, cur, wr, wc, fr, fq, lds_gen);
#undef PG8_SA
#undef PG8_SB
#undef PG8_STAGE
#undef PG8_STAGEB
#undef PG8_STAGEV
#undef PG8_LDA
#undef PG8_LDB
#undef PG8_MMA
#undef PG8_WAIT_V
#undef PG8_WAIT_L
#undef PG8_BAR
#undef PG8_SCHED
}

struct EpiG1 {
    float* u; bf16_t* qkv;
    __device__ __forceinline__ void apply(int row, int col, f32x4 v) const {
        const int bcol = col & ~255;
        const int seg = bcol < 512 ? 0 : 1 + ((bcol - 512) >> 10);
        if (seg == 0) { *(f32x4*)(u + (size_t)row * 512 + col) = v; }
        else {
            const int cc = col - 512 - (seg - 1) * 1024;
            if (seg == 2) v *= 0.0625f;
            if (seg >= 4) { v[0] = sigmoidf_(v[0]); v[1] = sigmoidf_(v[1]); v[2] = sigmoidf_(v[2]); v[3] = sigmoidf_(v[3]); }
            u32x2 w; w.x = pk_bf16(v[0], v[1]); w.y = pk_bf16(v[2], v[3]);
            *(u32x2*)(qkv + (size_t)(seg - 1) * MROWS * DM + (size_t)row * DM + cc) = w;
        }
    }
    __device__ __forceinline__ void apply8(int row, int col, f32x4 v0, f32x4 v1) const {
        const int bcol = col & ~255;
        const int seg = bcol < 512 ? 0 : 1 + ((bcol - 512) >> 10);
        if (seg == 0) { *(f32x4*)(u + (size_t)row * 512 + col) = v0; *(f32x4*)(u + (size_t)row * 512 + col + 4) = v1; }
        else {
            const int cc = col - 512 - (seg - 1) * 1024;
            if (seg == 2) { v0 *= 0.0625f; v1 *= 0.0625f; }
            if (seg >= 4) {
#pragma unroll
                for (int j = 0; j < 4; ++j) { v0[j] = sigmoidf_(v0[j]); v1[j] = sigmoidf_(v1[j]); } }
            u32x4 w; w.x = pk_bf16(v0[0], v0[1]); w.y = pk_bf16(v0[2], v0[3]); w.z = pk_bf16(v1[0], v1[1]); w.w = pk_bf16(v1[2], v1[3]);
            *(u32x4*)(qkv + (size_t)(seg - 1) * MROWS * DM + (size_t)row * DM + cc) = w;
        }
    }
};
struct EpiMerge {
    bf16_t* merged; const bf16_t* sg; int mode;
    __device__ __forceinline__ void apply(int row, int col, f32x4 v) const {
        const size_t idx = (size_t)row * DM + col;
        const u32x2 g = *(const u32x2*)(sg + idx);
        v[0] *= bflo(g.x); v[1] *= bfhi(g.x); v[2] *= bflo(g.y); v[3] *= bfhi(g.y);
        if (mode) { const u32x2 o = *(const u32x2*)(merged + idx); v[0] += bflo(o.x); v[1] += bfhi(o.x); v[2] += bflo(o.y); v[3] += bfhi(o.y); }
        u32x2 w; w.x = pk_bf16(v[0], v[1]); w.y = pk_bf16(v[2], v[3]);
        *(u32x2*)(merged + idx) = w;
    }
    __device__ __forceinline__ void apply8(int row, int col, f32x4 v0, f32x4 v1) const {
        const size_t idx = (size_t)row * DM + col;
        const u32x4 g = *(const u32x4*)(sg + idx);
        v0[0] *= bflo(g.x); v0[1] *= bfhi(g.x); v0[2] *= bflo(g.y); v0[3] *= bfhi(g.y); v1[0] *= bflo(g.z); v1[1] *= bfhi(g.z); v1[2] *= bflo(g.w); v1[3] *= bfhi(g.w);
        if (mode) { const u32x4 o = *(const u32x4*)(merged + idx); v0[0] += bflo(o.x); v0[1] += bfhi(o.x); v0[2] += bflo(o.y); v0[3] += bfhi(o.y); v1[0] += bflo(o.z); v1[1] += bfhi(o.z); v1[2] += bflo(o.w); v1[3] += bfhi(o.w); }
        u32x4 w; w.x = pk_bf16(v0[0], v0[1]); w.y = pk_bf16(v0[2], v0[3]); w.z = pk_bf16(v1[0], v1[1]); w.w = pk_bf16(v1[2], v1[3]);
        *(u32x4*)(merged + idx) = w;
    }
};
struct EpiRes {
    float* out; const float* xp; const float* xs; const float* ada; int gate_off; int xin;
    __device__ __forceinline__ void apply(int row, int col, f32x4 v) const {
        const f32x4 g = *(const f32x4*)(ada + (size_t)row_batch(row) * ADAW + gate_off + col);
        const float* bp = xin ? (row < NPR ? xp + (size_t)row * DM : xs + (size_t)(row - NPR) * DM) : out + (size_t)row * DM;
        const f32x4 b = *(const f32x4*)(bp + col);
        *(f32x4*)(out + (size_t)row * DM + col) = b + g * v;
    }
    __device__ __forceinline__ void apply8(int row, int col, f32x4 v0, f32x4 v1) const { apply(row, col, v0); apply(row, col + 4, v1); }
};
struct EpiAct {
    bf16_t* act;
    __device__ __forceinline__ void apply(int row, int col, f32x4 v) const {
#pragma unroll
        for (int j = 0; j < 4; ++j) { float t = fmaxf(v[j], 0.f); v[j] = t * t; }
        u32x2 w; w.x = pk_bf16(v[0], v[1]); w.y = pk_bf16(v[2], v[3]);
        *(u32x2*)(act + (size_t)row * DFF + col) = w;
    }
    __device__ __forceinline__ void apply8(int row, int col, f32x4 v0, f32x4 v1) const {
#pragma unroll
        for (int j = 0; j < 4; ++j) { float t0 = fmaxf(v0[j], 0.f); v0[j] = t0 * t0; float t1 = fmaxf(v1[j], 0.f); v1[j] = t1 * t1; }
        u32x4 w; w.x = pk_bf16(v0[0], v0[1]); w.y = pk_bf16(v0[2], v0[3]); w.z = pk_bf16(v1[0], v1[1]); w.w = pk_bf16(v1[2], v1[3]);
        *(u32x4*)(act + (size_t)row * DFF + col) = w;
    }
};

__device__ __forceinline__ void xchg_publish_wait(unsigned* cnt, unsigned need) {
    asm volatile("s_waitcnt vmcnt(0)" ::: "memory");
    __syncthreads();
    if (threadIdx.x == 0) {
        __builtin_amdgcn_fence(__ATOMIC_RELEASE, "agent");
        asm volatile("s_waitcnt vmcnt(0)" ::: "memory");
        __hip_atomic_fetch_add(cnt, 1u, __ATOMIC_RELAXED, __HIP_MEMORY_SCOPE_AGENT);
        unsigned spins = 0;
        while (__hip_atomic_load(cnt, __ATOMIC_RELAXED, __HIP_MEMORY_SCOPE_AGENT) < need) { __builtin_amdgcn_s_sleep(1); if (++spins > (1u << 24)) break; }
        __builtin_amdgcn_fence(__ATOMIC_ACQUIRE, "agent");
        asm volatile("s_waitcnt vmcnt(0)" ::: "memory");
    }
    __syncthreads();
}
extern __shared__ __attribute__((aligned(16))) unsigned char g_dyn_lds[];
struct EpiFinal {
    float* out; const float* ada; const float* gfin; float* rowpart; unsigned* cnt; float* rowpartS; unsigned* cntS;
    __device__ __forceinline__ void apply(int, int, f32x4) const {}
    __device__ __forceinline__ void apply8(int, int, f32x4, f32x4) const {}
    __device__ __forceinline__ void fused(f32x4 (&acc)[2][2][4][2], const Unit& u, int wr, int wc, int fr, int fq, unsigned char* lds) const {
        const int tid = otid();
        (void)lds;
        float* P = (float*)g_dyn_lds;
        float* S = P + 1024;
        const int r0 = u.pm * BM + wr * 64 + fr, c0 = u.pn * BM + wc * 32 + fq * 8;
#pragma unroll
        for (int ai = 0; ai < 2; ++ai)
#pragma unroll
            for (int m = 0; m < 4; ++m) {
                const int row = r0 + ai * 128 + m * 16;
                const float* ga = ada + (size_t)row_batch(row) * ADAW + 5120;
                float ss = 0.f;
#pragma unroll
                for (int bj = 0; bj < 2; ++bj)
#pragma unroll
                    for (int n = 0; n < 2; ++n) {
                        const int col = c0 + bj * 128 + n * 4;
                        const f32x4 g = *(const f32x4*)(ga + col);
                        const f32x4 b = *(const f32x4*)(out + (size_t)row * DM + col);
                        const f32x4 v = b + g * acc[ai][bj][m][n];
                        acc[ai][bj][m][n] = v;
                        ss += v[0] * v[0] + v[1] * v[1] + v[2] * v[2] + v[3] * v[3];
                    }
                ss += __shfl_xor(ss, 16); ss += __shfl_xor(ss, 32);
                if (fq == 0) P[(ai * 128 + wr * 64 + m * 16 + fr) * 4 + wc] = ss;
                asm volatile("" ::: "memory");
            }
        __syncthreads();
        if (tid < 256) rowpart[((size_t)u.pm * BM + tid) * 4 + u.pn] = (P[tid * 4] + P[tid * 4 + 1]) + (P[tid * 4 + 2] + P[tid * 4 + 3]);
        xchg_publish_wait(cnt + u.pm * 64, 8u);
        if (tid < 256) { const f32x4 rp = *(const f32x4*)(rowpart + ((size_t)u.pm * BM + tid) * 4); S[tid] = rsqrtf(((rp[0] + rp[1]) + (rp[2] + rp[3])) * (1.0f / DM) + EPS); }
        __syncthreads();
#pragma unroll
        for (int ai = 0; ai < 2; ++ai)
#pragma unroll
            for (int m = 0; m < 4; ++m) {
                const int row = r0 + ai * 128 + m * 16;
                const float rs = S[ai * 128 + wr * 64 + m * 16 + fr];
#pragma unroll
                for (int bj = 0; bj < 2; ++bj)
#pragma unroll
                    for (int n = 0; n < 2; ++n) {
                        const int col = c0 + bj * 128 + n * 4;
                        const f32x4 gf = *(const f32x4*)(gfin + col);
                        __builtin_nontemporal_store(acc[ai][bj][m][n] * rs * gf, (f32x4*)(out + (size_t)row * DM + col));
                    }
            }
        __syncthreads();
    }
};

struct EpiMid {
    float* out; const float* xp; const float* xs; const float* ada; const float* gffn; bf16_t* hbuf; float* rowpart; unsigned* cnt; float* rowpartS; unsigned* cntS;
    __device__ __forceinline__ void apply(int, int, f32x4) const {}
    __device__ __forceinline__ void apply8(int, int, f32x4, f32x4) const {}
    __device__ __forceinline__ void fused(f32x4 (&acc)[2][2][4][2], const Unit& u, int wr, int wc, int fr, int fq, unsigned char*) const {
        const int tid = otid();
        float* P = (float*)g_dyn_lds;
        float* S = P + 1024;
        const int r0 = u.pm * BM + wr * 64 + fr, c0 = u.pn * BM + wc * 32 + fq * 8;
#pragma unroll
        for (int ai = 0; ai < 2; ++ai)
#pragma unroll
            for (int m = 0; m < 4; ++m) {
                const int row = r0 + ai * 128 + m * 16;
                const float* ga = ada + (size_t)(row >> 11) * ADAW + 2048;
                float ss = 0.f;
#pragma unroll
                for (int bj = 0; bj < 2; ++bj)
#pragma unroll
                    for (int n = 0; n < 2; ++n) {
                        const int col = c0 + bj * 128 + n * 4;
                        const f32x4 g = *(const f32x4*)(ga + col);
                        const f32x4 b = *(const f32x4*)(xp + (size_t)row * DM + col);
                        const f32x4 v = b + g * acc[ai][bj][m][n];
                        acc[ai][bj][m][n] = v;
                        *(f32x4*)(out + (size_t)row * DM + col) = v;
                        ss += v[0] * v[0] + v[1] * v[1] + v[2] * v[2] + v[3] * v[3];
                    }
                ss += __shfl_xor(ss, 16); ss += __shfl_xor(ss, 32);
                if (fq == 0) P[(ai * 128 + wr * 64 + m * 16 + fr) * 4 + wc] = ss;
                asm volatile("" ::: "memory");
            }
        __syncthreads();
        if (tid < 256) rowpart[((size_t)u.pm * BM + tid) * 4 + u.pn] = (P[tid * 4] + P[tid * 4 + 1]) + (P[tid * 4 + 2] + P[tid * 4 + 3]);
        xchg_publish_wait(cnt + u.pm * 64, 4u);
        if (tid < 256) { const f32x4 rp = *(const f32x4*)(rowpart + ((size_t)u.pm * BM + tid) * 4); S[tid] = rsqrtf(((rp[0] + rp[1]) + (rp[2] + rp[3])) * (1.0f / DM) + EPS); }
        __syncthreads();
        const float* ab = ada + (size_t)(r0 >> 11) * ADAW;
#pragma unroll
        for (int bj = 0; bj < 2; ++bj) {
            const int col = c0 + bj * 128;
            f32x4 G0 = *(const f32x4*)(gffn + col), G1 = *(const f32x4*)(gffn + col + 4);
            G0 *= (*(const f32x4*)(ab + 4096 + col) + 1.0f); G1 *= (*(const f32x4*)(ab + 4096 + col + 4) + 1.0f);
            const f32x4 S0 = *(const f32x4*)(ab + 3072 + col), S1 = *(const f32x4*)(ab + 3072 + col + 4);
#pragma unroll
            for (int ai = 0; ai < 2; ++ai)
#pragma unroll
                for (int m = 0; m < 4; ++m) {
                    const int row = r0 + ai * 128 + m * 16;
                    const float rs = S[ai * 128 + wr * 64 + m * 16 + fr];
                    const f32x4 h0 = acc[ai][bj][m][0] * rs * G0 + S0, h1 = acc[ai][bj][m][1] * rs * G1 + S1;
                    u32x4 w; w.x = pk_bf16(h0[0], h0[1]); w.y = pk_bf16(h0[2], h0[3]); w.z = pk_bf16(h1[0], h1[1]); w.w = pk_bf16(h1[2], h1[3]);
                    *(u32x4*)(hbuf + (size_t)row * DM + col) = w;
                }
        }
        __syncthreads();
    }
};

template <class Epi, int FIN = 0>
__device__ __forceinline__ void small_gemm_phase(unsigned char* lds, const bf16_t* gA, const bf16_t* gBt, const int N, const int K, const Epi& E, const int t_begin, const int t_end) {
    int tid_ = threadIdx.x; asm volatile("" : "+v"(tid_));
    const int tid = tid_, lane = tid & 63, w = tid >> 6, fr = lane & 15, fq = lane >> 4;
    const int kw = K / 8;
    float* red = (float*)lds;
    for (int t = t_begin; t < t_end; ++t) {
        const int rt = t & 15, ct = t >> 4;
        const int row0 = NPR + rt * 32, col0 = ct * 64;
        const bf16_t* ap = gA + (size_t)(row0 + fr) * K + w * kw + fq * 8;
        const bf16_t* bp = gBt + (size_t)(col0 + fr) * K + w * kw + fq * 8;
        f32x4 acc[2][4] = {};
#pragma unroll 2
        for (int k0 = 0; k0 < kw; k0 += 64) {
            bf16x8 af[2][2], bfm[2][4];
#pragma unroll
            for (int s2 = 0; s2 < 2; ++s2) {
#pragma unroll
                for (int m = 0; m < 2; ++m) af[s2][m] = *(const bf16x8*)(ap + (size_t)m * 16 * K + k0 + s2 * 32);
#pragma unroll
                for (int n = 0; n < 4; ++n) bfm[s2][n] = *(const bf16x8*)(bp + (size_t)n * 16 * K + k0 + s2 * 32);
            }
#pragma unroll
            for (int s2 = 0; s2 < 2; ++s2)
#pragma unroll
                for (int m = 0; m < 2; ++m)
#pragma unroll
                    for (int n = 0; n < 4; ++n) acc[m][n] = MFMA16(bfm[s2][n], af[s2][m], acc[m][n]);
        }
#pragma unroll
        for (int m = 0; m < 2; ++m)
#pragma unroll
            for (int n = 0; n < 4; ++n) *(f32x4*)(red + ((w * 32 + m * 16 + fr) * 64 + n * 16 + fq * 4)) = acc[m][n];
        __syncthreads();
        {
            const int r = tid >> 4, c4 = (tid & 15) * 4;
            f32x4 v = *(const f32x4*)(red + (r * 64 + c4));
#pragma unroll
            for (int ww = 1; ww < 8; ++ww) v += *(const f32x4*)(red + ((ww * 32 + r) * 64 + c4));
            if constexpr (FIN == 0) E.apply(row0 + r, col0 + c4, v);
            else if constexpr (FIN == 2) {
                const int row = row0 + r, col = col0 + c4;
                const float* ab = E.ada + (size_t)row_batch(row) * ADAW;
                const f32x4 g = *(const f32x4*)(ab + 2048 + col);
                const f32x4 b = *(const f32x4*)(E.xs + (size_t)(row - NPR) * DM + col);
                const f32x4 x1 = b + g * v;
                *(f32x4*)(E.out + (size_t)row * DM + col) = x1;
                float ss = x1[0] * x1[0] + x1[1] * x1[1] + x1[2] * x1[2] + x1[3] * x1[3];
                ss += __shfl_xor(ss, 1); ss += __shfl_xor(ss, 2); ss += __shfl_xor(ss, 4); ss += __shfl_xor(ss, 8);
                if ((tid & 15) == 0) E.rowpartS[(size_t)(row - NPR) * 16 + ct] = ss;
                xchg_publish_wait(E.cntS + rt * 64, 16u);
                const float* rp = E.rowpartS + (size_t)(row - NPR) * 16;
                float tot = 0.f;
#pragma unroll
                for (int q = 0; q < 16; q += 4) { const f32x4 t4 = *(const f32x4*)(rp + q); tot += (t4[0] + t4[1]) + (t4[2] + t4[3]); }
                const float rs = rsqrtf(tot * (1.0f / DM) + EPS);
                const f32x4 G = *(const f32x4*)(E.gffn + col) * (*(const f32x4*)(ab + 4096 + col) + 1.0f);
                const f32x4 h = x1 * rs * G + *(const f32x4*)(ab + 3072 + col);
                u32x2 wv; wv.x = pk_bf16(h[0], h[1]); wv.y = pk_bf16(h[2], h[3]);
                *(u32x2*)(E.hbuf + (size_t)row * DM + col) = wv;
            }
            else {
                const int row = row0 + r, col = col0 + c4;
                const f32x4 g = *(const f32x4*)(E.ada + (size_t)row_batch(row) * ADAW + 5120 + col);
                const f32x4 b = *(const f32x4*)(E.out + (size_t)row * DM + col);
                const f32x4 x2 = b + g * v;
                float ss = x2[0] * x2[0] + x2[1] * x2[1] + x2[2] * x2[2] + x2[3] * x2[3];
                ss += __shfl_xor(ss, 1); ss += __shfl_xor(ss, 2); ss += __shfl_xor(ss, 4); ss += __shfl_xor(ss, 8);
                if ((tid & 15) == 0) E.rowpartS[(size_t)(row - NPR) * 16 + ct] = ss;
                xchg_publish_wait(E.cntS + rt * 64, 32u);
                const float* rp = E.rowpartS + (size_t)(row - NPR) * 16;
                float tot = 0.f;
#pragma unroll
                for (int q = 0; q < 16; q += 4) { const f32x4 t4 = *(const f32x4*)(rp + q); tot += (t4[0] + t4[1]) + (t4[2] + t4[3]); }
                const float rs = rsqrtf(tot * (1.0f / DM) + EPS);
                const f32x4 gf = *(const f32x4*)(E.gfin + col);
                *(f32x4*)(E.out + (size_t)row * DM + col) = x2 * rs * gf;
            }
        }
        __syncthreads();
    }
}

__device__ __forceinline__ void conv_tile(const float* __restrict__ src, int ld, int K, bf16_t* __restrict__ dst, int kt, int ntile, int src_col0, float* lds) {
    const int tid = otid();
    const int k0 = kt * 64, n0 = ntile * 64;
#pragma unroll
    for (int i = 0; i < 2; ++i) {
        const int r = (tid >> 4) + i * 32, c4 = (tid & 15) * 4;
        const f32x4 v = *(const f32x4*)(src + (size_t)(k0 + r) * ld + src_col0 + c4);
        lds[r * 65 + c4 + 0] = v[0]; lds[r * 65 + c4 + 1] = v[1]; lds[r * 65 + c4 + 2] = v[2]; lds[r * 65 + c4 + 3] = v[3];
    }
    __syncthreads();
    {
        const int n = tid >> 3, k8 = (tid & 7) * 8;
        float v[8];
#pragma unroll
        for (int i = 0; i < 8; ++i) v[i] = lds[(k8 + i) * 65 + n];
        u32x4 w; w.x = pk_bf16(v[0], v[1]); w.y = pk_bf16(v[2], v[3]); w.z = pk_bf16(v[4], v[5]); w.w = pk_bf16(v[6], v[7]);
        *(u32x4*)(dst + (size_t)(n0 + n) * K + k0 + k8) = w;
    }
    __syncthreads();
}

__device__ __forceinline__ void conv_strip(const float* __restrict__ src, int ld, int K, bf16_t* __restrict__ dst, int kt, int nt4, int src_col0, float* lds) {
    const int tid = otid();
    const int k0 = kt * 64, n0 = nt4 * 256;
    f32x4 v[8];
#pragma unroll
    for (int i = 0; i < 8; ++i) { const int r = (tid >> 6) + i * 8, c4 = (tid & 63) * 4; v[i] = __builtin_nontemporal_load((const f32x4*)(src + (size_t)(k0 + r) * ld + src_col0 + c4)); }
#pragma unroll
    for (int i = 0; i < 8; ++i) { const int r = (tid >> 6) + i * 8, c4 = (tid & 63) * 4;
        lds[r * 257 + c4 + 0] = v[i][0]; lds[r * 257 + c4 + 1] = v[i][1]; lds[r * 257 + c4 + 2] = v[i][2]; lds[r * 257 + c4 + 3] = v[i][3]; }
    __syncthreads();
#pragma unroll
    for (int j = 0; j < 4; ++j) {
        const int n = (tid >> 3) + j * 64, k8 = (tid & 7) * 8;
        float x[8];
#pragma unroll
        for (int i = 0; i < 8; ++i) x[i] = lds[(k8 + i) * 257 + n];
        u32x4 w; w.x = pk_bf16(x[0], x[1]); w.y = pk_bf16(x[2], x[3]); w.z = pk_bf16(x[4], x[5]); w.w = pk_bf16(x[6], x[7]);
        *(u32x4*)(dst + (size_t)(n0 + n) * K + k0 + k8) = w;
    }
    __syncthreads();
}

__device__ __forceinline__ void ada_item(const Params& p, int item, float* lds) {
    const int tid = otid(), lane = tid & 63, w = tid >> 6;
    const int cg_ = item >> 3, kq = item & 7;
    const int n0 = cg_ * 128 + lane * 2;
    const int kbase = kq * 128;
    f32x2 acc[17];
#pragma unroll
    for (int r = 0; r < 17; ++r) acc[r] = (f32x2){0.f, 0.f};
    f32x2 wv[16];
#pragma unroll
    for (int j = 0; j < 16; ++j) wv[j] = __builtin_nontemporal_load((const f32x2*)(p.w_ada + (size_t)(kbase + j) * ADAW + n0));
    for (int e = tid; e < NBATCH * 32; e += NTH) {
        const int r = e >> 5, k4 = (e & 31) * 4;
        const float* cp = r < 8 ? p.c_p + (size_t)r * DM : p.c_s + (size_t)(r - 8) * DM;
        f32x4 v = *(const f32x4*)(cp + kbase + k4);
#pragma unroll
        for (int j = 0; j < 4; ++j) v[j] = v[j] * sigmoidf_(v[j]);
        *(f32x4*)(lds + r * 128 + k4) = v;
    }
    __syncthreads();
#pragma unroll 1
    for (int kb = 0; kb < 128; kb += 16) {
        f32x2 wn[16];
        if (kb + 16 < 128) {
#pragma unroll
            for (int j = 0; j < 16; ++j) wn[j] = __builtin_nontemporal_load((const f32x2*)(p.w_ada + (size_t)(kbase + kb + 16 + j) * ADAW + n0));
        }
#pragma unroll
        for (int r = 0; r < 17; ++r) {
#pragma unroll
            for (int k4 = 0; k4 < 16; k4 += 4) {
                const f32x4 sv = *(const f32x4*)(lds + (w * 17 + r) * 128 + kb + k4);
                acc[r] += wv[k4] * sv[0]; acc[r] += wv[k4 + 1] * sv[1]; acc[r] += wv[k4 + 2] * sv[2]; acc[r] += wv[k4 + 3] * sv[3];
            }
        }
        if (kb + 16 < 128) {
#pragma unroll
            for (int j = 0; j < 16; ++j) wv[j] = wn[j];
        }
    }
    __syncthreads();
    float* part = (float*)(p.ws + WS_ADAP) + (size_t)kq * NBATCH * ADAW;
#pragma unroll
    for (int r = 0; r < 17; ++r) *(f32x2*)(part + (size_t)(w * 17 + r) * ADAW + n0) = acc[r];
}

__device__ __forceinline__ void phase0(const Params& p, float* lds) {
    const int NADA = 48 * 8;
    const int T_IN = 16 * 26, T_PG = 16, T_PO = 8 * 4, T_MO = 64, T_OUT = 64, T_W1 = 16 * 16, T_W2 = 64 * 4;
    const int total = NADA + T_IN + T_PG + T_PO + T_MO + T_OUT + T_W1 + T_W2 + 1;
    unsigned* qctr = (unsigned*)(p.ws + WS_CTR) + 16;
    volatile unsigned* slot = (volatile unsigned*)((unsigned char*)lds + LDS_BYTES - 16);
    for (;;) {
        if (threadIdx.x == 0) *slot = atomicAdd(qctr, 1u);
        __syncthreads();
        const int it = (int)*slot;
        __syncthreads();
        if (it >= total) break;
        int t = it;
        if (t < NADA) { ada_item(p, t, lds); continue; }
        t -= NADA;
        if (t < T_IN) { const int kt = t / 26, nt_ = t % 26; const int n0 = nt_ * 256; const int sc = n0 < 4608 ? n0 : n0 + 8;
            conv_strip(p.w_in, INW, DM, (bf16_t*)(p.ws + WS_WIN), kt, nt_, sc, lds); continue; }
        t -= T_IN;
        if (t < T_PG) { const int g = t >> 2, kt = (t >> 1) & 1, nt_ = t & 1;
            conv_tile(p.w_pg + (size_t)g * 128 * 128, 128, 128, (bf16_t*)(p.ws + WS_WPG) + (size_t)g * 128 * 128, kt, nt_, nt_ * 64, lds); continue; }
        t -= T_PG;
        if (t < T_PO) { const int kt = t / 4, nt_ = t % 4; conv_strip(p.w_po, 1024, 512, (bf16_t*)(p.ws + WS_WPO), kt, nt_, nt_ * 256, lds); continue; }
        t -= T_PO;
        if (t < T_MO) { const int kt = t / 4, nt_ = t % 4; conv_strip(p.w_mo, 1024, 1024, (bf16_t*)(p.ws + WS_WMO), kt, nt_, nt_ * 256, lds); continue; }
        t -= T_MO;
        if (t < T_OUT) { const int kt = t / 4, nt_ = t % 4; conv_strip(p.w_out, 1024, 1024, (bf16_t*)(p.ws + WS_WOUT), kt, nt_, nt_ * 256, lds); continue; }
        t -= T_OUT;
        if (t < T_W1) { const int kt = t / 16, nt_ = t % 16; conv_strip(p.w1, 4096, 1024, (bf16_t*)(p.ws + WS_W1), kt, nt_, nt_ * 256, lds); continue; }
        t -= T_W1;
        if (t < T_W2) { const int kt = t / 4, nt_ = t % 4; conv_strip(p.w2, 1024, 4096, (bf16_t*)(p.ws + WS_W2), kt, nt_, nt_ * 256, lds); continue; }
        for (int e = threadIdx.x; e < 1024 * 2; e += NTH) { const int k = e >> 1, hf = e & 1;
            *(f32x4*)((float*)(p.ws + WS_GW) + k * 8 + hf * 4) = *(const f32x4*)(p.w_in + (size_t)k * INW + 4608 + hf * 4); }
    }
}

__device__ __forceinline__ void norm_item(const Params& p, int item, int mode, float* lds) {
    const int tid = otid(), lane = tid & 63, w = tid >> 6;
    const float* adap = (const float*)(p.ws + WS_ADAP);
    const float* adaf = (const float*)(p.ws + WS_ADA);
    bf16_t* hbuf = (bf16_t*)(p.ws + WS_H);
    if (mode == 0) {
        for (int e = tid; e < 1024 * 2; e += NTH) *(f32x4*)(lds + e * 4) = *(const f32x4*)((const float*)(p.ws + WS_GW) + e * 4);
        __syncthreads();
    }
    const int r_begin = item * 64 + w * 8;
    const int r_extra = NPR + item * 2 + w;
    const int nrows = w < 2 ? 9 : 8;
    int cur_b = -1;
    f32x4 G[4], S[4], xn[4];
    { const int row = r_begin; const float* src0 = mode == 0 ? (row < NPR ? p.x_p + (size_t)row * DM : p.x_s + (size_t)(row - NPR) * DM) : p.out + (size_t)row * DM;
#pragma unroll
      for (int i = 0; i < 4; ++i) xn[i] = *(const f32x4*)(src0 + i * 256 + lane * 4); }
    for (int rr = 0; rr < nrows; ++rr) {
        const int row = rr < 8 ? r_begin + rr : r_extra;
        const int b = row_batch(row);
        if (mode != 2 && b != cur_b) {
            cur_b = b;
            const float* gw = mode == 0 ? p.g_mix : p.g_ffn;
            const int sh_off = mode == 0 ? 0 : 3072, sc_off = mode == 0 ? 1024 : 4096;
            f32x4 scv[4], shv[4];
            if (mode == 0) {
#pragma unroll
                for (int i = 0; i < 4; ++i) { const int col = i * 256 + lane * 4; scv[i] = *(const f32x4*)(p.b_ada + sc_off + col); shv[i] = *(const f32x4*)(p.b_ada + sh_off + col); }
#pragma unroll 2
                for (int q = 0; q < 8; ++q) {
                    const float* ap = adap + ((size_t)q * NBATCH + b) * ADAW;
#pragma unroll
                    for (int i = 0; i < 4; ++i) { const int col = i * 256 + lane * 4; scv[i] += *(const f32x4*)(ap + sc_off + col); shv[i] += *(const f32x4*)(ap + sh_off + col); }
                }
            } else {
#pragma unroll
                for (int i = 0; i < 4; ++i) { const int col = i * 256 + lane * 4; scv[i] = *(const f32x4*)(adaf + (size_t)b * ADAW + sc_off + col); shv[i] = *(const f32x4*)(adaf + (size_t)b * ADAW + sh_off + col); }
            }
#pragma unroll
            for (int i = 0; i < 4; ++i) { const f32x4 g = *(const f32x4*)(gw + i * 256 + lane * 4); G[i] = g * (scv[i] + 1.0f); S[i] = shv[i]; }
        }
        f32x4 x[4]; float ss = 0.f;
#pragma unroll
        for (int i = 0; i < 4; ++i) { x[i] = xn[i]; ss += x[i][0] * x[i][0] + x[i][1] * x[i][1] + x[i][2] * x[i][2] + x[i][3] * x[i][3]; }
        if (rr + 1 < nrows) { const int rown = rr + 1 < 8 ? row + 1 : r_extra;
            const float* srcn = mode == 0 ? (rown < NPR ? p.x_p + (size_t)rown * DM : p.x_s + (size_t)(rown - NPR) * DM) : p.out + (size_t)rown * DM;
#pragma unroll
            for (int i = 0; i < 4; ++i) xn[i] = *(const f32x4*)(srcn + i * 256 + lane * 4); }
        ss = wave_sum(ss);
        const float rstd = rsqrtf(ss * (1.0f / DM) + EPS);
        if (mode == 2) {
#pragma unroll
            for (int i = 0; i < 4; ++i) { const f32x4 g = *(const f32x4*)(p.g_final + i * 256 + lane * 4); __builtin_nontemporal_store(x[i] * rstd * g, (f32x4*)(p.out + (size_t)row * DM + i * 256 + lane * 4)); }
            continue;
        }
        f32x4 hv[4];
#pragma unroll
        for (int i = 0; i < 4; ++i) { hv[i] = x[i] * rstd * G[i] + S[i];
            u32x2 wv; wv.x = pk_bf16(hv[i][0], hv[i][1]); wv.y = pk_bf16(hv[i][2], hv[i][3]);
            *(u32x2*)(hbuf + (size_t)row * DM + i * 256 + lane * 4) = wv; }
        if (mode == 0) {
            float d[8];
#pragma unroll
            for (int j = 0; j < 8; ++j) d[j] = 0.f;
#pragma unroll
            for (int i = 0; i < 4; ++i)
#pragma unroll
                for (int e = 0; e < 4; ++e) {
                    const int k = i * 256 + lane * 4 + e;
                    const f32x4 w0 = *(const f32x4*)(lds + k * 8), w1 = *(const f32x4*)(lds + k * 8 + 4);
                    const float hvv = hv[i][e];
                    d[0] += hvv * w0[0]; d[1] += hvv * w0[1]; d[2] += hvv * w0[2]; d[3] += hvv * w0[3];
                    d[4] += hvv * w1[0]; d[5] += hvv * w1[1]; d[6] += hvv * w1[2]; d[7] += hvv * w1[3];
                }
#pragma unroll
            for (int j = 0; j < 8; ++j) d[j] = wave_sum(d[j]);
            if (lane < 4) {
                float di = lane == 0 ? d[0] : lane == 1 ? d[1] : lane == 2 ? d[2] : d[3];
                float df = lane == 0 ? d[4] : lane == 1 ? d[5] : lane == 2 ? d[6] : d[7];
                di += p.b_i[lane];
                const float z = df + p.b_f[lane];
                const float lf = fminf(z, 0.f) - log1pf(__expf(-fabsf(z)));
                ((float*)(p.ws + WS_GI))[(size_t)row * 4 + lane] = di;
                ((float*)(p.ws + WS_GF))[(size_t)row * 4 + lane] = lf;
            }
        }
    }
    if (mode == 0) __syncthreads();
}

__device__ __forceinline__ void ada_final_slice(const Params& p, int blk) {
    const float* adap = (const float*)(p.ws + WS_ADAP);
    float* adaf = (float*)(p.ws + WS_ADA);
    for (int e = threadIdx.x; e < 816; e += NTH) {
        const size_t idx = ((size_t)blk * 816 + e) * 4;
        f32x4 v = *(const f32x4*)(p.b_ada + (idx % ADAW));
#pragma unroll
        for (int q = 0; q < 8; ++q) v += *(const f32x4*)(adap + (size_t)q * NBATCH * ADAW + idx);
        *(f32x4*)(adaf + idx) = v;
    }
}

__device__ __forceinline__ void scan_item(const Params& p, int item, unsigned char* lds) {
    const int tid = otid(), lane = tid & 63, w = tid >> 6, fr = lane & 15, fq = lane >> 4;
    const int bh = item >> 2, j = item & 3, b = bh >> 2, hd = bh & 3, dv0 = j * 64;
    const float* gi = (const float*)(p.ws + WS_GI); const float* gf = (const float*)(p.ws + WS_GF);
    const bf16_t* kbuf = (const bf16_t*)(p.ws + WS_QKV) + (size_t)1 * MROWS * DM;
    const bf16_t* vbuf = (const bf16_t*)(p.ws + WS_QKV) + (size_t)2 * MROWS * DM;
    bf16_t* cst = (bf16_t*)(p.ws + WS_CST) + (size_t)bh * 31 * 65536;
    float* nst = (float*)(p.ws + WS_NST) + (size_t)bh * 32 * 256;
    float* mst = (float*)(p.ws + WS_MST) + (size_t)bh * 64;
    constexpr int KROW = 144;
    unsigned char* kimg[2] = {lds, lds + 256 * KROW};
    unsigned char* vimg[2] = {lds + 2 * 256 * KROW, lds + 2 * 256 * KROW + 64 * KROW};
    float* aA = (float*)(lds + 2 * 256 * KROW + 2 * 64 * KROW);
    float* bLs = aA + 2048;
    float* amx = bLs + 32;
    float* mch = amx + 32;
    float* dcy = mch + 40;
    for (int c = w * 4; c < w * 4 + 4; ++c) {
        const size_t tok = (size_t)b * SEQ + c * 64 + lane;
        const float lf = gf[tok * 4 + hd], il = gi[tok * 4 + hd];
        const float bs = wave_scan_add(lf, lane);
        const float bL = __shfl(bs, 63);
        const float a = bL - bs + il;
        const float am = wave_max(a);
        aA[c * 64 + lane] = a;
        if (lane == 0) { bLs[c] = bL; amx[c] = am; }
    }
    __syncthreads();
    if (tid == 0) {
        float m = 0.f; mch[0] = 0.f;
        for (int c = 0; c < 32; ++c) { const float mn = fmaxf(bLs[c] + m, amx[c]); dcy[c] = __expf(bLs[c] + m - mn); m = mn; mch[c + 1] = mn; }
    }
    __syncthreads();
    if (j == 0 && tid < 33) mst[tid] = mch[tid];
    if (j == 0 && tid == 0) p.out[O_MP + bh] = mch[32];
    f32x4 acc[2][4] = {};
    float nacc = 0.f;
    u32x4 krA[4], krB[4]; u32x4 vrA, vrB;
#define SCAN_GLOAD(KR, VR, cc) do { const size_t tok_ = (size_t)b * SEQ + (cc) * 64 + lane; const bf16_t* kp_ = kbuf + tok_ * DM + hd * 256 + w * 32; \
        _Pragma("unroll") for (int i_ = 0; i_ < 4; ++i_) KR[i_] = *(const u32x4*)(kp_ + i_ * 8); \
        VR = *(const u32x4*)(vbuf + tok_ * DM + hd * 256 + dv0 + w * 8); } while (0)
#define SCAN_WRITE(KR, VR, cc, ki, vi) do { const float wsv = __expf(aA[(cc) * 64 + lane] - mch[(cc) + 1]); \
        _Pragma("unroll") for (int i_ = 0; i_ < 4; ++i_) { const unsigned uu[4] = {KR[i_].x, KR[i_].y, KR[i_].z, KR[i_].w}; \
            _Pragma("unroll") for (int e_ = 0; e_ < 4; ++e_) { const int dk_ = w * 32 + i_ * 8 + e_ * 2; \
                *(bf16_t*)(ki + dk_ * KROW + lane * 2) = f2bf(bflo(uu[e_]) * wsv); *(bf16_t*)(ki + (dk_ + 1) * KROW + lane * 2) = f2bf(bfhi(uu[e_]) * wsv); } } \
        const int dv_ = w * 8; \
        *(bf16_t*)(vi + (dv_ + 0) * KROW + lane * 2) = (bf16_t)(VR.x & 0xffffu); *(bf16_t*)(vi + (dv_ + 1) * KROW + lane * 2) = (bf16_t)(VR.x >> 16); \
        *(bf16_t*)(vi + (dv_ + 2) * KROW + lane * 2) = (bf16_t)(VR.y & 0xffffu); *(bf16_t*)(vi + (dv_ + 3) * KROW + lane * 2) = (bf16_t)(VR.y >> 16); \
        *(bf16_t*)(vi + (dv_ + 4) * KROW + lane * 2) = (bf16_t)(VR.z & 0xffffu); *(bf16_t*)(vi + (dv_ + 5) * KROW + lane * 2) = (bf16_t)(VR.z >> 16); \
        *(bf16_t*)(vi + (dv_ + 6) * KROW + lane * 2) = (bf16_t)(VR.w & 0xffffu); *(bf16_t*)(vi + (dv_ + 7) * KROW + lane * 2) = (bf16_t)(VR.w >> 16); } while (0)
    SCAN_GLOAD(krA, vrA, 0);
    SCAN_GLOAD(krB, vrB, 1);
    for (int c = 0; c < 32; ++c) {
        unsigned char* ki = kimg[c & 1]; unsigned char* vi = vimg[c & 1];
        if ((c & 1) == 0) { SCAN_WRITE(krA, vrA, c, ki, vi); if (c + 2 < 32) SCAN_GLOAD(krA, vrA, c + 2); }
        else { SCAN_WRITE(krB, vrB, c, ki, vi); if (c + 2 < 32) SCAN_GLOAD(krB, vrB, c + 2); }
        __syncthreads();
        const float dc = dcy[c];
        bf16x8 af[2][2], bfr[4][2];
#pragma unroll
        for (int a = 0; a < 2; ++a)
#pragma unroll
            for (int k = 0; k < 2; ++k) af[a][k] = *(const bf16x8*)(ki + ((w * 2 + a) * 16 + fr) * KROW + (k * 32 + fq * 8) * 2);
#pragma unroll
        for (int a = 0; a < 4; ++a)
#pragma unroll
            for (int k = 0; k < 2; ++k) bfr[a][k] = *(const bf16x8*)(vi + (a * 16 + fr) * KROW + (k * 32 + fq * 8) * 2);
#pragma unroll
        for (int a = 0; a < 2; ++a)
#pragma unroll
            for (int q = 0; q < 4; ++q) {
                acc[a][q] *= dc;
#pragma unroll
                for (int k = 0; k < 2; ++k) acc[a][q] = MFMA16(af[a][k], bfr[q][k], acc[a][q]);
            }
        if (j == 0) {
            const int dk = tid >> 1, hf = tid & 1;
            float s = 0.f;
#pragma unroll
            for (int i = 0; i < 4; ++i) {
                const u32x4 v = *(const u32x4*)(ki + dk * KROW + hf * 64 + i * 16);
                s += bflo(v.x) + bfhi(v.x) + bflo(v.y) + bfhi(v.y) + bflo(v.z) + bfhi(v.z) + bflo(v.w) + bfhi(v.w);
            }
            s += __shfl_xor(s, 1);
            nacc = nacc * dc + s;
            if (hf == 0) { if (c < 31) nst[(c + 1) * 256 + dk] = nacc; else p.out[O_NP + (size_t)bh * 256 + dk] = nacc; }
        }
        if (c < 31) {
            bf16_t* cs = cst + (size_t)c * 65536;
#pragma unroll
            for (int a = 0; a < 2; ++a)
#pragma unroll
                for (int q = 0; q < 4; ++q) {
                    u32x2 wv; wv.x = pk_bf16(acc[a][q][0], acc[a][q][1]); wv.y = pk_bf16(acc[a][q][2], acc[a][q][3]);
                    *(u32x2*)(cs + (size_t)(dv0 + q * 16 + fr) * 256 + (w * 2 + a) * 16 + fq * 4) = wv;
                }
        } else {
            float* co = p.out + O_CP + (size_t)bh * 65536;
#pragma unroll
            for (int a = 0; a < 2; ++a)
#pragma unroll
                for (int q = 0; q < 4; ++q)
#pragma unroll
                    for (int jj = 0; jj < 4; ++jj) co[(size_t)((w * 2 + a) * 16 + fq * 4 + jj) * 256 + dv0 + q * 16 + fr] = acc[a][q][jj];
        }
    }
    __syncthreads();
}

__device__ __forceinline__ void sample_item(const Params& p, int item, unsigned char* ldsb) {
    const int tid = otid(), lane = tid & 63, w = tid >> 6;
    const int b = item >> 2, hd = item & 3, bh = item;
    const int r0 = NPR + b * 4;
    const bf16_t* qb = (const bf16_t*)(p.ws + WS_QKV);
    const bf16_t* kb = qb + (size_t)MROWS * DM; const bf16_t* vb = kb + (size_t)MROWS * DM; const bf16_t* ob = vb + (size_t)MROWS * DM;
    const float* gi = (const float*)(p.ws + WS_GI); const float* gf = (const float*)(p.ws + WS_GF);
    float* lds = (float*)ldsb;
    float* qf = lds;
    float* kf = qf + 1024;
    float* vf = kf + 1024;
    float* Sm = vf + 1024;
    float* sc = Sm + 16;
    float* red = sc + 64;
    float* ssq = red + 8192;
    float lfp[4] = {0.f, 0.f, 0.f, 0.f}, ilp[4] = {0.f, 0.f, 0.f, 0.f}, m0p = 0.f;
    if (tid == 0) {
#pragma unroll
        for (int t = 0; t < 4; ++t) { lfp[t] = gf[(size_t)(r0 + t) * 4 + hd]; ilp[t] = gi[(size_t)(r0 + t) * 4 + hd]; }
        m0p = p.st_m[bh];
    }
    const int dv4 = lane * 4;
    const float* C0 = p.st_C + (size_t)bh * 65536;
    float* Cn = p.out + O_CS + (size_t)bh * 65536;
    f32x4 cpre[16];
#pragma unroll
    for (int r = 0; r < 16; ++r) cpre[r] = __builtin_nontemporal_load((const f32x4*)(C0 + (size_t)(w * 32 + r) * 256 + dv4));
    float* n0s = ssq + 8;
    const int ft = tid >> 7, fdv = (tid & 127) * 2;
    const size_t foidx = (size_t)(r0 + ft) * DM + hd * 256 + fdv;
    const unsigned fog = *(const unsigned*)(ob + foidx);
    const float fm0 = p.m_norm[hd * 256 + fdv], fm1 = p.m_norm[hd * 256 + fdv + 1];
    if (tid < 256) n0s[tid] = p.st_n[(size_t)bh * 256 + tid];
    for (int e = tid; e < 3 * 4 * 256; e += NTH) {
        const int which = e >> 10, t = (e >> 8) & 3, d = e & 255;
        const bf16_t* src = which == 0 ? qb : which == 1 ? kb : vb;
        lds[which * 1024 + t * 256 + d] = bf2f(src[(size_t)(r0 + t) * DM + hd * 256 + d]);
    }
    if (tid == 0) {
        float lf[4], il[4], bs[4];
        for (int t = 0; t < 4; ++t) { lf[t] = lfp[t]; il[t] = ilp[t]; }
        bs[0] = lf[0]; bs[1] = bs[0] + lf[1]; bs[2] = bs[1] + lf[2]; bs[3] = bs[2] + lf[3];
        const float m0 = m0p;
        for (int t = 0; t < 4; ++t) {
            const float g = bs[t] + m0; float mt = g;
            for (int s = 0; s <= t; ++s) mt = fmaxf(mt, bs[t] - bs[s] + il[s]);
            sc[t] = __expf(g - mt); sc[4 + t] = __expf(-mt);
            for (int s = 0; s < 4; ++s) sc[16 + t * 4 + s] = s <= t ? __expf(bs[t] - bs[s] + il[s] - mt) : 0.f;
        }
        const float bL = bs[3]; float mn = bL + m0;
        for (int s = 0; s < 4; ++s) mn = fmaxf(mn, bL - bs[s] + il[s]);
        sc[12] = __expf(bL + m0 - mn);
        for (int s = 0; s < 4; ++s) sc[8 + s] = __expf(bL - bs[s] + il[s] - mn);
        p.out[O_MS + bh] = mn;
    }
    __syncthreads();
    {
        const int g = tid >> 5, l32 = tid & 31;
        {
            const int t = g >> 2, s = g & 3; float a = 0.f;
#pragma unroll
            for (int d = l32; d < 256; d += 32) a += qf[t * 256 + d] * kf[s * 256 + d];
#pragma unroll
            for (int dd = 16; dd >= 1; dd >>= 1) a += __shfl_xor(a, dd);
            if (l32 == 0) Sm[g] = a * sc[16 + g];
        }
        if (g < 4) {
            float a = 0.f;
#pragma unroll
            for (int d = l32; d < 256; d += 32) a += qf[g * 256 + d] * n0s[d];
#pragma unroll
            for (int dd = 16; dd >= 1; dd >>= 1) a += __shfl_xor(a, dd);
            if (l32 == 0) sc[32 + g] = a;
        }
    }
    const float decay = sc[12];
    const float ws0 = sc[8], ws1 = sc[9], ws2 = sc[10], ws3 = sc[11];
    if (tid < 256) {
        const float nn = decay * n0s[tid] + ws0 * kf[tid] + ws1 * kf[256 + tid] + ws2 * kf[512 + tid] + ws3 * kf[768 + tid];
        p.out[O_NS + (size_t)bh * 256 + tid] = nn;
    }
    {
        f32x4 vv[4], num[4];
        vv[0] = *(const f32x4*)(vf + dv4) * ws0; vv[1] = *(const f32x4*)(vf + 256 + dv4) * ws1; vv[2] = *(const f32x4*)(vf + 512 + dv4) * ws2; vv[3] = *(const f32x4*)(vf + 768 + dv4) * ws3;
#pragma unroll
        for (int s = 0; s < 4; ++s) num[s] = (f32x4){0.f, 0.f, 0.f, 0.f};
#pragma unroll
        for (int r = 0; r < 16; ++r) {
            const int dk = w * 32 + r;
            const f32x4 cv = cpre[r];
            f32x4 cn = cv * decay;
#pragma unroll
            for (int s = 0; s < 4; ++s) { num[s] += cv * qf[s * 256 + dk]; cn += vv[s] * kf[s * 256 + dk]; }
            __builtin_nontemporal_store(cn, (f32x4*)(Cn + (size_t)dk * 256 + dv4));
        }
#pragma unroll 16
        for (int r = 16; r < 32; ++r) {
            const int dk = w * 32 + r;
            const f32x4 cv = __builtin_nontemporal_load((const f32x4*)(C0 + (size_t)dk * 256 + dv4));
            f32x4 cn = cv * decay;
#pragma unroll
            for (int s = 0; s < 4; ++s) { num[s] += cv * qf[s * 256 + dk]; cn += vv[s] * kf[s * 256 + dk]; }
            __builtin_nontemporal_store(cn, (f32x4*)(Cn + (size_t)dk * 256 + dv4));
        }
        __syncthreads();
#pragma unroll
        for (int t = 0; t < 4; ++t) *(f32x4*)(red + (w * 4 + t) * 256 + dv4) = num[t];
    }
    __syncthreads();
    {
        const int t = tid >> 7, dv = (tid & 127) * 2;
        float n0_ = 0.f, n1_ = 0.f;
#pragma unroll
        for (int ww = 0; ww < 8; ++ww) { n0_ += red[(ww * 4 + t) * 256 + dv]; n1_ += red[(ww * 4 + t) * 256 + dv + 1]; }
        const float wint = sc[t];
        n0_ *= wint; n1_ *= wint;
        float rs = 0.f;
#pragma unroll
        for (int s = 0; s < 4; ++s) { const float sv = Sm[t * 4 + s]; rs += sv; n0_ += sv * vf[s * 256 + dv]; n1_ += sv * vf[s * 256 + dv + 1]; }
        const float den = wint * sc[32 + t] + rs;
        const float dinv = 1.0f / fmaxf(fabsf(den), sc[4 + t]);
        const float h0 = n0_ * dinv, h1 = n1_ * dinv;
        float q2 = wave_sum(h0 * h0 + h1 * h1);
        if (lane == 0) ssq[t * 2 + (w & 1)] = q2;
        __syncthreads();
        const float rstd = rsqrtf((ssq[t * 2] + ssq[t * 2 + 1]) * (1.0f / 256.f) + EPS);
        const float o0 = h0 * rstd * fm0 * bflo(fog), o1 = h1 * rstd * fm1 * bfhi(fog);
        *(unsigned*)((bf16_t*)(p.ws + WS_HM) + foidx) = pk_bf16(o0, o1);
    }
    __syncthreads();
}

__device__ __forceinline__ void pool_item(const Params& p, int item, unsigned char* lds) {
    const int tid = otid(), lane = tid & 63, w = tid >> 6, fr = lane & 15, fq = lane >> 4;
    const int r0 = item < 256 ? item * 64 : NPR + (item - 256) * 16;
    const int nm = item < 256 ? 4 : 1;
    const float* u = (const float*)(p.ws + WS_U);
    constexpr int AROW = 1040;
    bf16x8 bw[4][4];
    {
        const bf16_t* wt0 = (const bf16_t*)(p.ws + WS_WPG) + (size_t)(w >> 1) * 128 * 128;
#pragma unroll
        for (int k = 0; k < 4; ++k)
#pragma unroll
            for (int n = 0; n < 4; ++n) bw[k][n] = *(const bf16x8*)(wt0 + (size_t)(((w & 1) * 4 + n) * 16 + fr) * 128 + k * 32 + fq * 8);
    }
    {
        const int c = tid, gidx = c >> 7, win = 2 << gidx;
        float hist[31];
        if (r0 < NPR) {
            const int t0 = r0 & (SEQ - 1);
#pragma unroll
            for (int j = 0; j < 15; ++j) hist[j] = (t0 - 15 + j) >= 0 ? u[(size_t)(r0 - 15 + j) * 512 + c] : 0.f;
            float nxt[16];
#pragma unroll
            for (int j = 0; j < 16; ++j) nxt[j] = u[(size_t)(r0 + j) * 512 + c];
#pragma unroll 1
            for (int ch = 0; ch < 4; ++ch) {
#pragma unroll
                for (int j = 0; j < 16; ++j) hist[15 + j] = nxt[j];
                if (ch < 3) {
#pragma unroll
                    for (int j = 0; j < 16; ++j) nxt[j] = u[(size_t)(r0 + (ch + 1) * 16 + j) * 512 + c];
                }
#pragma unroll
                for (int j = 0; j < 16; ++j) {
                    const int i = ch * 16 + j, t = t0 + i, q = 15 + j;
                    const float s2 = hist[q] + hist[q - 1];
                    const float s4 = s2 + hist[q - 2] + hist[q - 3];
                    const float s8 = s4 + (hist[q - 4] + hist[q - 5]) + (hist[q - 6] + hist[q - 7]);
                    const float s16 = s8 + ((hist[q - 8] + hist[q - 9]) + (hist[q - 10] + hist[q - 11])) + ((hist[q - 12] + hist[q - 13]) + (hist[q - 14] + hist[q - 15]));
                    const float s = gidx == 0 ? s2 : gidx == 1 ? s4 : gidx == 2 ? s8 : s16;
                    const float rc = __builtin_amdgcn_rcpf((float)min(t + 1, win));
                    *(bf16_t*)(lds + i * AROW + c * 2) = f2bf(s * rc - hist[q]);
                }
#pragma unroll
                for (int j = 0; j < 15; ++j) hist[j] = hist[16 + j];
            }
        } else {
#pragma unroll 1
            for (int bi = 0; bi < 4; ++bi) {
                const int bb = ((r0 - NPR) >> 2) + bi;
#pragma unroll
                for (int j = 0; j < 15; ++j) hist[j] = p.st_pool[((size_t)bb * 15 + j) * 512 + c];
#pragma unroll
                for (int j = 0; j < 4; ++j) hist[15 + j] = u[((size_t)NPR + bb * 4 + j) * 512 + c];
#pragma unroll
                for (int j = 0; j < 4; ++j) {
                    const int i = bi * 4 + j, q = 15 + j;
                    const float s2 = hist[q] + hist[q - 1];
                    const float s4 = s2 + hist[q - 2] + hist[q - 3];
                    const float s8 = s4 + (hist[q - 4] + hist[q - 5]) + (hist[q - 6] + hist[q - 7]);
                    const float s16 = s8 + ((hist[q - 8] + hist[q - 9]) + (hist[q - 10] + hist[q - 11])) + ((hist[q - 12] + hist[q - 13]) + (hist[q - 14] + hist[q - 15]));
                    const float s = gidx == 0 ? s2 : gidx == 1 ? s4 : gidx == 2 ? s8 : s16;
                    *(bf16_t*)(lds + i * AROW + c * 2) = f2bf(s * (1.0f / (float)win) - hist[q]);
                }
            }
        }
    }
    __syncthreads();
    {
        const int g = w >> 1, nh = w & 1;
        f32x4 acc[4][4] = {};
#pragma unroll
        for (int k = 0; k < 4; ++k) {
            bf16x8 af[4];
#pragma unroll
            for (int m = 0; m < 4; ++m) if (m < nm) af[m] = *(const bf16x8*)(lds + (m * 16 + fr) * AROW + (g * 128 + k * 32 + fq * 8) * 2);
#pragma unroll
            for (int m = 0; m < 4; ++m) if (m < nm) {
#pragma unroll
                for (int n = 0; n < 4; ++n) acc[m][n] = MFMA16(bw[k][n], af[m], acc[m][n]); }
        }
        bf16_t* yp = (bf16_t*)(p.ws + WS_YP);
#pragma unroll
        for (int m = 0; m < 4; ++m) if (m < nm)
#pragma unroll
            for (int n = 0; n < 4; ++n) {
                const int col = g * 128 + (nh * 4 + n) * 16 + fq * 4;
                const f32x4 scv = *(const f32x4*)(p.pool_scale + col);
                const f32x4 v = acc[m][n] * scv;
                u32x2 wv; wv.x = pk_bf16(v[0], v[1]); wv.y = pk_bf16(v[2], v[3]);
                *(u32x2*)(yp + (size_t)(r0 + m * 16 + fr) * 512 + col) = wv;
            }
    }
    __syncthreads();
}

__device__ __forceinline__ void poolout_item(const Params& p, int item) {
    const float* u = (const float*)(p.ws + WS_U);
    for (int e = threadIdx.x; e < 15 * 512; e += NTH) {
        const int jj = e >> 9, c = e & 511;
        if (item < 8) p.out[O_POOLP + (size_t)item * 7680 + e] = u[((size_t)item * SEQ + 2033 + jj) * 512 + c];
        else { const int bb = item - 8;
            p.out[O_POOLS + (size_t)bb * 7680 + e] = jj < 11 ? p.st_pool[((size_t)bb * 15 + jj + 4) * 512 + c] : u[((size_t)NPR + bb * 4 + (jj - 11)) * 512 + c]; }
    }
}

__device__ __forceinline__ void mout_item(const Params& p, int item, unsigned char* lds) {
    const int tid = otid(), lane = tid & 63, w = tid >> 6, fr = lane & 15, fq = lane >> 4;
    const int bh = item >> 5, c = item & 31, b = bh >> 2, hd = bh & 3;
    const size_t tok0 = (size_t)b * SEQ + c * 64;
    const bf16_t* qb = (const bf16_t*)(p.ws + WS_QKV);
    const bf16_t* kb = qb + (size_t)MROWS * DM; const bf16_t* vb = kb + (size_t)MROWS * DM; const bf16_t* ob = vb + (size_t)MROWS * DM;
    const float* gi = (const float*)(p.ws + WS_GI); const float* gf = (const float*)(p.ws + WS_GF);
    constexpr int QROW = 528, VROW = 144;
    unsigned char* Qs = lds;
    unsigned char* Ks = Qs + 64 * QROW;
    unsigned char* Vt = Ks + 64 * QROW;
    unsigned char* Sp = Vt + 256 * VROW;
    float* scal = (float*)(Sp + 64 * VROW);
    float* rt = scal, *ct = scal + 64, *wint = scal + 128, *emt = scal + 192, *rowsum = scal + 256  , *qn = scal + 384, *ssq = scal + 448  , *ncs = scal + 960  ;
    const float lf_pre = gf[(tok0 + lane) * 4 + hd], il_pre = gi[(tok0 + lane) * 4 + hd];
    const float mc_pre = ((const float*)(p.ws + WS_MST))[bh * 64 + c];
    bf16x8 cfr[8][2];
    if (c > 0) {
        const bf16_t* cs = (const bf16_t*)(p.ws + WS_CST) + ((size_t)bh * 31 + (c - 1)) * 65536;
#pragma unroll
        for (int k = 0; k < 8; ++k)
#pragma unroll
            for (int n = 0; n < 2; ++n) cfr[k][n] = *(const bf16x8*)(cs + (size_t)(w * 32 + n * 16 + fr) * 256 + k * 32 + fq * 8);
    }
    u32x2 ogv[4][2]; f32x4 mnv[2];
#pragma unroll
    for (int n = 0; n < 2; ++n) { const int dvg = hd * 256 + w * 32 + n * 16 + fq * 4; mnv[n] = *(const f32x4*)(p.m_norm + dvg);
#pragma unroll
        for (int m = 0; m < 4; ++m) ogv[m][n] = *(const u32x2*)(ob + (tok0 + m * 16 + fr) * DM + dvg); }
    if (w == 0) {
        const float lf = lf_pre, il = il_pre;
        const float bs = wave_scan_add(lf, lane);
        const float mc = mc_pre;
        const float g = bs + mc, xx = il - bs;
        const float pm = wave_scan_max(xx, lane);
        const float mt = fmaxf(g, bs + pm);
        rt[lane] = bs - mt; ct[lane] = xx; wint[lane] = __expf(g - mt); emt[lane] = __expf(-mt);
    }
#pragma unroll
    for (int i = 0; i < 4; ++i) {
        const int pc = tid + NTH * i, row = pc >> 5, c8 = pc & 31;
        *(u32x4*)(Qs + row * QROW + c8 * 16) = *(const u32x4*)(qb + (tok0 + row) * DM + hd * 256 + c8 * 8);
        *(u32x4*)(Ks + row * QROW + c8 * 16) = *(const u32x4*)(kb + (tok0 + row) * DM + hd * 256 + c8 * 8);
    }
    {
        const bf16_t* vp = vb + (tok0 + lane) * DM + hd * 256 + w * 32;
#pragma unroll
        for (int i = 0; i < 4; ++i) {
            const u32x4 v = *(const u32x4*)(vp + i * 8);
            const unsigned uu[4] = {v.x, v.y, v.z, v.w};
#pragma unroll
            for (int e = 0; e < 4; ++e) {
                const int dv = w * 32 + i * 8 + e * 2;
                *(bf16_t*)(Vt + dv * VROW + lane * 2) = (bf16_t)(uu[e] & 0xffffu);
                *(bf16_t*)(Vt + (dv + 1) * VROW + lane * 2) = (bf16_t)(uu[e] >> 16);
            }
        }
    }
    if (c > 0 && tid >= 256) ncs[tid - 256] = ((const float*)(p.ws + WS_NST))[((size_t)bh * 32 + c) * 256 + tid - 256];
    __syncthreads();
    {
        const int tt = w >> 1, sh = w & 1;
        f32x4 sa[2] = {};
#pragma unroll
        for (int k = 0; k < 8; ++k) {
            const bf16x8 qf = *(const bf16x8*)(Qs + (tt * 16 + fr) * QROW + (k * 32 + fq * 8) * 2);
#pragma unroll
            for (int s2 = 0; s2 < 2; ++s2) {
                const bf16x8 kf = *(const bf16x8*)(Ks + ((sh * 2 + s2) * 16 + fr) * QROW + (k * 32 + fq * 8) * 2);
                sa[s2] = MFMA16(kf, qf, sa[s2]);
            }
        }
        const int t = tt * 16 + fr;
        const float rtt = rt[t];
        float rs = 0.f;
#pragma unroll
        for (int s2 = 0; s2 < 2; ++s2) {
            const int s0 = (sh * 2 + s2) * 16 + fq * 4;
            float v[4];
#pragma unroll
            for (int jj = 0; jj < 4; ++jj) { const int s = s0 + jj; v[jj] = s <= t ? sa[s2][jj] * __expf(rtt + ct[s]) : 0.f; rs += v[jj]; }
            u32x2 wv; wv.x = pk_bf16(v[0], v[1]); wv.y = pk_bf16(v[2], v[3]);
            *(u32x2*)(Sp + t * VROW + s0 * 2) = wv;
        }
        rs += __shfl_xor(rs, 16); rs += __shfl_xor(rs, 32);
        if (fq == 0) rowsum[t * 2 + sh] = rs;
    }
    {
        const int t = tid >> 3, part = tid & 7;
        float a = 0.f;
        if (c > 0) {
            const float* nc = ncs + part * 32;
            const unsigned char* qp = Qs + t * QROW + part * 64;
#pragma unroll
            for (int i = 0; i < 4; ++i) {
                const u32x4 qv = *(const u32x4*)(qp + i * 16);
                const f32x4 n0 = *(const f32x4*)(nc + i * 8), n1 = *(const f32x4*)(nc + i * 8 + 4);
                a += bflo(qv.x) * n0[0] + bfhi(qv.x) * n0[1] + bflo(qv.y) * n0[2] + bfhi(qv.y) * n0[3] + bflo(qv.z) * n1[0] + bfhi(qv.z) * n1[1] + bflo(qv.w) * n1[2] + bfhi(qv.w) * n1[3];
            }
        }
        a += __shfl_xor(a, 1); a += __shfl_xor(a, 2); a += __shfl_xor(a, 4);
        if (part == 0) qn[t] = a;
    }
    __syncthreads();
    f32x4 acc[4][2] = {};
    if (c > 0) {
#pragma unroll
        for (int k = 0; k < 8; ++k) {
            bf16x8 qf[4];
#pragma unroll
            for (int m = 0; m < 4; ++m) qf[m] = *(const bf16x8*)(Qs + (m * 16 + fr) * QROW + (k * 32 + fq * 8) * 2);
#pragma unroll
            for (int m = 0; m < 4; ++m)
#pragma unroll
                for (int n = 0; n < 2; ++n) acc[m][n] = MFMA16(cfr[k][n], qf[m], acc[m][n]);
        }
#pragma unroll
        for (int m = 0; m < 4; ++m) { const float wi = wint[m * 16 + fr]; acc[m][0] *= wi; acc[m][1] *= wi; }
    }
#pragma unroll
    for (int k = 0; k < 2; ++k) {
        bf16x8 vfr[2], sf[4];
#pragma unroll
        for (int n = 0; n < 2; ++n) vfr[n] = *(const bf16x8*)(Vt + (w * 32 + n * 16 + fr) * VROW + (k * 32 + fq * 8) * 2);
#pragma unroll
        for (int m = 0; m < 4; ++m) sf[m] = *(const bf16x8*)(Sp + (m * 16 + fr) * VROW + (k * 32 + fq * 8) * 2);
#pragma unroll
        for (int m = 0; m < 4; ++m)
#pragma unroll
            for (int n = 0; n < 2; ++n) acc[m][n] = MFMA16(vfr[n], sf[m], acc[m][n]);
    }
#pragma unroll
    for (int m = 0; m < 4; ++m) {
        const int t = m * 16 + fr;
        const float den = wint[t] * qn[t] + rowsum[t * 2] + rowsum[t * 2 + 1];
        const float dinv = 1.0f / fmaxf(fabsf(den), emt[t]);
        acc[m][0] *= dinv; acc[m][1] *= dinv;
        float q2 = 0.f;
#pragma unroll
        for (int n = 0; n < 2; ++n)
#pragma unroll
            for (int jj = 0; jj < 4; ++jj) q2 += acc[m][n][jj] * acc[m][n][jj];
        q2 += __shfl_xor(q2, 16); q2 += __shfl_xor(q2, 32);
        if (fq == 0) ssq[t * 8 + w] = q2;
    }
    __syncthreads();
#pragma unroll
    for (int m = 0; m < 4; ++m) {
        const int t = m * 16 + fr;
        float tot = 0.f;
#pragma unroll
        for (int ww = 0; ww < 8; ++ww) tot += ssq[t * 8 + ww];
        const float rstd = rsqrtf(tot * (1.0f / 256.f) + EPS);
#pragma unroll
        for (int n = 0; n < 2; ++n) {
            const int dvg = hd * 256 + w * 32 + n * 16 + fq * 4;
            const size_t oidx = (tok0 + t) * DM + dvg;
            const u32x2 og = ogv[m][n];
            const f32x4 v = acc[m][n] * rstd * mnv[n];
            u32x2 wv; wv.x = pk_bf16(v[0] * bflo(og.x), v[1] * bfhi(og.x)); wv.y = pk_bf16(v[2] * bflo(og.y), v[3] * bfhi(og.y));
            *(u32x2*)((bf16_t*)(p.ws + WS_HM) + oidx) = wv;
        }
    }
    __syncthreads();
}

__device__ __forceinline__ void grid_barrier(unsigned* bar, unsigned k) {
    asm volatile("s_waitcnt vmcnt(0)" ::: "memory");
    __syncthreads();
    if (threadIdx.x == 0) {
        const unsigned g = blockIdx.x & 7u, gsz = (gridDim.x + 7u - g) >> 3;
        __builtin_amdgcn_fence(__ATOMIC_RELEASE, "agent");
        asm volatile("s_waitcnt vmcnt(0)" ::: "memory");
        unsigned* sub = bar + 64u * (1u + g);
        const unsigned prev = __hip_atomic_fetch_add(sub, 1u, __ATOMIC_RELAXED, __HIP_MEMORY_SCOPE_AGENT);
        if (prev + 1u == k * gsz) __hip_atomic_fetch_add(bar, 1u, __ATOMIC_RELAXED, __HIP_MEMORY_SCOPE_AGENT);
        const unsigned ngroups = gridDim.x < 8u ? gridDim.x : 8u;
        unsigned spins = 0;
        while (__hip_atomic_load(bar, __ATOMIC_RELAXED, __HIP_MEMORY_SCOPE_AGENT) < k * ngroups) { __builtin_amdgcn_s_sleep(1); if (++spins > (1u << 24)) break; }
        __builtin_amdgcn_fence(__ATOMIC_ACQUIRE, "agent");
        asm volatile("s_waitcnt vmcnt(0)" ::: "memory");
    }
    __syncthreads();
}

__global__ void __launch_bounds__(NTH) hybrid_fwd(Params p) {
    extern __shared__ __attribute__((aligned(16))) unsigned char lds[];
    cg::grid_group grid = cg::this_grid();
    const int lo = p.ph_lo, hi = p.ph_hi;
#ifndef PHMASK
#define PHMASK 0x7ff
#endif
#define IN(k) (((PHMASK >> (k)) & 1) && lo <= (k) && (k) < hi)
#define SEAMN(n) do { grid_barrier((unsigned*)(p.ws + WS_CTR) + 64, (unsigned)(n)); } while (0)
    if (lo < 0) grid.sync();
    LAS unsigned char* ldsl = (LAS unsigned char*)lds;
    unsigned char* ws = p.ws;
    if (IN(0)) phase0(p, (float*)lds);
    SEAMN(1);
    if (IN(1)) {
        for (int it = blockIdx.x; it < 256; it += gridDim.x) { ada_final_slice(p, it); norm_item(p, it, 0, (float*)lds); }
    }
    SEAMN(2);
    if (IN(2)) { EpiG1 e{(float*)(ws + WS_U), (bf16_t*)(ws + WS_QKV)}; gemm_phase(ldsl, (const bf16_t*)(ws + WS_H), (const bf16_t*)(ws + WS_WIN), NIN, DM, e);
        { const int c = blockIdx.x; const int tb = c < 128 ? c * 2 : 256 + (c - 128) * 11;
          small_gemm_phase(lds, (const bf16_t*)(ws + WS_H), (const bf16_t*)(ws + WS_WIN), NIN, DM, e, tb, tb + (c < 128 ? 2 : 11)); } }
    SEAMN(3);
    if (IN(3)) {
        if (blockIdx.x < 128) { const int x = blockIdx.x & 7, r = blockIdx.x >> 3;
            scan_item(p, ((x + 8 * (r >> 2)) << 2) | (r & 3), lds); }
        {
            unsigned* ctr = (unsigned*)(ws + WS_CTR);
            volatile unsigned* slot = (volatile unsigned*)(lds + LDS_BYTES - 16);
            for (;;) {
                if (threadIdx.x == 0) *slot = atomicAdd(ctr, 1u);
                __syncthreads();
                const int it = (int)*slot;
                __syncthreads();
                if (it >= 512 + 288 + NBATCH) break;
                if (it < 512) sample_item(p, it, lds);
                else if (it < 800) pool_item(p, it - 512, lds);
                else poolout_item(p, it - 800);
            }
        }
    }
    SEAMN(4);
    if (IN(4)) { for (int it = blockIdx.x; it < 1024; it += gridDim.x) mout_item(p, it, lds); }
    if (IN(5)) {

        bf16_t* merged = (bf16_t*)(ws + WS_U);
        const bf16_t* sga = (const bf16_t*)(ws + WS_QKV) + (size_t)4 * MROWS * DM;
        const bf16_t* sgb = sga + (size_t)MROWS * DM;
        { EpiMerge e0{merged, sga, 0}; gemm_phase(ldsl, (const bf16_t*)(ws + WS_YP), (const bf16_t*)(ws + WS_WPO), DM, 512, e0);
          small_gemm_phase(lds, (const bf16_t*)(ws + WS_YP), (const bf16_t*)(ws + WS_WPO), DM, 512, e0, blockIdx.x, blockIdx.x + 1); }
        SEAMN(5);
        { EpiMerge e1{merged, sgb, 1}; gemm_phase(ldsl, (const bf16_t*)(ws + WS_HM), (const bf16_t*)(ws + WS_WMO), DM, DM, e1);
          small_gemm_phase(lds, (const bf16_t*)(ws + WS_HM), (const bf16_t*)(ws + WS_WMO), DM, DM, e1, blockIdx.x, blockIdx.x + 1); }
    }
    SEAMN(6);
    if (IN(6)) {
        EpiMid e{p.out, p.x_p, p.x_s, (const float*)(ws + WS_ADA), p.g_ffn, (bf16_t*)(ws + WS_H), (float*)(ws + WS_RSB), (unsigned*)(ws + WS_XCNT), (float*)(ws + WS_RSS), (unsigned*)(ws + WS_XCNT) + 64 * 64};
        gemm_phase<EpiMid, true>(ldsl, (const bf16_t*)(ws + WS_U), (const bf16_t*)(ws + WS_WOUT), DM, DM, e, lds);
        small_gemm_phase<EpiMid, 2>(lds, (const bf16_t*)(ws + WS_U), (const bf16_t*)(ws + WS_WOUT), DM, DM, e, blockIdx.x, blockIdx.x + 1);
    }
    SEAMN(7);
    if (IN(8)) { EpiAct e{(bf16_t*)(ws + WS_CST)}; gemm_phase(ldsl, (const bf16_t*)(ws + WS_H), (const bf16_t*)(ws + WS_W1), DFF, DM, e);
        small_gemm_phase(lds, (const bf16_t*)(ws + WS_H), (const bf16_t*)(ws + WS_W1), DFF, DM, e, blockIdx.x * 4, blockIdx.x * 4 + 4); }
    SEAMN(8);
    if (IN(9)) {
        EpiFinal e{p.out, (const float*)(ws + WS_ADA), p.g_final, (float*)(ws + WS_RSB), (unsigned*)(ws + WS_XCNT), (float*)(ws + WS_RSS), (unsigned*)(ws + WS_XCNT) + 64 * 64};
        gemm_phase<EpiFinal, true>(ldsl, (const bf16_t*)(ws + WS_CST), (const bf16_t*)(ws + WS_W2), DM, DFF, e, lds);
        small_gemm_phase<EpiFinal, 1>(lds, (const bf16_t*)(ws + WS_CST), (const bf16_t*)(ws + WS_W2), DM, DFF, e, blockIdx.x, blockIdx.x + 1);
    }
#undef IN
#undef SEAMN
}

extern "C" void kernel_launch(void* const* d_in, const int* in_sizes, int n_in, void* d_out, int out_size, void* d_ws, size_t ws_size, hipStream_t stream) {
    static int grid_blocks = 0;
    if (grid_blocks == 0) {
        if (ws_size < WS_END) { fprintf(stderr, "kernel_launch: workspace too small: %zu < %zu\n", ws_size, (size_t)WS_END); grid_blocks = -1; return; }
        int dev = 0, cus = 0, per_cu = 0;
        hipGetDevice(&dev);
        hipDeviceGetAttribute(&cus, hipDeviceAttributeMultiprocessorCount, dev);
        hipFuncSetAttribute((const void*)hybrid_fwd, hipFuncAttributeMaxDynamicSharedMemorySize, LDS_BYTES);
        hipOccupancyMaxActiveBlocksPerMultiprocessor(&per_cu, (const void*)hybrid_fwd, NTH, LDS_BYTES);
        if (per_cu < 1) per_cu = 1;
        if (per_cu > 1) per_cu = 1;
        grid_blocks = cus * per_cu;
    }
    if (grid_blocks < 0) return;
    hipMemsetAsync((char*)d_ws + WS_CTR, 0, 4096 + 80 * 256, stream);
    Params p{};
    const float** f = (const float**)&p;
    for (int i = 0; i < 24; ++i) f[i] = (const float*)d_in[i];
    p.out = (float*)d_out; p.ws = (unsigned char*)d_ws; p.ph_lo = 0; p.ph_hi = 11;
    void* args[] = {&p};
    hipError_t e = hipLaunchCooperativeKernel((const void*)hybrid_fwd, dim3(grid_blocks), dim3(NTH), args, LDS_BYTES, stream);
    if (e != hipSuccess) fprintf(stderr, "cooperative launch failed: %s (grid %d)\n", hipGetErrorString(e), grid_blocks);
}
```

```cpp
#include <hip/hip_runtime.h>
#include <hip/hip_cooperative_groups.h>
#include <cstdio>
#include <cstdint>
namespace cg = cooperative_groups;

typedef unsigned short bf16_t;
typedef short bf16x8 __attribute__((ext_vector_type(8)));
typedef float f32x4 __attribute__((ext_vector_type(4)));
typedef unsigned u32x4 __attribute__((ext_vector_type(4)));
typedef unsigned u32x2 __attribute__((ext_vector_type(2)));

constexpr int NTH = 512;
constexpr int DM = 1024, NPR = 16384, NSA = 512, MROWS = 16896, NBATCH = 136, SEQ = 2048;
constexpr int NIN = 6656, DFF = 4096, ADAW = 6144, INW = 6664;
constexpr int LDS_BYTES = 131072;
constexpr float EPS = 1e-6f;

constexpr size_t O_Y = 0;
constexpr size_t O_POOLP = 17301504;
constexpr size_t O_CP = 17362944;
constexpr size_t O_NP = 19460096;
constexpr size_t O_MP = 19468288;
constexpr size_t O_POOLS = 19468320;
constexpr size_t O_CS = 20451360;
constexpr size_t O_NS = 54005792;
constexpr size_t O_MS = 54136864;

constexpr size_t AL(size_t x) { return (x + 255) & ~(size_t)255; }
constexpr size_t WS_WIN = 0;
constexpr size_t WS_WPG = WS_WIN + AL((size_t)NIN * DM * 2);
constexpr size_t WS_WPO = WS_WPG + AL((size_t)4 * 128 * 128 * 2);
constexpr size_t WS_WMO = WS_WPO + AL((size_t)1024 * 512 * 2);
constexpr size_t WS_WOUT = WS_WMO + AL((size_t)1024 * 1024 * 2);
constexpr size_t WS_W1 = WS_WOUT + AL((size_t)1024 * 1024 * 2);
constexpr size_t WS_W2 = WS_W1 + AL((size_t)4096 * 1024 * 2);
constexpr size_t WS_ADAP = WS_W2 + AL((size_t)4096 * 1024 * 2);
constexpr size_t WS_ADA = WS_ADAP + AL((size_t)8 * NBATCH * ADAW * 4);
constexpr size_t WS_H = WS_ADA + AL((size_t)NBATCH * ADAW * 4);
constexpr size_t WS_GI = WS_H + AL((size_t)MROWS * DM * 2);
constexpr size_t WS_GF = WS_GI + AL((size_t)MROWS * 4 * 4);
constexpr size_t WS_U = WS_GF + AL((size_t)MROWS * 4 * 4);
constexpr size_t WS_QKV = WS_U + AL((size_t)MROWS * 512 * 4);
constexpr size_t WS_CST = WS_QKV + AL((size_t)6 * MROWS * DM * 2);
constexpr size_t WS_NST = WS_CST + AL((size_t)MROWS * DFF * 2);
constexpr size_t WS_MST = WS_NST + AL((size_t)32 * 32 * 256 * 4);
constexpr size_t WS_YP = WS_MST + AL((size_t)32 * 64 * 4);
constexpr size_t WS_HM = WS_YP + AL((size_t)MROWS * 512 * 2);
constexpr size_t WS_GW = WS_HM + AL((size_t)MROWS * DM * 2);
constexpr size_t WS_CTR = WS_GW + AL((size_t)1024 * 8 * 4);
constexpr size_t WS_XCNT = WS_CTR + 4096;
constexpr size_t WS_RSB = WS_XCNT + 80 * 256;
constexpr size_t WS_RSS = WS_RSB + AL((size_t)NPR * 4 * 4);
constexpr size_t WS_END = WS_RSS + AL((size_t)NSA * 16 * 4);
static_assert((size_t)32 * 31 * 65536 * 2 <= (size_t)MROWS * DFF * 2, "Cst fits in act region");
static_assert(WS_END <= (size_t)536870912, "workspace map exceeds 512 MiB");

struct Params {
    const float *x_p, *x_s, *st_pool, *st_C, *st_n, *st_m, *c_p, *c_s, *g_mix, *g_ffn, *w_ada, *b_ada, *w_in, *b_i, *b_f, *w_pg, *pool_scale, *w_po, *m_norm, *w_mo, *w_out, *w1, *w2, *g_final;
    float* out; unsigned char* ws; int ph_lo, ph_hi;
};

typedef float f32x2 __attribute__((ext_vector_type(2)));
typedef __bf16 bf16x2_t __attribute__((ext_vector_type(2)));
__device__ __forceinline__ unsigned pk_bf16(float lo, float hi) { f32x2 v = {lo, hi}; bf16x2_t b = __builtin_convertvector(v, bf16x2_t); return __builtin_bit_cast(unsigned, b); }
__device__ __forceinline__ float bf2f(unsigned v) { return __uint_as_float(v << 16); }
__device__ __forceinline__ float bflo(unsigned v) { return __uint_as_float(v << 16); }
__device__ __forceinline__ float bfhi(unsigned v) { return __uint_as_float(v & 0xffff0000u); }
__device__ __forceinline__ bf16_t f2bf(float f) { return (bf16_t)(pk_bf16(f, 0.f) & 0xffffu); }
__device__ __forceinline__ float sigmoidf_(float x) { return __builtin_amdgcn_rcpf(1.f + __expf(-x)); }
__device__ __forceinline__ int row_batch(int row) { return row < NPR ? (row >> 11) : 8 + ((row - NPR) >> 2); }
__device__ __forceinline__ float wave_sum(float v) {
#pragma unroll
    for (int d = 32; d >= 1; d >>= 1) v += __shfl_xor(v, d);
    return v;
}
__device__ __forceinline__ float wave_max(float v) {
#pragma unroll
    for (int d = 32; d >= 1; d >>= 1) v = fmaxf(v, __shfl_xor(v, d));
    return v;
}
__device__ __forceinline__ float wave_scan_add(float v, int lane) {
#pragma unroll
    for (int d = 1; d < 64; d <<= 1) { float t = __shfl_up(v, d); if (lane >= d) v += t; }
    return v;
}
__device__ __forceinline__ float wave_scan_max(float v, int lane) {
#pragma unroll
    for (int d = 1; d < 64; d <<= 1) { float t = __shfl_up(v, d); if (lane >= d) v = fmaxf(v, t); }
    return v;
}
__device__ __forceinline__ int otid() { int t = threadIdx.x; asm volatile("" : "+v"(t)); return t; }
#define MFMA16(a, b, c) __builtin_amdgcn_mfma_f32_16x16x32_bf16((a), (b), (c), 0, 0, 0)

#define LAS __attribute__((address_space(3)))
constexpr int BM = 256, BK = 64, HALF = 128, HTB = HALF * BK * 2, NXCD = 8, WGM = 8;
__device__ __forceinline__ int lds_byte(int r, int c) {
    const int st = (r >> 4) * 2 + (c >> 5), rr = r & 15, cc = c & 31, ob = rr * 64 + cc * 2;
    return st * 1024 + (ob ^ (((ob >> 9) & 1) << 5));
}
__device__ __forceinline__ void stage_rc(int b, int& R, int& C) {
    const int st = b / 1024, sb = b % 1024, swz = sb ^ (((sb >> 9) & 1) << 5);
    R = (st >> 1) * 16 + swz / 64; C = (st & 1) * 32 + (swz % 64) / 2;
}
__device__ __forceinline__ int perm32(int rho) { const int n = rho >> 4, i = rho & 15; return 8 * (i >> 2) + 4 * n + (i & 3); }
struct Unit { int pm, pn; };
struct StaticOrder {
    int nM, nN, nwg, G, c;
    __device__ void init(int M, int N, int G_, int c_) { nM = M / BM; nN = N / BM; nwg = nM * nN; G = G_; c = c_; }
    __device__ bool next(int i, Unit& u) const {
        const long L = (long)i * G + c; if (L >= nwg) return false;
        int wgid = (int)L; { const int q = nwg / NXCD, r = nwg % NXCD, xcd = wgid % NXCD, off = wgid / NXCD; wgid = (xcd < r ? xcd * (q + 1) : r * (q + 1) + (xcd - r) * q) + off; }
        const int nig = WGM * nN, gid = wgid / nig, fm = gid * WGM, gsz = (nM - fm) < WGM ? (nM - fm) : WGM;
        u.pm = fm + ((wgid % nig) % gsz); u.pn = (wgid % nig) / gsz; return true;
    }
};

#ifndef GEMM_SP2
#define GEMM_SP2 1
#endif
#ifndef GEMM_ALIGN
#define GEMM_ALIGN 1
#endif
template <class Epi, bool FUSED = false, bool SP2 = (GEMM_SP2 != 0), bool ALIGN_EPI = (GEMM_ALIGN != 0)>
__device__ __forceinline__ void gemm_phase(LAS unsigned char* lds, const bf16_t* gA, const bf16_t* gBt, const int N, const int K, const Epi& E, unsigned char* lds_gen = nullptr, const int Mrows = NPR) {
    const int tid = otid(), wid = __builtin_amdgcn_readfirstlane(tid >> 6), lane = tid & 63, wr = wid >> 2, wc = wid & 3, fr = lane & 15, fq = lane >> 4;
    const int nt = K / BK;
    StaticOrder S; S.init(Mrows, N, gridDim.x, blockIdx.x);
    unsigned voffA[2], voffB[2];
#pragma unroll
    for (int i = 0; i < 2; ++i) { int R, C; stage_rc(tid * 16 + i * 8192, R, C); const int Rb = (R & ~31) + perm32(R & 31); voffA[i] = (unsigned)(R * K + C) * 2u; voffB[i] = (unsigned)(Rb * K + C) * 2u; }
    const size_t kstep = (size_t)(BK * 2);
    const size_t hstep = (size_t)HALF * K * 2;
    const size_t tstep = 2 * hstep;
    const unsigned ldsw = (unsigned)wid * 1024u;
    const int aoff = lds_byte(wr * 64 + fr, fq * 8), boff = lds_byte(wc * 32 + fr, fq * 8);
#define PG8_SA(b, h) (((b) * 2 + (h)) * HTB)
#define PG8_SB(b, h) ((4 + (b) * 2 + (h)) * HTB)
#define PG8_STAGE(bufoff, gbase) PG8_STAGEV(bufoff, gbase, voffA)
#define PG8_STAGEB(bufoff, gbase) PG8_STAGEV(bufoff, gbase, voffB)
#define PG8_STAGEV(bufoff, gbase, voff) do { _Pragma("unroll") for (int _i = 0; _i < 2; ++_i) \
        __builtin_amdgcn_global_load_lds((const unsigned*)((const char*)(gbase) + (voff)[_i]), (LAS unsigned*)(lds + (bufoff) + ldsw + _i * 8192), 16, 0, 0); } while (0)
#define PG8_LDA(dst, b, h) do { _Pragma("unroll") for (int m = 0; m < 4; ++m) _Pragma("unroll") for (int k = 0; k < 2; ++k) dst[m][k] = *(const LAS bf16x8*)(lds + PG8_SA(b, h) + aoff + m * 2048 + k * 1024); } while (0)
#define PG8_LDB(dst, b, h) do { _Pragma("unroll") for (int n = 0; n < 2; ++n) _Pragma("unroll") for (int k = 0; k < 2; ++k) dst[n][k] = *(const LAS bf16x8*)(lds + PG8_SB(b, h) + boff + n * 2048 + k * 1024); } while (0)
#define PG8_MMA(ai, bj, At, Bt) do { __builtin_amdgcn_s_setprio(1); _Pragma("unroll") for (int m = 0; m < 4; ++m) _Pragma("unroll") for (int n = 0; n < 2; ++n) _Pragma("unroll") for (int k = 0; k < 2; ++k) \
        acc[ai][bj][m][n] = __builtin_amdgcn_mfma_f32_16x16x32_bf16(Bt[n][k], At[m][k], acc[ai][bj][m][n], 0, 0, 0); __builtin_amdgcn_s_setprio(0); } while (0)
#define PG8_WAIT_V(n) asm volatile("s_waitcnt vmcnt(" #n ")" ::: "memory")
#define PG8_WAIT_L(n) asm volatile("s_waitcnt lgkmcnt(" #n ")" ::: "memory")
#define PG8_BAR __builtin_amdgcn_s_barrier()
#define PG8_SCHED __builtin_amdgcn_sched_barrier(0)
    Unit cur, nxt; int ui = 0;
    if (!S.next(0, cur)) return;
    f32x4 acc[2][2][4][2];
#pragma unroll
    for (int a = 0; a < 2; ++a)
#pragma unroll
        for (int b = 0; b < 2; ++b)
#pragma unroll
            for (int m = 0; m < 4; ++m)
#pragma unroll
                for (int n = 0; n < 2; ++n) acc[a][b][m][n] = (f32x4){0.f, 0.f, 0.f, 0.f};
    bf16x8 At[4][2], B0[2][2], B1[2][2];
    const char* cA = (const char*)gA + (size_t)cur.pm * tstep; const char* cB = (const char*)gBt + (size_t)cur.pn * tstep;
    constexpr bool ALIGN = ALIGN_EPI && !FUSED;
    if constexpr (SP2) {
        PG8_STAGEB(PG8_SB(0, 0), cB); PG8_STAGEB(PG8_SB(0, 1), cB + hstep); PG8_STAGE(PG8_SA(0, 0), cA); PG8_STAGE(PG8_SA(0, 1), cA + hstep);
        if (wr == 1) PG8_BAR;
        PG8_WAIT_V(2); PG8_BAR;
        PG8_STAGEB(PG8_SB(1, 0), cB + kstep); PG8_STAGE(PG8_SA(1, 0), cA + kstep); PG8_STAGEB(PG8_SB(1, 1), cB + hstep + kstep);
        PG8_WAIT_V(6); PG8_BAR;
    } else {
        PG8_STAGEB(PG8_SB(0, 0), cB); PG8_STAGE(PG8_SA(0, 0), cA); PG8_STAGEB(PG8_SB(0, 1), cB + hstep); PG8_STAGE(PG8_SA(0, 1), cA + hstep);
        if (wr == 1) PG8_BAR;
        PG8_WAIT_V(4); PG8_BAR;
        PG8_STAGEB(PG8_SB(1, 0), cB + kstep); PG8_STAGE(PG8_SA(1, 0), cA + kstep); PG8_STAGEB(PG8_SB(1, 1), cB + hstep + kstep);
        PG8_WAIT_V(6); PG8_BAR;
    }
    for (;;) {
        const bool has_next = S.next(ui + 1, nxt);
        const char* nA = has_next ? (const char*)gA + (size_t)nxt.pm * tstep : cA; const char* nB = has_next ? (const char*)gBt + (size_t)nxt.pn * tstep : cB;
        for (int t = 0; t < nt; t += 2) {
            const bool last = (t == nt - 2);
            const char* a1 = cA + (size_t)(t + 1) * kstep;
            const char* a2 = last ? nA : cA + (size_t)(t + 2) * kstep; const char* b2 = last ? nB : cB + (size_t)(t + 2) * kstep;
            const char* a3 = a2 + kstep; const char* b3 = b2 + kstep;
            if constexpr (SP2) {
            PG8_LDB(B0, 0, 0); PG8_LDB(B1, 0, 1); PG8_SCHED; PG8_LDA(At, 0, 0); PG8_STAGE(PG8_SA(1, 1), a1 + hstep);
            PG8_WAIT_V(8); PG8_WAIT_L(0); PG8_BAR; PG8_MMA(0, 0, At, B0); PG8_MMA(0, 1, At, B1); PG8_BAR; PG8_SCHED;
            PG8_LDA(At, 0, 1); PG8_STAGEB(PG8_SB(0, 0), b2); PG8_STAGEB(PG8_SB(0, 1), b2 + hstep); PG8_STAGE(PG8_SA(0, 0), a2);
            PG8_WAIT_V(8); PG8_WAIT_L(0); PG8_BAR; PG8_MMA(1, 0, At, B0); PG8_MMA(1, 1, At, B1); PG8_BAR; PG8_SCHED;
            PG8_LDB(B0, 1, 0); PG8_LDB(B1, 1, 1); PG8_SCHED; PG8_LDA(At, 1, 0); PG8_STAGE(PG8_SA(0, 1), a2 + hstep);
            PG8_WAIT_V(8); PG8_WAIT_L(0); PG8_BAR; PG8_MMA(0, 0, At, B0); PG8_MMA(0, 1, At, B1); PG8_BAR; PG8_SCHED;
            PG8_LDA(At, 1, 1); PG8_STAGEB(PG8_SB(1, 0), b3); PG8_STAGEB(PG8_SB(1, 1), b3 + hstep); PG8_STAGE(PG8_SA(1, 0), a3);
            PG8_WAIT_V(8); PG8_WAIT_L(0); PG8_BAR; PG8_MMA(1, 0, At, B0); PG8_MMA(1, 1, At, B1); PG8_BAR; PG8_SCHED;
            } else {
            PG8_LDB(B0, 0, 0); PG8_SCHED; PG8_LDA(At, 0, 0); PG8_STAGE(PG8_SA(1, 1), a1 + hstep);
            PG8_WAIT_L(8); PG8_BAR; PG8_WAIT_L(0); PG8_MMA(0, 0, At, B0); PG8_BAR; PG8_SCHED;
            PG8_LDB(B1, 0, 1); PG8_STAGEB(PG8_SB(0, 0), b2);
            PG8_BAR; PG8_WAIT_L(0); PG8_MMA(0, 1, At, B1); PG8_BAR;
            PG8_LDA(At, 0, 1); PG8_STAGE(PG8_SA(0, 0), a2);
            PG8_BAR; PG8_WAIT_L(0); PG8_MMA(1, 0, At, B0); PG8_BAR; PG8_SCHED;
            PG8_STAGEB(PG8_SB(0, 1), b2 + hstep);
            PG8_WAIT_V(6); PG8_BAR; PG8_MMA(1, 1, At, B1); PG8_BAR;
            PG8_LDB(B0, 1, 0); PG8_SCHED; PG8_LDA(At, 1, 0); PG8_STAGE(PG8_SA(0, 1), a2 + hstep);
            PG8_WAIT_L(8); PG8_BAR; PG8_WAIT_L(0); PG8_MMA(0, 0, At, B0); PG8_BAR; PG8_SCHED;
            PG8_LDB(B1, 1, 1); PG8_STAGEB(PG8_SB(1, 0), b3);
            PG8_BAR; PG8_WAIT_L(0); PG8_MMA(0, 1, At, B1); PG8_BAR;
            PG8_LDA(At, 1, 1); PG8_STAGE(PG8_SA(1, 0), a3);
            PG8_BAR; PG8_WAIT_L(0); PG8_MMA(1, 0, At, B0); PG8_BAR; PG8_SCHED;
            PG8_STAGEB(PG8_SB(1, 1), b3 + hstep);
            PG8_WAIT_V(6); PG8_BAR; PG8_MMA(1, 1, At, B1); PG8_BAR;
            }
        }
        if constexpr (ALIGN) { if (wr == 0) PG8_BAR; }
        if constexpr (!FUSED) { const int r0 = cur.pm * BM + wr * 64 + fr, c0 = cur.pn * BM + wc * 32 + fq * 8;
#pragma unroll
          for (int ai = 0; ai < 2; ++ai)
#pragma unroll
            for (int m = 0; m < 4; ++m)
#pragma unroll
              for (int bj = 0; bj < 2; ++bj) E.apply8(r0 + ai * 128 + m * 16, c0 + bj * 128, acc[ai][bj][m][0], acc[ai][bj][m][1]); }
        if (!has_next) break;
#pragma unroll
        for (int a = 0; a < 2; ++a)
#pragma unroll
            for (int b = 0; b < 2; ++b)
#pragma unroll
                for (int m = 0; m < 4; ++m)
#pragma unroll
                    for (int n = 0; n < 2; ++n) acc[a][b][m][n] = (f32x4){0.f, 0.f, 0.f, 0.f};
        cur = nxt; cA = nA; cB = nB; ++ui;
        if constexpr (ALIGN) { if (wr == 1) PG8_BAR; }
    }
    PG8_WAIT_V(0);
    if constexpr (!ALIGN) { if (wr == 0) PG8_BAR; }
    PG8_BAR;
    if constexpr (FUSED) E.fused(acc, cur, wr, wc, fr, fq, lds_gen);
#undef PG8_SA
#undef PG8_SB
#undef PG8_STAGE
#undef PG8_STAGEB
#undef PG8_STAGEV
#undef PG8_LDA
#undef PG8_LDB
#undef PG8_MMA
#undef PG8_WAIT_V
#undef PG8_WAIT_L
#undef PG8_BAR
#undef PG8_SCHED
}

struct EpiG1 {
    float* u; bf16_t* qkv;
    __device__ __forceinline__ void apply(int row, int col, f32x4 v) const {
        const int bcol = col & ~255;
        const int seg = bcol < 512 ? 0 : 1 + ((bcol - 512) >> 10);
        if (seg == 0) { *(f32x4*)(u + (size_t)row * 512 + col) = v; }
        else {
            const int cc = col - 512 - (seg - 1) * 1024;
            if (seg == 2) v *= 0.0625f;
            if (seg >= 4) { v[0] = sigmoidf_(v[0]); v[1] = sigmoidf_(v[1]); v[2] = sigmoidf_(v[2]); v[3] = sigmoidf_(v[3]); }
            u32x2 w; w.x = pk_bf16(v[0], v[1]); w.y = pk_bf16(v[2], v[3]);
            *(u32x2*)(qkv + (size_t)(seg - 1) * MROWS * DM + (size_t)row * DM + cc) = w;
        }
    }
    __device__ __forceinline__ void apply8(int row, int col, f32x4 v0, f32x4 v1) const {
        const int bcol = col & ~255;
        const int seg = bcol < 512 ? 0 : 1 + ((bcol - 512) >> 10);
        if (seg == 0) { *(f32x4*)(u + (size_t)row * 512 + col) = v0; *(f32x4*)(u + (size_t)row * 512 + col + 4) = v1; }
        else {
            const int cc = col - 512 - (seg - 1) * 1024;
            if (seg == 2) { v0 *= 0.0625f; v1 *= 0.0625f; }
            if (seg >= 4) {
#pragma unroll
                for (int j = 0; j < 4; ++j) { v0[j] = sigmoidf_(v0[j]); v1[j] = sigmoidf_(v1[j]); } }
            u32x4 w; w.x = pk_bf16(v0[0], v0[1]); w.y = pk_bf16(v0[2], v0[3]); w.z = pk_bf16(v1[0], v1[1]); w.w = pk_bf16(v1[2], v1[3]);
            *(u32x4*)(qkv + (size_t)(seg - 1) * MROWS * DM + (size_t)row * DM + cc) = w;
        }
    }
};
struct EpiMerge {
    bf16_t* merged; const bf16_t* sg; int mode;
    __device__ __forceinline__ void apply(int row, int col, f32x4 v) const {
        const size_t idx = (size_t)row * DM + col;
        const u32x2 g = *(const u32x2*)(sg + idx);
        v[0] *= bflo(g.x); v[1] *= bfhi(g.x); v[2] *= bflo(g.y); v[3] *= bfhi(g.y);
        if (mode) { const u32x2 o = *(const u32x2*)(merged + idx); v[0] += bflo(o.x); v[1] += bfhi(o.x); v[2] += bflo(o.y); v[3] += bfhi(o.y); }
        u32x2 w; w.x = pk_bf16(v[0], v[1]); w.y = pk_bf16(v[2], v[3]);
        *(u32x2*)(merged + idx) = w;
    }
    __device__ __forceinline__ void apply8(int row, int col, f32x4 v0, f32x4 v1) const {
        const size_t idx = (size_t)row * DM + col;
        const u32x4 g = *(const u32x4*)(sg + idx);
        v0[0] *= bflo(g.x); v0[1] *= bfhi(g.x); v0[2] *= bflo(g.y); v0[3] *= bfhi(g.y); v1[0] *= bflo(g.z); v1[1] *= bfhi(g.z); v1[2] *= bflo(g.w); v1[3] *= bfhi(g.w);
        if (mode) { const u32x4 o = *(const u32x4*)(merged + idx); v0[0] += bflo(o.x); v0[1] += bfhi(o.x); v0[2] += bflo(o.y); v0[3] += bfhi(o.y); v1[0] += bflo(o.z); v1[1] += bfhi(o.z); v1[2] += bflo(o.w); v1[3] += bfhi(o.w); }
        u32x4 w; w.x = pk_bf16(v0[0], v0[1]); w.y = pk_bf16(v0[2], v0[3]); w.z = pk_bf16(v1[0], v1[1]); w.w = pk_bf16(v1[2], v1[3]);
        *(u32x4*)(merged + idx) = w;
    }
};
struct EpiRes {
    float* out; const float* xp; const float* xs; const float* ada; int gate_off; int xin;
    __device__ __forceinline__ void apply(int row, int col, f32x4 v) const {
        const f32x4 g = *(const f32x4*)(ada + (size_t)row_batch(row) * ADAW + gate_off + col);
        const float* bp = xin ? (row < NPR ? xp + (size_t)row * DM : xs + (size_t)(row - NPR) * DM) : out + (size_t)row * DM;
        const f32x4 b = *(const f32x4*)(bp + col);
        *(f32x4*)(out + (size_t)row * DM + col) = b + g * v;
    }
    __device__ __forceinline__ void apply8(int row, int col, f32x4 v0, f32x4 v1) const { apply(row, col, v0); apply(row, col + 4, v1); }
};
struct EpiAct {
    bf16_t* act;
    __device__ __forceinline__ void apply(int row, int col, f32x4 v) const {
#pragma unroll
        for (int j = 0; j < 4; ++j) { float t = fmaxf(v[j], 0.f); v[j] = t * t; }
        u32x2 w; w.x = pk_bf16(v[0], v[1]); w.y = pk_bf16(v[2], v[3]);
        *(u32x2*)(act + (size_t)row * DFF + col) = w;
    }
    __device__ __forceinline__ void apply8(int row, int col, f32x4 v0, f32x4 v1) const {
#pragma unroll
        for (int j = 0; j < 4; ++j) { float t0 = fmaxf(v0[j], 0.f); v0[j] = t0 * t0; float t1 = fmaxf(v1[j], 0.f); v1[j] = t1 * t1; }
        u32x4 w; w.x = pk_bf16(v0[0], v0[1]); w.y = pk_bf16(v0[2], v0[3]); w.z = pk_bf16(v1[0], v1[1]); w.w = pk_bf16(v1[2], v1[3]);
        *(u32x4*)(act + (size_t)row * DFF + col) = w;
    }
};

__device__ __forceinline__ void xchg_publish_wait(unsigned* cnt, unsigned need) {
    asm volatile("s_waitcnt vmcnt(0)" ::: "memory");
    __syncthreads();
    if (threadIdx.x == 0) {
        __builtin_amdgcn_fence(__ATOMIC_RELEASE, "agent");
        asm volatile("s_waitcnt vmcnt(0)" ::: "memory");
        __hip_atomic_fetch_add(cnt, 1u, __ATOMIC_RELAXED, __HIP_MEMORY_SCOPE_AGENT);
        unsigned spins = 0;
        while (__hip_atomic_load(cnt, __ATOMIC_RELAXED, __HIP_MEMORY_SCOPE_AGENT) < need) { __builtin_amdgcn_s_sleep(1); if (++spins > (1u << 24)) break; }
        __builtin_amdgcn_fence(__ATOMIC_ACQUIRE, "agent");
        asm volatile("s_waitcnt vmcnt(0)" ::: "memory");
    }
    __syncthreads();
}
extern __shared__ __attribute__((aligned(16))) unsigned char g_dyn_lds[];
struct EpiFinal {
    float* out; const float* ada; const float* gfin; float* rowpart; unsigned* cnt; float* rowpartS; unsigned* cntS;
    __device__ __forceinline__ void apply(int, int, f32x4) const {}
    __device__ __forceinline__ void apply8(int, int, f32x4, f32x4) const {}
    __device__ __forceinline__ void fused(f32x4 (&acc)[2][2][4][2], const Unit& u, int wr, int wc, int fr, int fq, unsigned char* lds) const {
        const int tid = otid();
        (void)lds;
        float* P = (float*)g_dyn_lds;
        float* S = P + 1024;
        const int r0 = u.pm * BM + wr * 64 + fr, c0 = u.pn * BM + wc * 32 + fq * 8;
#pragma unroll
        for (int ai = 0; ai < 2; ++ai)
#pragma unroll
            for (int m = 0; m < 4; ++m) {
                const int row = r0 + ai * 128 + m * 16;
                const float* ga = ada + (size_t)row_batch(row) * ADAW + 5120;
                float ss = 0.f;
#pragma unroll
                for (int bj = 0; bj < 2; ++bj)
#pragma unroll
                    for (int n = 0; n < 2; ++n) {
                        const int col = c0 + bj * 128 + n * 4;
                        const f32x4 g = *(const f32x4*)(ga + col);
                        const f32x4 b = *(const f32x4*)(out + (size_t)row * DM + col);
                        const f32x4 v = b + g * acc[ai][bj][m][n];
                        acc[ai][bj][m][n] = v;
                        ss += v[0] * v[0] + v[1] * v[1] + v[2] * v[2] + v[3] * v[3];
                    }
                ss += __shfl_xor(ss, 16); ss += __shfl_xor(ss, 32);
                if (fq == 0) P[(ai * 128 + wr * 64 + m * 16 + fr) * 4 + wc] = ss;
                asm volatile("" ::: "memory");
            }
        __syncthreads();
        if (tid < 256) rowpart[((size_t)u.pm * BM + tid) * 4 + u.pn] = (P[tid * 4] + P[tid * 4 + 1]) + (P[tid * 4 + 2] + P[tid * 4 + 3]);
        xchg_publish_wait(cnt + u.pm * 64, 8u);
        if (tid < 256) { const f32x4 rp = *(const f32x4*)(rowpart + ((size_t)u.pm * BM + tid) * 4); S[tid] = rsqrtf(((rp[0] + rp[1]) + (rp[2] + rp[3])) * (1.0f / DM) + EPS); }
        __syncthreads();
#pragma unroll
        for (int ai = 0; ai < 2; ++ai)
#pragma unroll
            for (int m = 0; m < 4; ++m) {
                const int row = r0 + ai * 128 + m * 16;
                const float rs = S[ai * 128 + wr * 64 + m * 16 + fr];
#pragma unroll
                for (int bj = 0; bj < 2; ++bj)
#pragma unroll
                    for (int n = 0; n < 2; ++n) {
                        const int col = c0 + bj * 128 + n * 4;
                        const f32x4 gf = *(const f32x4*)(gfin + col);
                        __builtin_nontemporal_store(acc[ai][bj][m][n] * rs * gf, (f32x4*)(out + (size_t)row * DM + col));
                    }
            }
        __syncthreads();
    }
};

struct EpiMid {
    float* out; const float* xp; const float* xs; const float* ada; const float* gffn; bf16_t* hbuf; float* rowpart; unsigned* cnt; float* rowpartS; unsigned* cntS;
    __device__ __forceinline__ void apply(int, int, f32x4) const {}
    __device__ __forceinline__ void apply8(int, int, f32x4, f32x4) const {}
    __device__ __forceinline__ void fused(f32x4 (&acc)[2][2][4][2], const Unit& u, int wr, int wc, int fr, int fq, unsigned char*) const {
        const int tid = otid();
        float* P = (float*)g_dyn_lds;
        float* S = P + 1024;
        const int r0 = u.pm * BM + wr * 64 + fr, c0 = u.pn * BM + wc * 32 + fq * 8;
#pragma unroll
        for (int ai = 0; ai < 2; ++ai)
#pragma unroll
            for (int m = 0; m < 4; ++m) {
                const int row = r0 + ai * 128 + m * 16;
                const float* ga = ada + (size_t)(row >> 11) * ADAW + 2048;
                float ss = 0.f;
#pragma unroll
                for (int bj = 0; bj < 2; ++bj)
#pragma unroll
                    for (int n = 0; n < 2; ++n) {
                        const int col = c0 + bj * 128 + n * 4;
                        const f32x4 g = *(const f32x4*)(ga + col);
                        const f32x4 b = *(const f32x4*)(xp + (size_t)row * DM + col);
                        const f32x4 v = b + g * acc[ai][bj][m][n];
                        acc[ai][bj][m][n] = v;
                        *(f32x4*)(out + (size_t)row * DM + col) = v;
                        ss += v[0] * v[0] + v[1] * v[1] + v[2] * v[2] + v[3] * v[3];
                    }
                ss += __shfl_xor(ss, 16); ss += __shfl_xor(ss, 32);
                if (fq == 0) P[(ai * 128 + wr * 64 + m * 16 + fr) * 4 + wc] = ss;
                asm volatile("" ::: "memory");
            }
        __syncthreads();
        if (tid < 256) rowpart[((size_t)u.pm * BM + tid) * 4 + u.pn] = (P[tid * 4] + P[tid * 4 + 1]) + (P[tid * 4 + 2] + P[tid * 4 + 3]);
        xchg_publish_wait(cnt + u.pm * 64, 4u);
        if (tid < 256) { const f32x4 rp = *(const f32x4*)(rowpart + ((size_t)u.pm * BM + tid) * 4); S[tid] = rsqrtf(((rp[0] + rp[1]) + (rp[2] + rp[3])) * (1.0f / DM) + EPS); }
        __syncthreads();
        const float* ab = ada + (size_t)(r0 >> 11) * ADAW;
#pragma unroll
        for (int bj = 0; bj < 2; ++bj) {
            const int col = c0 + bj * 128;
            f32x4 G0 = *(const f32x4*)(gffn + col), G1 = *(const f32x4*)(gffn + col + 4);
            G0 *= (*(const f32x4*)(ab + 4096 + col) + 1.0f); G1 *= (*(const f32x4*)(ab + 4096 + col + 4) + 1.0f);
            const f32x4 S0 = *(const f32x4*)(ab + 3072 + col), S1 = *(const f32x4*)(ab + 3072 + col + 4);
#pragma unroll
            for (int ai = 0; ai < 2; ++ai)
#pragma unroll
                for (int m = 0; m < 4; ++m) {
                    const int row = r0 + ai * 128 + m * 16;
                    const float rs = S[ai * 128 + wr * 64 + m * 16 + fr];
                    const f32x4 h0 = acc[ai][bj][m][0] * rs * G0 + S0, h1 = acc[ai][bj][m][1] * rs * G1 + S1;
                    u32x4 w; w.x = pk_bf16(h0[0], h0[1]); w.y = pk_bf16(h0[2], h0[3]); w.z = pk_bf16(h1[0], h1[1]); w.w = pk_bf16(h1[2], h1[3]);
                    *(u32x4*)(hbuf + (size_t)row * DM + col) = w;
                }
        }
        __syncthreads();
    }
};

template <class Epi, int FIN = 0>
__device__ __forceinline__ void small_gemm_phase(unsigned char* lds, const bf16_t* gA, const bf16_t* gBt, const int N, const int K, const Epi& E, const int t_begin, const int t_end) {
    int tid_ = threadIdx.x; asm volatile("" : "+v"(tid_));
    const int tid = tid_, lane = tid & 63, w = tid >> 6, fr = lane & 15, fq = lane >> 4;
    const int kw = K / 8;
    float* red = (float*)lds;
    for (int t = t_begin; t < t_end; ++t) {
        const int rt = t & 15, ct = t >> 4;
        const int row0 = NPR + rt * 32, col0 = ct * 64;
        const bf16_t* ap = gA + (size_t)(row0 + fr) * K + w * kw + fq * 8;
        const bf16_t* bp = gBt + (size_t)(col0 + fr) * K + w * kw + fq * 8;
        f32x4 acc[2][4] = {};
#pragma unroll 2
        for (int k0 = 0; k0 < kw; k0 += 64) {
            bf16x8 af[2][2], bfm[2][4];
#pragma unroll
            for (int s2 = 0; s2 < 2; ++s2) {
#pragma unroll
                for (int m = 0; m < 2; ++m) af[s2][m] = *(const bf16x8*)(ap + (size_t)m * 16 * K + k0 + s2 * 32);
#pragma unroll
                for (int n = 0; n < 4; ++n) bfm[s2][n] = *(const bf16x8*)(bp + (size_t)n * 16 * K + k0 + s2 * 32);
            }
#pragma unroll
            for (int s2 = 0; s2 < 2; ++s2)
#pragma unroll
                for (int m = 0; m < 2; ++m)
#pragma unroll
                    for (int n = 0; n < 4; ++n) acc[m][n] = MFMA16(bfm[s2][n], af[s2][m], acc[m][n]);
        }
#pragma unroll
        for (int m = 0; m < 2; ++m)
#pragma unroll
            for (int n = 0; n < 4; ++n) *(f32x4*)(red + ((w * 32 + m * 16 + fr) * 64 + n * 16 + fq * 4)) = acc[m][n];
        __syncthreads();
        {
            const int r = tid >> 4, c4 = (tid & 15) * 4;
            f32x4 v = *(const f32x4*)(red + (r * 64 + c4));
#pragma unroll
            for (int ww = 1; ww < 8; ++ww) v += *(const f32x4*)(red + ((ww * 32 + r) * 64 + c4));
            if constexpr (FIN == 0) E.apply(row0 + r, col0 + c4, v);
            else if constexpr (FIN == 2) {
                const int row = row0 + r, col = col0 + c4;
                const float* ab = E.ada + (size_t)row_batch(row) * ADAW;
                const f32x4 g = *(const f32x4*)(ab + 2048 + col);
                const f32x4 b = *(const f32x4*)(E.xs + (size_t)(row - NPR) * DM + col);
                const f32x4 x1 = b + g * v;
                *(f32x4*)(E.out + (size_t)row * DM + col) = x1;
                float ss = x1[0] * x1[0] + x1[1] * x1[1] + x1[2] * x1[2] + x1[3] * x1[3];
                ss += __shfl_xor(ss, 1); ss += __shfl_xor(ss, 2); ss += __shfl_xor(ss, 4); ss += __shfl_xor(ss, 8);
                if ((tid & 15) == 0) E.rowpartS[(size_t)(row - NPR) * 16 + ct] = ss;
                xchg_publish_wait(E.cntS + rt * 64, 16u);
                const float* rp = E.rowpartS + (size_t)(row - NPR) * 16;
                float tot = 0.f;
#pragma unroll
                for (int q = 0; q < 16; q += 4) { const f32x4 t4 = *(const f32x4*)(rp + q); tot += (t4[0] + t4[1]) + (t4[2] + t4[3]); }
                const float rs = rsqrtf(tot * (1.0f / DM) + EPS);
                const f32x4 G = *(const f32x4*)(E.gffn + col) * (*(const f32x4*)(ab + 4096 + col) + 1.0f);
                const f32x4 h = x1 * rs * G + *(const f32x4*)(ab + 3072 + col);
                u32x2 wv; wv.x = pk_bf16(h[0], h[1]); wv.y = pk_bf16(h[2], h[3]);
                *(u32x2*)(E.hbuf + (size_t)row * DM + col) = wv;
            }
            else {
                const int row = row0 + r, col = col0 + c4;
                const f32x4 g = *(const f32x4*)(E.ada + (size_t)row_batch(row) * ADAW + 5120 + col);
                const f32x4 b = *(const f32x4*)(E.out + (size_t)row * DM + col);
                const f32x4 x2 = b + g * v;
                float ss = x2[0] * x2[0] + x2[1] * x2[1] + x2[2] * x2[2] + x2[3] * x2[3];
                ss += __shfl_xor(ss, 1); ss += __shfl_xor(ss, 2); ss += __shfl_xor(ss, 4); ss += __shfl_xor(ss, 8);
                if ((tid & 15) == 0) E.rowpartS[(size_t)(row - NPR) * 16 + ct] = ss;
                xchg_publish_wait(E.cntS + rt * 64, 32u);
                const float* rp = E.rowpartS + (size_t)(row - NPR) * 16;
                float tot = 0.f;
#pragma unroll
                for (int q = 0; q < 16; q += 4) { const f32x4 t4 = *(const f32x4*)(rp + q); tot += (t4[0] + t4[1]) + (t4[2] + t4[3]); }
                const float rs = rsqrtf(tot * (1.0f / DM) + EPS);
                const f32x4 gf = *(const f32x4*)(E.gfin + col);
                *(f32x4*)(E.out + (size_t)row * DM + col) = x2 * rs * gf;
            }
        }
        __syncthreads();
    }
}

__device__ __forceinline__ void conv_tile(const float* __restrict__ src, int ld, int K, bf16_t* __restrict__ dst, int kt, int ntile, int src_col0, float* lds) {
    const int tid = otid();
    const int k0 = kt * 64, n0 = ntile * 64;
#pragma unroll
    for (int i = 0; i < 2; ++i) {
        const int r = (tid >> 4) + i * 32, c4 = (tid & 15) * 4;
        const f32x4 v = *(const f32x4*)(src + (size_t)(k0 + r) * ld + src_col0 + c4);
        lds[r * 65 + c4 + 0] = v[0]; lds[r * 65 + c4 + 1] = v[1]; lds[r * 65 + c4 + 2] = v[2]; lds[r * 65 + c4 + 3] = v[3];
    }
    __syncthreads();
    {
        const int n = tid >> 3, k8 = (tid & 7) * 8;
        float v[8];
#pragma unroll
        for (int i = 0; i < 8; ++i) v[i] = lds[(k8 + i) * 65 + n];
        u32x4 w; w.x = pk_bf16(v[0], v[1]); w.y = pk_bf16(v[2], v[3]); w.z = pk_bf16(v[4], v[5]); w.w = pk_bf16(v[6], v[7]);
        *(u32x4*)(dst + (size_t)(n0 + n) * K + k0 + k8) = w;
    }
    __syncthreads();
}

__device__ __forceinline__ void conv_strip(const float* __restrict__ src, int ld, int K, bf16_t* __restrict__ dst, int kt, int nt4, int src_col0, float* lds) {
    const int tid = otid();
    const int k0 = kt * 64, n0 = nt4 * 256;
    f32x4 v[8];
#pragma unroll
    for (int i = 0; i < 8; ++i) { const int r = (tid >> 6) + i * 8, c4 = (tid & 63) * 4; v[i] = __builtin_nontemporal_load((const f32x4*)(src + (size_t)(k0 + r) * ld + src_col0 + c4)); }
#pragma unroll
    for (int i = 0; i < 8; ++i) { const int r = (tid >> 6) + i * 8, c4 = (tid & 63) * 4;
        lds[r * 257 + c4 + 0] = v[i][0]; lds[r * 257 + c4 + 1] = v[i][1]; lds[r * 257 + c4 + 2] = v[i][2]; lds[r * 257 + c4 + 3] = v[i][3]; }
    __syncthreads();
#pragma unroll
    for (int j = 0; j < 4; ++j) {
        const int n = (tid >> 3) + j * 64, k8 = (tid & 7) * 8;
        float x[8];
#pragma unroll
        for (int i = 0; i < 8; ++i) x[i] = lds[(k8 + i) * 257 + n];
        u32x4 w; w.x = pk_bf16(x[0], x[1]); w.y = pk_bf16(x[2], x[3]); w.z = pk_bf16(x[4], x[5]); w.w = pk_bf16(x[6], x[7]);
        *(u32x4*)(dst + (size_t)(n0 + n) * K + k0 + k8) = w;
    }
    __syncthreads();
}

__device__ __forceinline__ void ada_item(const Params& p, int item, float* lds) {
    const int tid = otid(), lane = tid & 63, w = tid >> 6;
    const int cg_ = item >> 3, kq = item & 7;
    const int n0 = cg_ * 128 + lane * 2;
    const int kbase = kq * 128;
    f32x2 acc[17];
#pragma unroll
    for (int r = 0; r < 17; ++r) acc[r] = (f32x2){0.f, 0.f};
    f32x2 wv[16];
#pragma unroll
    for (int j = 0; j < 16; ++j) wv[j] = __builtin_nontemporal_load((const f32x2*)(p.w_ada + (size_t)(kbase + j) * ADAW + n0));
    for (int e = tid; e < NBATCH * 32; e += NTH) {
        const int r = e >> 5, k4 = (e & 31) * 4;
        const float* cp = r < 8 ? p.c_p + (size_t)r * DM : p.c_s + (size_t)(r - 8) * DM;
        f32x4 v = *(const f32x4*)(cp + kbase + k4);
#pragma unroll
        for (int j = 0; j < 4; ++j) v[j] = v[j] * sigmoidf_(v[j]);
        *(f32x4*)(lds + r * 128 + k4) = v;
    }
    __syncthreads();
#pragma unroll 1
    for (int kb = 0; kb < 128; kb += 16) {
        f32x2 wn[16];
        if (kb + 16 < 128) {
#pragma unroll
            for (int j = 0; j < 16; ++j) wn[j] = __builtin_nontemporal_load((const f32x2*)(p.w_ada + (size_t)(kbase + kb + 16 + j) * ADAW + n0));
        }
#pragma unroll
        for (int r = 0; r < 17; ++r) {
#pragma unroll
            for (int k4 = 0; k4 < 16; k4 += 4) {
                const f32x4 sv = *(const f32x4*)(lds + (w * 17 + r) * 128 + kb + k4);
                acc[r] += wv[k4] * sv[0]; acc[r] += wv[k4 + 1] * sv[1]; acc[r] += wv[k4 + 2] * sv[2]; acc[r] += wv[k4 + 3] * sv[3];
            }
        }
        if (kb + 16 < 128) {
#pragma unroll
            for (int j = 0; j < 16; ++j) wv[j] = wn[j];
        }
    }
    __syncthreads();
    float* part = (float*)(p.ws + WS_ADAP) + (size_t)kq * NBATCH * ADAW;
#pragma unroll
    for (int r = 0; r < 17; ++r) *(f32x2*)(part + (size_t)(w * 17 + r) * ADAW + n0) = acc[r];
}

__device__ __forceinline__ void phase0(const Params& p, float* lds) {
    const int NADA = 48 * 8;
    const int T_IN = 16 * 26, T_PG = 16, T_PO = 8 * 4, T_MO = 64, T_OUT = 64, T_W1 = 16 * 16, T_W2 = 64 * 4;
    const int total = NADA + T_IN + T_PG + T_PO + T_MO + T_OUT + T_W1 + T_W2 + 1;
    unsigned* qctr = (unsigned*)(p.ws + WS_CTR) + 16;
    volatile unsigned* slot = (volatile unsigned*)((unsigned char*)lds + LDS_BYTES - 16);
    for (;;) {
        if (threadIdx.x == 0) *slot = atomicAdd(qctr, 1u);
        __syncthreads();
        const int it = (int)*slot;
        __syncthreads();
        if (it >= total) break;
        int t = it;
        if (t < NADA) { ada_item(p, t, lds); continue; }
        t -= NADA;
        if (t < T_IN) { const int kt = t / 26, nt_ = t % 26; const int n0 = nt_ * 256; const int sc = n0 < 4608 ? n0 : n0 + 8;
            conv_strip(p.w_in, INW, DM, (bf16_t*)(p.ws + WS_WIN), kt, nt_, sc, lds); continue; }
        t -= T_IN;
        if (t < T_PG) { const int g = t >> 2, kt = (t >> 1) & 1, nt_ = t & 1;
            conv_tile(p.w_pg + (size_t)g * 128 * 128, 128, 128, (bf16_t*)(p.ws + WS_WPG) + (size_t)g * 128 * 128, kt, nt_, nt_ * 64, lds); continue; }
        t -= T_PG;
        if (t < T_PO) { const int kt = t / 4, nt_ = t % 4; conv_strip(p.w_po, 1024, 512, (bf16_t*)(p.ws + WS_WPO), kt, nt_, nt_ * 256, lds); continue; }
        t -= T_PO;
        if (t < T_MO) { const int kt = t / 4, nt_ = t % 4; conv_strip(p.w_mo, 1024, 1024, (bf16_t*)(p.ws + WS_WMO), kt, nt_, nt_ * 256, lds); continue; }
        t -= T_MO;
        if (t < T_OUT) { const int kt = t / 4, nt_ = t % 4; conv_strip(p.w_out, 1024, 1024, (bf16_t*)(p.ws + WS_WOUT), kt, nt_, nt_ * 256, lds); continue; }
        t -= T_OUT;
        if (t < T_W1) { const int kt = t / 16, nt_ = t % 16; conv_strip(p.w1, 4096, 1024, (bf16_t*)(p.ws + WS_W1), kt, nt_, nt_ * 256, lds); continue; }
        t -= T_W1;
        if (t < T_W2) { const int kt = t / 4, nt_ = t % 4; conv_strip(p.w2, 1024, 4096, (bf16_t*)(p.ws + WS_W2), kt, nt_, nt_ * 256, lds); continue; }
        for (int e = threadIdx.x; e < 1024 * 2; e += NTH) { const int k = e >> 1, hf = e & 1;
            *(f32x4*)((float*)(p.ws + WS_GW) + k * 8 + hf * 4) = *(const f32x4*)(p.w_in + (size_t)k * INW + 4608 + hf * 4); }
    }
}

__device__ __forceinline__ void norm_item(const Params& p, int item, int mode, float* lds) {
    const int tid = otid(), lane = tid & 63, w = tid >> 6;
    const float* adap = (const float*)(p.ws + WS_ADAP);
    const float* adaf = (const float*)(p.ws + WS_ADA);
    bf16_t* hbuf = (bf16_t*)(p.ws + WS_H);
    if (mode == 0) {
        for (int e = tid; e < 1024 * 2; e += NTH) *(f32x4*)(lds + e * 4) = *(const f32x4*)((const float*)(p.ws + WS_GW) + e * 4);
        __syncthreads();
    }
    const int r_begin = item * 64 + w * 8;
    const int r_extra = NPR + item * 2 + w;
    const int nrows = w < 2 ? 9 : 8;
    int cur_b = -1;
    f32x4 G[4], S[4], xn[4];
    { const int row = r_begin; const float* src0 = mode == 0 ? (row < NPR ? p.x_p + (size_t)row * DM : p.x_s + (size_t)(row - NPR) * DM) : p.out + (size_t)row * DM;
#pragma unroll
      for (int i = 0; i < 4; ++i) xn[i] = *(const f32x4*)(src0 + i * 256 + lane * 4); }
    for (int rr = 0; rr < nrows; ++rr) {
        const int row = rr < 8 ? r_begin + rr : r_extra;
        const int b = row_batch(row);
        if (mode != 2 && b != cur_b) {
            cur_b = b;
            const float* gw = mode == 0 ? p.g_mix : p.g_ffn;
            const int sh_off = mode == 0 ? 0 : 3072, sc_off = mode == 0 ? 1024 : 4096;
            f32x4 scv[4], shv[4];
            if (mode == 0) {
#pragma unroll
                for (int i = 0; i < 4; ++i) { const int col = i * 256 + lane * 4; scv[i] = *(const f32x4*)(p.b_ada + sc_off + col); shv[i] = *(const f32x4*)(p.b_ada + sh_off + col); }
#pragma unroll 2
                for (int q = 0; q < 8; ++q) {
                    const float* ap = adap + ((size_t)q * NBATCH + b) * ADAW;
#pragma unroll
                    for (int i = 0; i < 4; ++i) { const int col = i * 256 + lane * 4; scv[i] += *(const f32x4*)(ap + sc_off + col); shv[i] += *(const f32x4*)(ap + sh_off + col); }
                }
            } else {
#pragma unroll
                for (int i = 0; i < 4; ++i) { const int col = i * 256 + lane * 4; scv[i] = *(const f32x4*)(adaf + (size_t)b * ADAW + sc_off + col); shv[i] = *(const f32x4*)(adaf + (size_t)b * ADAW + sh_off + col); }
            }
#pragma unroll
            for (int i = 0; i < 4; ++i) { const f32x4 g = *(const f32x4*)(gw + i * 256 + lane * 4); G[i] = g * (scv[i] + 1.0f); S[i] = shv[i]; }
        }
        f32x4 x[4]; float ss = 0.f;
#pragma unroll
        for (int i = 0; i < 4; ++i) { x[i] = xn[i]; ss += x[i][0] * x[i][0] + x[i][1] * x[i][1] + x[i][2] * x[i][2] + x[i][3] * x[i][3]; }
        if (rr + 1 < nrows) { const int rown = rr + 1 < 8 ? row + 1 : r_extra;
            const float* srcn = mode == 0 ? (rown < NPR ? p.x_p + (size_t)rown * DM : p.x_s + (size_t)(rown - NPR) * DM) : p.out + (size_t)rown * DM;
#pragma unroll
            for (int i = 0; i < 4; ++i) xn[i] = *(const f32x4*)(srcn + i * 256 + lane * 4); }
        ss = wave_sum(ss);
        const float rstd = rsqrtf(ss * (1.0f / DM) + EPS);
        if (mode == 2) {
#pragma unroll
            for (int i = 0; i < 4; ++i) { const f32x4 g = *(const f32x4*)(p.g_final + i * 256 + lane * 4); __builtin_nontemporal_store(x[i] * rstd * g, (f32x4*)(p.out + (size_t)row * DM + i * 256 + lane * 4)); }
            continue;
        }
        f32x4 hv[4];
#pragma unroll
        for (int i = 0; i < 4; ++i) { hv[i] = x[i] * rstd * G[i] + S[i];
            u32x2 wv; wv.x = pk_bf16(hv[i][0], hv[i][1]); wv.y = pk_bf16(hv[i][2], hv[i][3]);
            *(u32x2*)(hbuf + (size_t)row * DM + i * 256 + lane * 4) = wv; }
        if (mode == 0) {
            float d[8];
#pragma unroll
            for (int j = 0; j < 8; ++j) d[j] = 0.f;
#pragma unroll
            for (int i = 0; i < 4; ++i)
#pragma unroll
                for (int e = 0; e < 4; ++e) {
                    const int k = i * 256 + lane * 4 + e;
                    const f32x4 w0 = *(const f32x4*)(lds + k * 8), w1 = *(const f32x4*)(lds + k * 8 + 4);
                    const float hvv = hv[i][e];
                    d[0] += hvv * w0[0]; d[1] += hvv * w0[1]; d[2] += hvv * w0[2]; d[3] += hvv * w0[3];
                    d[4] += hvv * w1[0]; d[5] += hvv * w1[1]; d[6] += hvv * w1[2]; d[7] += hvv * w1[3];
                }
#pragma unroll
            for (int j = 0; j < 8; ++j) d[j] = wave_sum(d[j]);
            if (lane < 4) {
                float di = lane == 0 ? d[0] : lane == 1 ? d[1] : lane == 2 ? d[2] : d[3];
                float df = lane == 0 ? d[4] : lane == 1 ? d[5] : lane == 2 ? d[6] : d[7];
                di += p.b_i[lane];
                const float z = df + p.b_f[lane];
                const float lf = fminf(z, 0.f) - log1pf(__expf(-fabsf(z)));
                ((float*)(p.ws + WS_GI))[(size_t)row * 4 + lane] = di;
                ((float*)(p.ws + WS_GF))[(size_t)row * 4 + lane] = lf;
            }
        }
    }
    if (mode == 0) __syncthreads();
}

__device__ __forceinline__ void ada_final_slice(const Params& p, int blk) {
    const float* adap = (const float*)(p.ws + WS_ADAP);
    float* adaf = (float*)(p.ws + WS_ADA);
    for (int e = threadIdx.x; e < 816; e += NTH) {
        const size_t idx = ((size_t)blk * 816 + e) * 4;
        f32x4 v = *(const f32x4*)(p.b_ada + (idx % ADAW));
#pragma unroll
        for (int q = 0; q < 8; ++q) v += *(const f32x4*)(adap + (size_t)q * NBATCH * ADAW + idx);
        *(f32x4*)(adaf + idx) = v;
    }
}

__device__ __forceinline__ void scan_item(const Params& p, int item, unsigned char* lds) {
    const int tid = otid(), lane = tid & 63, w = tid >> 6, fr = lane & 15, fq = lane >> 4;
    const int bh = item >> 2, j = item & 3, b = bh >> 2, hd = bh & 3, dv0 = j * 64;
    const float* gi = (const float*)(p.ws + WS_GI); const float* gf = (const float*)(p.ws + WS_GF);
    const bf16_t* kbuf = (const bf16_t*)(p.ws + WS_QKV) + (size_t)1 * MROWS * DM;
    const bf16_t* vbuf = (const bf16_t*)(p.ws + WS_QKV) + (size_t)2 * MROWS * DM;
    bf16_t* cst = (bf16_t*)(p.ws + WS_CST) + (size_t)bh * 31 * 65536;
    float* nst = (float*)(p.ws + WS_NST) + (size_t)bh * 32 * 256;
    float* mst = (float*)(p.ws + WS_MST) + (size_t)bh * 64;
    constexpr int KROW = 144;
    unsigned char* kimg[2] = {lds, lds + 256 * KROW};
    unsigned char* vimg[2] = {lds + 2 * 256 * KROW, lds + 2 * 256 * KROW + 64 * KROW};
    float* aA = (float*)(lds + 2 * 256 * KROW + 2 * 64 * KROW);
    float* bLs = aA + 2048;
    float* amx = bLs + 32;
    float* mch = amx + 32;
    float* dcy = mch + 40;
    for (int c = w * 4; c < w * 4 + 4; ++c) {
        const size_t tok = (size_t)b * SEQ + c * 64 + lane;
        const float lf = gf[tok * 4 + hd], il = gi[tok * 4 + hd];
        const float bs = wave_scan_add(lf, lane);
        const float bL = __shfl(bs, 63);
        const float a = bL - bs + il;
        const float am = wave_max(a);
        aA[c * 64 + lane] = a;
        if (lane == 0) { bLs[c] = bL; amx[c] = am; }
    }
    __syncthreads();
    if (tid == 0) {
        float m = 0.f; mch[0] = 0.f;
        for (int c = 0; c < 32; ++c) { const float mn = fmaxf(bLs[c] + m, amx[c]); dcy[c] = __expf(bLs[c] + m - mn); m = mn; mch[c + 1] = mn; }
    }
    __syncthreads();
    if (j == 0 && tid < 33) mst[tid] = mch[tid];
    if (j == 0 && tid == 0) p.out[O_MP + bh] = mch[32];
    f32x4 acc[2][4] = {};
    float nacc = 0.f;
    u32x4 krA[4], krB[4]; u32x4 vrA, vrB;
#define SCAN_GLOAD(KR, VR, cc) do { const size_t tok_ = (size_t)b * SEQ + (cc) * 64 + lane; const bf16_t* kp_ = kbuf + tok_ * DM + hd * 256 + w * 32; \
        _Pragma("unroll") for (int i_ = 0; i_ < 4; ++i_) KR[i_] = *(const u32x4*)(kp_ + i_ * 8); \
        VR = *(const u32x4*)(vbuf + tok_ * DM + hd * 256 + dv0 + w * 8); } while (0)
#define SCAN_WRITE(KR, VR, cc, ki, vi) do { const float wsv = __expf(aA[(cc) * 64 + lane] - mch[(cc) + 1]); \
        _Pragma("unroll") for (int i_ = 0; i_ < 4; ++i_) { const unsigned uu[4] = {KR[i_].x, KR[i_].y, KR[i_].z, KR[i_].w}; \
            _Pragma("unroll") for (int e_ = 0; e_ < 4; ++e_) { const int dk_ = w * 32 + i_ * 8 + e_ * 2; \
                *(bf16_t*)(ki + dk_ * KROW + lane * 2) = f2bf(bflo(uu[e_]) * wsv); *(bf16_t*)(ki + (dk_ + 1) * KROW + lane * 2) = f2bf(bfhi(uu[e_]) * wsv); } } \
        const int dv_ = w * 8; \
        *(bf16_t*)(vi + (dv_ + 0) * KROW + lane * 2) = (bf16_t)(VR.x & 0xffffu); *(bf16_t*)(vi + (dv_ + 1) * KROW + lane * 2) = (bf16_t)(VR.x >> 16); \
        *(bf16_t*)(vi + (dv_ + 2) * KROW + lane * 2) = (bf16_t)(VR.y & 0xffffu); *(bf16_t*)(vi + (dv_ + 3) * KROW + lane * 2) = (bf16_t)(VR.y >> 16); \
        *(bf16_t*)(vi + (dv_ + 4) * KROW + lane * 2) = (bf16_t)(VR.z & 0xffffu); *(bf16_t*)(vi + (dv_ + 5) * KROW + lane * 2) = (bf16_t)(VR.z >> 16); \
        *(bf16_t*)(vi + (dv_ + 6) * KROW + lane * 2) = (bf16_t)(VR.w & 0xffffu); *(bf16_t*)(vi + (dv_ + 7) * KROW + lane * 2) = (bf16_t)(VR.w >> 16); } while (0)
    SCAN_GLOAD(krA, vrA, 0);
    SCAN_GLOAD(krB, vrB, 1);
    for (int c = 0; c < 32; ++c) {
        unsigned char* ki = kimg[c & 1]; unsigned char* vi = vimg[c & 1];
        if ((c & 1) == 0) { SCAN_WRITE(krA, vrA, c, ki, vi); if (c + 2 < 32) SCAN_GLOAD(krA, vrA, c + 2); }
        else { SCAN_WRITE(krB, vrB, c, ki, vi); if (c + 2 < 32) SCAN_GLOAD(krB, vrB, c + 2); }
        __syncthreads();
        const float dc = dcy[c];
        bf16x8 af[2][2], bfr[4][2];
#pragma unroll
        for (int a = 0; a < 2; ++a)
#pragma unroll
            for (int k = 0; k < 2; ++k) af[a][k] = *(const bf16x8*)(ki + ((w * 2 + a) * 16 + fr) * KROW + (k * 32 + fq * 8) * 2);
#pragma unroll
        for (int a = 0; a < 4; ++a)
#pragma unroll
            for (int k = 0; k < 2; ++k) bfr[a][k] = *(const bf16x8*)(vi + (a * 16 + fr) * KROW + (k * 32 + fq * 8) * 2);
#pragma unroll
        for (int a = 0; a < 2; ++a)
#pragma unroll
            for (int q = 0; q < 4; ++q) {
                acc[a][q] *= dc;
#pragma unroll
                for (int k = 0; k < 2; ++k) acc[a][q] = MFMA16(af[a][k], bfr[q][k], acc[a][q]);
            }
        if (j == 0) {
            const int dk = tid >> 1, hf = tid & 1;
            float s = 0.f;
#pragma unroll
            for (int i = 0; i < 4; ++i) {
                const u32x4 v = *(const u32x4*)(ki + dk * KROW + hf * 64 + i * 16);
                s += bflo(v.x) + bfhi(v.x) + bflo(v.y) + bfhi(v.y) + bflo(v.z) + bfhi(v.z) + bflo(v.w) + bfhi(v.w);
            }
            s += __shfl_xor(s, 1);
            nacc = nacc * dc + s;
            if (hf == 0) { if (c < 31) nst[(c + 1) * 256 + dk] = nacc; else p.out[O_NP + (size_t)bh * 256 + dk] = nacc; }
        }
        if (c < 31) {
            bf16_t* cs = cst + (size_t)c * 65536;
#pragma unroll
            for (int a = 0; a < 2; ++a)
#pragma unroll
                for (int q = 0; q < 4; ++q) {
                    u32x2 wv; wv.x = pk_bf16(acc[a][q][0], acc[a][q][1]); wv.y = pk_bf16(acc[a][q][2], acc[a][q][3]);
                    *(u32x2*)(cs + (size_t)(dv0 + q * 16 + fr) * 256 + (w * 2 + a) * 16 + fq * 4) = wv;
                }
        } else {
            float* co = p.out + O_CP + (size_t)bh * 65536;
#pragma unroll
            for (int a = 0; a < 2; ++a)
#pragma unroll
                for (int q = 0; q < 4; ++q)
#pragma unroll
                    for (int jj = 0; jj < 4; ++jj) co[(size_t)((w * 2 + a) * 16 + fq * 4 + jj) * 256 + dv0 + q * 16 + fr] = acc[a][q][jj];
        }
    }
    __syncthreads();
}

__device__ __forceinline__ void sample_item(const Params& p, int item, unsigned char* ldsb) {
    const int tid = otid(), lane = tid & 63, w = tid >> 6;
    const int b = item >> 2, hd = item & 3, bh = item;
    const int r0 = NPR + b * 4;
    const bf16_t* qb = (const bf16_t*)(p.ws + WS_QKV);
    const bf16_t* kb = qb + (size_t)MROWS * DM; const bf16_t* vb = kb + (size_t)MROWS * DM; const bf16_t* ob = vb + (size_t)MROWS * DM;
    const float* gi = (const float*)(p.ws + WS_GI); const float* gf = (const float*)(p.ws + WS_GF);
    float* lds = (float*)ldsb;
    float* qf = lds;
    float* kf = qf + 1024;
    float* vf = kf + 1024;
    float* Sm = vf + 1024;
    float* sc = Sm + 16;
    float* red = sc + 64;
    float* ssq = red + 8192;
    float lfp[4] = {0.f, 0.f, 0.f, 0.f}, ilp[4] = {0.f, 0.f, 0.f, 0.f}, m0p = 0.f;
    if (tid == 0) {
#pragma unroll
        for (int t = 0; t < 4; ++t) { lfp[t] = gf[(size_t)(r0 + t) * 4 + hd]; ilp[t] = gi[(size_t)(r0 + t) * 4 + hd]; }
        m0p = p.st_m[bh];
    }
    const int dv4 = lane * 4;
    const float* C0 = p.st_C + (size_t)bh * 65536;
    float* Cn = p.out + O_CS + (size_t)bh * 65536;
    f32x4 cpre[16];
#pragma unroll
    for (int r = 0; r < 16; ++r) cpre[r] = __builtin_nontemporal_load((const f32x4*)(C0 + (size_t)(w * 32 + r) * 256 + dv4));
    float* n0s = ssq + 8;
    const int ft = tid >> 7, fdv = (tid & 127) * 2;
    const size_t foidx = (size_t)(r0 + ft) * DM + hd * 256 + fdv;
    const unsigned fog = *(const unsigned*)(ob + foidx);
    const float fm0 = p.m_norm[hd * 256 + fdv], fm1 = p.m_norm[hd * 256 + fdv + 1];
    if (tid < 256) n0s[tid] = p.st_n[(size_t)bh * 256 + tid];
    for (int e = tid; e < 3 * 4 * 256; e += NTH) {
        const int which = e >> 10, t = (e >> 8) & 3, d = e & 255;
        const bf16_t* src = which == 0 ? qb : which == 1 ? kb : vb;
        lds[which * 1024 + t * 256 + d] = bf2f(src[(size_t)(r0 + t) * DM + hd * 256 + d]);
    }
    if (tid == 0) {
        float lf[4], il[4], bs[4];
        for (int t = 0; t < 4; ++t) { lf[t] = lfp[t]; il[t] = ilp[t]; }
        bs[0] = lf[0]; bs[1] = bs[0] + lf[1]; bs[2] = bs[1] + lf[2]; bs[3] = bs[2] + lf[3];
        const float m0 = m0p;
        for (int t = 0; t < 4; ++t) {
            const float g = bs[t] + m0; float mt = g;
            for (int s = 0; s <= t; ++s) mt = fmaxf(mt, bs[t] - bs[s] + il[s]);
            sc[t] = __expf(g - mt); sc[4 + t] = __expf(-mt);
            for (int s = 0; s < 4; ++s) sc[16 + t * 4 + s] = s <= t ? __expf(bs[t] - bs[s] + il[s] - mt) : 0.f;
        }
        const float bL = bs[3]; float mn = bL + m0;
        for (int s = 0; s < 4; ++s) mn = fmaxf(mn, bL - bs[s] + il[s]);
        sc[12] = __expf(bL + m0 - mn);
        for (int s = 0; s < 4; ++s) sc[8 + s] = __expf(bL - bs[s] + il[s] - mn);
        p.out[O_MS + bh] = mn;
    }
    __syncthreads();
    {
        const int g = tid >> 5, l32 = tid & 31;
        {
            const int t = g >> 2, s = g & 3; float a = 0.f;
#pragma unroll
            for (int d = l32; d < 256; d += 32) a += qf[t * 256 + d] * kf[s * 256 + d];
#pragma unroll
            for (int dd = 16; dd >= 1; dd >>= 1) a += __shfl_xor(a, dd);
            if (l32 == 0) Sm[g] = a * sc[16 + g];
        }
        if (g < 4) {
            float a = 0.f;
#pragma unroll
            for (int d = l32; d < 256; d += 32) a += qf[g * 256 + d] * n0s[d];
#pragma unroll
            for (int dd = 16; dd >= 1; dd >>= 1) a += __shfl_xor(a, dd);
            if (l32 == 0) sc[32 + g] = a;
        }
    }
    const float decay = sc[12];
    const float ws0 = sc[8], ws1 = sc[9], ws2 = sc[10], ws3 = sc[11];
    if (tid < 256) {
        const float nn = decay * n0s[tid] + ws0 * kf[tid] + ws1 * kf[256 + tid] + ws2 * kf[512 + tid] + ws3 * kf[768 + tid];
        p.out[O_NS + (size_t)bh * 256 + tid] = nn;
    }
    {
        f32x4 vv[4], num[4];
        vv[0] = *(const f32x4*)(vf + dv4) * ws0; vv[1] = *(const f32x4*)(vf + 256 + dv4) * ws1; vv[2] = *(const f32x4*)(vf + 512 + dv4) * ws2; vv[3] = *(const f32x4*)(vf + 768 + dv4) * ws3;
#pragma unroll
        for (int s = 0; s < 4; ++s) num[s] = (f32x4){0.f, 0.f, 0.f, 0.f};
#pragma unroll
        for (int r = 0; r < 16; ++r) {
            const int dk = w * 32 + r;
            const f32x4 cv = cpre[r];
            f32x4 cn = cv * decay;
#pragma unroll
            for (int s = 0; s < 4; ++s) { num[s] += cv * qf[s * 256 + dk]; cn += vv[s] * kf[s * 256 + dk]; }
            __builtin_nontemporal_store(cn, (f32x4*)(Cn + (size_t)dk * 256 + dv4));
        }
#pragma unroll 16
        for (int r = 16; r < 32; ++r) {
            const int dk = w * 32 + r;
            const f32x4 cv = __builtin_nontemporal_load((const f32x4*)(C0 + (size_t)dk * 256 + dv4));
            f32x4 cn = cv * decay;
#pragma unroll
            for (int s = 0; s < 4; ++s) { num[s] += cv * qf[s * 256 + dk]; cn += vv[s] * kf[s * 256 + dk]; }
            __builtin_nontemporal_store(cn, (f32x4*)(Cn + (size_t)dk * 256 + dv4));
        }
        __syncthreads();
#pragma unroll
        for (int t = 0; t < 4; ++t) *(f32x4*)(red + (w * 4 + t) * 256 + dv4) = num[t];
    }
    __syncthreads();
    {
        const int t = tid >> 7, dv = (tid & 127) * 2;
        float n0_ = 0.f, n1_ = 0.f;
#pragma unroll
        for (int ww = 0; ww < 8; ++ww) { n0_ += red[(ww * 4 + t) * 256 + dv]; n1_ += red[(ww * 4 + t) * 256 + dv + 1]; }
        const float wint = sc[t];
        n0_ *= wint; n1_ *= wint;
        float rs = 0.f;
#pragma unroll
        for (int s = 0; s < 4; ++s) { const float sv = Sm[t * 4 + s]; rs += sv; n0_ += sv * vf[s * 256 + dv]; n1_ += sv * vf[s * 256 + dv + 1]; }
        const float den = wint * sc[32 + t] + rs;
        const float dinv = 1.0f / fmaxf(fabsf(den), sc[4 + t]);
        const float h0 = n0_ * dinv, h1 = n1_ * dinv;
        float q2 = wave_sum(h0 * h0 + h1 * h1);
        if (lane == 0) ssq[t * 2 + (w & 1)] = q2;
        __syncthreads();
        const float rstd = rsqrtf((ssq[t * 2] + ssq[t * 2 + 1]) * (1.0f / 256.f) + EPS);
        const float o0 = h0 * rstd * fm0 * bflo(fog), o1 = h1 * rstd * fm1 * bfhi(fog);
        *(unsigned*)((bf16_t*)(p.ws + WS_HM) + foidx) = pk_bf16(o0, o1);
    }
    __syncthreads();
}

__device__ __forceinline__ void pool_item(const Params& p, int item, unsigned char* lds) {
    const int tid = otid(), lane = tid & 63, w = tid >> 6, fr = lane & 15, fq = lane >> 4;
    const int r0 = item < 256 ? item * 64 : NPR + (item - 256) * 16;
    const int nm = item < 256 ? 4 : 1;
    const float* u = (const float*)(p.ws + WS_U);
    constexpr int AROW = 1040;
    bf16x8 bw[4][4];
    {
        const bf16_t* wt0 = (const bf16_t*)(p.ws + WS_WPG) + (size_t)(w >> 1) * 128 * 128;
#pragma unroll
        for (int k = 0; k < 4; ++k)
#pragma unroll
            for (int n = 0; n < 4; ++n) bw[k][n] = *(const bf16x8*)(wt0 + (size_t)(((w & 1) * 4 + n) * 16 + fr) * 128 + k * 32 + fq * 8);
    }
    {
        const int c = tid, gidx = c >> 7, win = 2 << gidx;
        float hist[31];
        if (r0 < NPR) {
            const int t0 = r0 & (SEQ - 1);
#pragma unroll
            for (int j = 0; j < 15; ++j) hist[j] = (t0 - 15 + j) >= 0 ? u[(size_t)(r0 - 15 + j) * 512 + c] : 0.f;
            float nxt[16];
#pragma unroll
            for (int j = 0; j < 16; ++j) nxt[j] = u[(size_t)(r0 + j) * 512 + c];
#pragma unroll 1
            for (int ch = 0; ch < 4; ++ch) {
#pragma unroll
                for (int j = 0; j < 16; ++j) hist[15 + j] = nxt[j];
                if (ch < 3) {
#pragma unroll
                    for (int j = 0; j < 16; ++j) nxt[j] = u[(size_t)(r0 + (ch + 1) * 16 + j) * 512 + c];
                }
#pragma unroll
                for (int j = 0; j < 16; ++j) {
                    const int i = ch * 16 + j, t = t0 + i, q = 15 + j;
                    const float s2 = hist[q] + hist[q - 1];
                    const float s4 = s2 + hist[q - 2] + hist[q - 3];
                    const float s8 = s4 + (hist[q - 4] + hist[q - 5]) + (hist[q - 6] + hist[q - 7]);
                    const float s16 = s8 + ((hist[q - 8] + hist[q - 9]) + (hist[q - 10] + hist[q - 11])) + ((hist[q - 12] + hist[q - 13]) + (hist[q - 14] + hist[q - 15]));
                    const float s = gidx == 0 ? s2 : gidx == 1 ? s4 : gidx == 2 ? s8 : s16;
                    const float rc = __builtin_amdgcn_rcpf((float)min(t + 1, win));
                    *(bf16_t*)(lds + i * AROW + c * 2) = f2bf(s * rc - hist[q]);
                }
#pragma unroll
                for (int j = 0; j < 15; ++j) hist[j] = hist[16 + j];
            }
        } else {
#pragma unroll 1
            for (int bi = 0; bi < 4; ++bi) {
                const int bb = ((r0 - NPR) >> 2) + bi;
#pragma unroll
                for (int j = 0; j < 15; ++j) hist[j] = p.st_pool[((size_t)bb * 15 + j) * 512 + c];
#pragma unroll
                for (int j = 0; j < 4; ++j) hist[15 + j] = u[((size_t)NPR + bb * 4 + j) * 512 + c];
#pragma unroll
                for (int j = 0; j < 4; ++j) {
                    const int i = bi * 4 + j, q = 15 + j;
                    const float s2 = hist[q] + hist[q - 1];
                    const float s4 = s2 + hist[q - 2] + hist[q - 3];
                    const float s8 = s4 + (hist[q - 4] + hist[q - 5]) + (hist[q - 6] + hist[q - 7]);
                    const float s16 = s8 + ((hist[q - 8] + hist[q - 9]) + (hist[q - 10] + hist[q - 11])) + ((hist[q - 12] + hist[q - 13]) + (hist[q - 14] + hist[q - 15]));
                    const float s = gidx == 0 ? s2 : gidx == 1 ? s4 : gidx == 2 ? s8 : s16;
                    *(bf16_t*)(lds + i * AROW + c * 2) = f2bf(s * (1.0f / (float)win) - hist[q]);
                }
            }
        }
    }
    __syncthreads();
    {
        const int g = w >> 1, nh = w & 1;
        f32x4 acc[4][4] = {};
#pragma unroll
        for (int k = 0; k < 4; ++k) {
            bf16x8 af[4];
#pragma unroll
            for (int m = 0; m < 4; ++m) if (m < nm) af[m] = *(const bf16x8*)(lds + (m * 16 + fr) * AROW + (g * 128 + k * 32 + fq * 8) * 2);
#pragma unroll
            for (int m = 0; m < 4; ++m) if (m < nm) {
#pragma unroll
                for (int n = 0; n < 4; ++n) acc[m][n] = MFMA16(bw[k][n], af[m], acc[m][n]); }
        }
        bf16_t* yp = (bf16_t*)(p.ws + WS_YP);
#pragma unroll
        for (int m = 0; m < 4; ++m) if (m < nm)
#pragma unroll
            for (int n = 0; n < 4; ++n) {
                const int col = g * 128 + (nh * 4 + n) * 16 + fq * 4;
                const f32x4 scv = *(const f32x4*)(p.pool_scale + col);
                const f32x4 v = acc[m][n] * scv;
                u32x2 wv; wv.x = pk_bf16(v[0], v[1]); wv.y = pk_bf16(v[2], v[3]);
                *(u32x2*)(yp + (size_t)(r0 + m * 16 + fr) * 512 + col) = wv;
            }
    }
    __syncthreads();
}

__device__ __forceinline__ void poolout_item(const Params& p, int item) {
    const float* u = (const float*)(p.ws + WS_U);
    for (int e = threadIdx.x; e < 15 * 512; e += NTH) {
        const int jj = e >> 9, c = e & 511;
        if (item < 8) p.out[O_POOLP + (size_t)item * 7680 + e] = u[((size_t)item * SEQ + 2033 + jj) * 512 + c];
        else { const int bb = item - 8;
            p.out[O_POOLS + (size_t)bb * 7680 + e] = jj < 11 ? p.st_pool[((size_t)bb * 15 + jj + 4) * 512 + c] : u[((size_t)NPR + bb * 4 + (jj - 11)) * 512 + c]; }
    }
}

__device__ __forceinline__ void mout_item(const Params& p, int item, unsigned char* lds) {
    const int tid = otid(), lane = tid & 63, w = tid >> 6, fr = lane & 15, fq = lane >> 4;
    const int bh = item >> 5, c = item & 31, b = bh >> 2, hd = bh & 3;
    const size_t tok0 = (size_t)b * SEQ + c * 64;
    const bf16_t* qb = (const bf16_t*)(p.ws + WS_QKV);
    const bf16_t* kb = qb + (size_t)MROWS * DM; const bf16_t* vb = kb + (size_t)MROWS * DM; const bf16_t* ob = vb + (size_t)MROWS * DM;
    const float* gi = (const float*)(p.ws + WS_GI); const float* gf = (const float*)(p.ws + WS_GF);
    constexpr int QROW = 528, VROW = 144;
    unsigned char* Qs = lds;
    unsigned char* Ks = Qs + 64 * QROW;
    unsigned char* Vt = Ks + 64 * QROW;
    unsigned char* Sp = Vt + 256 * VROW;
    float* scal = (float*)(Sp + 64 * VROW);
    float* rt = scal, *ct = scal + 64, *wint = scal + 128, *emt = scal + 192, *rowsum = scal + 256  , *qn = scal + 384, *ssq = scal + 448  , *ncs = scal + 960  ;
    const float lf_pre = gf[(tok0 + lane) * 4 + hd], il_pre = gi[(tok0 + lane) * 4 + hd];
    const float mc_pre = ((const float*)(p.ws + WS_MST))[bh * 64 + c];
    bf16x8 cfr[8][2];
    if (c > 0) {
        const bf16_t* cs = (const bf16_t*)(p.ws + WS_CST) + ((size_t)bh * 31 + (c - 1)) * 65536;
#pragma unroll
        for (int k = 0; k < 8; ++k)
#pragma unroll
            for (int n = 0; n < 2; ++n) cfr[k][n] = *(const bf16x8*)(cs + (size_t)(w * 32 + n * 16 + fr) * 256 + k * 32 + fq * 8);
    }
    u32x2 ogv[4][2]; f32x4 mnv[2];
#pragma unroll
    for (int n = 0; n < 2; ++n) { const int dvg = hd * 256 + w * 32 + n * 16 + fq * 4; mnv[n] = *(const f32x4*)(p.m_norm + dvg);
#pragma unroll
        for (int m = 0; m < 4; ++m) ogv[m][n] = *(const u32x2*)(ob + (tok0 + m * 16 + fr) * DM + dvg); }
    if (w == 0) {
        const float lf = lf_pre, il = il_pre;
        const float bs = wave_scan_add(lf, lane);
        const float mc = mc_pre;
        const float g = bs + mc, xx = il - bs;
        const float pm = wave_scan_max(xx, lane);
        const float mt = fmaxf(g, bs + pm);
        rt[lane] = bs - mt; ct[lane] = xx; wint[lane] = __expf(g - mt); emt[lane] = __expf(-mt);
    }
#pragma unroll
    for (int i = 0; i < 4; ++i) {
        const int pc = tid + NTH * i, row = pc >> 5, c8 = pc & 31;
        *(u32x4*)(Qs + row * QROW + c8 * 16) = *(const u32x4*)(qb + (tok0 + row) * DM + hd * 256 + c8 * 8);
        *(u32x4*)(Ks + row * QROW + c8 * 16) = *(const u32x4*)(kb + (tok0 + row) * DM + hd * 256 + c8 * 8);
    }
    {
        const bf16_t* vp = vb + (tok0 + lane) * DM + hd * 256 + w * 32;
#pragma unroll
        for (int i = 0; i < 4; ++i) {
            const u32x4 v = *(const u32x4*)(vp + i * 8);
            const unsigned uu[4] = {v.x, v.y, v.z, v.w};
#pragma unroll
            for (int e = 0; e < 4; ++e) {
                const int dv = w * 32 + i * 8 + e * 2;
                *(bf16_t*)(Vt + dv * VROW + lane * 2) = (bf16_t)(uu[e] & 0xffffu);
                *(bf16_t*)(Vt + (dv + 1) * VROW + lane * 2) = (bf16_t)(uu[e] >> 16);
            }
        }
    }
    if (c > 0 && tid >= 256) ncs[tid - 256] = ((const float*)(p.ws + WS_NST))[((size_t)bh * 32 + c) * 256 + tid - 256];
    __syncthreads();
    {
        const int tt = w >> 1, sh = w & 1;
        f32x4 sa[2] = {};
#pragma unroll
        for (int k = 0; k < 8; ++k) {
            const bf16x8 qf = *(const bf16x8*)(Qs + (tt * 16 + fr) * QROW + (k * 32 + fq * 8) * 2);
#pragma unroll
            for (int s2 = 0; s2 < 2; ++s2) {
                const bf16x8 kf = *(const bf16x8*)(Ks + ((sh * 2 + s2) * 16 + fr) * QROW + (k * 32 + fq * 8) * 2);
                sa[s2] = MFMA16(kf, qf, sa[s2]);
            }
        }
        const int t = tt * 16 + fr;
        const float rtt = rt[t];
        float rs = 0.f;
#pragma unroll
        for (int s2 = 0; s2 < 2; ++s2) {
            const int s0 = (sh * 2 + s2) * 16 + fq * 4;
            float v[4];
#pragma unroll
            for (int jj = 0; jj < 4; ++jj) { const int s = s0 + jj; v[jj] = s <= t ? sa[s2][jj] * __expf(rtt + ct[s]) : 0.f; rs += v[jj]; }
            u32x2 wv; wv.x = pk_bf16(v[0], v[1]); wv.y = pk_bf16(v[2], v[3]);
            *(u32x2*)(Sp + t * VROW + s0 * 2) = wv;
        }
        rs += __shfl_xor(rs, 16); rs += __shfl_xor(rs, 32);
        if (fq == 0) rowsum[t * 2 + sh] = rs;
    }
    {
        const int t = tid >> 3, part = tid & 7;
        float a = 0.f;
        if (c > 0) {
            const float* nc = ncs + part * 32;
            const unsigned char* qp = Qs + t * QROW + part * 64;
#pragma unroll
            for (int i = 0; i < 4; ++i) {
                const u32x4 qv = *(const u32x4*)(qp + i * 16);
                const f32x4 n0 = *(const f32x4*)(nc + i * 8), n1 = *(const f32x4*)(nc + i * 8 + 4);
                a += bflo(qv.x) * n0[0] + bfhi(qv.x) * n0[1] + bflo(qv.y) * n0[2] + bfhi(qv.y) * n0[3] + bflo(qv.z) * n1[0] + bfhi(qv.z) * n1[1] + bflo(qv.w) * n1[2] + bfhi(qv.w) * n1[3];
            }
        }
        a += __shfl_xor(a, 1); a += __shfl_xor(a, 2); a += __shfl_xor(a, 4);
        if (part == 0) qn[t] = a;
    }
    __syncthreads();
    f32x4 acc[4][2] = {};
    if (c > 0) {
#pragma unroll
        for (int k = 0; k < 8; ++k) {
            bf16x8 qf[4];
#pragma unroll
            for (int m = 0; m < 4; ++m) qf[m] = *(const bf16x8*)(Qs + (m * 16 + fr) * QROW + (k * 32 + fq * 8) * 2);
#pragma unroll
            for (int m = 0; m < 4; ++m)
#pragma unroll
                for (int n = 0; n < 2; ++n) acc[m][n] = MFMA16(cfr[k][n], qf[m], acc[m][n]);
        }
#pragma unroll
        for (int m = 0; m < 4; ++m) { const float wi = wint[m * 16 + fr]; acc[m][0] *= wi; acc[m][1] *= wi; }
    }
#pragma unroll
    for (int k = 0; k < 2; ++k) {
        bf16x8 vfr[2], sf[4];
#pragma unroll
        for (int n = 0; n < 2; ++n) vfr[n] = *(const bf16x8*)(Vt + (w * 32 + n * 16 + fr) * VROW + (k * 32 + fq * 8) * 2);
#pragma unroll
        for (int m = 0; m < 4; ++m) sf[m] = *(const bf16x8*)(Sp + (m * 16 + fr) * VROW + (k * 32 + fq * 8) * 2);
#pragma unroll
        for (int m = 0; m < 4; ++m)
#pragma unroll
            for (int n = 0; n < 2; ++n) acc[m][n] = MFMA16(vfr[n], sf[m], acc[m][n]);
    }
#pragma unroll
    for (int m = 0; m < 4; ++m) {
        const int t = m * 16 + fr;
        const float den = wint[t] * qn[t] + rowsum[t * 2] + rowsum[t * 2 + 1];
        const float dinv = 1.0f / fmaxf(fabsf(den), emt[t]);
        acc[m][0] *= dinv; acc[m][1] *= dinv;
        float q2 = 0.f;
#pragma unroll
        for (int n = 0; n < 2; ++n)
#pragma unroll
            for (int jj = 0; jj < 4; ++jj) q2 += acc[m][n][jj] * acc[m][n][jj];
        q2 += __shfl_xor(q2, 16); q2 += __shfl_xor(q2, 32);
        if (fq == 0) ssq[t * 8 + w] = q2;
    }
    __syncthreads();
#pragma unroll
    for (int m = 0; m < 4; ++m) {
        const int t = m * 16 + fr;
        float tot = 0.f;
#pragma unroll
        for (int ww = 0; ww < 8; ++ww) tot += ssq[t * 8 + ww];
        const float rstd = rsqrtf(tot * (1.0f / 256.f) + EPS);
#pragma unroll
        for (int n = 0; n < 2; ++n) {
            const int dvg = hd * 256 + w * 32 + n * 16 + fq * 4;
            const size_t oidx = (tok0 + t) * DM + dvg;
            const u32x2 og = ogv[m][n];
            const f32x4 v = acc[m][n] * rstd * mnv[n];
            u32x2 wv; wv.x = pk_bf16(v[0] * bflo(og.x), v[1] * bfhi(og.x)); wv.y = pk_bf16(v[2] * bflo(og.y), v[3] * bfhi(og.y));
            *(u32x2*)((bf16_t*)(p.ws + WS_HM) + oidx) = wv;
        }
    }
    __syncthreads();
}

__device__ __forceinline__ void grid_barrier(unsigned* bar, unsigned k) {
    asm volatile("s_waitcnt vmcnt(0)" ::: "memory");
    __syncthreads();
    if (threadIdx.x == 0) {
        const unsigned g = blockIdx.x & 7u, gsz = (gridDim.x + 7u - g) >> 3;
        __builtin_amdgcn_fence(__ATOMIC_RELEASE, "agent");
        asm volatile("s_waitcnt vmcnt(0)" ::: "memory");
        unsigned* sub = bar + 64u * (1u + g);
        const unsigned prev = __hip_atomic_fetch_add(sub, 1u, __ATOMIC_RELAXED, __HIP_MEMORY_SCOPE_AGENT);
        if (prev + 1u == k * gsz) __hip_atomic_fetch_add(bar, 1u, __ATOMIC_RELAXED, __HIP_MEMORY_SCOPE_AGENT);
        const unsigned ngroups = gridDim.x < 8u ? gridDim.x : 8u;
        unsigned spins = 0;
        while (__hip_atomic_load(bar, __ATOMIC_RELAXED, __HIP_MEMORY_SCOPE_AGENT) < k * ngroups) { __builtin_amdgcn_s_sleep(1); if (++spins > (1u << 24)) break; }
        __builtin_amdgcn_fence(__ATOMIC_ACQUIRE, "agent");
        asm volatile("s_waitcnt vmcnt(0)" ::: "memory");
    }
    __syncthreads();
}

__global__ void __launch_bounds__(NTH) hybrid_fwd(Params p) {
    extern __shared__ __attribute__((aligned(16))) unsigned char lds[];
    cg::grid_group grid = cg::this_grid();
    const int lo = p.ph_lo, hi = p.ph_hi;
#ifndef PHMASK
#define PHMASK 0x7ff
#endif
#define IN(k) (((PHMASK >> (k)) & 1) && lo <= (k) && (k) < hi)
#define SEAMN(n) do { grid_barrier((unsigned*)(p.ws + WS_CTR) + 64, (unsigned)(n)); } while (0)
    if (lo < 0) grid.sync();
    LAS unsigned char* ldsl = (LAS unsigned char*)lds;
    unsigned char* ws = p.ws;
    if (IN(0)) phase0(p, (float*)lds);
    SEAMN(1);
    if (IN(1)) {
        for (int it = blockIdx.x; it < 256; it += gridDim.x) { ada_final_slice(p, it); norm_item(p, it, 0, (float*)lds); }
    }
    SEAMN(2);
    if (IN(2)) { EpiG1 e{(float*)(ws + WS_U), (bf16_t*)(ws + WS_QKV)};
        gemm_phase(ldsl, (const bf16_t*)(ws + WS_H), (const bf16_t*)(ws + WS_WIN), NIN, DM, e, nullptr, MROWS); }
    SEAMN(3);
    if (IN(3)) {
        if (blockIdx.x < 128) { const int x = blockIdx.x & 7, r = blockIdx.x >> 3;
            scan_item(p, ((x + 8 * (r >> 2)) << 2) | (r & 3), lds); }
        {
            unsigned* ctr = (unsigned*)(ws + WS_CTR);
            volatile unsigned* slot = (volatile unsigned*)(lds + LDS_BYTES - 16);
            for (;;) {
                if (threadIdx.x == 0) *slot = atomicAdd(ctr, 1u);
                __syncthreads();
                const int it = (int)*slot;
                __syncthreads();
                if (it >= 512 + 288 + NBATCH) break;
                if (it < 512) sample_item(p, it, lds);
                else if (it < 800) pool_item(p, it - 512, lds);
                else poolout_item(p, it - 800);
            }
        }
    }
    SEAMN(4);
    if (IN(4)) { for (int it = blockIdx.x; it < 1024; it += gridDim.x) mout_item(p, it, lds); }
    if (IN(5)) {

        bf16_t* merged = (bf16_t*)(ws + WS_U);
        const bf16_t* sga = (const bf16_t*)(ws + WS_QKV) + (size_t)4 * MROWS * DM;
        const bf16_t* sgb = sga + (size_t)MROWS * DM;
        { EpiMerge e0{merged, sga, 0}; gemm_phase(ldsl, (const bf16_t*)(ws + WS_YP), (const bf16_t*)(ws + WS_WPO), DM, 512, e0);
          small_gemm_phase(lds, (const bf16_t*)(ws + WS_YP), (const bf16_t*)(ws + WS_WPO), DM, 512, e0, blockIdx.x, blockIdx.x + 1); }
        SEAMN(5);
        { EpiMerge e1{merged, sgb, 1}; gemm_phase(ldsl, (const bf16_t*)(ws + WS_HM), (const bf16_t*)(ws + WS_WMO), DM, DM, e1);
          small_gemm_phase(lds, (const bf16_t*)(ws + WS_HM), (const bf16_t*)(ws + WS_WMO), DM, DM, e1, blockIdx.x, blockIdx.x + 1); }
    }
    SEAMN(6);
    if (IN(6)) {
        EpiMid e{p.out, p.x_p, p.x_s, (const float*)(ws + WS_ADA), p.g_ffn, (bf16_t*)(ws + WS_H), (float*)(ws + WS_RSB), (unsigned*)(ws + WS_XCNT), (float*)(ws + WS_RSS), (unsigned*)(ws + WS_XCNT) + 64 * 64};
        gemm_phase<EpiMid, true>(ldsl, (const bf16_t*)(ws + WS_U), (const bf16_t*)(ws + WS_WOUT), DM, DM, e, lds);
        small_gemm_phase<EpiMid, 2>(lds, (const bf16_t*)(ws + WS_U), (const bf16_t*)(ws + WS_WOUT), DM, DM, e, blockIdx.x, blockIdx.x + 1);
    }
    SEAMN(7);
    if (IN(8)) { EpiAct e{(bf16_t*)(ws + WS_CST)};
        gemm_phase(ldsl, (const bf16_t*)(ws + WS_H), (const bf16_t*)(ws + WS_W1), DFF, DM, e, nullptr, MROWS); }
    SEAMN(8);
    if (IN(9)) {
        EpiFinal e{p.out, (const float*)(ws + WS_ADA), p.g_final, (float*)(ws + WS_RSB), (unsigned*)(ws + WS_XCNT), (float*)(ws + WS_RSS), (unsigned*)(ws + WS_XCNT) + 64 * 64};
        gemm_phase<EpiFinal, true>(ldsl, (const bf16_t*)(ws + WS_CST), (const bf16_t*)(ws + WS_W2), DM, DFF, e, lds);
        small_gemm_phase<EpiFinal, 1>(lds, (const bf16_t*)(ws + WS_CST), (const bf16_t*)(ws + WS_W2), DM, DFF, e, blockIdx.x, blockIdx.x + 1);
    }
#undef IN
#undef SEAMN
}

extern "C" void kernel_launch(void* const* d_in, const int* in_sizes, int n_in, void* d_out, int out_size, void* d_ws, size_t ws_size, hipStream_t stream) {
    static int grid_blocks = 0;
    if (grid_blocks == 0) {
        if (ws_size < WS_END) { fprintf(stderr, "kernel_launch: workspace too small: %zu < %zu\n", ws_size, (size_t)WS_END); grid_blocks = -1; return; }
        int dev = 0, cus = 0, per_cu = 0;
        hipGetDevice(&dev);
        hipDeviceGetAttribute(&cus, hipDeviceAttributeMultiprocessorCount, dev);
        hipFuncSetAttribute((const void*)hybrid_fwd, hipFuncAttributeMaxDynamicSharedMemorySize, LDS_BYTES);
        hipOccupancyMaxActiveBlocksPerMultiprocessor(&per_cu, (const void*)hybrid_fwd, NTH, LDS_BYTES);
        if (per_cu < 1) per_cu = 1;
        if (per_cu > 1) per_cu = 1;
        grid_blocks = cus * per_cu;
    }
    if (grid_blocks < 0) return;
    hipMemsetAsync((char*)d_ws + WS_CTR, 0, 4096 + 80 * 256, stream);
    Params p{};
    const float** f = (const float**)&p;
    for (int i = 0; i < 24; ++i) f[i] = (const float*)d_in[i];
    p.out = (float*)d_out; p.ws = (unsigned char*)d_ws; p.ph_lo = 0; p.ph_hi = 11;
    void* args[] = {&p};
    hipError_t e = hipLaunchCooperativeKernel((const void*)hybrid_fwd, dim3(grid_blocks), dim3(NTH), args, LDS_BYTES, stream);
    if (e != hipSuccess) fprintf(stderr, "cooperative launch failed: %s (grid %d)\n", hipGetErrorString(e), grid_blocks);
}
```

```cpp
#include <hip/hip_runtime.h>
#include <hip/hip_cooperative_groups.h>
#include <cstdio>
#include <cstdint>
namespace cg = cooperative_groups;

typedef unsigned short bf16_t;
typedef short bf16x8 __attribute__((ext_vector_type(8)));
typedef float f32x4 __attribute__((ext_vector_type(4)));
typedef unsigned u32x4 __attribute__((ext_vector_type(4)));
typedef unsigned u32x2 __attribute__((ext_vector_type(2)));

constexpr int NTH = 512;
constexpr int DM = 1024, NPR = 16384, NSA = 512, MROWS = 16896, NBATCH = 136, SEQ = 2048;
constexpr int NIN = 6656, DFF = 4096, ADAW = 6144, INW = 6664;
constexpr int LDS_BYTES = 131072;
constexpr float EPS = 1e-6f;

constexpr size_t O_Y = 0;
constexpr size_t O_POOLP = 17301504;
constexpr size_t O_CP = 17362944;
constexpr size_t O_NP = 19460096;
constexpr size_t O_MP = 19468288;
constexpr size_t O_POOLS = 19468320;
constexpr size_t O_CS = 20451360;
constexpr size_t O_NS = 54005792;
constexpr size_t O_MS = 54136864;

constexpr size_t AL(size_t x) { return (x + 255) & ~(size_t)255; }
constexpr size_t WS_WIN = 0;
constexpr size_t WS_WPG = WS_WIN + AL((size_t)NIN * DM * 2);
constexpr size_t WS_WPO = WS_WPG + AL((size_t)4 * 128 * 128 * 2);
constexpr size_t WS_WMO = WS_WPO + AL((size_t)1024 * 512 * 2);
constexpr size_t WS_WOUT = WS_WMO + AL((size_t)1024 * 1024 * 2);
constexpr size_t WS_W1 = WS_WOUT + AL((size_t)1024 * 1024 * 2);
constexpr size_t WS_W2 = WS_W1 + AL((size_t)4096 * 1024 * 2);
constexpr size_t WS_ADAP = WS_W2 + AL((size_t)4096 * 1024 * 2);
constexpr size_t WS_ADA = WS_ADAP + AL((size_t)8 * NBATCH * ADAW * 4);
constexpr size_t WS_H = WS_ADA + AL((size_t)NBATCH * ADAW * 4);
constexpr size_t WS_GI = WS_H + AL((size_t)MROWS * DM * 2);
constexpr size_t WS_GF = WS_GI + AL((size_t)MROWS * 4 * 4);
constexpr size_t WS_U = WS_GF + AL((size_t)MROWS * 4 * 4);
constexpr size_t WS_QKV = WS_U + AL((size_t)MROWS * 512 * 4);
constexpr size_t WS_CST = WS_QKV + AL((size_t)6 * MROWS * DM * 2);
constexpr size_t WS_NST = WS_CST + AL((size_t)MROWS * DFF * 2);
constexpr size_t WS_MST = WS_NST + AL((size_t)32 * 32 * 256 * 4);
constexpr size_t WS_YP = WS_MST + AL((size_t)32 * 64 * 4);
constexpr size_t WS_HM = WS_YP + AL((size_t)MROWS * 512 * 2);
constexpr size_t WS_GW = WS_HM + AL((size_t)MROWS * DM * 2);
constexpr size_t WS_CTR = WS_GW + AL((size_t)1024 * 8 * 4);
constexpr size_t WS_XCNT = WS_CTR + 4096;
constexpr size_t WS_RSB = WS_XCNT + 80 * 256;
constexpr size_t WS_RSS = WS_RSB + AL((size_t)NPR * 4 * 4);
constexpr size_t WS_END = WS_RSS + AL((size_t)NSA * 16 * 4);
static_assert((size_t)32 * 31 * 65536 * 2 <= (size_t)MROWS * DFF * 2, "Cst fits in act region");
static_assert(WS_END <= (size_t)536870912, "workspace map exceeds 512 MiB");

struct Params {
    const float *x_p, *x_s, *st_pool, *st_C, *st_n, *st_m, *c_p, *c_s, *g_mix, *g_ffn, *w_ada, *b_ada, *w_in, *b_i, *b_f, *w_pg, *pool_scale, *w_po, *m_norm, *w_mo, *w_out, *w1, *w2, *g_final;
    float* out; unsigned char* ws; int ph_lo, ph_hi;
};

typedef float f32x2 __attribute__((ext_vector_type(2)));
typedef __bf16 bf16x2_t __attribute__((ext_vector_type(2)));
__device__ __forceinline__ unsigned pk_bf16(float lo, float hi) { f32x2 v = {lo, hi}; bf16x2_t b = __builtin_convertvector(v, bf16x2_t); return __builtin_bit_cast(unsigned, b); }
__device__ __forceinline__ float bf2f(unsigned v) { return __uint_as_float(v << 16); }
__device__ __forceinline__ float bflo(unsigned v) { return __uint_as_float(v << 16); }
__device__ __forceinline__ float bfhi(unsigned v) { return __uint_as_float(v & 0xffff0000u); }
__device__ __forceinline__ bf16_t f2bf(float f) { return (bf16_t)(pk_bf16(f, 0.f) & 0xffffu); }
__device__ __forceinline__ float sigmoidf_(float x) { return __builtin_amdgcn_rcpf(1.f + __expf(-x)); }
__device__ __forceinline__ int row_batch(int row) { return row < NPR ? (row >> 11) : 8 + ((row - NPR) >> 2); }
__device__ __forceinline__ float wave_sum(float v) {
#pragma unroll
    for (int d = 32; d >= 1; d >>= 1) v += __shfl_xor(v, d);
    return v;
}
__device__ __forceinline__ float wave_max(float v) {
#pragma unroll
    for (int d = 32; d >= 1; d >>= 1) v = fmaxf(v, __shfl_xor(v, d));
    return v;
}
__device__ __forceinline__ float wave_scan_add(float v, int lane) {
#pragma unroll
    for (int d = 1; d < 64; d <<= 1) { float t = __shfl_up(v, d); if (lane >= d) v += t; }
    return v;
}
__device__ __forceinline__ float wave_scan_max(float v, int lane) {
#pragma unroll
    for (int d = 1; d < 64; d <<= 1) { float t = __shfl_up(v, d); if (lane >= d) v = fmaxf(v, t); }
    return v;
}
__device__ __forceinline__ int otid() { int t = threadIdx.x; asm volatile("" : "+v"(t)); return t; }
__device__ __forceinline__ void lds_barrier() { asm volatile("s_waitcnt lgkmcnt(0)" ::: "memory"); __builtin_amdgcn_s_barrier(); asm volatile("" ::: "memory"); }
#define MFMA16(a, b, c) __builtin_amdgcn_mfma_f32_16x16x32_bf16((a), (b), (c), 0, 0, 0)

#define LAS __attribute__((address_space(3)))
constexpr int BM = 256, BK = 64, HALF = 128, HTB = HALF * BK * 2, NXCD = 8, WGM = 8;
__device__ __forceinline__ int lds_byte(int r, int c) {
    const int st = (r >> 4) * 2 + (c >> 5), rr = r & 15, cc = c & 31, ob = rr * 64 + cc * 2;
    return st * 1024 + (ob ^ (((ob >> 9) & 1) << 5));
}
__device__ __forceinline__ void stage_rc(int b, int& R, int& C) {
    const int st = b / 1024, sb = b % 1024, swz = sb ^ (((sb >> 9) & 1) << 5);
    R = (st >> 1) * 16 + swz / 64; C = (st & 1) * 32 + (swz % 64) / 2;
}
__device__ __forceinline__ int perm32(int rho) { const int n = rho >> 4, i = rho & 15; return 8 * (i >> 2) + 4 * n + (i & 3); }
struct Unit { int pm, pn; };
struct StaticOrder {
    int nM, nN, nwg, G, c;
    __device__ void init(int M, int N, int G_, int c_) { nM = M / BM; nN = N / BM; nwg = nM * nN; G = G_; c = c_; }
    __device__ bool next(int i, Unit& u) const {
        const long L = (long)i * G + c; if (L >= nwg) return false;
        int wgid = (int)L; { const int q = nwg / NXCD, r = nwg % NXCD, xcd = wgid % NXCD, off = wgid / NXCD; wgid = (xcd < r ? xcd * (q + 1) : r * (q + 1) + (xcd - r) * q) + off; }
        const int nig = WGM * nN, gid = wgid / nig, fm = gid * WGM, gsz = (nM - fm) < WGM ? (nM - fm) : WGM;
        u.pm = fm + ((wgid % nig) % gsz); u.pn = (wgid % nig) / gsz; return true;
    }
};

#ifndef GEMM_SP2
#define GEMM_SP2 1
#endif
#ifndef GEMM_ALIGN
#define GEMM_ALIGN 1
#endif
template <class Epi, bool FUSED = false, bool SP2 = (GEMM_SP2 != 0), bool ALIGN_EPI = (GEMM_ALIGN != 0)>
__device__ __forceinline__ void gemm_phase(LAS unsigned char* lds, const bf16_t* gA, const bf16_t* gBt, const int N, const int K, const Epi& E, unsigned char* lds_gen = nullptr, const int Mrows = NPR) {
    const int tid = otid(), wid = __builtin_amdgcn_readfirstlane(tid >> 6), lane = tid & 63, wr = wid >> 2, wc = wid & 3, fr = lane & 15, fq = lane >> 4;
    const int nt = K / BK;
    StaticOrder S; S.init(Mrows, N, gridDim.x, blockIdx.x);
    unsigned voffA[2], voffB[2];
#pragma unroll
    for (int i = 0; i < 2; ++i) { int R, C; stage_rc(tid * 16 + i * 8192, R, C); const int Rb = (R & ~31) + perm32(R & 31); voffA[i] = (unsigned)(R * K + C) * 2u; voffB[i] = (unsigned)(Rb * K + C) * 2u; }
    const size_t kstep = (size_t)(BK * 2);
    const size_t hstep = (size_t)HALF * K * 2;
    const size_t tstep = 2 * hstep;
    const unsigned ldsw = (unsigned)wid * 1024u;
    const int aoff = lds_byte(wr * 64 + fr, fq * 8), boff = lds_byte(wc * 32 + fr, fq * 8);
#define PG8_SA(b, h) (((b) * 2 + (h)) * HTB)
#define PG8_SB(b, h) ((4 + (b) * 2 + (h)) * HTB)
#define PG8_STAGE(bufoff, gbase) PG8_STAGEV(bufoff, gbase, voffA)
#define PG8_STAGEB(bufoff, gbase) PG8_STAGEV(bufoff, gbase, voffB)
#define PG8_STAGEV(bufoff, gbase, voff) do { _Pragma("unroll") for (int _i = 0; _i < 2; ++_i) \
        __builtin_amdgcn_global_load_lds((const unsigned*)((const char*)(gbase) + (voff)[_i]), (LAS unsigned*)(lds + (bufoff) + ldsw + _i * 8192), 16, 0, 0); } while (0)
#define PG8_LDA(dst, b, h) do { _Pragma("unroll") for (int m = 0; m < 4; ++m) _Pragma("unroll") for (int k = 0; k < 2; ++k) dst[m][k] = *(const LAS bf16x8*)(lds + PG8_SA(b, h) + aoff + m * 2048 + k * 1024); } while (0)
#define PG8_LDB(dst, b, h) do { _Pragma("unroll") for (int n = 0; n < 2; ++n) _Pragma("unroll") for (int k = 0; k < 2; ++k) dst[n][k] = *(const LAS bf16x8*)(lds + PG8_SB(b, h) + boff + n * 2048 + k * 1024); } while (0)
#define PG8_MMA(ai, bj, At, Bt) do { __builtin_amdgcn_s_setprio(1); _Pragma("unroll") for (int m = 0; m < 4; ++m) _Pragma("unroll") for (int n = 0; n < 2; ++n) _Pragma("unroll") for (int k = 0; k < 2; ++k) \
        acc[ai][bj][m][n] = __builtin_amdgcn_mfma_f32_16x16x32_bf16(Bt[n][k], At[m][k], acc[ai][bj][m][n], 0, 0, 0); __builtin_amdgcn_s_setprio(0); } while (0)
#define PG8_WAIT_V(n) asm volatile("s_waitcnt vmcnt(" #n ")" ::: "memory")
#define PG8_WAIT_L(n) asm volatile("s_waitcnt lgkmcnt(" #n ")" ::: "memory")
#define PG8_BAR __builtin_amdgcn_s_barrier()
#define PG8_SCHED __builtin_amdgcn_sched_barrier(0)
    Unit cur, nxt; int ui = 0;
    if (!S.next(0, cur)) return;
    f32x4 acc[2][2][4][2];
#pragma unroll
    for (int a = 0; a < 2; ++a)
#pragma unroll
        for (int b = 0; b < 2; ++b)
#pragma unroll
            for (int m = 0; m < 4; ++m)
#pragma unroll
                for (int n = 0; n < 2; ++n) acc[a][b][m][n] = (f32x4){0.f, 0.f, 0.f, 0.f};
    bf16x8 At[4][2], B0[2][2], B1[2][2];
    const char* cA = (const char*)gA + (size_t)cur.pm * tstep; const char* cB = (const char*)gBt + (size_t)cur.pn * tstep;
    constexpr bool ALIGN = ALIGN_EPI && !FUSED;
    if constexpr (SP2) {
        PG8_STAGEB(PG8_SB(0, 0), cB); PG8_STAGEB(PG8_SB(0, 1), cB + hstep); PG8_STAGE(PG8_SA(0, 0), cA); PG8_STAGE(PG8_SA(0, 1), cA + hstep);
        if (wr == 1) PG8_BAR;
        PG8_WAIT_V(2); PG8_BAR;
        PG8_STAGEB(PG8_SB(1, 0), cB + kstep); PG8_STAGE(PG8_SA(1, 0), cA + kstep); PG8_STAGEB(PG8_SB(1, 1), cB + hstep + kstep);
        PG8_WAIT_V(6); PG8_BAR;
    } else {
        PG8_STAGEB(PG8_SB(0, 0), cB); PG8_STAGE(PG8_SA(0, 0), cA); PG8_STAGEB(PG8_SB(0, 1), cB + hstep); PG8_STAGE(PG8_SA(0, 1), cA + hstep);
        if (wr == 1) PG8_BAR;
        PG8_WAIT_V(4); PG8_BAR;
        PG8_STAGEB(PG8_SB(1, 0), cB + kstep); PG8_STAGE(PG8_SA(1, 0), cA + kstep); PG8_STAGEB(PG8_SB(1, 1), cB + hstep + kstep);
        PG8_WAIT_V(6); PG8_BAR;
    }
    for (;;) {
        const bool has_next = S.next(ui + 1, nxt);
        const char* nA = has_next ? (const char*)gA + (size_t)nxt.pm * tstep : cA; const char* nB = has_next ? (const char*)gBt + (size_t)nxt.pn * tstep : cB;
        for (int t = 0; t < nt; t += 2) {
            const bool last = (t == nt - 2);
            const char* a1 = cA + (size_t)(t + 1) * kstep;
            const char* a2 = last ? nA : cA + (size_t)(t + 2) * kstep; const char* b2 = last ? nB : cB + (size_t)(t + 2) * kstep;
            const char* a3 = a2 + kstep; const char* b3 = b2 + kstep;
            if constexpr (SP2) {
            PG8_LDB(B0, 0, 0); PG8_LDB(B1, 0, 1); PG8_SCHED; PG8_LDA(At, 0, 0); PG8_STAGE(PG8_SA(1, 1), a1 + hstep);
            PG8_WAIT_V(8); PG8_WAIT_L(0); PG8_BAR; PG8_MMA(0, 0, At, B0); PG8_MMA(0, 1, At, B1); PG8_BAR; PG8_SCHED;
            PG8_LDA(At, 0, 1); PG8_STAGEB(PG8_SB(0, 0), b2); PG8_STAGEB(PG8_SB(0, 1), b2 + hstep); PG8_STAGE(PG8_SA(0, 0), a2);
            PG8_WAIT_V(8); PG8_WAIT_L(0); PG8_BAR; PG8_MMA(1, 0, At, B0); PG8_MMA(1, 1, At, B1); PG8_BAR; PG8_SCHED;
            PG8_LDB(B0, 1, 0); PG8_LDB(B1, 1, 1); PG8_SCHED; PG8_LDA(At, 1, 0); PG8_STAGE(PG8_SA(0, 1), a2 + hstep);
            PG8_WAIT_V(8); PG8_WAIT_L(0); PG8_BAR; PG8_MMA(0, 0, At, B0); PG8_MMA(0, 1, At, B1); PG8_BAR; PG8_SCHED;
            PG8_LDA(At, 1, 1); PG8_STAGEB(PG8_SB(1, 0), b3); PG8_STAGEB(PG8_SB(1, 1), b3 + hstep); PG8_STAGE(PG8_SA(1, 0), a3);
            PG8_WAIT_V(8); PG8_WAIT_L(0); PG8_BAR; PG8_MMA(1, 0, At, B0); PG8_MMA(1, 1, At, B1); PG8_BAR; PG8_SCHED;
            } else {
            PG8_LDB(B0, 0, 0); PG8_SCHED; PG8_LDA(At, 0, 0); PG8_STAGE(PG8_SA(1, 1), a1 + hstep);
            PG8_WAIT_L(8); PG8_BAR; PG8_WAIT_L(0); PG8_MMA(0, 0, At, B0); PG8_BAR; PG8_SCHED;
            PG8_LDB(B1, 0, 1); PG8_STAGEB(PG8_SB(0, 0), b2);
            PG8_BAR; PG8_WAIT_L(0); PG8_MMA(0, 1, At, B1); PG8_BAR;
            PG8_LDA(At, 0, 1); PG8_STAGE(PG8_SA(0, 0), a2);
            PG8_BAR; PG8_WAIT_L(0); PG8_MMA(1, 0, At, B0); PG8_BAR; PG8_SCHED;
            PG8_STAGEB(PG8_SB(0, 1), b2 + hstep);
            PG8_WAIT_V(6); PG8_BAR; PG8_MMA(1, 1, At, B1); PG8_BAR;
            PG8_LDB(B0, 1, 0); PG8_SCHED; PG8_LDA(At, 1, 0); PG8_STAGE(PG8_SA(0, 1), a2 + hstep);
            PG8_WAIT_L(8); PG8_BAR; PG8_WAIT_L(0); PG8_MMA(0, 0, At, B0); PG8_BAR; PG8_SCHED;
            PG8_LDB(B1, 1, 1); PG8_STAGEB(PG8_SB(1, 0), b3);
            PG8_BAR; PG8_WAIT_L(0); PG8_MMA(0, 1, At, B1); PG8_BAR;
            PG8_LDA(At, 1, 1); PG8_STAGE(PG8_SA(1, 0), a3);
            PG8_BAR; PG8_WAIT_L(0); PG8_MMA(1, 0, At, B0); PG8_BAR; PG8_SCHED;
            PG8_STAGEB(PG8_SB(1, 1), b3 + hstep);
            PG8_WAIT_V(6); PG8_BAR; PG8_MMA(1, 1, At, B1); PG8_BAR;
            }
        }
        if constexpr (ALIGN) { if (wr == 0) PG8_BAR; }
        if constexpr (!FUSED) { const int r0 = cur.pm * BM + wr * 64 + fr, c0 = cur.pn * BM + wc * 32 + fq * 8;
#pragma unroll
          for (int ai = 0; ai < 2; ++ai)
#pragma unroll
            for (int m = 0; m < 4; ++m)
#pragma unroll
              for (int bj = 0; bj < 2; ++bj) E.apply8(r0 + ai * 128 + m * 16, c0 + bj * 128, acc[ai][bj][m][0], acc[ai][bj][m][1]); }
        if (!has_next) break;
#pragma unroll
        for (int a = 0; a < 2; ++a)
#pragma unroll
            for (int b = 0; b < 2; ++b)
#pragma unroll
                for (int m = 0; m < 4; ++m)
#pragma unroll
                    for (int n = 0; n < 2; ++n) acc[a][b][m][n] = (f32x4){0.f, 0.f, 0.f, 0.f};
        cur = nxt; cA = nA; cB = nB; ++ui;
        if constexpr (ALIGN) { if (wr == 1) PG8_BAR; }
    }
    PG8_WAIT_V(0);
    if constexpr (!ALIGN) { if (wr == 0) PG8_BAR; }
    PG8_BAR;
    if constexpr (FUSED) E.fused(acc, cur, wr, wc, fr, fq, lds_gen);
#undef PG8_SA
#undef PG8_SB
#undef PG8_STAGE
#undef PG8_STAGEB
#undef PG8_STAGEV
#undef PG8_LDA
#undef PG8_LDB
#undef PG8_MMA
#undef PG8_WAIT_V
#undef PG8_WAIT_L
#undef PG8_BAR
#undef PG8_SCHED
}

struct EpiG1 {
    float* u; bf16_t* qkv;
    __device__ __forceinline__ void apply(int row, int col, f32x4 v) const {
        const int bcol = col & ~255;
        const int seg = bcol < 512 ? 0 : 1 + ((bcol - 512) >> 10);
        if (seg == 0) { *(f32x4*)(u + (size_t)row * 512 + col) = v; }
        else {
            const int cc = col - 512 - (seg - 1) * 1024;
            if (seg == 2) v *= 0.0625f;
            if (seg >= 4) { v[0] = sigmoidf_(v[0]); v[1] = sigmoidf_(v[1]); v[2] = sigmoidf_(v[2]); v[3] = sigmoidf_(v[3]); }
            u32x2 w; w.x = pk_bf16(v[0], v[1]); w.y = pk_bf16(v[2], v[3]);
            *(u32x2*)(qkv + (size_t)(seg - 1) * MROWS * DM + (size_t)row * DM + cc) = w;
        }
    }
    __device__ __forceinline__ void apply8(int row, int col, f32x4 v0, f32x4 v1) const {
        const int bcol = col & ~255;
        const int seg = bcol < 512 ? 0 : 1 + ((bcol - 512) >> 10);
        if (seg == 0) { *(f32x4*)(u + (size_t)row * 512 + col) = v0; *(f32x4*)(u + (size_t)row * 512 + col + 4) = v1; }
        else {
            const int cc = col - 512 - (seg - 1) * 1024;
            if (seg == 2) { v0 *= 0.0625f; v1 *= 0.0625f; }
            if (seg >= 4) {
#pragma unroll
                for (int j = 0; j < 4; ++j) { v0[j] = sigmoidf_(v0[j]); v1[j] = sigmoidf_(v1[j]); } }
            u32x4 w; w.x = pk_bf16(v0[0], v0[1]); w.y = pk_bf16(v0[2], v0[3]); w.z = pk_bf16(v1[0], v1[1]); w.w = pk_bf16(v1[2], v1[3]);
            *(u32x4*)(qkv + (size_t)(seg - 1) * MROWS * DM + (size_t)row * DM + cc) = w;
        }
    }
};
struct EpiMerge {
    bf16_t* merged; const bf16_t* sg; int mode;
    __device__ __forceinline__ void apply(int row, int col, f32x4 v) const {
        const size_t idx = (size_t)row * DM + col;
        const u32x2 g = *(const u32x2*)(sg + idx);
        v[0] *= bflo(g.x); v[1] *= bfhi(g.x); v[2] *= bflo(g.y); v[3] *= bfhi(g.y);
        if (mode) { const u32x2 o = *(const u32x2*)(merged + idx); v[0] += bflo(o.x); v[1] += bfhi(o.x); v[2] += bflo(o.y); v[3] += bfhi(o.y); }
        u32x2 w; w.x = pk_bf16(v[0], v[1]); w.y = pk_bf16(v[2], v[3]);
        *(u32x2*)(merged + idx) = w;
    }
    __device__ __forceinline__ void apply8(int row, int col, f32x4 v0, f32x4 v1) const {
        const size_t idx = (size_t)row * DM + col;
        const u32x4 g = *(const u32x4*)(sg + idx);
        v0[0] *= bflo(g.x); v0[1] *= bfhi(g.x); v0[2] *= bflo(g.y); v0[3] *= bfhi(g.y); v1[0] *= bflo(g.z); v1[1] *= bfhi(g.z); v1[2] *= bflo(g.w); v1[3] *= bfhi(g.w);
        if (mode) { const u32x4 o = *(const u32x4*)(merged + idx); v0[0] += bflo(o.x); v0[1] += bfhi(o.x); v0[2] += bflo(o.y); v0[3] += bfhi(o.y); v1[0] += bflo(o.z); v1[1] += bfhi(o.z); v1[2] += bflo(o.w); v1[3] += bfhi(o.w); }
        u32x4 w; w.x = pk_bf16(v0[0], v0[1]); w.y = pk_bf16(v0[2], v0[3]); w.z = pk_bf16(v1[0], v1[1]); w.w = pk_bf16(v1[2], v1[3]);
        *(u32x4*)(merged + idx) = w;
    }
};
struct EpiRes {
    float* out; const float* xp; const float* xs; const float* ada; int gate_off; int xin;
    __device__ __forceinline__ void apply(int row, int col, f32x4 v) const {
        const f32x4 g = *(const f32x4*)(ada + (size_t)row_batch(row) * ADAW + gate_off + col);
        const float* bp = xin ? (row < NPR ? xp + (size_t)row * DM : xs + (size_t)(row - NPR) * DM) : out + (size_t)row * DM;
        const f32x4 b = *(const f32x4*)(bp + col);
        *(f32x4*)(out + (size_t)row * DM + col) = b + g * v;
    }
    __device__ __forceinline__ void apply8(int row, int col, f32x4 v0, f32x4 v1) const { apply(row, col, v0); apply(row, col + 4, v1); }
};
struct EpiAct {
    bf16_t* act;
    __device__ __forceinline__ void apply(int row, int col, f32x4 v) const {
#pragma unroll
        for (int j = 0; j < 4; ++j) { float t = fmaxf(v[j], 0.f); v[j] = t * t; }
        u32x2 w; w.x = pk_bf16(v[0], v[1]); w.y = pk_bf16(v[2], v[3]);
        *(u32x2*)(act + (size_t)row * DFF + col) = w;
    }
    __device__ __forceinline__ void apply8(int row, int col, f32x4 v0, f32x4 v1) const {
#pragma unroll
        for (int j = 0; j < 4; ++j) { float t0 = fmaxf(v0[j], 0.f); v0[j] = t0 * t0; float t1 = fmaxf(v1[j], 0.f); v1[j] = t1 * t1; }
        u32x4 w; w.x = pk_bf16(v0[0], v0[1]); w.y = pk_bf16(v0[2], v0[3]); w.z = pk_bf16(v1[0], v1[1]); w.w = pk_bf16(v1[2], v1[3]);
        *(u32x4*)(act + (size_t)row * DFF + col) = w;
    }
};

__device__ __forceinline__ void xchg_publish_wait(unsigned* cnt, unsigned need) {
    asm volatile("s_waitcnt vmcnt(0)" ::: "memory");
    __syncthreads();
    if (threadIdx.x == 0) {
        __builtin_amdgcn_fence(__ATOMIC_RELEASE, "agent");
        asm volatile("s_waitcnt vmcnt(0)" ::: "memory");
        __hip_atomic_fetch_add(cnt, 1u, __ATOMIC_RELAXED, __HIP_MEMORY_SCOPE_AGENT);
        unsigned spins = 0;
        while (__hip_atomic_load(cnt, __ATOMIC_RELAXED, __HIP_MEMORY_SCOPE_AGENT) < need) { __builtin_amdgcn_s_sleep(1); if (++spins > (1u << 24)) break; }
        __builtin_amdgcn_fence(__ATOMIC_ACQUIRE, "agent");
        asm volatile("s_waitcnt vmcnt(0)" ::: "memory");
    }
    __syncthreads();
}
extern __shared__ __attribute__((aligned(16))) unsigned char g_dyn_lds[];
struct EpiFinal {
    float* out; const float* ada; const float* gfin; float* rowpart; unsigned* cnt; float* rowpartS; unsigned* cntS;
    __device__ __forceinline__ void apply(int, int, f32x4) const {}
    __device__ __forceinline__ void apply8(int, int, f32x4, f32x4) const {}
    __device__ __forceinline__ void fused(f32x4 (&acc)[2][2][4][2], const Unit& u, int wr, int wc, int fr, int fq, unsigned char* lds) const {
        const int tid = otid();
        (void)lds;
        float* P = (float*)g_dyn_lds;
        float* S = P + 1024;
        const int r0 = u.pm * BM + wr * 64 + fr, c0 = u.pn * BM + wc * 32 + fq * 8;
#pragma unroll
        for (int ai = 0; ai < 2; ++ai)
#pragma unroll
            for (int m = 0; m < 4; ++m) {
                const int row = r0 + ai * 128 + m * 16;
                const float* ga = ada + (size_t)row_batch(row) * ADAW + 5120;
                float ss = 0.f;
#pragma unroll
                for (int bj = 0; bj < 2; ++bj)
#pragma unroll
                    for (int n = 0; n < 2; ++n) {
                        const int col = c0 + bj * 128 + n * 4;
                        const f32x4 g = *(const f32x4*)(ga + col);
                        const f32x4 b = *(const f32x4*)(out + (size_t)row * DM + col);
                        const f32x4 v = b + g * acc[ai][bj][m][n];
                        acc[ai][bj][m][n] = v;
                        ss += v[0] * v[0] + v[1] * v[1] + v[2] * v[2] + v[3] * v[3];
                    }
                ss += __shfl_xor(ss, 16); ss += __shfl_xor(ss, 32);
                if (fq == 0) P[(ai * 128 + wr * 64 + m * 16 + fr) * 4 + wc] = ss;
                asm volatile("" ::: "memory");
            }
        __syncthreads();
        if (tid < 256) rowpart[((size_t)u.pm * BM + tid) * 4 + u.pn] = (P[tid * 4] + P[tid * 4 + 1]) + (P[tid * 4 + 2] + P[tid * 4 + 3]);
        xchg_publish_wait(cnt + u.pm * 64, 8u);
        if (tid < 256) { const f32x4 rp = *(const f32x4*)(rowpart + ((size_t)u.pm * BM + tid) * 4); S[tid] = rsqrtf(((rp[0] + rp[1]) + (rp[2] + rp[3])) * (1.0f / DM) + EPS); }
        __syncthreads();
#pragma unroll
        for (int ai = 0; ai < 2; ++ai)
#pragma unroll
            for (int m = 0; m < 4; ++m) {
                const int row = r0 + ai * 128 + m * 16;
                const float rs = S[ai * 128 + wr * 64 + m * 16 + fr];
#pragma unroll
                for (int bj = 0; bj < 2; ++bj)
#pragma unroll
                    for (int n = 0; n < 2; ++n) {
                        const int col = c0 + bj * 128 + n * 4;
                        const f32x4 gf = *(const f32x4*)(gfin + col);
                        __builtin_nontemporal_store(acc[ai][bj][m][n] * rs * gf, (f32x4*)(out + (size_t)row * DM + col));
                    }
            }
        __syncthreads();
    }
};

struct EpiMid {
    float* out; const float* xp; const float* xs; const float* ada; const float* gffn; bf16_t* hbuf; float* rowpart; unsigned* cnt; float* rowpartS; unsigned* cntS;
    __device__ __forceinline__ void apply(int, int, f32x4) const {}
    __device__ __forceinline__ void apply8(int, int, f32x4, f32x4) const {}
    __device__ __forceinline__ void fused(f32x4 (&acc)[2][2][4][2], const Unit& u, int wr, int wc, int fr, int fq, unsigned char*) const {
        const int tid = otid();
        float* P = (float*)g_dyn_lds;
        float* S = P + 1024;
        const int r0 = u.pm * BM + wr * 64 + fr, c0 = u.pn * BM + wc * 32 + fq * 8;
#pragma unroll
        for (int ai = 0; ai < 2; ++ai)
#pragma unroll
            for (int m = 0; m < 4; ++m) {
                const int row = r0 + ai * 128 + m * 16;
                const float* ga = ada + (size_t)(row >> 11) * ADAW + 2048;
                float ss = 0.f;
#pragma unroll
                for (int bj = 0; bj < 2; ++bj)
#pragma unroll
                    for (int n = 0; n < 2; ++n) {
                        const int col = c0 + bj * 128 + n * 4;
                        const f32x4 g = *(const f32x4*)(ga + col);
                        const f32x4 b = *(const f32x4*)(xp + (size_t)row * DM + col);
                        const f32x4 v = b + g * acc[ai][bj][m][n];
                        acc[ai][bj][m][n] = v;
                        *(f32x4*)(out + (size_t)row * DM + col) = v;
                        ss += v[0] * v[0] + v[1] * v[1] + v[2] * v[2] + v[3] * v[3];
                    }
                ss += __shfl_xor(ss, 16); ss += __shfl_xor(ss, 32);
                if (fq == 0) P[(ai * 128 + wr * 64 + m * 16 + fr) * 4 + wc] = ss;
                asm volatile("" ::: "memory");
            }
        __syncthreads();
        if (tid < 256) rowpart[((size_t)u.pm * BM + tid) * 4 + u.pn] = (P[tid * 4] + P[tid * 4 + 1]) + (P[tid * 4 + 2] + P[tid * 4 + 3]);
        xchg_publish_wait(cnt + u.pm * 64, 4u);
        if (tid < 256) { const f32x4 rp = *(const f32x4*)(rowpart + ((size_t)u.pm * BM + tid) * 4); S[tid] = rsqrtf(((rp[0] + rp[1]) + (rp[2] + rp[3])) * (1.0f / DM) + EPS); }
        __syncthreads();
        const float* ab = ada + (size_t)(r0 >> 11) * ADAW;
#pragma unroll
        for (int bj = 0; bj < 2; ++bj) {
            const int col = c0 + bj * 128;
            f32x4 G0 = *(const f32x4*)(gffn + col), G1 = *(const f32x4*)(gffn + col + 4);
            G0 *= (*(const f32x4*)(ab + 4096 + col) + 1.0f); G1 *= (*(const f32x4*)(ab + 4096 + col + 4) + 1.0f);
            const f32x4 S0 = *(const f32x4*)(ab + 3072 + col), S1 = *(const f32x4*)(ab + 3072 + col + 4);
#pragma unroll
            for (int ai = 0; ai < 2; ++ai)
#pragma unroll
                for (int m = 0; m < 4; ++m) {
                    const int row = r0 + ai * 128 + m * 16;
                    const float rs = S[ai * 128 + wr * 64 + m * 16 + fr];
                    const f32x4 h0 = acc[ai][bj][m][0] * rs * G0 + S0, h1 = acc[ai][bj][m][1] * rs * G1 + S1;
                    u32x4 w; w.x = pk_bf16(h0[0], h0[1]); w.y = pk_bf16(h0[2], h0[3]); w.z = pk_bf16(h1[0], h1[1]); w.w = pk_bf16(h1[2], h1[3]);
                    *(u32x4*)(hbuf + (size_t)row * DM + col) = w;
                }
        }
        __syncthreads();
    }
};

template <class Epi, int FIN = 0>
__device__ __forceinline__ void small_gemm_phase(unsigned char* lds, const bf16_t* gA, const bf16_t* gBt, const int N, const int K, const Epi& E, const int t_begin, const int t_end) {
    int tid_ = threadIdx.x; asm volatile("" : "+v"(tid_));
    const int tid = tid_, lane = tid & 63, w = tid >> 6, fr = lane & 15, fq = lane >> 4;
    const int kw = K / 8;
    float* red = (float*)lds;
    for (int t = t_begin; t < t_end; ++t) {
        const int rt = t & 15, ct = t >> 4;
        const int row0 = NPR + rt * 32, col0 = ct * 64;
        const bf16_t* ap = gA + (size_t)(row0 + fr) * K + w * kw + fq * 8;
        const bf16_t* bp = gBt + (size_t)(col0 + fr) * K + w * kw + fq * 8;
        f32x4 acc[2][4] = {};
#pragma unroll 2
        for (int k0 = 0; k0 < kw; k0 += 64) {
            bf16x8 af[2][2], bfm[2][4];
#pragma unroll
            for (int s2 = 0; s2 < 2; ++s2) {
#pragma unroll
                for (int m = 0; m < 2; ++m) af[s2][m] = *(const bf16x8*)(ap + (size_t)m * 16 * K + k0 + s2 * 32);
#pragma unroll
                for (int n = 0; n < 4; ++n) bfm[s2][n] = *(const bf16x8*)(bp + (size_t)n * 16 * K + k0 + s2 * 32);
            }
#pragma unroll
            for (int s2 = 0; s2 < 2; ++s2)
#pragma unroll
                for (int m = 0; m < 2; ++m)
#pragma unroll
                    for (int n = 0; n < 4; ++n) acc[m][n] = MFMA16(bfm[s2][n], af[s2][m], acc[m][n]);
        }
#pragma unroll
        for (int m = 0; m < 2; ++m)
#pragma unroll
            for (int n = 0; n < 4; ++n) *(f32x4*)(red + ((w * 32 + m * 16 + fr) * 64 + n * 16 + fq * 4)) = acc[m][n];
        __syncthreads();
        {
            const int r = tid >> 4, c4 = (tid & 15) * 4;
            f32x4 v = *(const f32x4*)(red + (r * 64 + c4));
#pragma unroll
            for (int ww = 1; ww < 8; ++ww) v += *(const f32x4*)(red + ((ww * 32 + r) * 64 + c4));
            if constexpr (FIN == 0) E.apply(row0 + r, col0 + c4, v);
            else if constexpr (FIN == 2) {
                const int row = row0 + r, col = col0 + c4;
                const float* ab = E.ada + (size_t)row_batch(row) * ADAW;
                const f32x4 g = *(const f32x4*)(ab + 2048 + col);
                const f32x4 b = *(const f32x4*)(E.xs + (size_t)(row - NPR) * DM + col);
                const f32x4 x1 = b + g * v;
                *(f32x4*)(E.out + (size_t)row * DM + col) = x1;
                float ss = x1[0] * x1[0] + x1[1] * x1[1] + x1[2] * x1[2] + x1[3] * x1[3];
                ss += __shfl_xor(ss, 1); ss += __shfl_xor(ss, 2); ss += __shfl_xor(ss, 4); ss += __shfl_xor(ss, 8);
                if ((tid & 15) == 0) E.rowpartS[(size_t)(row - NPR) * 16 + ct] = ss;
                xchg_publish_wait(E.cntS + rt * 64, 16u);
                const float* rp = E.rowpartS + (size_t)(row - NPR) * 16;
                float tot = 0.f;
#pragma unroll
                for (int q = 0; q < 16; q += 4) { const f32x4 t4 = *(const f32x4*)(rp + q); tot += (t4[0] + t4[1]) + (t4[2] + t4[3]); }
                const float rs = rsqrtf(tot * (1.0f / DM) + EPS);
                const f32x4 G = *(const f32x4*)(E.gffn + col) * (*(const f32x4*)(ab + 4096 + col) + 1.0f);
                const f32x4 h = x1 * rs * G + *(const f32x4*)(ab + 3072 + col);
                u32x2 wv; wv.x = pk_bf16(h[0], h[1]); wv.y = pk_bf16(h[2], h[3]);
                *(u32x2*)(E.hbuf + (size_t)row * DM + col) = wv;
            }
            else {
                const int row = row0 + r, col = col0 + c4;
                const f32x4 g = *(const f32x4*)(E.ada + (size_t)row_batch(row) * ADAW + 5120 + col);
                const f32x4 b = *(const f32x4*)(E.out + (size_t)row * DM + col);
                const f32x4 x2 = b + g * v;
                float ss = x2[0] * x2[0] + x2[1] * x2[1] + x2[2] * x2[2] + x2[3] * x2[3];
                ss += __shfl_xor(ss, 1); ss += __shfl_xor(ss, 2); ss += __shfl_xor(ss, 4); ss += __shfl_xor(ss, 8);
                if ((tid & 15) == 0) E.rowpartS[(size_t)(row - NPR) * 16 + ct] = ss;
                xchg_publish_wait(E.cntS + rt * 64, 32u);
                const float* rp = E.rowpartS + (size_t)(row - NPR) * 16;
                float tot = 0.f;
#pragma unroll
                for (int q = 0; q < 16; q += 4) { const f32x4 t4 = *(const f32x4*)(rp + q); tot += (t4[0] + t4[1]) + (t4[2] + t4[3]); }
                const float rs = rsqrtf(tot * (1.0f / DM) + EPS);
                const f32x4 gf = *(const f32x4*)(E.gfin + col);
                *(f32x4*)(E.out + (size_t)row * DM + col) = x2 * rs * gf;
            }
        }
        __syncthreads();
    }
}

__device__ __forceinline__ void conv_tile(const float* __restrict__ src, int ld, int K, bf16_t* __restrict__ dst, int kt, int ntile, int src_col0, float* lds) {
    const int tid = otid();
    const int k0 = kt * 64, n0 = ntile * 64;
#pragma unroll
    for (int i = 0; i < 2; ++i) {
        const int r = (tid >> 4) + i * 32, c4 = (tid & 15) * 4;
        const f32x4 v = *(const f32x4*)(src + (size_t)(k0 + r) * ld + src_col0 + c4);
        lds[r * 65 + c4 + 0] = v[0]; lds[r * 65 + c4 + 1] = v[1]; lds[r * 65 + c4 + 2] = v[2]; lds[r * 65 + c4 + 3] = v[3];
    }
    __syncthreads();
    {
        const int n = tid >> 3, k8 = (tid & 7) * 8;
        float v[8];
#pragma unroll
        for (int i = 0; i < 8; ++i) v[i] = lds[(k8 + i) * 65 + n];
        u32x4 w; w.x = pk_bf16(v[0], v[1]); w.y = pk_bf16(v[2], v[3]); w.z = pk_bf16(v[4], v[5]); w.w = pk_bf16(v[6], v[7]);
        *(u32x4*)(dst + (size_t)(n0 + n) * K + k0 + k8) = w;
    }
    __syncthreads();
}

__device__ __forceinline__ void conv_strip(const float* __restrict__ src, int ld, int K, bf16_t* __restrict__ dst, int kt, int nt4, int src_col0, float* lds) {
    const int tid = otid();
    const int k0 = kt * 64, n0 = nt4 * 256;
    f32x4 v[8];
#pragma unroll
    for (int i = 0; i < 8; ++i) { const int r = (tid >> 6) + i * 8, c4 = (tid & 63) * 4; v[i] = __builtin_nontemporal_load((const f32x4*)(src + (size_t)(k0 + r) * ld + src_col0 + c4)); }
#pragma unroll
    for (int i = 0; i < 8; ++i) { const int r = (tid >> 6) + i * 8, c4 = (tid & 63) * 4;
        lds[r * 257 + c4 + 0] = v[i][0]; lds[r * 257 + c4 + 1] = v[i][1]; lds[r * 257 + c4 + 2] = v[i][2]; lds[r * 257 + c4 + 3] = v[i][3]; }
    __syncthreads();
#pragma unroll
    for (int j = 0; j < 4; ++j) {
        const int n = (tid >> 3) + j * 64, k8 = (tid & 7) * 8;
        float x[8];
#pragma unroll
        for (int i = 0; i < 8; ++i) x[i] = lds[(k8 + i) * 257 + n];
        u32x4 w; w.x = pk_bf16(x[0], x[1]); w.y = pk_bf16(x[2], x[3]); w.z = pk_bf16(x[4], x[5]); w.w = pk_bf16(x[6], x[7]);
        *(u32x4*)(dst + (size_t)(n0 + n) * K + k0 + k8) = w;
    }
    __syncthreads();
}

__device__ __forceinline__ void ada_item(const Params& p, int item, float* lds) {
    const int tid = otid(), lane = tid & 63, w = tid >> 6;
    const int cg_ = item >> 3, kq = item & 7;
    const int n0 = cg_ * 128 + lane * 2;
    const int kbase = kq * 128;
    f32x2 acc[17];
#pragma unroll
    for (int r = 0; r < 17; ++r) acc[r] = (f32x2){0.f, 0.f};
    f32x2 wv[16];
#pragma unroll
    for (int j = 0; j < 16; ++j) wv[j] = __builtin_nontemporal_load((const f32x2*)(p.w_ada + (size_t)(kbase + j) * ADAW + n0));
    for (int e = tid; e < NBATCH * 32; e += NTH) {
        const int r = e >> 5, k4 = (e & 31) * 4;
        const float* cp = r < 8 ? p.c_p + (size_t)r * DM : p.c_s + (size_t)(r - 8) * DM;
        f32x4 v = *(const f32x4*)(cp + kbase + k4);
#pragma unroll
        for (int j = 0; j < 4; ++j) v[j] = v[j] * sigmoidf_(v[j]);
        *(f32x4*)(lds + r * 128 + k4) = v;
    }
    __syncthreads();
#pragma unroll 1
    for (int kb = 0; kb < 128; kb += 16) {
        f32x2 wn[16];
        if (kb + 16 < 128) {
#pragma unroll
            for (int j = 0; j < 16; ++j) wn[j] = __builtin_nontemporal_load((const f32x2*)(p.w_ada + (size_t)(kbase + kb + 16 + j) * ADAW + n0));
        }
#pragma unroll
        for (int r = 0; r < 17; ++r) {
#pragma unroll
            for (int k4 = 0; k4 < 16; k4 += 4) {
                const f32x4 sv = *(const f32x4*)(lds + (w * 17 + r) * 128 + kb + k4);
                acc[r] += wv[k4] * sv[0]; acc[r] += wv[k4 + 1] * sv[1]; acc[r] += wv[k4 + 2] * sv[2]; acc[r] += wv[k4 + 3] * sv[3];
            }
        }
        if (kb + 16 < 128) {
#pragma unroll
            for (int j = 0; j < 16; ++j) wv[j] = wn[j];
        }
    }
    __syncthreads();
    float* part = (float*)(p.ws + WS_ADAP) + (size_t)kq * NBATCH * ADAW;
#pragma unroll
    for (int r = 0; r < 17; ++r) *(f32x2*)(part + (size_t)(w * 17 + r) * ADAW + n0) = acc[r];
}

__device__ __forceinline__ void phase0(const Params& p, float* lds) {
    const int NADA = 48 * 8;
    const int T_IN = 16 * 26, T_PG = 16, T_PO = 8 * 4, T_MO = 64, T_OUT = 64, T_W1 = 16 * 16, T_W2 = 64 * 4;
    const int total = NADA + T_IN + T_PG + T_PO + T_MO + T_OUT + T_W1 + T_W2 + 1;
    unsigned* qctr = (unsigned*)(p.ws + WS_CTR) + 16;
    volatile unsigned* slot = (volatile unsigned*)((unsigned char*)lds + LDS_BYTES - 16);
    for (;;) {
        if (threadIdx.x == 0) *slot = atomicAdd(qctr, 1u);
        __syncthreads();
        const int it = (int)*slot;
        __syncthreads();
        if (it >= total) break;
        int t = it;
        if (t < NADA) { ada_item(p, t, lds); continue; }
        t -= NADA;
        if (t < T_IN) { const int kt = t / 26, nt_ = t % 26; const int n0 = nt_ * 256; const int sc = n0 < 4608 ? n0 : n0 + 8;
            conv_strip(p.w_in, INW, DM, (bf16_t*)(p.ws + WS_WIN), kt, nt_, sc, lds); continue; }
        t -= T_IN;
        if (t < T_PG) { const int g = t >> 2, kt = (t >> 1) & 1, nt_ = t & 1;
            conv_tile(p.w_pg + (size_t)g * 128 * 128, 128, 128, (bf16_t*)(p.ws + WS_WPG) + (size_t)g * 128 * 128, kt, nt_, nt_ * 64, lds); continue; }
        t -= T_PG;
        if (t < T_PO) { const int kt = t / 4, nt_ = t % 4; conv_strip(p.w_po, 1024, 512, (bf16_t*)(p.ws + WS_WPO), kt, nt_, nt_ * 256, lds); continue; }
        t -= T_PO;
        if (t < T_MO) { const int kt = t / 4, nt_ = t % 4; conv_strip(p.w_mo, 1024, 1024, (bf16_t*)(p.ws + WS_WMO), kt, nt_, nt_ * 256, lds); continue; }
        t -= T_MO;
        if (t < T_OUT) { const int kt = t / 4, nt_ = t % 4; conv_strip(p.w_out, 1024, 1024, (bf16_t*)(p.ws + WS_WOUT), kt, nt_, nt_ * 256, lds); continue; }
        t -= T_OUT;
        if (t < T_W1) { const int kt = t / 16, nt_ = t % 16; conv_strip(p.w1, 4096, 1024, (bf16_t*)(p.ws + WS_W1), kt, nt_, nt_ * 256, lds); continue; }
        t -= T_W1;
        if (t < T_W2) { const int kt = t / 4, nt_ = t % 4; conv_strip(p.w2, 1024, 4096, (bf16_t*)(p.ws + WS_W2), kt, nt_, nt_ * 256, lds); continue; }
        for (int e = threadIdx.x; e < 1024 * 2; e += NTH) { const int k = e >> 1, hf = e & 1;
            *(f32x4*)((float*)(p.ws + WS_GW) + k * 8 + hf * 4) = *(const f32x4*)(p.w_in + (size_t)k * INW + 4608 + hf * 4); }
    }
}

__device__ __forceinline__ void norm_item(const Params& p, int item, int mode, float* lds) {
    const int tid = otid(), lane = tid & 63, w = tid >> 6;
    const float* adap = (const float*)(p.ws + WS_ADAP);
    const float* adaf = (const float*)(p.ws + WS_ADA);
    bf16_t* hbuf = (bf16_t*)(p.ws + WS_H);
    if (mode == 0) {
        for (int e = tid; e < 1024 * 2; e += NTH) *(f32x4*)(lds + e * 4) = *(const f32x4*)((const float*)(p.ws + WS_GW) + e * 4);
        __syncthreads();
    }
    const int r_begin = item * 64 + w * 8;
    const int r_extra = NPR + item * 2 + w;
    const int nrows = w < 2 ? 9 : 8;
    int cur_b = -1;
    f32x4 G[4], S[4], xn[4];
    { const int row = r_begin; const float* src0 = mode == 0 ? (row < NPR ? p.x_p + (size_t)row * DM : p.x_s + (size_t)(row - NPR) * DM) : p.out + (size_t)row * DM;
#pragma unroll
      for (int i = 0; i < 4; ++i) xn[i] = *(const f32x4*)(src0 + i * 256 + lane * 4); }
    for (int rr = 0; rr < nrows; ++rr) {
        const int row = rr < 8 ? r_begin + rr : r_extra;
        const int b = row_batch(row);
        if (mode != 2 && b != cur_b) {
            cur_b = b;
            const float* gw = mode == 0 ? p.g_mix : p.g_ffn;
            const int sh_off = mode == 0 ? 0 : 3072, sc_off = mode == 0 ? 1024 : 4096;
            f32x4 scv[4], shv[4];
            if (mode == 0) {
#pragma unroll
                for (int i = 0; i < 4; ++i) { const int col = i * 256 + lane * 4; scv[i] = *(const f32x4*)(p.b_ada + sc_off + col); shv[i] = *(const f32x4*)(p.b_ada + sh_off + col); }
#pragma unroll 2
                for (int q = 0; q < 8; ++q) {
                    const float* ap = adap + ((size_t)q * NBATCH + b) * ADAW;
#pragma unroll
                    for (int i = 0; i < 4; ++i) { const int col = i * 256 + lane * 4; scv[i] += *(const f32x4*)(ap + sc_off + col); shv[i] += *(const f32x4*)(ap + sh_off + col); }
                }
            } else {
#pragma unroll
                for (int i = 0; i < 4; ++i) { const int col = i * 256 + lane * 4; scv[i] = *(const f32x4*)(adaf + (size_t)b * ADAW + sc_off + col); shv[i] = *(const f32x4*)(adaf + (size_t)b * ADAW + sh_off + col); }
            }
#pragma unroll
            for (int i = 0; i < 4; ++i) { const f32x4 g = *(const f32x4*)(gw + i * 256 + lane * 4); G[i] = g * (scv[i] + 1.0f); S[i] = shv[i]; }
        }
        f32x4 x[4]; float ss = 0.f;
#pragma unroll
        for (int i = 0; i < 4; ++i) { x[i] = xn[i]; ss += x[i][0] * x[i][0] + x[i][1] * x[i][1] + x[i][2] * x[i][2] + x[i][3] * x[i][3]; }
        if (rr + 1 < nrows) { const int rown = rr + 1 < 8 ? row + 1 : r_extra;
            const float* srcn = mode == 0 ? (rown < NPR ? p.x_p + (size_t)rown * DM : p.x_s + (size_t)(rown - NPR) * DM) : p.out + (size_t)rown * DM;
#pragma unroll
            for (int i = 0; i < 4; ++i) xn[i] = *(const f32x4*)(srcn + i * 256 + lane * 4); }
        ss = wave_sum(ss);
        const float rstd = rsqrtf(ss * (1.0f / DM) + EPS);
        if (mode == 2) {
#pragma unroll
            for (int i = 0; i < 4; ++i) { const f32x4 g = *(const f32x4*)(p.g_final + i * 256 + lane * 4); __builtin_nontemporal_store(x[i] * rstd * g, (f32x4*)(p.out + (size_t)row * DM + i * 256 + lane * 4)); }
            continue;
        }
        f32x4 hv[4];
#pragma unroll
        for (int i = 0; i < 4; ++i) { hv[i] = x[i] * rstd * G[i] + S[i];
            u32x2 wv; wv.x = pk_bf16(hv[i][0], hv[i][1]); wv.y = pk_bf16(hv[i][2], hv[i][3]);
            *(u32x2*)(hbuf + (size_t)row * DM + i * 256 + lane * 4) = wv; }
        if (mode == 0) {
            float d[8];
#pragma unroll
            for (int j = 0; j < 8; ++j) d[j] = 0.f;
#pragma unroll
            for (int i = 0; i < 4; ++i)
#pragma unroll
                for (int e = 0; e < 4; ++e) {
                    const int k = i * 256 + lane * 4 + e;
                    const f32x4 w0 = *(const f32x4*)(lds + k * 8), w1 = *(const f32x4*)(lds + k * 8 + 4);
                    const float hvv = hv[i][e];
                    d[0] += hvv * w0[0]; d[1] += hvv * w0[1]; d[2] += hvv * w0[2]; d[3] += hvv * w0[3];
                    d[4] += hvv * w1[0]; d[5] += hvv * w1[1]; d[6] += hvv * w1[2]; d[7] += hvv * w1[3];
                }
#pragma unroll
            for (int j = 0; j < 8; ++j) d[j] = wave_sum(d[j]);
            if (lane < 4) {
                float di = lane == 0 ? d[0] : lane == 1 ? d[1] : lane == 2 ? d[2] : d[3];
                float df = lane == 0 ? d[4] : lane == 1 ? d[5] : lane == 2 ? d[6] : d[7];
                di += p.b_i[lane];
                const float z = df + p.b_f[lane];
                const float lf = fminf(z, 0.f) - log1pf(__expf(-fabsf(z)));
                ((float*)(p.ws + WS_GI))[(size_t)row * 4 + lane] = di;
                ((float*)(p.ws + WS_GF))[(size_t)row * 4 + lane] = lf;
            }
        }
    }
    if (mode == 0) __syncthreads();
}

__device__ __forceinline__ void ada_final_slice(const Params& p, int blk) {
    const float* adap = (const float*)(p.ws + WS_ADAP);
    float* adaf = (float*)(p.ws + WS_ADA);
    for (int e = threadIdx.x; e < 816; e += NTH) {
        const size_t idx = ((size_t)blk * 816 + e) * 4;
        f32x4 v = *(const f32x4*)(p.b_ada + (idx % ADAW));
#pragma unroll
        for (int q = 0; q < 8; ++q) v += *(const f32x4*)(adap + (size_t)q * NBATCH * ADAW + idx);
        *(f32x4*)(adaf + idx) = v;
    }
}

__device__ __forceinline__ void scan_item(const Params& p, int item, unsigned char* lds) {
    const int tid = otid(), lane = tid & 63, w = tid >> 6, fr = lane & 15, fq = lane >> 4;
    const int bh = item >> 2, j = item & 3, b = bh >> 2, hd = bh & 3, dv0 = j * 64;
    const float* gi = (const float*)(p.ws + WS_GI); const float* gf = (const float*)(p.ws + WS_GF);
    const bf16_t* kbuf = (const bf16_t*)(p.ws + WS_QKV) + (size_t)1 * MROWS * DM;
    const bf16_t* vbuf = (const bf16_t*)(p.ws + WS_QKV) + (size_t)2 * MROWS * DM;
    bf16_t* cst = (bf16_t*)(p.ws + WS_CST) + (size_t)bh * 31 * 65536;
    float* nst = (float*)(p.ws + WS_NST) + (size_t)bh * 32 * 256;
    float* mst = (float*)(p.ws + WS_MST) + (size_t)bh * 64;
    constexpr int KROW = 144;
    unsigned char* kimg[2] = {lds, lds + 256 * KROW};
    unsigned char* vimg[2] = {lds + 2 * 256 * KROW, lds + 2 * 256 * KROW + 64 * KROW};
    float* aA = (float*)(lds + 2 * 256 * KROW + 2 * 64 * KROW);
    float* bLs = aA + 2048;
    float* amx = bLs + 32;
    float* mch = amx + 32;
    float* dcy = mch + 40;
    for (int c = w * 4; c < w * 4 + 4; ++c) {
        const size_t tok = (size_t)b * SEQ + c * 64 + lane;
        const float lf = gf[tok * 4 + hd], il = gi[tok * 4 + hd];
        const float bs = wave_scan_add(lf, lane);
        const float bL = __shfl(bs, 63);
        const float a = bL - bs + il;
        const float am = wave_max(a);
        aA[c * 64 + lane] = a;
        if (lane == 0) { bLs[c] = bL; amx[c] = am; }
    }
    lds_barrier();
    if (tid == 0) {
        float m = 0.f; mch[0] = 0.f;
        for (int c = 0; c < 32; ++c) { const float mn = fmaxf(bLs[c] + m, amx[c]); dcy[c] = __expf(bLs[c] + m - mn); m = mn; mch[c + 1] = mn; }
    }
    lds_barrier();
    if (j == 0 && tid < 33) mst[tid] = mch[tid];
    if (j == 0 && tid == 0) p.out[O_MP + bh] = mch[32];
    f32x4 acc[2][4] = {};
    float nacc = 0.f;
    u32x4 krA[4], krB[4]; u32x4 vrA, vrB;
#define SCAN_GLOAD(KR, VR, cc) do { const size_t tok_ = (size_t)b * SEQ + (cc) * 64 + lane; const bf16_t* kp_ = kbuf + tok_ * DM + hd * 256 + w * 32; \
        _Pragma("unroll") for (int i_ = 0; i_ < 4; ++i_) KR[i_] = *(const u32x4*)(kp_ + i_ * 8); \
        VR = *(const u32x4*)(vbuf + tok_ * DM + hd * 256 + dv0 + w * 8); } while (0)
#define SCAN_WRITE(KR, VR, cc, ki, vi) do { const float wsv = __expf(aA[(cc) * 64 + lane] - mch[(cc) + 1]); const int odd_ = lane & 1; const int scol_ = (lane & ~1) * 2; \
          \
        _Pragma("unroll") for (int i_ = 0; i_ < 4; ++i_) { const unsigned uu[4] = {KR[i_].x, KR[i_].y, KR[i_].z, KR[i_].w}; \
            _Pragma("unroll") for (int e_ = 0; e_ < 4; ++e_) { const int dk_ = w * 32 + i_ * 8 + e_ * 2; \
                const unsigned P_ = pk_bf16(bflo(uu[e_]) * wsv, bfhi(uu[e_]) * wsv); const unsigned Q_ = (unsigned)__shfl_xor((int)P_, 1); \
                const unsigned W_ = odd_ ? ((Q_ >> 16) | (P_ & 0xffff0000u)) : ((P_ & 0xffffu) | (Q_ << 16)); \
                *(unsigned*)(ki + (dk_ + odd_) * KROW + scol_) = W_; } } \
        { const unsigned vv_[4] = {VR.x, VR.y, VR.z, VR.w}; \
          _Pragma("unroll") for (int e_ = 0; e_ < 4; ++e_) { const int dv_ = w * 8 + e_ * 2; const unsigned P_ = vv_[e_]; const unsigned Q_ = (unsigned)__shfl_xor((int)P_, 1); \
            const unsigned W_ = odd_ ? ((Q_ >> 16) | (P_ & 0xffff0000u)) : ((P_ & 0xffffu) | (Q_ << 16)); \
            *(unsigned*)(vi + (dv_ + odd_) * KROW + scol_) = W_; } } } while (0)
    SCAN_GLOAD(krA, vrA, 0);
    SCAN_GLOAD(krB, vrB, 1);
#pragma unroll 2
    for (int c = 0; c < 32; ++c) {
        unsigned char* ki = kimg[c & 1]; unsigned char* vi = vimg[c & 1];
        { const int cn = c + 2 < 32 ? c + 2 : 31;
          if ((c & 1) == 0) { SCAN_WRITE(krA, vrA, c, ki, vi); SCAN_GLOAD(krA, vrA, cn); }
          else { SCAN_WRITE(krB, vrB, c, ki, vi); SCAN_GLOAD(krB, vrB, cn); } }
        lds_barrier();
        const float dc = dcy[c];
        bf16x8 af[2][2], bfr[4][2];
#pragma unroll
        for (int a = 0; a < 2; ++a)
#pragma unroll
            for (int k = 0; k < 2; ++k) af[a][k] = *(const bf16x8*)(ki + ((w * 2 + a) * 16 + fr) * KROW + (k * 32 + fq * 8) * 2);
#pragma unroll
        for (int a = 0; a < 4; ++a)
#pragma unroll
            for (int k = 0; k < 2; ++k) bfr[a][k] = *(const bf16x8*)(vi + (a * 16 + fr) * KROW + (k * 32 + fq * 8) * 2);
#pragma unroll
        for (int a = 0; a < 2; ++a)
#pragma unroll
            for (int q = 0; q < 4; ++q) {
                acc[a][q] *= dc;
#pragma unroll
                for (int k = 0; k < 2; ++k) acc[a][q] = MFMA16(af[a][k], bfr[q][k], acc[a][q]);
            }
        if (j == 0) {
            const int dk = tid >> 1, hf = tid & 1;
            float s = 0.f;
#pragma unroll
            for (int i = 0; i < 4; ++i) {
                const u32x4 v = *(const u32x4*)(ki + dk * KROW + hf * 64 + i * 16);
                s += bflo(v.x) + bfhi(v.x) + bflo(v.y) + bfhi(v.y) + bflo(v.z) + bfhi(v.z) + bflo(v.w) + bfhi(v.w);
            }
            s += __shfl_xor(s, 1);
            nacc = nacc * dc + s;
            if (hf == 0) { if (c < 31) nst[(c + 1) * 256 + dk] = nacc; else p.out[O_NP + (size_t)bh * 256 + dk] = nacc; }
        }
        if (c < 31) {
            bf16_t* cs = cst + (size_t)c * 65536;
#pragma unroll
            for (int a = 0; a < 2; ++a)
#pragma unroll
                for (int q = 0; q < 4; ++q) {
                    u32x2 wv; wv.x = pk_bf16(acc[a][q][0], acc[a][q][1]); wv.y = pk_bf16(acc[a][q][2], acc[a][q][3]);
                    *(u32x2*)(cs + (size_t)(dv0 + q * 16 + fr) * 256 + (w * 2 + a) * 16 + fq * 4) = wv;
                }
        } else {
            float* co = p.out + O_CP + (size_t)bh * 65536;
#pragma unroll
            for (int a = 0; a < 2; ++a)
#pragma unroll
                for (int q = 0; q < 4; ++q)
#pragma unroll
                    for (int jj = 0; jj < 4; ++jj) co[(size_t)((w * 2 + a) * 16 + fq * 4 + jj) * 256 + dv0 + q * 16 + fr] = acc[a][q][jj];
        }
    }
    lds_barrier();
}

__device__ __forceinline__ void sample_item(const Params& p, int item, unsigned char* ldsb) {
    const int tid = otid(), lane = tid & 63, w = tid >> 6;
    const int b = item >> 2, hd = item & 3, bh = item;
    const int r0 = NPR + b * 4;
    const bf16_t* qb = (const bf16_t*)(p.ws + WS_QKV);
    const bf16_t* kb = qb + (size_t)MROWS * DM; const bf16_t* vb = kb + (size_t)MROWS * DM; const bf16_t* ob = vb + (size_t)MROWS * DM;
    const float* gi = (const float*)(p.ws + WS_GI); const float* gf = (const float*)(p.ws + WS_GF);
    float* lds = (float*)ldsb;
    float* qf = lds;
    float* kf = qf + 1024;
    float* vf = kf + 1024;
    float* Sm = vf + 1024;
    float* sc = Sm + 16;
    float* red = sc + 64;
    float* ssq = red + 8192;
    float lfp[4] = {0.f, 0.f, 0.f, 0.f}, ilp[4] = {0.f, 0.f, 0.f, 0.f}, m0p = 0.f;
    if (tid == 0) {
#pragma unroll
        for (int t = 0; t < 4; ++t) { lfp[t] = gf[(size_t)(r0 + t) * 4 + hd]; ilp[t] = gi[(size_t)(r0 + t) * 4 + hd]; }
        m0p = p.st_m[bh];
    }
    const int dv4 = lane * 4;
    const float* C0 = p.st_C + (size_t)bh * 65536;
    float* Cn = p.out + O_CS + (size_t)bh * 65536;
    f32x4 cpre[16];
#pragma unroll
    for (int r = 0; r < 16; ++r) cpre[r] = __builtin_nontemporal_load((const f32x4*)(C0 + (size_t)(w * 32 + r) * 256 + dv4));
    float* n0s = ssq + 8;
    const int ft = tid >> 7, fdv = (tid & 127) * 2;
    const size_t foidx = (size_t)(r0 + ft) * DM + hd * 256 + fdv;
    const unsigned fog = *(const unsigned*)(ob + foidx);
    const float fm0 = p.m_norm[hd * 256 + fdv], fm1 = p.m_norm[hd * 256 + fdv + 1];
    if (tid < 256) n0s[tid] = p.st_n[(size_t)bh * 256 + tid];
    for (int e = tid; e < 3 * 4 * 256; e += NTH) {
        const int which = e >> 10, t = (e >> 8) & 3, d = e & 255;
        const bf16_t* src = which == 0 ? qb : which == 1 ? kb : vb;
        lds[which * 1024 + t * 256 + d] = bf2f(src[(size_t)(r0 + t) * DM + hd * 256 + d]);
    }
    if (tid == 0) {
        float lf[4], il[4], bs[4];
        for (int t = 0; t < 4; ++t) { lf[t] = lfp[t]; il[t] = ilp[t]; }
        bs[0] = lf[0]; bs[1] = bs[0] + lf[1]; bs[2] = bs[1] + lf[2]; bs[3] = bs[2] + lf[3];
        const float m0 = m0p;
        for (int t = 0; t < 4; ++t) {
            const float g = bs[t] + m0; float mt = g;
            for (int s = 0; s <= t; ++s) mt = fmaxf(mt, bs[t] - bs[s] + il[s]);
            sc[t] = __expf(g - mt); sc[4 + t] = __expf(-mt);
            for (int s = 0; s < 4; ++s) sc[16 + t * 4 + s] = s <= t ? __expf(bs[t] - bs[s] + il[s] - mt) : 0.f;
        }
        const float bL = bs[3]; float mn = bL + m0;
        for (int s = 0; s < 4; ++s) mn = fmaxf(mn, bL - bs[s] + il[s]);
        sc[12] = __expf(bL + m0 - mn);
        for (int s = 0; s < 4; ++s) sc[8 + s] = __expf(bL - bs[s] + il[s] - mn);
        p.out[O_MS + bh] = mn;
    }
    lds_barrier();
    {
        const int g = tid >> 5, l32 = tid & 31;
        {
            const int t = g >> 2, s = g & 3; float a = 0.f;
#pragma unroll
            for (int d = l32; d < 256; d += 32) a += qf[t * 256 + d] * kf[s * 256 + d];
#pragma unroll
            for (int dd = 16; dd >= 1; dd >>= 1) a += __shfl_xor(a, dd);
            if (l32 == 0) Sm[g] = a * sc[16 + g];
        }
        if (g < 4) {
            float a = 0.f;
#pragma unroll
            for (int d = l32; d < 256; d += 32) a += qf[g * 256 + d] * n0s[d];
#pragma unroll
            for (int dd = 16; dd >= 1; dd >>= 1) a += __shfl_xor(a, dd);
            if (l32 == 0) sc[32 + g] = a;
        }
    }
    const float decay = sc[12];
    const float ws0 = sc[8], ws1 = sc[9], ws2 = sc[10], ws3 = sc[11];
    if (tid < 256) {
        const float nn = decay * n0s[tid] + ws0 * kf[tid] + ws1 * kf[256 + tid] + ws2 * kf[512 + tid] + ws3 * kf[768 + tid];
        p.out[O_NS + (size_t)bh * 256 + tid] = nn;
    }
    {
        f32x4 vv[4], num[4];
        vv[0] = *(const f32x4*)(vf + dv4) * ws0; vv[1] = *(const f32x4*)(vf + 256 + dv4) * ws1; vv[2] = *(const f32x4*)(vf + 512 + dv4) * ws2; vv[3] = *(const f32x4*)(vf + 768 + dv4) * ws3;
#pragma unroll
        for (int s = 0; s < 4; ++s) num[s] = (f32x4){0.f, 0.f, 0.f, 0.f};
#pragma unroll
        for (int r = 0; r < 16; ++r) {
            const int dk = w * 32 + r;
            const f32x4 cv = cpre[r];
            f32x4 cn = cv * decay;
#pragma unroll
            for (int s = 0; s < 4; ++s) { num[s] += cv * qf[s * 256 + dk]; cn += vv[s] * kf[s * 256 + dk]; }
            __builtin_nontemporal_store(cn, (f32x4*)(Cn + (size_t)dk * 256 + dv4));
        }
#pragma unroll 16
        for (int r = 16; r < 32; ++r) {
            const int dk = w * 32 + r;
            const f32x4 cv = __builtin_nontemporal_load((const f32x4*)(C0 + (size_t)dk * 256 + dv4));
            f32x4 cn = cv * decay;
#pragma unroll
            for (int s = 0; s < 4; ++s) { num[s] += cv * qf[s * 256 + dk]; cn += vv[s] * kf[s * 256 + dk]; }
            __builtin_nontemporal_store(cn, (f32x4*)(Cn + (size_t)dk * 256 + dv4));
        }
        lds_barrier();
#pragma unroll
        for (int t = 0; t < 4; ++t) *(f32x4*)(red + (w * 4 + t) * 256 + dv4) = num[t];
    }
    lds_barrier();
    {
        const int t = tid >> 7, dv = (tid & 127) * 2;
        float n0_ = 0.f, n1_ = 0.f;
#pragma unroll
        for (int ww = 0; ww < 8; ++ww) { n0_ += red[(ww * 4 + t) * 256 + dv]; n1_ += red[(ww * 4 + t) * 256 + dv + 1]; }
        const float wint = sc[t];
        n0_ *= wint; n1_ *= wint;
        float rs = 0.f;
#pragma unroll
        for (int s = 0; s < 4; ++s) { const float sv = Sm[t * 4 + s]; rs += sv; n0_ += sv * vf[s * 256 + dv]; n1_ += sv * vf[s * 256 + dv + 1]; }
        const float den = wint * sc[32 + t] + rs;
        const float dinv = 1.0f / fmaxf(fabsf(den), sc[4 + t]);
        const float h0 = n0_ * dinv, h1 = n1_ * dinv;
        float q2 = wave_sum(h0 * h0 + h1 * h1);
        if (lane == 0) ssq[t * 2 + (w & 1)] = q2;
        lds_barrier();
        const float rstd = rsqrtf((ssq[t * 2] + ssq[t * 2 + 1]) * (1.0f / 256.f) + EPS);
        const float o0 = h0 * rstd * fm0 * bflo(fog), o1 = h1 * rstd * fm1 * bfhi(fog);
        *(unsigned*)((bf16_t*)(p.ws + WS_HM) + foidx) = pk_bf16(o0, o1);
    }
    lds_barrier();
}

__device__ __forceinline__ void pool_item(const Params& p, int item, unsigned char* lds) {
    const int tid = otid(), lane = tid & 63, w = tid >> 6, fr = lane & 15, fq = lane >> 4;
    const int r0 = item < 256 ? item * 64 : NPR + (item - 256) * 16;
    const int nm = item < 256 ? 4 : 1;
    const float* u = (const float*)(p.ws + WS_U);
    constexpr int AROW = 1040;
    bf16x8 bw[4][4];
    {
        const bf16_t* wt0 = (const bf16_t*)(p.ws + WS_WPG) + (size_t)(w >> 1) * 128 * 128;
#pragma unroll
        for (int k = 0; k < 4; ++k)
#pragma unroll
            for (int n = 0; n < 4; ++n) bw[k][n] = *(const bf16x8*)(wt0 + (size_t)(((w & 1) * 4 + n) * 16 + fr) * 128 + k * 32 + fq * 8);
    }
    {
        const int c = tid, gidx = c >> 7, win = 2 << gidx;
        float hist[31];
        if (r0 < NPR) {
            const int t0 = r0 & (SEQ - 1);
#pragma unroll
            for (int j = 0; j < 15; ++j) hist[j] = (t0 - 15 + j) >= 0 ? u[(size_t)(r0 - 15 + j) * 512 + c] : 0.f;
            float nxt[16];
#pragma unroll
            for (int j = 0; j < 16; ++j) nxt[j] = u[(size_t)(r0 + j) * 512 + c];
#pragma unroll 1
            for (int ch = 0; ch < 4; ++ch) {
#pragma unroll
                for (int j = 0; j < 16; ++j) hist[15 + j] = nxt[j];
                if (ch < 3) {
#pragma unroll
                    for (int j = 0; j < 16; ++j) nxt[j] = u[(size_t)(r0 + (ch + 1) * 16 + j) * 512 + c];
                }
#pragma unroll
                for (int j = 0; j < 16; ++j) {
                    const int i = ch * 16 + j, t = t0 + i, q = 15 + j;
                    const float s2 = hist[q] + hist[q - 1];
                    const float s4 = s2 + hist[q - 2] + hist[q - 3];
                    const float s8 = s4 + (hist[q - 4] + hist[q - 5]) + (hist[q - 6] + hist[q - 7]);
                    const float s16 = s8 + ((hist[q - 8] + hist[q - 9]) + (hist[q - 10] + hist[q - 11])) + ((hist[q - 12] + hist[q - 13]) + (hist[q - 14] + hist[q - 15]));
                    const float s = gidx == 0 ? s2 : gidx == 1 ? s4 : gidx == 2 ? s8 : s16;
                    const float rc = __builtin_amdgcn_rcpf((float)min(t + 1, win));
                    *(bf16_t*)(lds + i * AROW + c * 2) = f2bf(s * rc - hist[q]);
                }
#pragma unroll
                for (int j = 0; j < 15; ++j) hist[j] = hist[16 + j];
            }
        } else {
#pragma unroll 1
            for (int bi = 0; bi < 4; ++bi) {
                const int bb = ((r0 - NPR) >> 2) + bi;
#pragma unroll
                for (int j = 0; j < 15; ++j) hist[j] = p.st_pool[((size_t)bb * 15 + j) * 512 + c];
#pragma unroll
                for (int j = 0; j < 4; ++j) hist[15 + j] = u[((size_t)NPR + bb * 4 + j) * 512 + c];
#pragma unroll
                for (int j = 0; j < 4; ++j) {
                    const int i = bi * 4 + j, q = 15 + j;
                    const float s2 = hist[q] + hist[q - 1];
                    const float s4 = s2 + hist[q - 2] + hist[q - 3];
                    const float s8 = s4 + (hist[q - 4] + hist[q - 5]) + (hist[q - 6] + hist[q - 7]);
                    const float s16 = s8 + ((hist[q - 8] + hist[q - 9]) + (hist[q - 10] + hist[q - 11])) + ((hist[q - 12] + hist[q - 13]) + (hist[q - 14] + hist[q - 15]));
                    const float s = gidx == 0 ? s2 : gidx == 1 ? s4 : gidx == 2 ? s8 : s16;
                    *(bf16_t*)(lds + i * AROW + c * 2) = f2bf(s * (1.0f / (float)win) - hist[q]);
                }
            }
        }
    }
    lds_barrier();
    {
        const int g = w >> 1, nh = w & 1;
        f32x4 acc[4][4] = {};
#pragma unroll
        for (int k = 0; k < 4; ++k) {
            bf16x8 af[4];
#pragma unroll
            for (int m = 0; m < 4; ++m) if (m < nm) af[m] = *(const bf16x8*)(lds + (m * 16 + fr) * AROW + (g * 128 + k * 32 + fq * 8) * 2);
#pragma unroll
            for (int m = 0; m < 4; ++m) if (m < nm) {
#pragma unroll
                for (int n = 0; n < 4; ++n) acc[m][n] = MFMA16(bw[k][n], af[m], acc[m][n]); }
        }
        bf16_t* yp = (bf16_t*)(p.ws + WS_YP);
#pragma unroll
        for (int m = 0; m < 4; ++m) if (m < nm)
#pragma unroll
            for (int n = 0; n < 4; ++n) {
                const int col = g * 128 + (nh * 4 + n) * 16 + fq * 4;
                const f32x4 scv = *(const f32x4*)(p.pool_scale + col);
                const f32x4 v = acc[m][n] * scv;
                u32x2 wv; wv.x = pk_bf16(v[0], v[1]); wv.y = pk_bf16(v[2], v[3]);
                *(u32x2*)(yp + (size_t)(r0 + m * 16 + fr) * 512 + col) = wv;
            }
    }
    lds_barrier();
}

__device__ __forceinline__ void poolout_item(const Params& p, int item) {
    const float* u = (const float*)(p.ws + WS_U);
    for (int e = threadIdx.x; e < 15 * 512; e += NTH) {
        const int jj = e >> 9, c = e & 511;
        if (item < 8) p.out[O_POOLP + (size_t)item * 7680 + e] = u[((size_t)item * SEQ + 2033 + jj) * 512 + c];
        else { const int bb = item - 8;
            p.out[O_POOLS + (size_t)bb * 7680 + e] = jj < 11 ? p.st_pool[((size_t)bb * 15 + jj + 4) * 512 + c] : u[((size_t)NPR + bb * 4 + (jj - 11)) * 512 + c]; }
    }
}

__device__ __forceinline__ void mout_item(const Params& p, int item, unsigned char* lds) {
    const int tid = otid(), lane = tid & 63, w = tid >> 6, fr = lane & 15, fq = lane >> 4;
    const int bh = item >> 5, c = item & 31, b = bh >> 2, hd = bh & 3;
    const size_t tok0 = (size_t)b * SEQ + c * 64;
    const bf16_t* qb = (const bf16_t*)(p.ws + WS_QKV);
    const bf16_t* kb = qb + (size_t)MROWS * DM; const bf16_t* vb = kb + (size_t)MROWS * DM; const bf16_t* ob = vb + (size_t)MROWS * DM;
    const float* gi = (const float*)(p.ws + WS_GI); const float* gf = (const float*)(p.ws + WS_GF);
    constexpr int QROW = 528, VROW = 144;
    unsigned char* Qs = lds;
    unsigned char* Ks = Qs + 64 * QROW;
    unsigned char* Vt = Ks + 64 * QROW;
    unsigned char* Sp = Vt + 256 * VROW;
    float* scal = (float*)(Sp + 64 * VROW);
    float* rt = scal, *ct = scal + 64, *wint = scal + 128, *emt = scal + 192, *rowsum = scal + 256  , *qn = scal + 384, *ssq = scal + 448  , *ncs = scal + 960  ;
    const float lf_pre = gf[(tok0 + lane) * 4 + hd], il_pre = gi[(tok0 + lane) * 4 + hd];
    const float mc_pre = ((const float*)(p.ws + WS_MST))[bh * 64 + c];
    bf16x8 cfr[8][2];
    if (c > 0) {
        const bf16_t* cs = (const bf16_t*)(p.ws + WS_CST) + ((size_t)bh * 31 + (c - 1)) * 65536;
#pragma unroll
        for (int k = 0; k < 8; ++k)
#pragma unroll
            for (int n = 0; n < 2; ++n) cfr[k][n] = *(const bf16x8*)(cs + (size_t)(w * 32 + n * 16 + fr) * 256 + k * 32 + fq * 8);
    }
    u32x2 ogv[4][2]; f32x4 mnv[2];
#pragma unroll
    for (int n = 0; n < 2; ++n) { const int dvg = hd * 256 + w * 32 + n * 16 + fq * 4; mnv[n] = *(const f32x4*)(p.m_norm + dvg);
#pragma unroll
        for (int m = 0; m < 4; ++m) ogv[m][n] = *(const u32x2*)(ob + (tok0 + m * 16 + fr) * DM + dvg); }
    if (w == 0) {
        const float lf = lf_pre, il = il_pre;
        const float bs = wave_scan_add(lf, lane);
        const float mc = mc_pre;
        const float g = bs + mc, xx = il - bs;
        const float pm = wave_scan_max(xx, lane);
        const float mt = fmaxf(g, bs + pm);
        rt[lane] = bs - mt; ct[lane] = xx; wint[lane] = __expf(g - mt); emt[lane] = __expf(-mt);
    }
#pragma unroll
    for (int i = 0; i < 4; ++i) {
        const int pc = tid + NTH * i, row = pc >> 5, c8 = pc & 31;
        *(u32x4*)(Qs + row * QROW + c8 * 16) = *(const u32x4*)(qb + (tok0 + row) * DM + hd * 256 + c8 * 8);
        *(u32x4*)(Ks + row * QROW + c8 * 16) = *(const u32x4*)(kb + (tok0 + row) * DM + hd * 256 + c8 * 8);
    }
    {
        const bf16_t* vp = vb + (tok0 + lane) * DM + hd * 256 + w * 32;
        const int odd = lane & 1, scol = (lane & ~1) * 2;
#pragma unroll
        for (int i = 0; i < 4; ++i) {
            const u32x4 v = *(const u32x4*)(vp + i * 8);
            const unsigned uu[4] = {v.x, v.y, v.z, v.w};
#pragma unroll
            for (int e = 0; e < 4; ++e) {
                const int dv = w * 32 + i * 8 + e * 2;
                const unsigned P = uu[e], Q = (unsigned)__shfl_xor((int)P, 1);
                const unsigned W = odd ? ((Q >> 16) | (P & 0xffff0000u)) : ((P & 0xffffu) | (Q << 16));
                *(unsigned*)(Vt + (dv + odd) * VROW + scol) = W;
            }
        }
    }
    if (c > 0 && tid >= 256) ncs[tid - 256] = ((const float*)(p.ws + WS_NST))[((size_t)bh * 32 + c) * 256 + tid - 256];
    lds_barrier();
    {
        const int tt = w >> 1, sh = w & 1;
        f32x4 sa[2] = {};
#pragma unroll
        for (int k = 0; k < 8; ++k) {
            const bf16x8 qf = *(const bf16x8*)(Qs + (tt * 16 + fr) * QROW + (k * 32 + fq * 8) * 2);
#pragma unroll
            for (int s2 = 0; s2 < 2; ++s2) {
                const bf16x8 kf = *(const bf16x8*)(Ks + ((sh * 2 + s2) * 16 + fr) * QROW + (k * 32 + fq * 8) * 2);
                sa[s2] = MFMA16(kf, qf, sa[s2]);
            }
        }
        const int t = tt * 16 + fr;
        const float rtt = rt[t];
        float rs = 0.f;
#pragma unroll
        for (int s2 = 0; s2 < 2; ++s2) {
            const int s0 = (sh * 2 + s2) * 16 + fq * 4;
            float v[4];
#pragma unroll
            for (int jj = 0; jj < 4; ++jj) { const int s = s0 + jj; v[jj] = s <= t ? sa[s2][jj] * __expf(rtt + ct[s]) : 0.f; rs += v[jj]; }
            u32x2 wv; wv.x = pk_bf16(v[0], v[1]); wv.y = pk_bf16(v[2], v[3]);
            *(u32x2*)(Sp + t * VROW + s0 * 2) = wv;
        }
        rs += __shfl_xor(rs, 16); rs += __shfl_xor(rs, 32);
        if (fq == 0) rowsum[t * 2 + sh] = rs;
    }
    {
        const int t = tid >> 3, part = tid & 7;
        float a = 0.f;
        if (c > 0) {
            const float* nc = ncs + part * 32;
            const unsigned char* qp = Qs + t * QROW + part * 64;
#pragma unroll
            for (int i = 0; i < 4; ++i) {
                const u32x4 qv = *(const u32x4*)(qp + i * 16);
                const f32x4 n0 = *(const f32x4*)(nc + i * 8), n1 = *(const f32x4*)(nc + i * 8 + 4);
                a += bflo(qv.x) * n0[0] + bfhi(qv.x) * n0[1] + bflo(qv.y) * n0[2] + bfhi(qv.y) * n0[3] + bflo(qv.z) * n1[0] + bfhi(qv.z) * n1[1] + bflo(qv.w) * n1[2] + bfhi(qv.w) * n1[3];
            }
        }
        a += __shfl_xor(a, 1); a += __shfl_xor(a, 2); a += __shfl_xor(a, 4);
        if (part == 0) qn[t] = a;
    }
    lds_barrier();
    f32x4 acc[4][2] = {};
    if (c > 0) {
#pragma unroll
        for (int k = 0; k < 8; ++k) {
            bf16x8 qf[4];
#pragma unroll
            for (int m = 0; m < 4; ++m) qf[m] = *(const bf16x8*)(Qs + (m * 16 + fr) * QROW + (k * 32 + fq * 8) * 2);
#pragma unroll
            for (int m = 0; m < 4; ++m)
#pragma unroll
                for (int n = 0; n < 2; ++n) acc[m][n] = MFMA16(cfr[k][n], qf[m], acc[m][n]);
        }
#pragma unroll
        for (int m = 0; m < 4; ++m) { const float wi = wint[m * 16 + fr]; acc[m][0] *= wi; acc[m][1] *= wi; }
    }
#pragma unroll
    for (int k = 0; k < 2; ++k) {
        bf16x8 vfr[2], sf[4];
#pragma unroll
        for (int n = 0; n < 2; ++n) vfr[n] = *(const bf16x8*)(Vt + (w * 32 + n * 16 + fr) * VROW + (k * 32 + fq * 8) * 2);
#pragma unroll
        for (int m = 0; m < 4; ++m) sf[m] = *(const bf16x8*)(Sp + (m * 16 + fr) * VROW + (k * 32 + fq * 8) * 2);
#pragma unroll
        for (int m = 0; m < 4; ++m)
#pragma unroll
            for (int n = 0; n < 2; ++n) acc[m][n] = MFMA16(vfr[n], sf[m], acc[m][n]);
    }
#pragma unroll
    for (int m = 0; m < 4; ++m) {
        const int t = m * 16 + fr;
        const float den = wint[t] * qn[t] + rowsum[t * 2] + rowsum[t * 2 + 1];
        const float dinv = 1.0f / fmaxf(fabsf(den), emt[t]);
        acc[m][0] *= dinv; acc[m][1] *= dinv;
        float q2 = 0.f;
#pragma unroll
        for (int n = 0; n < 2; ++n)
#pragma unroll
            for (int jj = 0; jj < 4; ++jj) q2 += acc[m][n][jj] * acc[m][n][jj];
        q2 += __shfl_xor(q2, 16); q2 += __shfl_xor(q2, 32);
        if (fq == 0) ssq[t * 8 + w] = q2;
    }
    lds_barrier();
#pragma unroll
    for (int m = 0; m < 4; ++m) {
        const int t = m * 16 + fr;
        float tot = 0.f;
#pragma unroll
        for (int ww = 0; ww < 8; ++ww) tot += ssq[t * 8 + ww];
        const float rstd = rsqrtf(tot * (1.0f / 256.f) + EPS);
#pragma unroll
        for (int n = 0; n < 2; ++n) {
            const int dvg = hd * 256 + w * 32 + n * 16 + fq * 4;
            const size_t oidx = (tok0 + t) * DM + dvg;
            const u32x2 og = ogv[m][n];
            const f32x4 v = acc[m][n] * rstd * mnv[n];
            u32x2 wv; wv.x = pk_bf16(v[0] * bflo(og.x), v[1] * bfhi(og.x)); wv.y = pk_bf16(v[2] * bflo(og.y), v[3] * bfhi(og.y));
            *(u32x2*)((bf16_t*)(p.ws + WS_HM) + oidx) = wv;
        }
    }
    lds_barrier();
}

__device__ __forceinline__ void grid_barrier(unsigned* bar, unsigned k) {
    asm volatile("s_waitcnt vmcnt(0)" ::: "memory");
    __syncthreads();
    if (threadIdx.x == 0) {
        const unsigned g = blockIdx.x & 7u, gsz = (gridDim.x + 7u - g) >> 3;
        __builtin_amdgcn_fence(__ATOMIC_RELEASE, "agent");
        asm volatile("s_waitcnt vmcnt(0)" ::: "memory");
        unsigned* sub = bar + 64u * (1u + g);
        const unsigned prev = __hip_atomic_fetch_add(sub, 1u, __ATOMIC_RELAXED, __HIP_MEMORY_SCOPE_AGENT);
        if (prev + 1u == k * gsz) __hip_atomic_fetch_add(bar, 1u, __ATOMIC_RELAXED, __HIP_MEMORY_SCOPE_AGENT);
        const unsigned ngroups = gridDim.x < 8u ? gridDim.x : 8u;
        unsigned spins = 0;
        while (__hip_atomic_load(bar, __ATOMIC_RELAXED, __HIP_MEMORY_SCOPE_AGENT) < k * ngroups) { __builtin_amdgcn_s_sleep(1); if (++spins > (1u << 24)) break; }
        __builtin_amdgcn_fence(__ATOMIC_ACQUIRE, "agent");
        asm volatile("s_waitcnt vmcnt(0)" ::: "memory");
    }
    __syncthreads();
}

__global__ void __launch_bounds__(NTH) hybrid_fwd(Params p) {
    extern __shared__ __attribute__((aligned(16))) unsigned char lds[];
    cg::grid_group grid = cg::this_grid();
    const int lo = p.ph_lo, hi = p.ph_hi;
#ifndef PHMASK
#define PHMASK 0x7ff
#endif
#define IN(k) (((PHMASK >> (k)) & 1) && lo <= (k) && (k) < hi)
#define SEAMN(n) do { grid_barrier((unsigned*)(p.ws + WS_CTR) + 64, (unsigned)(n)); } while (0)
    if (lo < 0) grid.sync();
    LAS unsigned char* ldsl = (LAS unsigned char*)lds;
    unsigned char* ws = p.ws;
    if (IN(0)) phase0(p, (float*)lds);
    SEAMN(1);
    if (IN(1)) {
        for (int it = blockIdx.x; it < 256; it += gridDim.x) { ada_final_slice(p, it); norm_item(p, it, 0, (float*)lds); }
    }
    SEAMN(2);
    if (IN(2)) { EpiG1 e{(float*)(ws + WS_U), (bf16_t*)(ws + WS_QKV)};
        gemm_phase(ldsl, (const bf16_t*)(ws + WS_H), (const bf16_t*)(ws + WS_WIN), NIN, DM, e, nullptr, MROWS); }
    SEAMN(3);
    if (IN(3)) {
        if (blockIdx.x < 128) { const int x = blockIdx.x & 7, r = blockIdx.x >> 3;
            scan_item(p, ((x + 8 * (r >> 2)) << 2) | (r & 3), lds); }
        {
            unsigned* ctr = (unsigned*)(ws + WS_CTR);
            volatile unsigned* slot = (volatile unsigned*)(lds + LDS_BYTES - 16);
            for (;;) {
                if (threadIdx.x == 0) *slot = atomicAdd(ctr, 1u);
                __syncthreads();
                const int it = (int)*slot;
                __syncthreads();
                if (it >= 512 + 288 + NBATCH) break;
                if (it < 512) sample_item(p, it, lds);
                else if (it < 800) pool_item(p, it - 512, lds);
                else poolout_item(p, it - 800);
            }
        }
    }
    SEAMN(4);
    if (IN(4)) { for (int it = blockIdx.x; it < 1024; it += gridDim.x) mout_item(p, it, lds); }
    if (IN(5)) {

        bf16_t* merged = (bf16_t*)(ws + WS_U);
        const bf16_t* sga = (const bf16_t*)(ws + WS_QKV) + (size_t)4 * MROWS * DM;
        const bf16_t* sgb = sga + (size_t)MROWS * DM;
        { EpiMerge e0{merged, sga, 0}; gemm_phase(ldsl, (const bf16_t*)(ws + WS_YP), (const bf16_t*)(ws + WS_WPO), DM, 512, e0);
          small_gemm_phase(lds, (const bf16_t*)(ws + WS_YP), (const bf16_t*)(ws + WS_WPO), DM, 512, e0, blockIdx.x, blockIdx.x + 1); }
        SEAMN(5);
        { EpiMerge e1{merged, sgb, 1}; gemm_phase(ldsl, (const bf16_t*)(ws + WS_HM), (const bf16_t*)(ws + WS_WMO), DM, DM, e1);
          small_gemm_phase(lds, (const bf16_t*)(ws + WS_HM), (const bf16_t*)(ws + WS_WMO), DM, DM, e1, blockIdx.x, blockIdx.x + 1); }
    }
    SEAMN(6);
    if (IN(6)) {
        EpiMid e{p.out, p.x_p, p.x_s, (const float*)(ws + WS_ADA), p.g_ffn, (bf16_t*)(ws + WS_H), (float*)(ws + WS_RSB), (unsigned*)(ws + WS_XCNT), (float*)(ws + WS_RSS), (unsigned*)(ws + WS_XCNT) + 64 * 64};
        gemm_phase<EpiMid, true>(ldsl, (const bf16_t*)(ws + WS_U), (const bf16_t*)(ws + WS_WOUT), DM, DM, e, lds);
        small_gemm_phase<EpiMid, 2>(lds, (const bf16_t*)(ws + WS_U), (const bf16_t*)(ws + WS_WOUT), DM, DM, e, blockIdx.x, blockIdx.x + 1);
    }
    SEAMN(7);
    if (IN(8)) { EpiAct e{(bf16_t*)(ws + WS_CST)};
        gemm_phase(ldsl, (const bf16_t*)(ws + WS_H), (const bf16_t*)(ws + WS_W1), DFF, DM, e, nullptr, MROWS); }
    SEAMN(8);
    if (IN(9)) {
        EpiFinal e{p.out, (const float*)(ws + WS_ADA), p.g_final, (float*)(ws + WS_RSB), (unsigned*)(ws + WS_XCNT), (float*)(ws + WS_RSS), (unsigned*)(ws + WS_XCNT) + 64 * 64};
        gemm_phase<EpiFinal, true>(ldsl, (const bf16_t*)(ws + WS_CST), (const bf16_t*)(ws + WS_W2), DM, DFF, e, lds);
        small_gemm_phase<EpiFinal, 1>(lds, (const bf16_t*)(ws + WS_CST), (const bf16_t*)(ws + WS_W2), DM, DFF, e, blockIdx.x, blockIdx.x + 1);
    }
#undef IN
#undef SEAMN
}

extern "C" void kernel_launch(void* const* d_in, const int* in_sizes, int n_in, void* d_out, int out_size, void* d_ws, size_t ws_size, hipStream_t stream) {
    static int grid_blocks = 0;
    if (grid_blocks == 0) {
        if (ws_size < WS_END) { fprintf(stderr, "kernel_launch: workspace too small: %zu < %zu\n", ws_size, (size_t)WS_END); grid_blocks = -1; return; }
        int dev = 0, cus = 0, per_cu = 0;
        hipGetDevice(&dev);
        hipDeviceGetAttribute(&cus, hipDeviceAttributeMultiprocessorCount, dev);
        hipFuncSetAttribute((const void*)hybrid_fwd, hipFuncAttributeMaxDynamicSharedMemorySize, LDS_BYTES);
        hipOccupancyMaxActiveBlocksPerMultiprocessor(&per_cu, (const void*)hybrid_fwd, NTH, LDS_BYTES);
        if (per_cu < 1) per_cu = 1;
        if (per_cu > 1) per_cu = 1;
        grid_blocks = cus * per_cu;
    }
    if (grid_blocks < 0) return;
    hipMemsetAsync((char*)d_ws + WS_CTR, 0, 4096 + 80 * 256, stream);
    Params p{};
    const float** f = (const float**)&p;
    for (int i = 0; i < 24; ++i) f[i] = (const float*)d_in[i];
    p.out = (float*)d_out; p.ws = (unsigned char*)d_ws; p.ph_lo = 0; p.ph_hi = 11;
    void* args[] = {&p};
    hipError_t e = hipLaunchCooperativeKernel((const void*)hybrid_fwd, dim3(grid_blocks), dim3(NTH), args, LDS_BYTES, stream);
    if (e != hipSuccess) fprintf(stderr, "cooperative launch failed: %s (grid %d)\n", hipGetErrorString(e), grid_blocks);
}
```

```cpp
#include <hip/hip_runtime.h>
#include <hip/hip_cooperative_groups.h>
#include <cstdio>
#include <cstdint>
namespace cg = cooperative_groups;

typedef unsigned short bf16_t;
typedef short bf16x8 __attribute__((ext_vector_type(8)));
typedef float f32x4 __attribute__((ext_vector_type(4)));
typedef unsigned u32x4 __attribute__((ext_vector_type(4)));
typedef unsigned u32x2 __attribute__((ext_vector_type(2)));

constexpr int NTH = 512;
constexpr int DM = 1024, NPR = 16384, NSA = 512, MROWS = 16896, NBATCH = 136, SEQ = 2048;
constexpr int NIN = 6656, DFF = 4096, ADAW = 6144, INW = 6664;
constexpr int LDS_BYTES = 131072;
constexpr float EPS = 1e-6f;

constexpr size_t O_Y = 0;
constexpr size_t O_POOLP = 17301504;
constexpr size_t O_CP = 17362944;
constexpr size_t O_NP = 19460096;
constexpr size_t O_MP = 19468288;
constexpr size_t O_POOLS = 19468320;
constexpr size_t O_CS = 20451360;
constexpr size_t O_NS = 54005792;
constexpr size_t O_MS = 54136864;

constexpr size_t AL(size_t x) { return (x + 255) & ~(size_t)255; }
constexpr size_t WS_WIN = 0;
constexpr size_t WS_WPG = WS_WIN + AL((size_t)NIN * DM * 2);
constexpr size_t WS_WPO = WS_WPG + AL((size_t)4 * 128 * 128 * 2);
constexpr size_t WS_WMO = WS_WPO + AL((size_t)1024 * 512 * 2);
constexpr size_t WS_WOUT = WS_WMO + AL((size_t)1024 * 1024 * 2);
constexpr size_t WS_W1 = WS_WOUT + AL((size_t)1024 * 1024 * 2);
constexpr size_t WS_W2 = WS_W1 + AL((size_t)4096 * 1024 * 2);
constexpr size_t WS_ADAP = WS_W2 + AL((size_t)4096 * 1024 * 2);
constexpr size_t WS_ADA = WS_ADAP + AL((size_t)8 * NBATCH * ADAW * 4);
constexpr size_t WS_H = WS_ADA + AL((size_t)NBATCH * ADAW * 4);
constexpr size_t WS_GI = WS_H + AL((size_t)MROWS * DM * 2);
constexpr size_t WS_GF = WS_GI + AL((size_t)MROWS * 4 * 4);
constexpr size_t WS_U = WS_GF + AL((size_t)MROWS * 4 * 4);
constexpr size_t WS_QKV = WS_U + AL((size_t)MROWS * 512 * 4);
constexpr size_t WS_CST = WS_QKV + AL((size_t)6 * MROWS * DM * 2);
constexpr size_t WS_NST = WS_CST + AL((size_t)MROWS * DFF * 2);
constexpr size_t WS_MST = WS_NST + AL((size_t)32 * 32 * 256 * 4);
constexpr size_t WS_YP = WS_MST + AL((size_t)32 * 64 * 4);
constexpr size_t WS_HM = WS_YP + AL((size_t)MROWS * 512 * 2);
constexpr size_t WS_GW = WS_HM + AL((size_t)MROWS * DM * 2);
constexpr size_t WS_CTR = WS_GW + AL((size_t)1024 * 8 * 4);
constexpr size_t WS_XCNT = WS_CTR + 4096;
constexpr size_t WS_RSB = WS_XCNT + 80 * 256;
constexpr size_t WS_RSS = WS_RSB + AL((size_t)NPR * 4 * 4);
constexpr size_t WS_END = WS_RSS + AL((size_t)NSA * 16 * 4);
static_assert((size_t)32 * 31 * 65536 * 2 <= (size_t)MROWS * DFF * 2, "Cst fits in act region");
static_assert(WS_END <= (size_t)536870912, "workspace map exceeds 512 MiB");

struct Params {
    const float *x_p, *x_s, *st_pool, *st_C, *st_n, *st_m, *c_p, *c_s, *g_mix, *g_ffn, *w_ada, *b_ada, *w_in, *b_i, *b_f, *w_pg, *pool_scale, *w_po, *m_norm, *w_mo, *w_out, *w1, *w2, *g_final;
    float* out; unsigned char* ws; int ph_lo, ph_hi;
};

typedef float f32x2 __attribute__((ext_vector_type(2)));
typedef __bf16 bf16x2_t __attribute__((ext_vector_type(2)));
__device__ __forceinline__ unsigned pk_bf16(float lo, float hi) { f32x2 v = {lo, hi}; bf16x2_t b = __builtin_convertvector(v, bf16x2_t); return __builtin_bit_cast(unsigned, b); }
__device__ __forceinline__ float bf2f(unsigned v) { return __uint_as_float(v << 16); }
__device__ __forceinline__ float bflo(unsigned v) { return __uint_as_float(v << 16); }
__device__ __forceinline__ float bfhi(unsigned v) { return __uint_as_float(v & 0xffff0000u); }
__device__ __forceinline__ bf16_t f2bf(float f) { return (bf16_t)(pk_bf16(f, 0.f) & 0xffffu); }
__device__ __forceinline__ float sigmoidf_(float x) { return __builtin_amdgcn_rcpf(1.f + __expf(-x)); }
__device__ __forceinline__ int row_batch(int row) { return row < NPR ? (row >> 11) : 8 + ((row - NPR) >> 2); }
__device__ __forceinline__ float wave_sum(float v) {
#pragma unroll
    for (int d = 32; d >= 1; d >>= 1) v += __shfl_xor(v, d);
    return v;
}
__device__ __forceinline__ float wave_max(float v) {
#pragma unroll
    for (int d = 32; d >= 1; d >>= 1) v = fmaxf(v, __shfl_xor(v, d));
    return v;
}
__device__ __forceinline__ float wave_scan_add(float v, int lane) {
#pragma unroll
    for (int d = 1; d < 64; d <<= 1) { float t = __shfl_up(v, d); if (lane >= d) v += t; }
    return v;
}
__device__ __forceinline__ float wave_scan_max(float v, int lane) {
#pragma unroll
    for (int d = 1; d < 64; d <<= 1) { float t = __shfl_up(v, d); if (lane >= d) v = fmaxf(v, t); }
    return v;
}
__device__ __forceinline__ int otid() { int t = threadIdx.x; asm volatile("" : "+v"(t)); return t; }
__device__ __forceinline__ void lds_barrier() { asm volatile("s_waitcnt lgkmcnt(0)" ::: "memory"); __builtin_amdgcn_s_barrier(); asm volatile("" ::: "memory"); }
#define MFMA16(a, b, c) __builtin_amdgcn_mfma_f32_16x16x32_bf16((a), (b), (c), 0, 0, 0)

#define LAS __attribute__((address_space(3)))
constexpr int BM = 256, BK = 64, HALF = 128, HTB = HALF * BK * 2, NXCD = 8, WGM = 8;
__device__ __forceinline__ int lds_byte(int r, int c) {
    const int st = (r >> 4) * 2 + (c >> 5), rr = r & 15, cc = c & 31, ob = rr * 64 + cc * 2;
    return st * 1024 + (ob ^ (((ob >> 9) & 1) << 5));
}
__device__ __forceinline__ void stage_rc(int b, int& R, int& C) {
    const int st = b / 1024, sb = b % 1024, swz = sb ^ (((sb >> 9) & 1) << 5);
    R = (st >> 1) * 16 + swz / 64; C = (st & 1) * 32 + (swz % 64) / 2;
}
__device__ __forceinline__ int perm32(int rho) { const int n = rho >> 4, i = rho & 15; return 8 * (i >> 2) + 4 * n + (i & 3); }
struct Unit { int pm, pn; };
struct StaticOrder {
    int nM, nN, nwg, G, c;
    __device__ void init(int M, int N, int G_, int c_) { nM = M / BM; nN = N / BM; nwg = nM * nN; G = G_; c = c_; }
    __device__ bool next(int i, Unit& u) const {
        const long L = (long)i * G + c; if (L >= nwg) return false;
        int wgid = (int)L; { const int q = nwg / NXCD, r = nwg % NXCD, xcd = wgid % NXCD, off = wgid / NXCD; wgid = (xcd < r ? xcd * (q + 1) : r * (q + 1) + (xcd - r) * q) + off; }
        const int nig = WGM * nN, gid = wgid / nig, fm = gid * WGM, gsz = (nM - fm) < WGM ? (nM - fm) : WGM;
        u.pm = fm + ((wgid % nig) % gsz); u.pn = (wgid % nig) / gsz; return true;
    }
};

#ifndef GEMM_SP2
#define GEMM_SP2 1
#endif
#ifndef GEMM_ALIGN
#define GEMM_ALIGN 1
#endif
template <class Epi, bool FUSED = false, bool SP2 = (GEMM_SP2 != 0), bool ALIGN_EPI = (GEMM_ALIGN != 0)>
__device__ __forceinline__ void gemm_phase(LAS unsigned char* lds, const bf16_t* gA, const bf16_t* gBt, const int N, const int K, const Epi& E, unsigned char* lds_gen = nullptr, const int Mrows = NPR) {
    const int tid = otid(), wid = __builtin_amdgcn_readfirstlane(tid >> 6), lane = tid & 63, wr = wid >> 2, wc = wid & 3, fr = lane & 15, fq = lane >> 4;
    const int nt = K / BK;
    StaticOrder S; S.init(Mrows, N, gridDim.x, blockIdx.x);
    unsigned voffA[2], voffB[2];
#pragma unroll
    for (int i = 0; i < 2; ++i) { int R, C; stage_rc(tid * 16 + i * 8192, R, C); const int Rb = (R & ~31) + perm32(R & 31); voffA[i] = (unsigned)(R * K + C) * 2u; voffB[i] = (unsigned)(Rb * K + C) * 2u; }
    const size_t kstep = (size_t)(BK * 2);
    const size_t hstep = (size_t)HALF * K * 2;
    const size_t tstep = 2 * hstep;
    const unsigned ldsw = (unsigned)wid * 1024u;
    const int aoff = lds_byte(wr * 64 + fr, fq * 8), boff = lds_byte(wc * 32 + fr, fq * 8);
#define PG8_SA(b, h) (((b) * 2 + (h)) * HTB)
#define PG8_SB(b, h) ((4 + (b) * 2 + (h)) * HTB)
#define PG8_STAGE(bufoff, gbase) PG8_STAGEV(bufoff, gbase, voffA)
#define PG8_STAGEB(bufoff, gbase) PG8_STAGEV(bufoff, gbase, voffB)
#define PG8_STAGEV(bufoff, gbase, voff) do { _Pragma("unroll") for (int _i = 0; _i < 2; ++_i) \
        __builtin_amdgcn_global_load_lds((const unsigned*)((const char*)(gbase) + (voff)[_i]), (LAS unsigned*)(lds + (bufoff) + ldsw + _i * 8192), 16, 0, 0); } while (0)
#define PG8_LDA(dst, b, h) do { _Pragma("unroll") for (int m = 0; m < 4; ++m) _Pragma("unroll") for (int k = 0; k < 2; ++k) dst[m][k] = *(const LAS bf16x8*)(lds + PG8_SA(b, h) + aoff + m * 2048 + k * 1024); } while (0)
#define PG8_LDB(dst, b, h) do { _Pragma("unroll") for (int n = 0; n < 2; ++n) _Pragma("unroll") for (int k = 0; k < 2; ++k) dst[n][k] = *(const LAS bf16x8*)(lds + PG8_SB(b, h) + boff + n * 2048 + k * 1024); } while (0)
#define PG8_MMA(ai, bj, At, Bt) do { __builtin_amdgcn_s_setprio(1); _Pragma("unroll") for (int m = 0; m < 4; ++m) _Pragma("unroll") for (int n = 0; n < 2; ++n) _Pragma("unroll") for (int k = 0; k < 2; ++k) \
        acc[ai][bj][m][n] = __builtin_amdgcn_mfma_f32_16x16x32_bf16(Bt[n][k], At[m][k], acc[ai][bj][m][n], 0, 0, 0); __builtin_amdgcn_s_setprio(0); } while (0)
#define PG8_WAIT_V(n) asm volatile("s_waitcnt vmcnt(" #n ")" ::: "memory")
#define PG8_WAIT_L(n) asm volatile("s_waitcnt lgkmcnt(" #n ")" ::: "memory")
#define PG8_BAR __builtin_amdgcn_s_barrier()
#define PG8_SCHED __builtin_amdgcn_sched_barrier(0)
    Unit cur, nxt; int ui = 0;
    if (!S.next(0, cur)) return;
    f32x4 acc[2][2][4][2];
#pragma unroll
    for (int a = 0; a < 2; ++a)
#pragma unroll
        for (int b = 0; b < 2; ++b)
#pragma unroll
            for (int m = 0; m < 4; ++m)
#pragma unroll
                for (int n = 0; n < 2; ++n) acc[a][b][m][n] = (f32x4){0.f, 0.f, 0.f, 0.f};
    bf16x8 At[4][2], B0[2][2], B1[2][2];
    const char* cA = (const char*)gA + (size_t)cur.pm * tstep; const char* cB = (const char*)gBt + (size_t)cur.pn * tstep;
    constexpr bool ALIGN = ALIGN_EPI && !FUSED;
    if constexpr (SP2) {
        PG8_STAGEB(PG8_SB(0, 0), cB); PG8_STAGEB(PG8_SB(0, 1), cB + hstep); PG8_STAGE(PG8_SA(0, 0), cA); PG8_STAGE(PG8_SA(0, 1), cA + hstep);
        if (wr == 1) PG8_BAR;
        PG8_WAIT_V(2); PG8_BAR;
        PG8_STAGEB(PG8_SB(1, 0), cB + kstep); PG8_STAGE(PG8_SA(1, 0), cA + kstep); PG8_STAGEB(PG8_SB(1, 1), cB + hstep + kstep);
        PG8_WAIT_V(6); PG8_BAR;
    } else {
        PG8_STAGEB(PG8_SB(0, 0), cB); PG8_STAGE(PG8_SA(0, 0), cA); PG8_STAGEB(PG8_SB(0, 1), cB + hstep); PG8_STAGE(PG8_SA(0, 1), cA + hstep);
        if (wr == 1) PG8_BAR;
        PG8_WAIT_V(4); PG8_BAR;
        PG8_STAGEB(PG8_SB(1, 0), cB + kstep); PG8_STAGE(PG8_SA(1, 0), cA + kstep); PG8_STAGEB(PG8_SB(1, 1), cB + hstep + kstep);
        PG8_WAIT_V(6); PG8_BAR;
    }
    for (;;) {
        const bool has_next = S.next(ui + 1, nxt);
        const char* nA = has_next ? (const char*)gA + (size_t)nxt.pm * tstep : cA; const char* nB = has_next ? (const char*)gBt + (size_t)nxt.pn * tstep : cB;
        for (int t = 0; t < nt; t += 2) {
            const bool last = (t == nt - 2);
            const char* a1 = cA + (size_t)(t + 1) * kstep;
            const char* a2 = last ? nA : cA + (size_t)(t + 2) * kstep; const char* b2 = last ? nB : cB + (size_t)(t + 2) * kstep;
            const char* a3 = a2 + kstep; const char* b3 = b2 + kstep;
            if constexpr (SP2) {
            PG8_LDB(B0, 0, 0); PG8_LDB(B1, 0, 1); PG8_SCHED; PG8_LDA(At, 0, 0); PG8_STAGE(PG8_SA(1, 1), a1 + hstep);
            PG8_WAIT_V(8); PG8_WAIT_L(0); PG8_BAR; PG8_MMA(0, 0, At, B0); PG8_MMA(0, 1, At, B1); PG8_BAR; PG8_SCHED;
            PG8_LDA(At, 0, 1); PG8_STAGEB(PG8_SB(0, 0), b2); PG8_STAGEB(PG8_SB(0, 1), b2 + hstep); PG8_STAGE(PG8_SA(0, 0), a2);
            PG8_WAIT_V(8); PG8_WAIT_L(0); PG8_BAR; PG8_MMA(1, 0, At, B0); PG8_MMA(1, 1, At, B1); PG8_BAR; PG8_SCHED;
            PG8_LDB(B0, 1, 0); PG8_LDB(B1, 1, 1); PG8_SCHED; PG8_LDA(At, 1, 0); PG8_STAGE(PG8_SA(0, 1), a2 + hstep);
            PG8_WAIT_V(8); PG8_WAIT_L(0); PG8_BAR; PG8_MMA(0, 0, At, B0); PG8_MMA(0, 1, At, B1); PG8_BAR; PG8_SCHED;
            PG8_LDA(At, 1, 1); PG8_STAGEB(PG8_SB(1, 0), b3); PG8_STAGEB(PG8_SB(1, 1), b3 + hstep); PG8_STAGE(PG8_SA(1, 0), a3);
            PG8_WAIT_V(8); PG8_WAIT_L(0); PG8_BAR; PG8_MMA(1, 0, At, B0); PG8_MMA(1, 1, At, B1); PG8_BAR; PG8_SCHED;
            } else {
            PG8_LDB(B0, 0, 0); PG8_SCHED; PG8_LDA(At, 0, 0); PG8_STAGE(PG8_SA(1, 1), a1 + hstep);
            PG8_WAIT_L(8); PG8_BAR; PG8_WAIT_L(0); PG8_MMA(0, 0, At, B0); PG8_BAR; PG8_SCHED;
            PG8_LDB(B1, 0, 1); PG8_STAGEB(PG8_SB(0, 0), b2);
            PG8_BAR; PG8_WAIT_L(0); PG8_MMA(0, 1, At, B1); PG8_BAR;
            PG8_LDA(At, 0, 1); PG8_STAGE(PG8_SA(0, 0), a2);
            PG8_BAR; PG8_WAIT_L(0); PG8_MMA(1, 0, At, B0); PG8_BAR; PG8_SCHED;
            PG8_STAGEB(PG8_SB(0, 1), b2 + hstep);
            PG8_WAIT_V(6); PG8_BAR; PG8_MMA(1, 1, At, B1); PG8_BAR;
            PG8_LDB(B0, 1, 0); PG8_SCHED; PG8_LDA(At, 1, 0); PG8_STAGE(PG8_SA(0, 1), a2 + hstep);
            PG8_WAIT_L(8); PG8_BAR; PG8_WAIT_L(0); PG8_MMA(0, 0, At, B0); PG8_BAR; PG8_SCHED;
            PG8_LDB(B1, 1, 1); PG8_STAGEB(PG8_SB(1, 0), b3);
            PG8_BAR; PG8_WAIT_L(0); PG8_MMA(0, 1, At, B1); PG8_BAR;
            PG8_LDA(At, 1, 1); PG8_STAGE(PG8_SA(1, 0), a3);
            PG8_BAR; PG8_WAIT_L(0); PG8_MMA(1, 0, At, B0); PG8_BAR; PG8_SCHED;
            PG8_STAGEB(PG8_SB(1, 1), b3 + hstep);
            PG8_WAIT_V(6); PG8_BAR; PG8_MMA(1, 1, At, B1); PG8_BAR;
            }
        }
        if constexpr (ALIGN) { if (wr == 0) PG8_BAR; }
        if constexpr (!FUSED) { const int r0 = cur.pm * BM + wr * 64 + fr, c0 = cur.pn * BM + wc * 32 + fq * 8;
#pragma unroll
          for (int ai = 0; ai < 2; ++ai)
#pragma unroll
            for (int m = 0; m < 4; ++m)
#pragma unroll
              for (int bj = 0; bj < 2; ++bj) E.apply8(r0 + ai * 128 + m * 16, c0 + bj * 128, acc[ai][bj][m][0], acc[ai][bj][m][1]); }
        if (!has_next) break;
#pragma unroll
        for (int a = 0; a < 2; ++a)
#pragma unroll
            for (int b = 0; b < 2; ++b)
#pragma unroll
                for (int m = 0; m < 4; ++m)
#pragma unroll
                    for (int n = 0; n < 2; ++n) acc[a][b][m][n] = (f32x4){0.f, 0.f, 0.f, 0.f};
        cur = nxt; cA = nA; cB = nB; ++ui;
        if constexpr (ALIGN) { if (wr == 1) PG8_BAR; }
    }
    PG8_WAIT_V(0);
    if constexpr (!ALIGN) { if (wr == 0) PG8_BAR; }
    PG8_BAR;
    if constexpr (FUSED) E.fused(acc, cur, wr, wc, fr, fq, lds_gen);
#undef PG8_SA
#undef PG8_SB
#undef PG8_STAGE
#undef PG8_STAGEB
#undef PG8_STAGEV
#undef PG8_LDA
#undef PG8_LDB
#undef PG8_MMA
#undef PG8_WAIT_V
#undef PG8_WAIT_L
#undef PG8_BAR
#undef PG8_SCHED
}

struct EpiG1 {
    float* u; bf16_t* qkv;
    __device__ __forceinline__ void apply(int row, int col, f32x4 v) const {
        const int bcol = col & ~255;
        const int seg = bcol < 512 ? 0 : 1 + ((bcol - 512) >> 10);
        if (seg == 0) { *(f32x4*)(u + (size_t)row * 512 + col) = v; }
        else {
            const int cc = col - 512 - (seg - 1) * 1024;
            if (seg == 2) v *= 0.0625f;
            if (seg >= 4) { v[0] = sigmoidf_(v[0]); v[1] = sigmoidf_(v[1]); v[2] = sigmoidf_(v[2]); v[3] = sigmoidf_(v[3]); }
            u32x2 w; w.x = pk_bf16(v[0], v[1]); w.y = pk_bf16(v[2], v[3]);
            *(u32x2*)(qkv + (size_t)(seg - 1) * MROWS * DM + (size_t)row * DM + cc) = w;
        }
    }
    __device__ __forceinline__ void apply8(int row, int col, f32x4 v0, f32x4 v1) const {
        const int bcol = col & ~255;
        const int seg = bcol < 512 ? 0 : 1 + ((bcol - 512) >> 10);
        if (seg == 0) { *(f32x4*)(u + (size_t)row * 512 + col) = v0; *(f32x4*)(u + (size_t)row * 512 + col + 4) = v1; }
        else {
            const int cc = col - 512 - (seg - 1) * 1024;
            if (seg == 2) { v0 *= 0.0625f; v1 *= 0.0625f; }
            if (seg >= 4) {
#pragma unroll
                for (int j = 0; j < 4; ++j) { v0[j] = sigmoidf_(v0[j]); v1[j] = sigmoidf_(v1[j]); } }
            u32x4 w; w.x = pk_bf16(v0[0], v0[1]); w.y = pk_bf16(v0[2], v0[3]); w.z = pk_bf16(v1[0], v1[1]); w.w = pk_bf16(v1[2], v1[3]);
            *(u32x4*)(qkv + (size_t)(seg - 1) * MROWS * DM + (size_t)row * DM + cc) = w;
        }
    }
};
struct EpiMerge {
    bf16_t* merged; const bf16_t* sg; int mode;
    __device__ __forceinline__ void apply(int row, int col, f32x4 v) const {
        const size_t idx = (size_t)row * DM + col;
        const u32x2 g = *(const u32x2*)(sg + idx);
        v[0] *= bflo(g.x); v[1] *= bfhi(g.x); v[2] *= bflo(g.y); v[3] *= bfhi(g.y);
        if (mode) { const u32x2 o = *(const u32x2*)(merged + idx); v[0] += bflo(o.x); v[1] += bfhi(o.x); v[2] += bflo(o.y); v[3] += bfhi(o.y); }
        u32x2 w; w.x = pk_bf16(v[0], v[1]); w.y = pk_bf16(v[2], v[3]);
        *(u32x2*)(merged + idx) = w;
    }
    __device__ __forceinline__ void apply8(int row, int col, f32x4 v0, f32x4 v1) const {
        const size_t idx = (size_t)row * DM + col;
        const u32x4 g = *(const u32x4*)(sg + idx);
        v0[0] *= bflo(g.x); v0[1] *= bfhi(g.x); v0[2] *= bflo(g.y); v0[3] *= bfhi(g.y); v1[0] *= bflo(g.z); v1[1] *= bfhi(g.z); v1[2] *= bflo(g.w); v1[3] *= bfhi(g.w);
        if (mode) { const u32x4 o = *(const u32x4*)(merged + idx); v0[0] += bflo(o.x); v0[1] += bfhi(o.x); v0[2] += bflo(o.y); v0[3] += bfhi(o.y); v1[0] += bflo(o.z); v1[1] += bfhi(o.z); v1[2] += bflo(o.w); v1[3] += bfhi(o.w); }
        u32x4 w; w.x = pk_bf16(v0[0], v0[1]); w.y = pk_bf16(v0[2], v0[3]); w.z = pk_bf16(v1[0], v1[1]); w.w = pk_bf16(v1[2], v1[3]);
        *(u32x4*)(merged + idx) = w;
    }
};
struct EpiRes {
    float* out; const float* xp; const float* xs; const float* ada; int gate_off; int xin;
    __device__ __forceinline__ void apply(int row, int col, f32x4 v) const {
        const f32x4 g = *(const f32x4*)(ada + (size_t)row_batch(row) * ADAW + gate_off + col);
        const float* bp = xin ? (row < NPR ? xp + (size_t)row * DM : xs + (size_t)(row - NPR) * DM) : out + (size_t)row * DM;
        const f32x4 b = *(const f32x4*)(bp + col);
        *(f32x4*)(out + (size_t)row * DM + col) = b + g * v;
    }
    __device__ __forceinline__ void apply8(int row, int col, f32x4 v0, f32x4 v1) const { apply(row, col, v0); apply(row, col + 4, v1); }
};
struct EpiAct {
    bf16_t* act;
    __device__ __forceinline__ void apply(int row, int col, f32x4 v) const {
#pragma unroll
        for (int j = 0; j < 4; ++j) { float t = fmaxf(v[j], 0.f); v[j] = t * t; }
        u32x2 w; w.x = pk_bf16(v[0], v[1]); w.y = pk_bf16(v[2], v[3]);
        *(u32x2*)(act + (size_t)row * DFF + col) = w;
    }
    __device__ __forceinline__ void apply8(int row, int col, f32x4 v0, f32x4 v1) const {
#pragma unroll
        for (int j = 0; j < 4; ++j) { float t0 = fmaxf(v0[j], 0.f); v0[j] = t0 * t0; float t1 = fmaxf(v1[j], 0.f); v1[j] = t1 * t1; }
        u32x4 w; w.x = pk_bf16(v0[0], v0[1]); w.y = pk_bf16(v0[2], v0[3]); w.z = pk_bf16(v1[0], v1[1]); w.w = pk_bf16(v1[2], v1[3]);
        *(u32x4*)(act + (size_t)row * DFF + col) = w;
    }
};

__device__ __forceinline__ void xchg_publish_wait(unsigned* cnt, unsigned need) {
    asm volatile("s_waitcnt vmcnt(0)" ::: "memory");
    __syncthreads();
    if (threadIdx.x == 0) {
        __builtin_amdgcn_fence(__ATOMIC_RELEASE, "agent");
        asm volatile("s_waitcnt vmcnt(0)" ::: "memory");
        __hip_atomic_fetch_add(cnt, 1u, __ATOMIC_RELAXED, __HIP_MEMORY_SCOPE_AGENT);
        unsigned spins = 0;
        while (__hip_atomic_load(cnt, __ATOMIC_RELAXED, __HIP_MEMORY_SCOPE_AGENT) < need) { __builtin_amdgcn_s_sleep(1); if (++spins > (1u << 24)) break; }
        __builtin_amdgcn_fence(__ATOMIC_ACQUIRE, "agent");
        asm volatile("s_waitcnt vmcnt(0)" ::: "memory");
    }
    __syncthreads();
}
extern __shared__ __attribute__((aligned(16))) unsigned char g_dyn_lds[];
struct EpiFinal {
    float* out; const float* ada; const float* gfin; float* rowpart; unsigned* cnt; float* rowpartS; unsigned* cntS;
    __device__ __forceinline__ void apply(int, int, f32x4) const {}
    __device__ __forceinline__ void apply8(int, int, f32x4, f32x4) const {}
    __device__ __forceinline__ void fused(f32x4 (&acc)[2][2][4][2], const Unit& u, int wr, int wc, int fr, int fq, unsigned char* lds) const {
        const int tid = otid();
        (void)lds;
        float* P = (float*)g_dyn_lds;
        float* S = P + 1024;
        const int r0 = u.pm * BM + wr * 64 + fr, c0 = u.pn * BM + wc * 32 + fq * 8;
#pragma unroll
        for (int ai = 0; ai < 2; ++ai)
#pragma unroll
            for (int m = 0; m < 4; ++m) {
                const int row = r0 + ai * 128 + m * 16;
                const float* ga = ada + (size_t)row_batch(row) * ADAW + 5120;
                float ss = 0.f;
#pragma unroll
                for (int bj = 0; bj < 2; ++bj)
#pragma unroll
                    for (int n = 0; n < 2; ++n) {
                        const int col = c0 + bj * 128 + n * 4;
                        const f32x4 g = *(const f32x4*)(ga + col);
                        const f32x4 b = *(const f32x4*)(out + (size_t)row * DM + col);
                        const f32x4 v = b + g * acc[ai][bj][m][n];
                        acc[ai][bj][m][n] = v;
                        ss += v[0] * v[0] + v[1] * v[1] + v[2] * v[2] + v[3] * v[3];
                    }
                ss += __shfl_xor(ss, 16); ss += __shfl_xor(ss, 32);
                if (fq == 0) P[(ai * 128 + wr * 64 + m * 16 + fr) * 4 + wc] = ss;
                asm volatile("" ::: "memory");
            }
        __syncthreads();
        if (tid < 256) rowpart[((size_t)u.pm * BM + tid) * 4 + u.pn] = (P[tid * 4] + P[tid * 4 + 1]) + (P[tid * 4 + 2] + P[tid * 4 + 3]);
        xchg_publish_wait(cnt + u.pm * 64, 8u);
        if (tid < 256) { const f32x4 rp = *(const f32x4*)(rowpart + ((size_t)u.pm * BM + tid) * 4); S[tid] = rsqrtf(((rp[0] + rp[1]) + (rp[2] + rp[3])) * (1.0f / DM) + EPS); }
        __syncthreads();
#pragma unroll
        for (int ai = 0; ai < 2; ++ai)
#pragma unroll
            for (int m = 0; m < 4; ++m) {
                const int row = r0 + ai * 128 + m * 16;
                const float rs = S[ai * 128 + wr * 64 + m * 16 + fr];
#pragma unroll
                for (int bj = 0; bj < 2; ++bj)
#pragma unroll
                    for (int n = 0; n < 2; ++n) {
                        const int col = c0 + bj * 128 + n * 4;
                        const f32x4 gf = *(const f32x4*)(gfin + col);
                        __builtin_nontemporal_store(acc[ai][bj][m][n] * rs * gf, (f32x4*)(out + (size_t)row * DM + col));
                    }
            }
        __syncthreads();
    }
};

struct EpiMid {
    float* out; const float* xp; const float* xs; const float* ada; const float* gffn; bf16_t* hbuf; float* rowpart; unsigned* cnt; float* rowpartS; unsigned* cntS;
    __device__ __forceinline__ void apply(int, int, f32x4) const {}
    __device__ __forceinline__ void apply8(int, int, f32x4, f32x4) const {}
    __device__ __forceinline__ void fused(f32x4 (&acc)[2][2][4][2], const Unit& u, int wr, int wc, int fr, int fq, unsigned char*) const {
        const int tid = otid();
        float* P = (float*)g_dyn_lds;
        float* S = P + 1024;
        const int r0 = u.pm * BM + wr * 64 + fr, c0 = u.pn * BM + wc * 32 + fq * 8;
#pragma unroll
        for (int ai = 0; ai < 2; ++ai)
#pragma unroll
            for (int m = 0; m < 4; ++m) {
                const int row = r0 + ai * 128 + m * 16;
                const float* ga = ada + (size_t)(row >> 11) * ADAW + 2048;
                float ss = 0.f;
#pragma unroll
                for (int bj = 0; bj < 2; ++bj)
#pragma unroll
                    for (int n = 0; n < 2; ++n) {
                        const int col = c0 + bj * 128 + n * 4;
                        const f32x4 g = *(const f32x4*)(ga + col);
                        const f32x4 b = *(const f32x4*)(xp + (size_t)row * DM + col);
                        const f32x4 v = b + g * acc[ai][bj][m][n];
                        acc[ai][bj][m][n] = v;
                        *(f32x4*)(out + (size_t)row * DM + col) = v;
                        ss += v[0] * v[0] + v[1] * v[1] + v[2] * v[2] + v[3] * v[3];
                    }
                ss += __shfl_xor(ss, 16); ss += __shfl_xor(ss, 32);
                if (fq == 0) P[(ai * 128 + wr * 64 + m * 16 + fr) * 4 + wc] = ss;
                asm volatile("" ::: "memory");
            }
        __syncthreads();
        if (tid < 256) rowpart[((size_t)u.pm * BM + tid) * 4 + u.pn] = (P[tid * 4] + P[tid * 4 + 1]) + (P[tid * 4 + 2] + P[tid * 4 + 3]);
        xchg_publish_wait(cnt + u.pm * 64, 4u);
        if (tid < 256) { const f32x4 rp = *(const f32x4*)(rowpart + ((size_t)u.pm * BM + tid) * 4); S[tid] = rsqrtf(((rp[0] + rp[1]) + (rp[2] + rp[3])) * (1.0f / DM) + EPS); }
        __syncthreads();
        const float* ab = ada + (size_t)(r0 >> 11) * ADAW;
#pragma unroll
        for (int bj = 0; bj < 2; ++bj) {
            const int col = c0 + bj * 128;
            f32x4 G0 = *(const f32x4*)(gffn + col), G1 = *(const f32x4*)(gffn + col + 4);
            G0 *= (*(const f32x4*)(ab + 4096 + col) + 1.0f); G1 *= (*(const f32x4*)(ab + 4096 + col + 4) + 1.0f);
            const f32x4 S0 = *(const f32x4*)(ab + 3072 + col), S1 = *(const f32x4*)(ab + 3072 + col + 4);
#pragma unroll
            for (int ai = 0; ai < 2; ++ai)
#pragma unroll
                for (int m = 0; m < 4; ++m) {
                    const int row = r0 + ai * 128 + m * 16;
                    const float rs = S[ai * 128 + wr * 64 + m * 16 + fr];
                    const f32x4 h0 = acc[ai][bj][m][0] * rs * G0 + S0, h1 = acc[ai][bj][m][1] * rs * G1 + S1;
                    u32x4 w; w.x = pk_bf16(h0[0], h0[1]); w.y = pk_bf16(h0[2], h0[3]); w.z = pk_bf16(h1[0], h1[1]); w.w = pk_bf16(h1[2], h1[3]);
                    *(u32x4*)(hbuf + (size_t)row * DM + col) = w;
                }
        }
        __syncthreads();
    }
};

template <class Epi, int FIN = 0>
__device__ __forceinline__ void small_gemm_phase(unsigned char* lds, const bf16_t* gA, const bf16_t* gBt, const int N, const int K, const Epi& E, const int t_begin, const int t_end) {
    int tid_ = threadIdx.x; asm volatile("" : "+v"(tid_));
    const int tid = tid_, lane = tid & 63, w = tid >> 6, fr = lane & 15, fq = lane >> 4;
    const int kw = K / 8;
    float* red = (float*)lds;
    for (int t = t_begin; t < t_end; ++t) {
        const int rt = t & 15, ct = t >> 4;
        const int row0 = NPR + rt * 32, col0 = ct * 64;
        const bf16_t* ap = gA + (size_t)(row0 + fr) * K + w * kw + fq * 8;
        const bf16_t* bp = gBt + (size_t)(col0 + fr) * K + w * kw + fq * 8;
        f32x4 acc[2][4] = {};
#pragma unroll 2
        for (int k0 = 0; k0 < kw; k0 += 64) {
            bf16x8 af[2][2], bfm[2][4];
#pragma unroll
            for (int s2 = 0; s2 < 2; ++s2) {
#pragma unroll
                for (int m = 0; m < 2; ++m) af[s2][m] = *(const bf16x8*)(ap + (size_t)m * 16 * K + k0 + s2 * 32);
#pragma unroll
                for (int n = 0; n < 4; ++n) bfm[s2][n] = *(const bf16x8*)(bp + (size_t)n * 16 * K + k0 + s2 * 32);
            }
#pragma unroll
            for (int s2 = 0; s2 < 2; ++s2)
#pragma unroll
                for (int m = 0; m < 2; ++m)
#pragma unroll
                    for (int n = 0; n < 4; ++n) acc[m][n] = MFMA16(bfm[s2][n], af[s2][m], acc[m][n]);
        }
#pragma unroll
        for (int m = 0; m < 2; ++m)
#pragma unroll
            for (int n = 0; n < 4; ++n) *(f32x4*)(red + ((w * 32 + m * 16 + fr) * 64 + n * 16 + fq * 4)) = acc[m][n];
        __syncthreads();
        {
            const int r = tid >> 4, c4 = (tid & 15) * 4;
            f32x4 v = *(const f32x4*)(red + (r * 64 + c4));
#pragma unroll
            for (int ww = 1; ww < 8; ++ww) v += *(const f32x4*)(red + ((ww * 32 + r) * 64 + c4));
            if constexpr (FIN == 0) E.apply(row0 + r, col0 + c4, v);
            else if constexpr (FIN == 2) {
                const int row = row0 + r, col = col0 + c4;
                const float* ab = E.ada + (size_t)row_batch(row) * ADAW;
                const f32x4 g = *(const f32x4*)(ab + 2048 + col);
                const f32x4 b = *(const f32x4*)(E.xs + (size_t)(row - NPR) * DM + col);
                const f32x4 x1 = b + g * v;
                *(f32x4*)(E.out + (size_t)row * DM + col) = x1;
                float ss = x1[0] * x1[0] + x1[1] * x1[1] + x1[2] * x1[2] + x1[3] * x1[3];
                ss += __shfl_xor(ss, 1); ss += __shfl_xor(ss, 2); ss += __shfl_xor(ss, 4); ss += __shfl_xor(ss, 8);
                if ((tid & 15) == 0) E.rowpartS[(size_t)(row - NPR) * 16 + ct] = ss;
                xchg_publish_wait(E.cntS + rt * 64, 16u);
                const float* rp = E.rowpartS + (size_t)(row - NPR) * 16;
                float tot = 0.f;
#pragma unroll
                for (int q = 0; q < 16; q += 4) { const f32x4 t4 = *(const f32x4*)(rp + q); tot += (t4[0] + t4[1]) + (t4[2] + t4[3]); }
                const float rs = rsqrtf(tot * (1.0f / DM) + EPS);
                const f32x4 G = *(const f32x4*)(E.gffn + col) * (*(const f32x4*)(ab + 4096 + col) + 1.0f);
                const f32x4 h = x1 * rs * G + *(const f32x4*)(ab + 3072 + col);
                u32x2 wv; wv.x = pk_bf16(h[0], h[1]); wv.y = pk_bf16(h[2], h[3]);
                *(u32x2*)(E.hbuf + (size_t)row * DM + col) = wv;
            }
            else {
                const int row = row0 + r, col = col0 + c4;
                const f32x4 g = *(const f32x4*)(E.ada + (size_t)row_batch(row) * ADAW + 5120 + col);
                const f32x4 b = *(const f32x4*)(E.out + (size_t)row * DM + col);
                const f32x4 x2 = b + g * v;
                float ss = x2[0] * x2[0] + x2[1] * x2[1] + x2[2] * x2[2] + x2[3] * x2[3];
                ss += __shfl_xor(ss, 1); ss += __shfl_xor(ss, 2); ss += __shfl_xor(ss, 4); ss += __shfl_xor(ss, 8);
                if ((tid & 15) == 0) E.rowpartS[(size_t)(row - NPR) * 16 + ct] = ss;
                xchg_publish_wait(E.cntS + rt * 64, 32u);
                const float* rp = E.rowpartS + (size_t)(row - NPR) * 16;
                float tot = 0.f;
#pragma unroll
                for (int q = 0; q < 16; q += 4) { const f32x4 t4 = *(const f32x4*)(rp + q); tot += (t4[0] + t4[1]) + (t4[2] + t4[3]); }
                const float rs = rsqrtf(tot * (1.0f / DM) + EPS);
                const f32x4 gf = *(const f32x4*)(E.gfin + col);
                *(f32x4*)(E.out + (size_t)row * DM + col) = x2 * rs * gf;
            }
        }
        __syncthreads();
    }
}

__device__ __forceinline__ void conv_tile(const float* __restrict__ src, int ld, int K, bf16_t* __restrict__ dst, int kt, int ntile, int src_col0, float* lds) {
    const int tid = otid();
    const int k0 = kt * 64, n0 = ntile * 64;
#pragma unroll
    for (int i = 0; i < 2; ++i) {
        const int r = (tid >> 4) + i * 32, c4 = (tid & 15) * 4;
        const f32x4 v = *(const f32x4*)(src + (size_t)(k0 + r) * ld + src_col0 + c4);
        lds[r * 65 + c4 + 0] = v[0]; lds[r * 65 + c4 + 1] = v[1]; lds[r * 65 + c4 + 2] = v[2]; lds[r * 65 + c4 + 3] = v[3];
    }
    __syncthreads();
    {
        const int n = tid >> 3, k8 = (tid & 7) * 8;
        float v[8];
#pragma unroll
        for (int i = 0; i < 8; ++i) v[i] = lds[(k8 + i) * 65 + n];
        u32x4 w; w.x = pk_bf16(v[0], v[1]); w.y = pk_bf16(v[2], v[3]); w.z = pk_bf16(v[4], v[5]); w.w = pk_bf16(v[6], v[7]);
        *(u32x4*)(dst + (size_t)(n0 + n) * K + k0 + k8) = w;
    }
    __syncthreads();
}

__device__ __forceinline__ void conv_strip(const float* __restrict__ src, int ld, int K, bf16_t* __restrict__ dst, int kt, int nt4, int src_col0, float* lds) {
    const int tid = otid();
    const int k0 = kt * 64, n0 = nt4 * 256;
    f32x4 v[8];
#pragma unroll
    for (int i = 0; i < 8; ++i) { const int r = (tid >> 6) + i * 8, c4 = (tid & 63) * 4; v[i] = __builtin_nontemporal_load((const f32x4*)(src + (size_t)(k0 + r) * ld + src_col0 + c4)); }
#pragma unroll
    for (int i = 0; i < 8; ++i) { const int r = (tid >> 6) + i * 8, c4 = (tid & 63) * 4;
        lds[r * 257 + c4 + 0] = v[i][0]; lds[r * 257 + c4 + 1] = v[i][1]; lds[r * 257 + c4 + 2] = v[i][2]; lds[r * 257 + c4 + 3] = v[i][3]; }
    __syncthreads();
#pragma unroll
    for (int j = 0; j < 4; ++j) {
        const int n = (tid >> 3) + j * 64, k8 = (tid & 7) * 8;
        float x[8];
#pragma unroll
        for (int i = 0; i < 8; ++i) x[i] = lds[(k8 + i) * 257 + n];
        u32x4 w; w.x = pk_bf16(x[0], x[1]); w.y = pk_bf16(x[2], x[3]); w.z = pk_bf16(x[4], x[5]); w.w = pk_bf16(x[6], x[7]);
        *(u32x4*)(dst + (size_t)(n0 + n) * K + k0 + k8) = w;
    }
    __syncthreads();
}

__device__ __forceinline__ void ada_item(const Params& p, int item, float* lds) {
    const int tid = otid(), lane = tid & 63, w = tid >> 6;
    const int cg_ = item >> 3, kq = item & 7;
    const int n0 = cg_ * 128 + lane * 2;
    const int kbase = kq * 128;
    f32x2 acc[17];
#pragma unroll
    for (int r = 0; r < 17; ++r) acc[r] = (f32x2){0.f, 0.f};
    f32x2 wv[16];
#pragma unroll
    for (int j = 0; j < 16; ++j) wv[j] = __builtin_nontemporal_load((const f32x2*)(p.w_ada + (size_t)(kbase + j) * ADAW + n0));
    for (int e = tid; e < NBATCH * 32; e += NTH) {
        const int r = e >> 5, k4 = (e & 31) * 4;
        const float* cp = r < 8 ? p.c_p + (size_t)r * DM : p.c_s + (size_t)(r - 8) * DM;
        f32x4 v = *(const f32x4*)(cp + kbase + k4);
#pragma unroll
        for (int j = 0; j < 4; ++j) v[j] = v[j] * sigmoidf_(v[j]);
        *(f32x4*)(lds + r * 128 + k4) = v;
    }
    __syncthreads();
#pragma unroll 1
    for (int kb = 0; kb < 128; kb += 16) {
        f32x2 wn[16];
        if (kb + 16 < 128) {
#pragma unroll
            for (int j = 0; j < 16; ++j) wn[j] = __builtin_nontemporal_load((const f32x2*)(p.w_ada + (size_t)(kbase + kb + 16 + j) * ADAW + n0));
        }
#pragma unroll
        for (int r = 0; r < 17; ++r) {
#pragma unroll
            for (int k4 = 0; k4 < 16; k4 += 4) {
                const f32x4 sv = *(const f32x4*)(lds + (w * 17 + r) * 128 + kb + k4);
                acc[r] += wv[k4] * sv[0]; acc[r] += wv[k4 + 1] * sv[1]; acc[r] += wv[k4 + 2] * sv[2]; acc[r] += wv[k4 + 3] * sv[3];
            }
        }
        if (kb + 16 < 128) {
#pragma unroll
            for (int j = 0; j < 16; ++j) wv[j] = wn[j];
        }
    }
    __syncthreads();
    float* part = (float*)(p.ws + WS_ADAP) + (size_t)kq * NBATCH * ADAW;
#pragma unroll
    for (int r = 0; r < 17; ++r) *(f32x2*)(part + (size_t)(w * 17 + r) * ADAW + n0) = acc[r];
}

__device__ __forceinline__ void phase0(const Params& p, float* lds) {
    const int NADA = 48 * 8;
    const int T_IN = 16 * 26, T_PG = 16, T_PO = 8 * 4, T_MO = 64, T_OUT = 64, T_W1 = 16 * 16, T_W2 = 64 * 4;
    const int total = NADA + T_IN + T_PG + T_PO + T_MO + T_OUT + T_W1 + T_W2 + 1;
    unsigned* qctr = (unsigned*)(p.ws + WS_CTR) + 16;
    volatile unsigned* slot = (volatile unsigned*)((unsigned char*)lds + LDS_BYTES - 16);
    for (;;) {
        if (threadIdx.x == 0) *slot = atomicAdd(qctr, 1u);
        __syncthreads();
        const int it = (int)*slot;
        __syncthreads();
        if (it >= total) break;
        int t = it;
        if (t < NADA) { ada_item(p, t, lds); continue; }
        t -= NADA;
        if (t < T_IN) { const int kt = t / 26, nt_ = t % 26; const int n0 = nt_ * 256; const int sc = n0 < 4608 ? n0 : n0 + 8;
            conv_strip(p.w_in, INW, DM, (bf16_t*)(p.ws + WS_WIN), kt, nt_, sc, lds); continue; }
        t -= T_IN;
        if (t < T_PG) { const int g = t >> 2, kt = (t >> 1) & 1, nt_ = t & 1;
            conv_tile(p.w_pg + (size_t)g * 128 * 128, 128, 128, (bf16_t*)(p.ws + WS_WPG) + (size_t)g * 128 * 128, kt, nt_, nt_ * 64, lds); continue; }
        t -= T_PG;
        if (t < T_PO) { const int kt = t / 4, nt_ = t % 4; conv_strip(p.w_po, 1024, 512, (bf16_t*)(p.ws + WS_WPO), kt, nt_, nt_ * 256, lds); continue; }
        t -= T_PO;
        if (t < T_MO) { const int kt = t / 4, nt_ = t % 4; conv_strip(p.w_mo, 1024, 1024, (bf16_t*)(p.ws + WS_WMO), kt, nt_, nt_ * 256, lds); continue; }
        t -= T_MO;
        if (t < T_OUT) { const int kt = t / 4, nt_ = t % 4; conv_strip(p.w_out, 1024, 1024, (bf16_t*)(p.ws + WS_WOUT), kt, nt_, nt_ * 256, lds); continue; }
        t -= T_OUT;
        if (t < T_W1) { const int kt = t / 16, nt_ = t % 16; conv_strip(p.w1, 4096, 1024, (bf16_t*)(p.ws + WS_W1), kt, nt_, nt_ * 256, lds); continue; }
        t -= T_W1;
        if (t < T_W2) { const int kt = t / 4, nt_ = t % 4; conv_strip(p.w2, 1024, 4096, (bf16_t*)(p.ws + WS_W2), kt, nt_, nt_ * 256, lds); continue; }
        for (int e = threadIdx.x; e < 1024 * 2; e += NTH) { const int k = e >> 1, hf = e & 1;
            *(f32x4*)((float*)(p.ws + WS_GW) + k * 8 + hf * 4) = *(const f32x4*)(p.w_in + (size_t)k * INW + 4608 + hf * 4); }
    }
}

__device__ __forceinline__ void norm_item(const Params& p, int item, int mode, float* lds) {
    const int tid = otid(), lane = tid & 63, w = tid >> 6;
    const float* adap = (const float*)(p.ws + WS_ADAP);
    const float* adaf = (const float*)(p.ws + WS_ADA);
    bf16_t* hbuf = (bf16_t*)(p.ws + WS_H);
    if (mode == 0) {
        for (int e = tid; e < 1024 * 2; e += NTH) *(f32x4*)(lds + e * 4) = *(const f32x4*)((const float*)(p.ws + WS_GW) + e * 4);
        __syncthreads();
    }
    const int r_begin = item * 64 + w * 8;
    const int r_extra = NPR + item * 2 + w;
    const int nrows = w < 2 ? 9 : 8;
    int cur_b = -1;
    f32x4 G[4], S[4], xn[4];
    { const int row = r_begin; const float* src0 = mode == 0 ? (row < NPR ? p.x_p + (size_t)row * DM : p.x_s + (size_t)(row - NPR) * DM) : p.out + (size_t)row * DM;
#pragma unroll
      for (int i = 0; i < 4; ++i) xn[i] = *(const f32x4*)(src0 + i * 256 + lane * 4); }
    for (int rr = 0; rr < nrows; ++rr) {
        const int row = rr < 8 ? r_begin + rr : r_extra;
        const int b = row_batch(row);
        if (mode != 2 && b != cur_b) {
            cur_b = b;
            const float* gw = mode == 0 ? p.g_mix : p.g_ffn;
            const int sh_off = mode == 0 ? 0 : 3072, sc_off = mode == 0 ? 1024 : 4096;
            f32x4 scv[4], shv[4];
            if (mode == 0) {
#pragma unroll
                for (int i = 0; i < 4; ++i) { const int col = i * 256 + lane * 4; scv[i] = *(const f32x4*)(p.b_ada + sc_off + col); shv[i] = *(const f32x4*)(p.b_ada + sh_off + col); }
#pragma unroll 2
                for (int q = 0; q < 8; ++q) {
                    const float* ap = adap + ((size_t)q * NBATCH + b) * ADAW;
#pragma unroll
                    for (int i = 0; i < 4; ++i) { const int col = i * 256 + lane * 4; scv[i] += *(const f32x4*)(ap + sc_off + col); shv[i] += *(const f32x4*)(ap + sh_off + col); }
                }
            } else {
#pragma unroll
                for (int i = 0; i < 4; ++i) { const int col = i * 256 + lane * 4; scv[i] = *(const f32x4*)(adaf + (size_t)b * ADAW + sc_off + col); shv[i] = *(const f32x4*)(adaf + (size_t)b * ADAW + sh_off + col); }
            }
#pragma unroll
            for (int i = 0; i < 4; ++i) { const f32x4 g = *(const f32x4*)(gw + i * 256 + lane * 4); G[i] = g * (scv[i] + 1.0f); S[i] = shv[i]; }
        }
        f32x4 x[4]; float ss = 0.f;
#pragma unroll
        for (int i = 0; i < 4; ++i) { x[i] = xn[i]; ss += x[i][0] * x[i][0] + x[i][1] * x[i][1] + x[i][2] * x[i][2] + x[i][3] * x[i][3]; }
        if (rr + 1 < nrows) { const int rown = rr + 1 < 8 ? row + 1 : r_extra;
            const float* srcn = mode == 0 ? (rown < NPR ? p.x_p + (size_t)rown * DM : p.x_s + (size_t)(rown - NPR) * DM) : p.out + (size_t)rown * DM;
#pragma unroll
            for (int i = 0; i < 4; ++i) xn[i] = *(const f32x4*)(srcn + i * 256 + lane * 4); }
        ss = wave_sum(ss);
        const float rstd = rsqrtf(ss * (1.0f / DM) + EPS);
        if (mode == 2) {
#pragma unroll
            for (int i = 0; i < 4; ++i) { const f32x4 g = *(const f32x4*)(p.g_final + i * 256 + lane * 4); __builtin_nontemporal_store(x[i] * rstd * g, (f32x4*)(p.out + (size_t)row * DM + i * 256 + lane * 4)); }
            continue;
        }
        f32x4 hv[4];
#pragma unroll
        for (int i = 0; i < 4; ++i) { hv[i] = x[i] * rstd * G[i] + S[i];
            u32x2 wv; wv.x = pk_bf16(hv[i][0], hv[i][1]); wv.y = pk_bf16(hv[i][2], hv[i][3]);
            *(u32x2*)(hbuf + (size_t)row * DM + i * 256 + lane * 4) = wv; }
        if (mode == 0) {
            float d[8];
#pragma unroll
            for (int j = 0; j < 8; ++j) d[j] = 0.f;
#pragma unroll
            for (int i = 0; i < 4; ++i)
#pragma unroll
                for (int e = 0; e < 4; ++e) {
                    const int k = i * 256 + lane * 4 + e;
                    const f32x4 w0 = *(const f32x4*)(lds + k * 8), w1 = *(const f32x4*)(lds + k * 8 + 4);
                    const float hvv = hv[i][e];
                    d[0] += hvv * w0[0]; d[1] += hvv * w0[1]; d[2] += hvv * w0[2]; d[3] += hvv * w0[3];
                    d[4] += hvv * w1[0]; d[5] += hvv * w1[1]; d[6] += hvv * w1[2]; d[7] += hvv * w1[3];
                }
#pragma unroll
            for (int j = 0; j < 8; ++j) d[j] = wave_sum(d[j]);
            if (lane < 4) {
                float di = lane == 0 ? d[0] : lane == 1 ? d[1] : lane == 2 ? d[2] : d[3];
                float df = lane == 0 ? d[4] : lane == 1 ? d[5] : lane == 2 ? d[6] : d[7];
                di += p.b_i[lane];
                const float z = df + p.b_f[lane];
                const float lf = fminf(z, 0.f) - log1pf(__expf(-fabsf(z)));
                ((float*)(p.ws + WS_GI))[(size_t)row * 4 + lane] = di;
                ((float*)(p.ws + WS_GF))[(size_t)row * 4 + lane] = lf;
            }
        }
    }
    if (mode == 0) __syncthreads();
}

__device__ __forceinline__ void ada_final_slice(const Params& p, int blk) {
    const float* adap = (const float*)(p.ws + WS_ADAP);
    float* adaf = (float*)(p.ws + WS_ADA);
    for (int e = threadIdx.x; e < 816; e += NTH) {
        const size_t idx = ((size_t)blk * 816 + e) * 4;
        f32x4 v = *(const f32x4*)(p.b_ada + (idx % ADAW));
#pragma unroll
        for (int q = 0; q < 8; ++q) v += *(const f32x4*)(adap + (size_t)q * NBATCH * ADAW + idx);
        *(f32x4*)(adaf + idx) = v;
    }
}

__device__ __forceinline__ void scan_item(const Params& p, int item, unsigned char* lds) {
    const int tid = otid(), lane = tid & 63, w = tid >> 6, fr = lane & 15, fq = lane >> 4;
    const int bh = item >> 2, j = item & 3, b = bh >> 2, hd = bh & 3, dv0 = j * 64;
    const float* gi = (const float*)(p.ws + WS_GI); const float* gf = (const float*)(p.ws + WS_GF);
    const bf16_t* kbuf = (const bf16_t*)(p.ws + WS_QKV) + (size_t)1 * MROWS * DM;
    const bf16_t* vbuf = (const bf16_t*)(p.ws + WS_QKV) + (size_t)2 * MROWS * DM;
    bf16_t* cst = (bf16_t*)(p.ws + WS_CST) + (size_t)bh * 31 * 65536;
    float* nst = (float*)(p.ws + WS_NST) + (size_t)bh * 32 * 256;
    float* mst = (float*)(p.ws + WS_MST) + (size_t)bh * 64;
    constexpr int KROW = 144;
    unsigned char* kimg[2] = {lds, lds + 256 * KROW};
    unsigned char* vimg[2] = {lds + 2 * 256 * KROW, lds + 2 * 256 * KROW + 64 * KROW};
    float* aA = (float*)(lds + 2 * 256 * KROW + 2 * 64 * KROW);
    float* bLs = aA + 2048;
    float* amx = bLs + 32;
    float* mch = amx + 32;
    float* dcy = mch + 40;
    for (int c = w * 4; c < w * 4 + 4; ++c) {
        const size_t tok = (size_t)b * SEQ + c * 64 + lane;
        const float lf = gf[tok * 4 + hd], il = gi[tok * 4 + hd];
        const float bs = wave_scan_add(lf, lane);
        const float bL = __shfl(bs, 63);
        const float a = bL - bs + il;
        const float am = wave_max(a);
        aA[c * 64 + lane] = a;
        if (lane == 0) { bLs[c] = bL; amx[c] = am; }
    }
    lds_barrier();
    if (tid == 0) {
        float m = 0.f; mch[0] = 0.f;
        for (int c = 0; c < 32; ++c) { const float mn = fmaxf(bLs[c] + m, amx[c]); dcy[c] = __expf(bLs[c] + m - mn); m = mn; mch[c + 1] = mn; }
    }
    lds_barrier();
    if (j == 0 && tid < 33) mst[tid] = mch[tid];
    if (j == 0 && tid == 0) p.out[O_MP + bh] = mch[32];
    f32x4 acc[2][4] = {};
    float nacc = 0.f;
    u32x4 krA[4], krB[4]; u32x4 vrA, vrB;
#define SCAN_GLOAD(KR, VR, cc) do { const size_t tok_ = (size_t)b * SEQ + (cc) * 64 + lane; const bf16_t* kp_ = kbuf + tok_ * DM + hd * 256 + w * 32; \
        _Pragma("unroll") for (int i_ = 0; i_ < 4; ++i_) KR[i_] = *(const u32x4*)(kp_ + i_ * 8); \
        VR = *(const u32x4*)(vbuf + tok_ * DM + hd * 256 + dv0 + w * 8); } while (0)
#define SCAN_WRITE(KR, VR, cc, ki, vi) do { const float wsv = __expf(aA[(cc) * 64 + lane] - mch[(cc) + 1]); const int odd_ = lane & 1; const int scol_ = (lane & ~1) * 2; \
          \
        _Pragma("unroll") for (int i_ = 0; i_ < 4; ++i_) { const unsigned uu[4] = {KR[i_].x, KR[i_].y, KR[i_].z, KR[i_].w}; \
            _Pragma("unroll") for (int e_ = 0; e_ < 4; ++e_) { const int dk_ = w * 32 + i_ * 8 + e_ * 2; \
                const unsigned P_ = pk_bf16(bflo(uu[e_]) * wsv, bfhi(uu[e_]) * wsv); const unsigned Q_ = (unsigned)__shfl_xor((int)P_, 1); \
                const unsigned W_ = odd_ ? ((Q_ >> 16) | (P_ & 0xffff0000u)) : ((P_ & 0xffffu) | (Q_ << 16)); \
                *(unsigned*)(ki + (dk_ + odd_) * KROW + scol_) = W_; } } \
        { const unsigned vv_[4] = {VR.x, VR.y, VR.z, VR.w}; \
          _Pragma("unroll") for (int e_ = 0; e_ < 4; ++e_) { const int dv_ = w * 8 + e_ * 2; const unsigned P_ = vv_[e_]; const unsigned Q_ = (unsigned)__shfl_xor((int)P_, 1); \
            const unsigned W_ = odd_ ? ((Q_ >> 16) | (P_ & 0xffff0000u)) : ((P_ & 0xffffu) | (Q_ << 16)); \
            *(unsigned*)(vi + (dv_ + odd_) * KROW + scol_) = W_; } } } while (0)
    SCAN_GLOAD(krA, vrA, 0);
    SCAN_GLOAD(krB, vrB, 1);
#pragma unroll 2
    for (int c = 0; c < 32; ++c) {
        unsigned char* ki = kimg[c & 1]; unsigned char* vi = vimg[c & 1];
        { const int cn = c + 2 < 32 ? c + 2 : 31;
          if ((c & 1) == 0) { SCAN_WRITE(krA, vrA, c, ki, vi); SCAN_GLOAD(krA, vrA, cn); }
          else { SCAN_WRITE(krB, vrB, c, ki, vi); SCAN_GLOAD(krB, vrB, cn); } }
        lds_barrier();
        const float dc = dcy[c];
        bf16x8 af[2][2], bfr[4][2];
#pragma unroll
        for (int a = 0; a < 2; ++a)
#pragma unroll
            for (int k = 0; k < 2; ++k) af[a][k] = *(const bf16x8*)(ki + ((w * 2 + a) * 16 + fr) * KROW + (k * 32 + fq * 8) * 2);
#pragma unroll
        for (int a = 0; a < 4; ++a)
#pragma unroll
            for (int k = 0; k < 2; ++k) bfr[a][k] = *(const bf16x8*)(vi + (a * 16 + fr) * KROW + (k * 32 + fq * 8) * 2);
#pragma unroll
        for (int a = 0; a < 2; ++a)
#pragma unroll
            for (int q = 0; q < 4; ++q) {
                acc[a][q] *= dc;
#pragma unroll
                for (int k = 0; k < 2; ++k) acc[a][q] = MFMA16(af[a][k], bfr[q][k], acc[a][q]);
            }
        if (j == 0) {
            const int dk = tid >> 1, hf = tid & 1;
            float s = 0.f;
#pragma unroll
            for (int i = 0; i < 4; ++i) {
                const u32x4 v = *(const u32x4*)(ki + dk * KROW + hf * 64 + i * 16);
                s += bflo(v.x) + bfhi(v.x) + bflo(v.y) + bfhi(v.y) + bflo(v.z) + bfhi(v.z) + bflo(v.w) + bfhi(v.w);
            }
            s += __shfl_xor(s, 1);
            nacc = nacc * dc + s;
            if (hf == 0) { if (c < 31) nst[(c + 1) * 256 + dk] = nacc; else p.out[O_NP + (size_t)bh * 256 + dk] = nacc; }
        }
        if (c < 31) {
            bf16_t* cs = cst + (size_t)c * 65536;
#pragma unroll
            for (int a = 0; a < 2; ++a)
#pragma unroll
                for (int q = 0; q < 4; ++q) {
                    u32x2 wv; wv.x = pk_bf16(acc[a][q][0], acc[a][q][1]); wv.y = pk_bf16(acc[a][q][2], acc[a][q][3]);
                    *(u32x2*)(cs + (size_t)(dv0 + q * 16 + fr) * 256 + (w * 2 + a) * 16 + fq * 4) = wv;
                }
        } else {
            float* co = p.out + O_CP + (size_t)bh * 65536;
#pragma unroll
            for (int a = 0; a < 2; ++a)
#pragma unroll
                for (int q = 0; q < 4; ++q)
#pragma unroll
                    for (int jj = 0; jj < 4; ++jj) co[(size_t)((w * 2 + a) * 16 + fq * 4 + jj) * 256 + dv0 + q * 16 + fr] = acc[a][q][jj];
        }
    }
    lds_barrier();
}

__device__ __forceinline__ void sample_item(const Params& p, int item, unsigned char* ldsb) {
    const int tid = otid(), lane = tid & 63, w = tid >> 6;
    const int b = item >> 2, hd = item & 3, bh = item;
    const int r0 = NPR + b * 4;
    const bf16_t* qb = (const bf16_t*)(p.ws + WS_QKV);
    const bf16_t* kb = qb + (size_t)MROWS * DM; const bf16_t* vb = kb + (size_t)MROWS * DM; const bf16_t* ob = vb + (size_t)MROWS * DM;
    const float* gi = (const float*)(p.ws + WS_GI); const float* gf = (const float*)(p.ws + WS_GF);
    float* lds = (float*)ldsb;
    float* qf = lds;
    float* kf = qf + 1024;
    float* vf = kf + 1024;
    float* Sm = vf + 1024;
    float* sc = Sm + 16;
    float* red = sc + 64;
    float* ssq = red + 8192;
    float lfp[4] = {0.f, 0.f, 0.f, 0.f}, ilp[4] = {0.f, 0.f, 0.f, 0.f}, m0p = 0.f;
    if (tid == 0) {
#pragma unroll
        for (int t = 0; t < 4; ++t) { lfp[t] = gf[(size_t)(r0 + t) * 4 + hd]; ilp[t] = gi[(size_t)(r0 + t) * 4 + hd]; }
        m0p = p.st_m[bh];
    }
    const int dv4 = lane * 4;
    const float* C0 = p.st_C + (size_t)bh * 65536;
    float* Cn = p.out + O_CS + (size_t)bh * 65536;
    f32x4 cpre[16];
#pragma unroll
    for (int r = 0; r < 16; ++r) cpre[r] = __builtin_nontemporal_load((const f32x4*)(C0 + (size_t)(w * 32 + r) * 256 + dv4));
    float* n0s = ssq + 8;
    const int ft = tid >> 7, fdv = (tid & 127) * 2;
    const size_t foidx = (size_t)(r0 + ft) * DM + hd * 256 + fdv;
    const unsigned fog = *(const unsigned*)(ob + foidx);
    const float fm0 = p.m_norm[hd * 256 + fdv], fm1 = p.m_norm[hd * 256 + fdv + 1];
    if (tid < 256) n0s[tid] = p.st_n[(size_t)bh * 256 + tid];
    for (int e = tid; e < 3 * 4 * 256; e += NTH) {
        const int which = e >> 10, t = (e >> 8) & 3, d = e & 255;
        const bf16_t* src = which == 0 ? qb : which == 1 ? kb : vb;
        lds[which * 1024 + t * 256 + d] = bf2f(src[(size_t)(r0 + t) * DM + hd * 256 + d]);
    }
    if (tid == 0) {
        float lf[4], il[4], bs[4];
        for (int t = 0; t < 4; ++t) { lf[t] = lfp[t]; il[t] = ilp[t]; }
        bs[0] = lf[0]; bs[1] = bs[0] + lf[1]; bs[2] = bs[1] + lf[2]; bs[3] = bs[2] + lf[3];
        const float m0 = m0p;
        for (int t = 0; t < 4; ++t) {
            const float g = bs[t] + m0; float mt = g;
            for (int s = 0; s <= t; ++s) mt = fmaxf(mt, bs[t] - bs[s] + il[s]);
            sc[t] = __expf(g - mt); sc[4 + t] = __expf(-mt);
            for (int s = 0; s < 4; ++s) sc[16 + t * 4 + s] = s <= t ? __expf(bs[t] - bs[s] + il[s] - mt) : 0.f;
        }
        const float bL = bs[3]; float mn = bL + m0;
        for (int s = 0; s < 4; ++s) mn = fmaxf(mn, bL - bs[s] + il[s]);
        sc[12] = __expf(bL + m0 - mn);
        for (int s = 0; s < 4; ++s) sc[8 + s] = __expf(bL - bs[s] + il[s] - mn);
        p.out[O_MS + bh] = mn;
    }
    lds_barrier();
    {
        const int g = tid >> 5, l32 = tid & 31;
        {
            const int t = g >> 2, s = g & 3; float a = 0.f;
#pragma unroll
            for (int d = l32; d < 256; d += 32) a += qf[t * 256 + d] * kf[s * 256 + d];
#pragma unroll
            for (int dd = 16; dd >= 1; dd >>= 1) a += __shfl_xor(a, dd);
            if (l32 == 0) Sm[g] = a * sc[16 + g];
        }
        if (g < 4) {
            float a = 0.f;
#pragma unroll
            for (int d = l32; d < 256; d += 32) a += qf[g * 256 + d] * n0s[d];
#pragma unroll
            for (int dd = 16; dd >= 1; dd >>= 1) a += __shfl_xor(a, dd);
            if (l32 == 0) sc[32 + g] = a;
        }
    }
    const float decay = sc[12];
    const float ws0 = sc[8], ws1 = sc[9], ws2 = sc[10], ws3 = sc[11];
    if (tid < 256) {
        const float nn = decay * n0s[tid] + ws0 * kf[tid] + ws1 * kf[256 + tid] + ws2 * kf[512 + tid] + ws3 * kf[768 + tid];
        p.out[O_NS + (size_t)bh * 256 + tid] = nn;
    }
    {
        f32x4 vv[4], num[4];
        vv[0] = *(const f32x4*)(vf + dv4) * ws0; vv[1] = *(const f32x4*)(vf + 256 + dv4) * ws1; vv[2] = *(const f32x4*)(vf + 512 + dv4) * ws2; vv[3] = *(const f32x4*)(vf + 768 + dv4) * ws3;
#pragma unroll
        for (int s = 0; s < 4; ++s) num[s] = (f32x4){0.f, 0.f, 0.f, 0.f};
#pragma unroll
        for (int r = 0; r < 16; ++r) {
            const int dk = w * 32 + r;
            const f32x4 cv = cpre[r];
            f32x4 cn = cv * decay;
#pragma unroll
            for (int s = 0; s < 4; ++s) { num[s] += cv * qf[s * 256 + dk]; cn += vv[s] * kf[s * 256 + dk]; }
            __builtin_nontemporal_store(cn, (f32x4*)(Cn + (size_t)dk * 256 + dv4));
        }
#pragma unroll 16
        for (int r = 16; r < 32; ++r) {
            const int dk = w * 32 + r;
            const f32x4 cv = __builtin_nontemporal_load((const f32x4*)(C0 + (size_t)dk * 256 + dv4));
            f32x4 cn = cv * decay;
#pragma unroll
            for (int s = 0; s < 4; ++s) { num[s] += cv * qf[s * 256 + dk]; cn += vv[s] * kf[s * 256 + dk]; }
            __builtin_nontemporal_store(cn, (f32x4*)(Cn + (size_t)dk * 256 + dv4));
        }
        lds_barrier();
#pragma unroll
        for (int t = 0; t < 4; ++t) *(f32x4*)(red + (w * 4 + t) * 256 + dv4) = num[t];
    }
    lds_barrier();
    {
        const int t = tid >> 7, dv = (tid & 127) * 2;
        float n0_ = 0.f, n1_ = 0.f;
#pragma unroll
        for (int ww = 0; ww < 8; ++ww) { n0_ += red[(ww * 4 + t) * 256 + dv]; n1_ += red[(ww * 4 + t) * 256 + dv + 1]; }
        const float wint = sc[t];
        n0_ *= wint; n1_ *= wint;
        float rs = 0.f;
#pragma unroll
        for (int s = 0; s < 4; ++s) { const float sv = Sm[t * 4 + s]; rs += sv; n0_ += sv * vf[s * 256 + dv]; n1_ += sv * vf[s * 256 + dv + 1]; }
        const float den = wint * sc[32 + t] + rs;
        const float dinv = 1.0f / fmaxf(fabsf(den), sc[4 + t]);
        const float h0 = n0_ * dinv, h1 = n1_ * dinv;
        float q2 = wave_sum(h0 * h0 + h1 * h1);
        if (lane == 0) ssq[t * 2 + (w & 1)] = q2;
        lds_barrier();
        const float rstd = rsqrtf((ssq[t * 2] + ssq[t * 2 + 1]) * (1.0f / 256.f) + EPS);
        const float o0 = h0 * rstd * fm0 * bflo(fog), o1 = h1 * rstd * fm1 * bfhi(fog);
        *(unsigned*)((bf16_t*)(p.ws + WS_HM) + foidx) = pk_bf16(o0, o1);
    }
    lds_barrier();
}

__device__ __forceinline__ void pool_item(const Params& p, int item, unsigned char* lds) {
    const int tid = otid(), lane = tid & 63, w = tid >> 6, fr = lane & 15, fq = lane >> 4;
    const int r0 = item < 256 ? item * 64 : NPR + (item - 256) * 16;
    const int nm = item < 256 ? 4 : 1;
    const float* u = (const float*)(p.ws + WS_U);
    constexpr int AROW = 1040;
    bf16x8 bw[4][4];
    {
        const bf16_t* wt0 = (const bf16_t*)(p.ws + WS_WPG) + (size_t)(w >> 1) * 128 * 128;
#pragma unroll
        for (int k = 0; k < 4; ++k)
#pragma unroll
            for (int n = 0; n < 4; ++n) bw[k][n] = *(const bf16x8*)(wt0 + (size_t)(((w & 1) * 4 + n) * 16 + fr) * 128 + k * 32 + fq * 8);
    }
    {
        const int c = tid, gidx = c >> 7, win = 2 << gidx;
        float hist[31];
        if (r0 < NPR) {
            const int t0 = r0 & (SEQ - 1);
#pragma unroll
            for (int j = 0; j < 15; ++j) hist[j] = (t0 - 15 + j) >= 0 ? u[(size_t)(r0 - 15 + j) * 512 + c] : 0.f;
            float nxt[16];
#pragma unroll
            for (int j = 0; j < 16; ++j) nxt[j] = u[(size_t)(r0 + j) * 512 + c];
#pragma unroll 1
            for (int ch = 0; ch < 4; ++ch) {
#pragma unroll
                for (int j = 0; j < 16; ++j) hist[15 + j] = nxt[j];
                if (ch < 3) {
#pragma unroll
                    for (int j = 0; j < 16; ++j) nxt[j] = u[(size_t)(r0 + (ch + 1) * 16 + j) * 512 + c];
                }
#pragma unroll
                for (int j = 0; j < 16; ++j) {
                    const int i = ch * 16 + j, t = t0 + i, q = 15 + j;
                    const float s2 = hist[q] + hist[q - 1];
                    const float s4 = s2 + hist[q - 2] + hist[q - 3];
                    const float s8 = s4 + (hist[q - 4] + hist[q - 5]) + (hist[q - 6] + hist[q - 7]);
                    const float s16 = s8 + ((hist[q - 8] + hist[q - 9]) + (hist[q - 10] + hist[q - 11])) + ((hist[q - 12] + hist[q - 13]) + (hist[q - 14] + hist[q - 15]));
                    const float s = gidx == 0 ? s2 : gidx == 1 ? s4 : gidx == 2 ? s8 : s16;
                    const float rc = __builtin_amdgcn_rcpf((float)min(t + 1, win));
                    *(bf16_t*)(lds + i * AROW + c * 2) = f2bf(s * rc - hist[q]);
                }
#pragma unroll
                for (int j = 0; j < 15; ++j) hist[j] = hist[16 + j];
            }
        } else {
#pragma unroll 1
            for (int bi = 0; bi < 4; ++bi) {
                const int bb = ((r0 - NPR) >> 2) + bi;
#pragma unroll
                for (int j = 0; j < 15; ++j) hist[j] = p.st_pool[((size_t)bb * 15 + j) * 512 + c];
#pragma unroll
                for (int j = 0; j < 4; ++j) hist[15 + j] = u[((size_t)NPR + bb * 4 + j) * 512 + c];
#pragma unroll
                for (int j = 0; j < 4; ++j) {
                    const int i = bi * 4 + j, q = 15 + j;
                    const float s2 = hist[q] + hist[q - 1];
                    const float s4 = s2 + hist[q - 2] + hist[q - 3];
                    const float s8 = s4 + (hist[q - 4] + hist[q - 5]) + (hist[q - 6] + hist[q - 7]);
                    const float s16 = s8 + ((hist[q - 8] + hist[q - 9]) + (hist[q - 10] + hist[q - 11])) + ((hist[q - 12] + hist[q - 13]) + (hist[q - 14] + hist[q - 15]));
                    const float s = gidx == 0 ? s2 : gidx == 1 ? s4 : gidx == 2 ? s8 : s16;
                    *(bf16_t*)(lds + i * AROW + c * 2) = f2bf(s * (1.0f / (float)win) - hist[q]);
                }
            }
        }
    }
    lds_barrier();
    {
        const int g = w >> 1, nh = w & 1;
        f32x4 acc[4][4] = {};
#pragma unroll
        for (int k = 0; k < 4; ++k) {
            bf16x8 af[4];
#pragma unroll
            for (int m = 0; m < 4; ++m) if (m < nm) af[m] = *(const bf16x8*)(lds + (m * 16 + fr) * AROW + (g * 128 + k * 32 + fq * 8) * 2);
#pragma unroll
            for (int m = 0; m < 4; ++m) if (m < nm) {
#pragma unroll
                for (int n = 0; n < 4; ++n) acc[m][n] = MFMA16(bw[k][n], af[m], acc[m][n]); }
        }
        bf16_t* yp = (bf16_t*)(p.ws + WS_YP);
#pragma unroll
        for (int m = 0; m < 4; ++m) if (m < nm)
#pragma unroll
            for (int n = 0; n < 4; ++n) {
                const int col = g * 128 + (nh * 4 + n) * 16 + fq * 4;
                const f32x4 scv = *(const f32x4*)(p.pool_scale + col);
                const f32x4 v = acc[m][n] * scv;
                u32x2 wv; wv.x = pk_bf16(v[0], v[1]); wv.y = pk_bf16(v[2], v[3]);
                *(u32x2*)(yp + (size_t)(r0 + m * 16 + fr) * 512 + col) = wv;
            }
    }
    lds_barrier();
}

__device__ __forceinline__ void poolout_item(const Params& p, int item) {
    const float* u = (const float*)(p.ws + WS_U);
    for (int e = threadIdx.x; e < 15 * 512; e += NTH) {
        const int jj = e >> 9, c = e & 511;
        if (item < 8) p.out[O_POOLP + (size_t)item * 7680 + e] = u[((size_t)item * SEQ + 2033 + jj) * 512 + c];
        else { const int bb = item - 8;
            p.out[O_POOLS + (size_t)bb * 7680 + e] = jj < 11 ? p.st_pool[((size_t)bb * 15 + jj + 4) * 512 + c] : u[((size_t)NPR + bb * 4 + (jj - 11)) * 512 + c]; }
    }
}

__device__ __forceinline__ void mout_item(const Params& p, int item, unsigned char* lds) {
    const int tid = otid(), lane = tid & 63, w = tid >> 6, fr = lane & 15, fq = lane >> 4;
    const int bh = item >> 5, c = item & 31, b = bh >> 2, hd = bh & 3;
    const size_t tok0 = (size_t)b * SEQ + c * 64;
    const bf16_t* qb = (const bf16_t*)(p.ws + WS_QKV);
    const bf16_t* kb = qb + (size_t)MROWS * DM; const bf16_t* vb = kb + (size_t)MROWS * DM; const bf16_t* ob = vb + (size_t)MROWS * DM;
    const float* gi = (const float*)(p.ws + WS_GI); const float* gf = (const float*)(p.ws + WS_GF);
    constexpr int QROW = 528, VROW = 144;
    unsigned char* Qs = lds;
    unsigned char* Ks = Qs + 64 * QROW;
    unsigned char* Vt = Ks + 64 * QROW;
    unsigned char* Sp = Vt + 256 * VROW;
    float* scal = (float*)(Sp + 64 * VROW);
    float* rt = scal, *ct = scal + 64, *wint = scal + 128, *emt = scal + 192, *rowsum = scal + 256  , *qn = scal + 384, *ssq = scal + 448  , *ncs = scal + 960  ;
    const float lf_pre = gf[(tok0 + lane) * 4 + hd], il_pre = gi[(tok0 + lane) * 4 + hd];
    const float mc_pre = ((const float*)(p.ws + WS_MST))[bh * 64 + c];
    bf16x8 cfr[8][2];
    if (c > 0) {
        const bf16_t* cs = (const bf16_t*)(p.ws + WS_CST) + ((size_t)bh * 31 + (c - 1)) * 65536;
#pragma unroll
        for (int k = 0; k < 8; ++k)
#pragma unroll
            for (int n = 0; n < 2; ++n) cfr[k][n] = __builtin_nontemporal_load((const bf16x8*)(cs + (size_t)(w * 32 + n * 16 + fr) * 256 + k * 32 + fq * 8));
    }
    u32x2 ogv[4][2]; f32x4 mnv[2];
#pragma unroll
    for (int n = 0; n < 2; ++n) { const int dvg = hd * 256 + w * 32 + n * 16 + fq * 4; mnv[n] = *(const f32x4*)(p.m_norm + dvg);
#pragma unroll
        for (int m = 0; m < 4; ++m) ogv[m][n] = *(const u32x2*)(ob + (tok0 + m * 16 + fr) * DM + dvg); }
    if (w == 0) {
        const float lf = lf_pre, il = il_pre;
        const float bs = wave_scan_add(lf, lane);
        const float mc = mc_pre;
        const float g = bs + mc, xx = il - bs;
        const float pm = wave_scan_max(xx, lane);
        const float mt = fmaxf(g, bs + pm);
        rt[lane] = bs - mt; ct[lane] = xx; wint[lane] = __expf(g - mt); emt[lane] = __expf(-mt);
    }
#pragma unroll
    for (int i = 0; i < 4; ++i) {
        const int pc = tid + NTH * i, row = pc >> 5, c8 = pc & 31;
        *(u32x4*)(Qs + row * QROW + c8 * 16) = *(const u32x4*)(qb + (tok0 + row) * DM + hd * 256 + c8 * 8);
        *(u32x4*)(Ks + row * QROW + c8 * 16) = *(const u32x4*)(kb + (tok0 + row) * DM + hd * 256 + c8 * 8);
    }
    {
        const bf16_t* vp = vb + (tok0 + lane) * DM + hd * 256 + w * 32;
        const int odd = lane & 1, scol = (lane & ~1) * 2;
#pragma unroll
        for (int i = 0; i < 4; ++i) {
            const u32x4 v = *(const u32x4*)(vp + i * 8);
            const unsigned uu[4] = {v.x, v.y, v.z, v.w};
#pragma unroll
            for (int e = 0; e < 4; ++e) {
                const int dv = w * 32 + i * 8 + e * 2;
                const unsigned P = uu[e], Q = (unsigned)__shfl_xor((int)P, 1);
                const unsigned W = odd ? ((Q >> 16) | (P & 0xffff0000u)) : ((P & 0xffffu) | (Q << 16));
                *(unsigned*)(Vt + (dv + odd) * VROW + scol) = W;
            }
        }
    }
    if (c > 0 && tid >= 256) ncs[tid - 256] = ((const float*)(p.ws + WS_NST))[((size_t)bh * 32 + c) * 256 + tid - 256];
    lds_barrier();
    {
        const int tt = w >> 1, sh = w & 1;
        f32x4 sa[2] = {};
#pragma unroll
        for (int k = 0; k < 8; ++k) {
            const bf16x8 qf = *(const bf16x8*)(Qs + (tt * 16 + fr) * QROW + (k * 32 + fq * 8) * 2);
#pragma unroll
            for (int s2 = 0; s2 < 2; ++s2) {
                const bf16x8 kf = *(const bf16x8*)(Ks + ((sh * 2 + s2) * 16 + fr) * QROW + (k * 32 + fq * 8) * 2);
                sa[s2] = MFMA16(kf, qf, sa[s2]);
            }
        }
        const int t = tt * 16 + fr;
        const float rtt = rt[t];
        float rs = 0.f;
#pragma unroll
        for (int s2 = 0; s2 < 2; ++s2) {
            const int s0 = (sh * 2 + s2) * 16 + fq * 4;
            float v[4];
#pragma unroll
            for (int jj = 0; jj < 4; ++jj) { const int s = s0 + jj; v[jj] = s <= t ? sa[s2][jj] * __expf(rtt + ct[s]) : 0.f; rs += v[jj]; }
            u32x2 wv; wv.x = pk_bf16(v[0], v[1]); wv.y = pk_bf16(v[2], v[3]);
            *(u32x2*)(Sp + t * VROW + s0 * 2) = wv;
        }
        rs += __shfl_xor(rs, 16); rs += __shfl_xor(rs, 32);
        if (fq == 0) rowsum[t * 2 + sh] = rs;
    }
    {
        const int t = tid >> 3, part = tid & 7;
        float a = 0.f;
        if (c > 0) {
            const float* nc = ncs + part * 32;
            const unsigned char* qp = Qs + t * QROW + part * 64;
#pragma unroll
            for (int i = 0; i < 4; ++i) {
                const u32x4 qv = *(const u32x4*)(qp + i * 16);
                const f32x4 n0 = *(const f32x4*)(nc + i * 8), n1 = *(const f32x4*)(nc + i * 8 + 4);
                a += bflo(qv.x) * n0[0] + bfhi(qv.x) * n0[1] + bflo(qv.y) * n0[2] + bfhi(qv.y) * n0[3] + bflo(qv.z) * n1[0] + bfhi(qv.z) * n1[1] + bflo(qv.w) * n1[2] + bfhi(qv.w) * n1[3];
            }
        }
        a += __shfl_xor(a, 1); a += __shfl_xor(a, 2); a += __shfl_xor(a, 4);
        if (part == 0) qn[t] = a;
    }
    lds_barrier();
    f32x4 acc[4][2] = {};
    if (c > 0) {
#pragma unroll
        for (int k = 0; k < 8; ++k) {
            bf16x8 qf[4];
#pragma unroll
            for (int m = 0; m < 4; ++m) qf[m] = *(const bf16x8*)(Qs + (m * 16 + fr) * QROW + (k * 32 + fq * 8) * 2);
#pragma unroll
            for (int m = 0; m < 4; ++m)
#pragma unroll
                for (int n = 0; n < 2; ++n) acc[m][n] = MFMA16(cfr[k][n], qf[m], acc[m][n]);
        }
#pragma unroll
        for (int m = 0; m < 4; ++m) { const float wi = wint[m * 16 + fr]; acc[m][0] *= wi; acc[m][1] *= wi; }
    }
#pragma unroll
    for (int k = 0; k < 2; ++k) {
        bf16x8 vfr[2], sf[4];
#pragma unroll
        for (int n = 0; n < 2; ++n) vfr[n] = *(const bf16x8*)(Vt + (w * 32 + n * 16 + fr) * VROW + (k * 32 + fq * 8) * 2);
#pragma unroll
        for (int m = 0; m < 4; ++m) sf[m] = *(const bf16x8*)(Sp + (m * 16 + fr) * VROW + (k * 32 + fq * 8) * 2);
#pragma unroll
        for (int m = 0; m < 4; ++m)
#pragma unroll
            for (int n = 0; n < 2; ++n) acc[m][n] = MFMA16(vfr[n], sf[m], acc[m][n]);
    }
#pragma unroll
    for (int m = 0; m < 4; ++m) {
        const int t = m * 16 + fr;
        const float den = wint[t] * qn[t] + rowsum[t * 2] + rowsum[t * 2 + 1];
        const float dinv = 1.0f / fmaxf(fabsf(den), emt[t]);
        acc[m][0] *= dinv; acc[m][1] *= dinv;
        float q2 = 0.f;
#pragma unroll
        for (int n = 0; n < 2; ++n)
#pragma unroll
            for (int jj = 0; jj < 4; ++jj) q2 += acc[m][n][jj] * acc[m][n][jj];
        q2 += __shfl_xor(q2, 16); q2 += __shfl_xor(q2, 32);
        if (fq == 0) ssq[t * 8 + w] = q2;
    }
    lds_barrier();
#pragma unroll
    for (int m = 0; m < 4; ++m) {
        const int t = m * 16 + fr;
        float tot = 0.f;
#pragma unroll
        for (int ww = 0; ww < 8; ++ww) tot += ssq[t * 8 + ww];
        const float rstd = rsqrtf(tot * (1.0f / 256.f) + EPS);
#pragma unroll
        for (int n = 0; n < 2; ++n) {
            const int dvg = hd * 256 + w * 32 + n * 16 + fq * 4;
            const size_t oidx = (tok0 + t) * DM + dvg;
            const u32x2 og = ogv[m][n];
            const f32x4 v = acc[m][n] * rstd * mnv[n];
            u32x2 wv; wv.x = pk_bf16(v[0] * bflo(og.x), v[1] * bfhi(og.x)); wv.y = pk_bf16(v[2] * bflo(og.y), v[3] * bfhi(og.y));
            *(u32x2*)((bf16_t*)(p.ws + WS_HM) + oidx) = wv;
        }
    }
    lds_barrier();
}

__device__ __forceinline__ void grid_barrier(unsigned* bar, unsigned k) {
    asm volatile("s_waitcnt vmcnt(0)" ::: "memory");
    __syncthreads();
    if (threadIdx.x == 0) {
        const unsigned g = blockIdx.x & 7u, gsz = (gridDim.x + 7u - g) >> 3;
        __builtin_amdgcn_fence(__ATOMIC_RELEASE, "agent");
        asm volatile("s_waitcnt vmcnt(0)" ::: "memory");
        unsigned* sub = bar + 64u * (1u + g);
        const unsigned prev = __hip_atomic_fetch_add(sub, 1u, __ATOMIC_RELAXED, __HIP_MEMORY_SCOPE_AGENT);
        if (prev + 1u == k * gsz) __hip_atomic_fetch_add(bar, 1u, __ATOMIC_RELAXED, __HIP_MEMORY_SCOPE_AGENT);
        const unsigned ngroups = gridDim.x < 8u ? gridDim.x : 8u;
        unsigned spins = 0;
        while (__hip_atomic_load(bar, __ATOMIC_RELAXED, __HIP_MEMORY_SCOPE_AGENT) < k * ngroups) { __builtin_amdgcn_s_sleep(1); if (++spins > (1u << 24)) break; }
        __builtin_amdgcn_fence(__ATOMIC_ACQUIRE, "agent");
        asm volatile("s_waitcnt vmcnt(0)" ::: "memory");
    }
    __syncthreads();
}

__global__ void __launch_bounds__(NTH) hybrid_fwd(Params p) {
    extern __shared__ __attribute__((aligned(16))) unsigned char lds[];
    cg::grid_group grid = cg::this_grid();
    const int lo = p.ph_lo, hi = p.ph_hi;
#ifndef PHMASK
#define PHMASK 0x7ff
#endif
#define IN(k) (((PHMASK >> (k)) & 1) && lo <= (k) && (k) < hi)
#define SEAMN(n) do { grid_barrier((unsigned*)(p.ws + WS_CTR) + 64, (unsigned)(n)); } while (0)
    if (lo < 0) grid.sync();
    LAS unsigned char* ldsl = (LAS unsigned char*)lds;
    unsigned char* ws = p.ws;
    if (IN(0)) phase0(p, (float*)lds);
    SEAMN(1);
    if (IN(1)) {
        for (int it = blockIdx.x; it < 256; it += gridDim.x) { ada_final_slice(p, it); norm_item(p, it, 0, (float*)lds); }
    }
    SEAMN(2);
    if (IN(2)) { EpiG1 e{(float*)(ws + WS_U), (bf16_t*)(ws + WS_QKV)};
        gemm_phase(ldsl, (const bf16_t*)(ws + WS_H), (const bf16_t*)(ws + WS_WIN), NIN, DM, e, nullptr, MROWS); }
    SEAMN(3);
    if (IN(3)) {
        if (blockIdx.x < 128) { const int x = blockIdx.x & 7, r = blockIdx.x >> 3;
            scan_item(p, ((x + 8 * (r >> 2)) << 2) | (r & 3), lds); }
        {
            unsigned* ctr = (unsigned*)(ws + WS_CTR);
            volatile unsigned* slot = (volatile unsigned*)(lds + LDS_BYTES - 16);
            for (;;) {
                if (threadIdx.x == 0) *slot = atomicAdd(ctr, 1u);
                __syncthreads();
                const int it = (int)*slot;
                __syncthreads();
                if (it >= 512 + 288 + NBATCH) break;
                if (it < 512) sample_item(p, it, lds);
                else if (it < 800) pool_item(p, it - 512, lds);
                else poolout_item(p, it - 800);
            }
        }
    }
    SEAMN(4);
    if (IN(4)) { for (int it = blockIdx.x; it < 1024; it += gridDim.x) mout_item(p, it, lds); }
    if (IN(5)) {

        bf16_t* merged = (bf16_t*)(ws + WS_U);
        const bf16_t* sga = (const bf16_t*)(ws + WS_QKV) + (size_t)4 * MROWS * DM;
        const bf16_t* sgb = sga + (size_t)MROWS * DM;
        { EpiMerge e0{merged, sga, 0}; gemm_phase(ldsl, (const bf16_t*)(ws + WS_YP), (const bf16_t*)(ws + WS_WPO), DM, 512, e0);
          small_gemm_phase(lds, (const bf16_t*)(ws + WS_YP), (const bf16_t*)(ws + WS_WPO), DM, 512, e0, blockIdx.x, blockIdx.x + 1); }
        SEAMN(5);
        { EpiMerge e1{merged, sgb, 1}; gemm_phase(ldsl, (const bf16_t*)(ws + WS_HM), (const bf16_t*)(ws + WS_WMO), DM, DM, e1);
          small_gemm_phase(lds, (const bf16_t*)(ws + WS_HM), (const bf16_t*)(ws + WS_WMO), DM, DM, e1, blockIdx.x, blockIdx.x + 1); }
    }
    SEAMN(6);
    if (IN(6)) {
        EpiMid e{p.out, p.x_p, p.x_s, (const float*)(ws + WS_ADA), p.g_ffn, (bf16_t*)(ws + WS_H), (float*)(ws + WS_RSB), (unsigned*)(ws + WS_XCNT), (float*)(ws + WS_RSS), (unsigned*)(ws + WS_XCNT) + 64 * 64};
        gemm_phase<EpiMid, true>(ldsl, (const bf16_t*)(ws + WS_U), (const bf16_t*)(ws + WS_WOUT), DM, DM, e, lds);
        small_gemm_phase<EpiMid, 2>(lds, (const bf16_t*)(ws + WS_U), (const bf16_t*)(ws + WS_WOUT), DM, DM, e, blockIdx.x, blockIdx.x + 1);
    }
    SEAMN(7);
    if (IN(8)) { EpiAct e{(bf16_t*)(ws + WS_CST)};
        gemm_phase(ldsl, (const bf16_t*)(ws + WS_H), (const bf16_t*)(ws + WS_W1), DFF, DM, e, nullptr, MROWS); }
    SEAMN(8);
    if (IN(9)) {
        EpiFinal e{p.out, (const float*)(ws + WS_ADA), p.g_final, (float*)(ws + WS_RSB), (unsigned*)(ws + WS_XCNT), (float*)(ws + WS_RSS), (unsigned*)(ws + WS_XCNT) + 64 * 64};
        gemm_phase<EpiFinal, true>(ldsl, (const bf16_t*)(ws + WS_CST), (const bf16_t*)(ws + WS_W2), DM, DFF, e, lds);
        small_gemm_phase<EpiFinal, 1>(lds, (const bf16_t*)(ws + WS_CST), (const bf16_t*)(ws + WS_W2), DM, DFF, e, blockIdx.x, blockIdx.x + 1);
    }
#undef IN
#undef SEAMN
}

extern "C" void kernel_launch(void* const* d_in, const int* in_sizes, int n_in, void* d_out, int out_size, void* d_ws, size_t ws_size, hipStream_t stream) {
    static int grid_blocks = 0;
    if (grid_blocks == 0) {
        if (ws_size < WS_END) { fprintf(stderr, "kernel_launch: workspace too small: %zu < %zu\n", ws_size, (size_t)WS_END); grid_blocks = -1; return; }
        int dev = 0, cus = 0, per_cu = 0;
        hipGetDevice(&dev);
        hipDeviceGetAttribute(&cus, hipDeviceAttributeMultiprocessorCount, dev);
        hipFuncSetAttribute((const void*)hybrid_fwd, hipFuncAttributeMaxDynamicSharedMemorySize, LDS_BYTES);
        hipOccupancyMaxActiveBlocksPerMultiprocessor(&per_cu, (const void*)hybrid_fwd, NTH, LDS_BYTES);
        if (per_cu < 1) per_cu = 1;
        if (per_cu > 1) per_cu = 1;
        grid_blocks = cus * per_cu;
    }
    if (grid_blocks < 0) return;
    hipMemsetAsync((char*)d_ws + WS_CTR, 0, 4096 + 80 * 256, stream);
    Params p{};
    const float** f = (const float**)&p;
    for (int i = 0; i < 24; ++i) f[i] = (const float*)d_in[i];
    p.out = (float*)d_out; p.ws = (unsigned char*)d_ws; p.ph_lo = 0; p.ph_hi = 11;
    void* args[] = {&p};
    hipError_t e = hipLaunchCooperativeKernel((const void*)hybrid_fwd, dim3(grid_blocks), dim3(NTH), args, LDS_BYTES, stream);
    if (e != hipSuccess) fprintf(stderr, "cooperative launch failed: %s (grid %d)\n", hipGetErrorString(e), grid_blocks);
}
```
